# Optimizing an MI355X kernel written in HIP

```python
import jax, jax.numpy as jnp
from jax import lax
import numpy as np

D_MODEL = 1024
BATCH = 16
SEQ = 2048
DEPTH = 4

N_A_LAYERS = DEPTH // 2
N_B_LAYERS = DEPTH - N_A_LAYERS
D_FF = 4 * D_MODEL
NORM_EPS = 1e-6
CHUNK = 128
SGU_WIDTH = D_MODEL
SGU_GROUPS = 8
SGU_GROUP_DIM = SGU_WIDTH // SGU_GROUPS
N_HEADS = 16
N_KV_HEADS = 4
HEADS_PER_GROUP = N_HEADS // N_KV_HEADS
HEAD_DIM = D_MODEL // N_HEADS
CMP_BLOCK = 32
CMP_STRIDE = 16
CMP_HIDDEN = 4 * HEAD_DIM
SEL_BLOCK = 64
N_SELECT = 16
WINDOW = 512
Q_BLOCK = 16
N_BRANCH = 3
FORCE_SCORE = 1e4

kernel_name = 'yoco_gmlp_nsa_hybrid'


def rms_norm(x, g):
    xf = x.astype(jnp.float32)
    y = xf * lax.rsqrt(jnp.mean(xf * xf, axis=-1, keepdims=True) + NORM_EPS)
    return (y * g.astype(jnp.float32)).astype(x.dtype)


def layer_norm(x, g, b):
    xf = x.astype(jnp.float32)
    mu = jnp.mean(xf, axis=-1, keepdims=True)
    var = jnp.mean(jnp.square(xf - mu), axis=-1, keepdims=True)
    y = (xf - mu) * lax.rsqrt(var + NORM_EPS) * g.astype(jnp.float32) + b.astype(jnp.float32)
    return y.astype(x.dtype)


def modulate(h, shift, scale):
    return h * (1.0 + scale[:, None, :]) + shift[:, None, :]


def masked_softmax(s, mask):
    s = jnp.where(mask, s.astype(jnp.float32), -jnp.inf)
    m = jnp.max(s, axis=-1, keepdims=True)
    m = jnp.where(jnp.isfinite(m), m, 0.0)
    e = jnp.exp(s - m)
    den = jnp.sum(e, axis=-1, keepdims=True)
    return e / jnp.where(den > 0, den, 1.0)


def gmlp_mixer(h, w_in, ln_g, ln_b, w_s, b_s, w_out):
    B, T, _ = h.shape
    z = jax.nn.gelu(h @ w_in)
    u, v = jnp.split(z, 2, axis=-1)
    v = layer_norm(v, ln_g, ln_b)
    v = v.reshape(B, T // CHUNK, CHUNK, SGU_GROUPS, SGU_GROUP_DIM)
    causal = jnp.tril(jnp.ones((CHUNK, CHUNK), dtype=bool))
    w = jnp.where(causal[None], w_s, 0.0).astype(v.dtype)
    mixed = jnp.einsum('gts,bcsgd->bctgd', w, v) + b_s.T[:, :, None]
    out = u * mixed.reshape(B, T, SGU_WIDTH)
    return out @ w_out


def nsa_shared_kv(x, c_act, ada_w, ada_b, norm_g, w_kv, cmp_pos, cmp_w1, cmp_b1, cmp_w2, cmp_b2):
    B, T, _ = x.shape
    shift, scale = jnp.split(c_act @ ada_w + ada_b, 2, axis=-1)
    h = modulate(rms_norm(x, norm_g), shift, scale)
    kv = (h @ w_kv).reshape(B, T, 2 * N_BRANCH, N_KV_HEADS, HEAD_DIM)
    k_cmp_raw, v_cmp_raw = kv[:, :, 0], kv[:, :, 1]
    k_sel, v_sel = kv[:, :, 2], kv[:, :, 3]
    k_win, v_win = kv[:, :, 4], kv[:, :, 5]
    n_cmp = (T - CMP_BLOCK) // CMP_STRIDE + 1
    tok = jnp.arange(n_cmp)[:, None] * CMP_STRIDE + jnp.arange(CMP_BLOCK)[None, :]

    def compress(raw, j):
        blk = raw[:, tok] + cmp_pos[j][None, None, :, None, :]
        blk = blk.transpose(0, 1, 3, 2, 4).reshape(B, n_cmp, N_KV_HEADS, CMP_BLOCK * HEAD_DIM)
        hid = jax.nn.gelu(blk @ cmp_w1[j] + cmp_b1[j])
        return hid @ cmp_w2[j] + cmp_b2[j]

    n_sel = T // SEL_BLOCK

    def to_blocks(a):
        return a.reshape(B, n_sel, SEL_BLOCK, N_KV_HEADS, HEAD_DIM).transpose(0, 3, 1, 2, 4)

    pad = ((0, 0), (WINDOW, 0), (0, 0), (0, 0))
    return (compress(k_cmp_raw, 0), compress(v_cmp_raw, 1), to_blocks(k_sel), to_blocks(v_sel),
            jnp.pad(k_win, pad), jnp.pad(v_win, pad))


def nsa_mixer(h, w_in, w_out, k_cmp, v_cmp, k_sel, v_sel, k_win, v_win):
    B, T, _ = h.shape
    HD = N_HEADS * HEAD_DIM
    proj = h @ w_in
    q = proj[..., :HD].reshape(B, T, N_KV_HEADS, HEADS_PER_GROUP, HEAD_DIM) * (HEAD_DIM ** -0.5)
    gates = jax.nn.sigmoid(proj[..., HD:].astype(jnp.float32)).reshape(
        B, T, N_KV_HEADS, HEADS_PER_GROUP, N_BRANCH)
    pos = jnp.arange(T)

    n_cmp = k_cmp.shape[1]
    cmp_end = jnp.arange(n_cmp) * CMP_STRIDE + CMP_BLOCK - 1
    s_cmp = jnp.einsum('btghd,bcgd->bghtc', q, k_cmp)
    p_cmp = masked_softmax(s_cmp, cmp_end[None, :] <= pos[:, None])
    o_cmp = jnp.einsum('bghtc,bcgd->btghd', p_cmp.astype(v_cmp.dtype), v_cmp)

    n_blocks = k_sel.shape[2]
    ci = jnp.arange(n_cmp)[:, None] * CMP_STRIDE
    sj = jnp.arange(n_blocks)[None, :] * SEL_BLOCK
    overlap = ((ci < sj + SEL_BLOCK) & (ci + CMP_BLOCK > sj)).astype(jnp.float32)
    imp = jnp.einsum('bghtc,cj->bgtj', p_cmp, overlap)
    cur = (pos // SEL_BLOCK)[:, None]
    js = jnp.arange(n_blocks)[None, :]
    imp = jnp.where(js > cur, -1.0, imp)
    forced = (js == 0) | (js == cur) | (js == cur - 1)
    imp = jnp.where(forced, FORCE_SCORE, imp)
    n_top = min(N_SELECT, n_blocks)
    _, sel_idx = lax.top_k(imp, n_top)

    bi = jnp.arange(B)[:, None, None, None]
    gi = jnp.arange(N_KV_HEADS)[None, :, None, None]
    in_blk = jnp.arange(SEL_BLOCK)
    win_off = jnp.arange(WINDOW + Q_BLOCK)

    def block_step(start):
        tq = start + jnp.arange(Q_BLOCK)
        qb = lax.dynamic_slice_in_dim(q, start, Q_BLOCK, axis=1)
        gb = lax.dynamic_slice_in_dim(gates, start, Q_BLOCK, axis=1)
        ocb = lax.dynamic_slice_in_dim(o_cmp, start, Q_BLOCK, axis=1)
        ib = lax.dynamic_slice_in_dim(sel_idx, start, Q_BLOCK, axis=2)
        ks = k_sel[bi, gi, ib].reshape(B, N_KV_HEADS, Q_BLOCK, n_top * SEL_BLOCK, HEAD_DIM)
        vs = v_sel[bi, gi, ib].reshape(B, N_KV_HEADS, Q_BLOCK, n_top * SEL_BLOCK, HEAD_DIM)
        kpos = (ib[..., None] * SEL_BLOCK + in_blk).reshape(B, N_KV_HEADS, 1, Q_BLOCK, n_top * SEL_BLOCK)
        s_sel = jnp.einsum('bqghd,bgqmd->bghqm', qb, ks)
        p_sel = masked_softmax(s_sel, kpos <= tq[None, None, None, :, None])
        o_sel = jnp.einsum('bghqm,bgqmd->bqghd', p_sel.astype(vs.dtype), vs)
        kw = lax.dynamic_slice_in_dim(k_win, start, WINDOW + Q_BLOCK, axis=1)
        vw = lax.dynamic_slice_in_dim(v_win, start, WINDOW + Q_BLOCK, axis=1)
        kpos_w = start - WINDOW + win_off
        dist = tq[:, None] - kpos_w[None, :]
        mask_w = (dist >= 0) & (dist < WINDOW) & (kpos_w[None, :] >= 0)
        s_w = jnp.einsum('bqghd,bkgd->bghqk', qb, kw)
        p_w = masked_softmax(s_w, mask_w)
        o_win = jnp.einsum('bghqk,bkgd->bqghd', p_w.astype(vw.dtype), vw)
        o = gb[..., 0:1] * ocb + gb[..., 1:2] * o_sel + gb[..., 2:3] * o_win
        return o.reshape(B, Q_BLOCK, HD).astype(h.dtype)

    starts = jnp.arange(T // Q_BLOCK) * Q_BLOCK
    o = lax.map(block_step, starts)
    o = o.transpose(1, 0, 2, 3).reshape(B, T, HD)
    return o @ w_out


def setup_inputs(seed: int = 0) -> dict:
    key = jax.random.key(seed)
    ks = jax.random.split(key, 32)
    f32 = jnp.float32
    D = D_MODEL
    n = lambda k, shape, s: jax.random.normal(k, shape, f32) * s
    HD = N_HEADS * HEAD_DIM
    return {
        'x': n(ks[0], (BATCH, SEQ, D), 1.0),
        'c': n(ks[1], (BATCH, D), 1.0),
        'ada_w': n(ks[2], (DEPTH, D, 6 * D), D ** -0.5),
        'ada_b': n(ks[3], (DEPTH, 6 * D), 0.05),
        'norm_g': 1.0 + n(ks[4], (DEPTH, 4, D), 0.1),
        'a_w_in': n(ks[5], (N_A_LAYERS, D, 2 * SGU_WIDTH), D ** -0.5),
        'a_ln_g': 1.0 + n(ks[6], (N_A_LAYERS, SGU_WIDTH), 0.1),
        'a_ln_b': n(ks[7], (N_A_LAYERS, SGU_WIDTH), 0.05),
        'a_w_s': n(ks[8], (N_A_LAYERS, SGU_GROUPS, CHUNK, CHUNK), CHUNK ** -0.5),
        'a_b_s': 1.0 + n(ks[9], (N_A_LAYERS, SGU_GROUPS, CHUNK), 0.1),
        'a_w_out': n(ks[10], (N_A_LAYERS, SGU_WIDTH, D), SGU_WIDTH ** -0.5),
        'kv_ada_w': n(ks[11], (D, 2 * D), D ** -0.5),
        'kv_ada_b': n(ks[12], (2 * D,), 0.05),
        'kv_norm_g': 1.0 + n(ks[13], (D,), 0.1),
        'kv_w': n(ks[14], (D, 2 * N_BRANCH * N_KV_HEADS * HEAD_DIM), D ** -0.5),
        'cmp_pos': n(ks[15], (2, CMP_BLOCK, HEAD_DIM), 0.5),
        'cmp_w1': n(ks[16], (2, CMP_BLOCK * HEAD_DIM, CMP_HIDDEN), (CMP_BLOCK * HEAD_DIM) ** -0.5),
        'cmp_b1': n(ks[17], (2, CMP_HIDDEN), 0.05),
        'cmp_w2': n(ks[18], (2, CMP_HIDDEN, HEAD_DIM), CMP_HIDDEN ** -0.5),
        'cmp_b2': n(ks[19], (2, HEAD_DIM), 0.05),
        'b_w_in': n(ks[20], (N_B_LAYERS, D, HD + N_BRANCH * N_HEADS), D ** -0.5),
        'b_w_out': n(ks[21], (N_B_LAYERS, HD, D), HD ** -0.5),
        'ff_w_in': n(ks[22], (DEPTH, D, D_FF), D ** -0.5),
        'ff_w_out': n(ks[23], (DEPTH, D_FF, D), D_FF ** -0.5),
    }


def reference(x, c, ada_w, ada_b, norm_g, a_w_in, a_ln_g, a_ln_b, a_w_s, a_b_s, a_w_out,
              kv_ada_w, kv_ada_b, kv_norm_g, kv_w, cmp_pos, cmp_w1, cmp_b1, cmp_w2, cmp_b2,
              b_w_in, b_w_out, ff_w_in, ff_w_out):
    c_act = jax.nn.silu(c)
    shared = None
    for layer in range(DEPTH):
        mod = c_act @ ada_w[layer] + ada_b[layer]
        sh1, sc1, g1, sh2, sc2, g2 = jnp.split(mod, 6, axis=-1)
        h = modulate(rms_norm(x, norm_g[layer, 0]), sh1, sc1)
        if layer < N_A_LAYERS:
            y = gmlp_mixer(h, a_w_in[layer], a_ln_g[layer], a_ln_b[layer], a_w_s[layer],
                           a_b_s[layer], a_w_out[layer])
        else:
            if layer == N_A_LAYERS:
                shared = nsa_shared_kv(x, c_act, kv_ada_w, kv_ada_b, kv_norm_g, kv_w,
                                       cmp_pos, cmp_w1, cmp_b1, cmp_w2, cmp_b2)
            j = layer - N_A_LAYERS
            y = nsa_mixer(h, b_w_in[j], b_w_out[j], *shared)
        x = x + g1[:, None, :] * rms_norm(y, norm_g[layer, 1])
        h = modulate(rms_norm(x, norm_g[layer, 2]), sh2, sc2)
        y = jnp.square(jax.nn.relu(h @ ff_w_in[layer])) @ ff_w_out[layer]
        x = x + g2[:, None, :] * rms_norm(y, norm_g[layer, 3])
    return x
```

```cpp
#include <hip/hip_runtime.h>
#include <cstdio>
#include <cstdint>
#include <cmath>
#define MK_MULTI 0
namespace pg8 {
#define PG8_LAS __attribute__((address_space(3)))
typedef unsigned short bf16_t;
typedef short bf16x8 __attribute__((ext_vector_type(8)));
typedef float f32x4 __attribute__((ext_vector_type(4)));
typedef unsigned u32x4 __attribute__((ext_vector_type(4)));
constexpr int BM = 256, BK = 64, HALF = 128, HTB = HALF * BK * 2  , STAGE_BYTES = 8 * HTB, NXCD = 8, WGM = 8;

__host__ __device__ __forceinline__ int lds_byte(int r, int c) { const int st = (r >> 4) * 2 + (c >> 5), rr = r & 15, cc = c & 31, ob = rr * 64 + cc * 2; return st * 1024 + (ob ^ (((ob >> 9) & 1) << 5)); }
__host__ __device__ __forceinline__ void stage_rc(int b, int& R, int& C) { const int st = b / 1024, sb = b % 1024, swz = sb ^ (((sb >> 9) & 1) << 5); R = (st >> 1) * 16 + swz / 64; C = (st & 1) * 32 + (swz % 64) / 2; }
__host__ __device__ __forceinline__ int perm32(int rho) { const int n = rho >> 4, i = rho & 15; return 8 * (i >> 2) + 4 * n + (i & 3); }

struct Unit { int pm, pn; };
struct Gemm { const bf16_t* A; const bf16_t* Bt; int M, N, K; unsigned a_rs; size_t a_hstep, a_kstep, a_t1, a_t0; int a_sh; };
__device__ __forceinline__ Gemm make_gemm(const bf16_t* A, const bf16_t* Bt, int M, int N, int K) {
    Gemm g; g.A = A; g.Bt = Bt; g.M = M; g.N = N; g.K = K; g.a_rs = (unsigned)K * 2u; g.a_hstep = (size_t)HALF * K * 2; g.a_kstep = BK * 2; g.a_t1 = (size_t)BM * K * 2; g.a_t0 = 0; g.a_sh = 0; return g; }

struct StaticOrder {
    int nM, nN, nwg, G, c;
    __host__ __device__ void init(int M, int N, int G_, int c_) { nM = M / BM; nN = N / BM; nwg = nM * nN; G = G_; c = c_; }
    __host__ __device__ bool next(int i, Unit& u) const {
        const long L = (long)i * G + c; if (L >= nwg) return false;
        int wgid = (int)L; { const int q = nwg / NXCD, r = nwg % NXCD, xcd = wgid % NXCD, off = wgid / NXCD; wgid = (xcd < r ? xcd * (q + 1) : r * (q + 1) + (xcd - r) * q) + off; }
        const int nig = WGM * nN, gid = wgid / nig, fm = gid * WGM, gsz = (nM - fm) < WGM ? (nM - fm) : WGM;
        u.pm = fm + ((wgid % nig) % gsz); u.pn = (wgid % nig) / gsz; return true;
    }
    __device__ __forceinline__ void a_ready(const Unit&) const {}
    __device__ __forceinline__ void done(const Unit&) const {}
};

__device__ __forceinline__ unsigned cvt_pk_bf16(float lo, float hi) { unsigned r; asm volatile("v_cvt_pk_bf16_f32 %0, %1, %2" : "=v"(r) : "v"(lo), "v"(hi)); return r; }
__device__ __forceinline__ float gelu_tanh(float v) {
    const float u = v * (0.7978845608028654f + 0.035677408136300125f * v * v);
    const float e = __builtin_amdgcn_exp2f(u * -2.8853900817779268f);
    return v * __builtin_amdgcn_rcpf(1.0f + e);
}
template <int ACT> __device__ __forceinline__ float act_fn(float v) {
    if (ACT == 2) return gelu_tanh(v);
    if (ACT == 3) { const float r = v > 0.f ? v : 0.f; return r * r; }
    return v;
}

template <int ACT  > struct EpiBf16 {
    static constexpr bool PERM = true, AFTER_DRAIN = false;
    bf16_t* O; int ldc; const float* bias; int split_cols; size_t split_stride; float scale0;
    __device__ __forceinline__ void operator()(const f32x4 (&acc)[2][2][4][2], const Unit& u, int wr, int wc, int fr, int fq) const {
        const int row0 = u.pm * BM + wr * 64 + fr; int colt = u.pn * BM; bf16_t* base = O;
        float sc = 1.f; if (split_cols) { const int t = colt / split_cols; base += (size_t)t * split_stride; colt -= t * split_cols; if (t == 0) sc = scale0; }
        const int col0 = colt + wc * 32 + 8 * fq, bcol0 = u.pn * BM + wc * 32 + 8 * fq;
        f32x4 bv[2][2];
#pragma unroll
        for (int bj = 0; bj < 2; ++bj)
#pragma unroll
            for (int n = 0; n < 2; ++n) bv[bj][n] = bias ? *(const f32x4*)(bias + bcol0 + bj * HALF + 4 * n) : (f32x4){0.f, 0.f, 0.f, 0.f};
#pragma unroll
        for (int ai = 0; ai < 2; ++ai)
#pragma unroll
            for (int m = 0; m < 4; ++m) { bf16_t* rowp = base + (size_t)(row0 + ai * HALF + m * 16) * ldc + col0;
#pragma unroll
                for (int bj = 0; bj < 2; ++bj) { f32x4 v0 = acc[ai][bj][m][0] + bv[bj][0], v1 = acc[ai][bj][m][1] + bv[bj][1];
                    if (ACT != 0) {
#pragma unroll
                        for (int e = 0; e < 4; ++e) { v0[e] = act_fn<ACT>(v0[e]); v1[e] = act_fn<ACT>(v1[e]); } }
                    v0 = v0 * sc; v1 = v1 * sc; u32x4 w; w.x = cvt_pk_bf16(v0[0], v0[1]); w.y = cvt_pk_bf16(v0[2], v0[3]); w.z = cvt_pk_bf16(v1[0], v1[1]); w.w = cvt_pk_bf16(v1[2], v1[3]);
                    *(u32x4*)(rowp + bj * HALF) = w; } }
    }
};
struct EpiQG {
    static constexpr bool PERM = true, AFTER_DRAIN = false;
    bf16_t* Q; float* G; float qscale;
    __device__ __forceinline__ void operator()(const f32x4 (&acc)[2][2][4][2], const Unit& u, int wr, int wc, int fr, int fq) const {
        const int row0 = u.pm * BM + wr * 64 + fr;
        if (u.pn < 4) {
            const int col0 = u.pn * BM + wc * 32 + 8 * fq;
#pragma unroll
            for (int ai = 0; ai < 2; ++ai)
#pragma unroll
                for (int m = 0; m < 4; ++m) { bf16_t* rowp = Q + (size_t)(row0 + ai * HALF + m * 16) * 1024 + col0;
#pragma unroll
                    for (int bj = 0; bj < 2; ++bj) { const f32x4 v0 = acc[ai][bj][m][0] * qscale, v1 = acc[ai][bj][m][1] * qscale;
                        u32x4 w; w.x = cvt_pk_bf16(v0[0], v0[1]); w.y = cvt_pk_bf16(v0[2], v0[3]); w.z = cvt_pk_bf16(v1[0], v1[1]); w.w = cvt_pk_bf16(v1[2], v1[3]);
                        *(u32x4*)(rowp + bj * HALF) = w; } }
        } else if (wc < 2) {
#pragma unroll
            for (int ai = 0; ai < 2; ++ai)
#pragma unroll
                for (int m = 0; m < 4; ++m) { float* rowp = G + (size_t)(row0 + ai * HALF + m * 16) * 48;
#pragma unroll
                    for (int n = 0; n < 2; ++n) { const int col = wc * 32 + 8 * fq + 4 * n;
                        if (col < 48) { f32x4 v = acc[ai][0][m][n];
#pragma unroll
                            for (int e = 0; e < 4; ++e) v[e] = __builtin_amdgcn_rcpf(1.0f + __builtin_amdgcn_exp2f(v[e] * -1.4426950408889634f));
                            *(f32x4*)(rowp + col) = v; } } }
        }
    }
};

template <class Epi, class Sched, bool ALIGN_EPI = false, bool SP2 = false>
__device__ __forceinline__ void gemm_phase(PG8_LAS unsigned char* lds, const Gemm g, const Sched& S, const Epi& E) {
    int tid_ = threadIdx.x; asm volatile("" : "+v"(tid_));
    const int tid = tid_, wid = __builtin_amdgcn_readfirstlane(tid >> 6), lane = tid & 63, wr = wid >> 2, wc = wid & 3, fr = lane & 15, fq = lane >> 4;
    const int K = g.K, nt = K / BK;
    unsigned voffA[2], voffB[2];
#pragma unroll
    for (int i = 0; i < 2; ++i) { int R, C; stage_rc(tid * 16 + i * 8192, R, C); const int Rb = Epi::PERM ? ((R & ~31) + perm32(R & 31)) : R;
        voffA[i] = (unsigned)R * g.a_rs + (unsigned)C * 2u; voffB[i] = (unsigned)(Rb * K + C) * 2u; }
    const size_t kstepA = g.a_kstep, kstepB = (size_t)(BK * 2);
    const size_t hstepA = g.a_hstep, hstepB = (size_t)HALF * K * 2;
    const size_t tstepB = 2 * hstepB;
    const int a_msk = (1 << g.a_sh) - 1;
#define PG8_ATILE(pm) ((const char*)g.A + (size_t)((pm) >> g.a_sh) * g.a_t1 + (size_t)((pm) & a_msk) * g.a_t0)
    const unsigned ldsw = (unsigned)wid * 1024u;
    const int aoff = lds_byte(wr * 64 + fr, fq * 8), boff = lds_byte(wc * 32 + fr, fq * 8);
#define PG8_SA(b, h) (((b) * 2 + (h)) * HTB)
#define PG8_SB(b, h) ((4 + (b) * 2 + (h)) * HTB)
#define PG8_STAGE(bufoff, gbase, voff) do { _Pragma("unroll") for (int _i = 0; _i < 2; ++_i) \
        __builtin_amdgcn_global_load_lds((const unsigned*)((const char*)(gbase) + (voff)[_i]), (PG8_LAS unsigned*)(lds + (bufoff) + ldsw + _i * 8192), 16, 0, 0); } while (0)
#define PG8_LDA(dst, b, h) do { _Pragma("unroll") for (int m = 0; m < 4; ++m) _Pragma("unroll") for (int k = 0; k < 2; ++k) dst[m][k] = *(const PG8_LAS bf16x8*)(lds + PG8_SA(b, h) + aoff + m * 2048 + k * 1024); } while (0)
#define PG8_LDB(dst, b, h) do { _Pragma("unroll") for (int n = 0; n < 2; ++n) _Pragma("unroll") for (int k = 0; k < 2; ++k) dst[n][k] = *(const PG8_LAS bf16x8*)(lds + PG8_SB(b, h) + boff + n * 2048 + k * 1024); } while (0)
#define PG8_MMA(ai, bj, At, Bt) do { __builtin_amdgcn_s_setprio(1); _Pragma("unroll") for (int m = 0; m < 4; ++m) _Pragma("unroll") for (int n = 0; n < 2; ++n) _Pragma("unroll") for (int k = 0; k < 2; ++k) \
        acc[ai][bj][m][n] = __builtin_amdgcn_mfma_f32_16x16x32_bf16(Bt[n][k], At[m][k], acc[ai][bj][m][n], 0, 0, 0); __builtin_amdgcn_s_setprio(0); } while (0)
#define PG8_WAIT_V(n) asm volatile("s_waitcnt vmcnt(" #n ")" ::: "memory")
#define PG8_WAIT_L(n) asm volatile("s_waitcnt lgkmcnt(" #n ")" ::: "memory")
#define PG8_BAR __builtin_amdgcn_s_barrier()
#define PG8_SCHED __builtin_amdgcn_sched_barrier(0)
    Unit cur, nxt; int ui = 0;
    if (!S.next(0, cur)) return;
    f32x4 acc[2][2][4][2];
#pragma unroll
    for (int a = 0; a < 2; ++a)
#pragma unroll
        for (int b = 0; b < 2; ++b)
#pragma unroll
            for (int m = 0; m < 4; ++m)
#pragma unroll
                for (int n = 0; n < 2; ++n) acc[a][b][m][n] = (f32x4){0.f, 0.f, 0.f, 0.f};
    bf16x8 At[4][2], B0[2][2], B1[2][2];
    const char* cA = PG8_ATILE(cur.pm); const char* cB = (const char*)g.Bt + (size_t)cur.pn * tstepB;
    S.a_ready(cur);
    if constexpr (SP2) {
        PG8_STAGE(PG8_SB(0, 0), cB, voffB); PG8_STAGE(PG8_SB(0, 1), cB + hstepB, voffB); PG8_STAGE(PG8_SA(0, 0), cA, voffA); PG8_STAGE(PG8_SA(0, 1), cA + hstepA, voffA);
        if (wr == 1) PG8_BAR;
        PG8_WAIT_V(2); PG8_BAR;
        PG8_STAGE(PG8_SB(1, 0), cB + kstepB, voffB); PG8_STAGE(PG8_SA(1, 0), cA + kstepA, voffA); PG8_STAGE(PG8_SB(1, 1), cB + hstepB + kstepB, voffB);
        PG8_WAIT_V(6); PG8_BAR;
    } else {
        PG8_STAGE(PG8_SB(0, 0), cB, voffB); PG8_STAGE(PG8_SA(0, 0), cA, voffA); PG8_STAGE(PG8_SB(0, 1), cB + hstepB, voffB); PG8_STAGE(PG8_SA(0, 1), cA + hstepA, voffA);
        if (wr == 1) PG8_BAR;
        PG8_WAIT_V(4); PG8_BAR;
        PG8_STAGE(PG8_SB(1, 0), cB + kstepB, voffB); PG8_STAGE(PG8_SA(1, 0), cA + kstepA, voffA); PG8_STAGE(PG8_SB(1, 1), cB + hstepB + kstepB, voffB);
        PG8_WAIT_V(6); PG8_BAR;
    }
    for (;;) {
        const bool has_next = S.next(ui + 1, nxt);
        const char* nA = has_next ? PG8_ATILE(nxt.pm) : cA; const char* nB = has_next ? (const char*)g.Bt + (size_t)nxt.pn * tstepB : cB;
        for (int t = 0; t < nt; t += 2) {
            const bool last = (t == nt - 2);
            const char* a1 = cA + (size_t)(t + 1) * kstepA;
            const char* a2 = last ? nA : cA + (size_t)(t + 2) * kstepA; const char* b2 = last ? nB : cB + (size_t)(t + 2) * kstepB;
            const char* a3 = a2 + kstepA; const char* b3 = b2 + kstepB;
            if (last && has_next) S.a_ready(nxt);
            if constexpr (SP2) {
            PG8_LDB(B0, 0, 0); PG8_LDB(B1, 0, 1); PG8_SCHED; PG8_LDA(At, 0, 0); PG8_STAGE(PG8_SA(1, 1), a1 + hstepA, voffA);
            PG8_WAIT_V(8); PG8_WAIT_L(0); PG8_BAR; PG8_MMA(0, 0, At, B0); PG8_MMA(0, 1, At, B1); PG8_BAR; PG8_SCHED;
            PG8_LDA(At, 0, 1); PG8_STAGE(PG8_SB(0, 0), b2, voffB); PG8_STAGE(PG8_SB(0, 1), b2 + hstepB, voffB); PG8_STAGE(PG8_SA(0, 0), a2, voffA);
            PG8_WAIT_V(8); PG8_WAIT_L(0); PG8_BAR; PG8_MMA(1, 0, At, B0); PG8_MMA(1, 1, At, B1); PG8_BAR; PG8_SCHED;
            PG8_LDB(B0, 1, 0); PG8_LDB(B1, 1, 1); PG8_SCHED; PG8_LDA(At, 1, 0); PG8_STAGE(PG8_SA(0, 1), a2 + hstepA, voffA);
            PG8_WAIT_V(8); PG8_WAIT_L(0); PG8_BAR; PG8_MMA(0, 0, At, B0); PG8_MMA(0, 1, At, B1); PG8_BAR; PG8_SCHED;
            PG8_LDA(At, 1, 1); PG8_STAGE(PG8_SB(1, 0), b3, voffB); PG8_STAGE(PG8_SB(1, 1), b3 + hstepB, voffB); PG8_STAGE(PG8_SA(1, 0), a3, voffA);
            PG8_WAIT_V(8); PG8_WAIT_L(0); PG8_BAR; PG8_MMA(1, 0, At, B0); PG8_MMA(1, 1, At, B1); PG8_BAR; PG8_SCHED;
            } else {
            PG8_LDB(B0, 0, 0); PG8_SCHED; PG8_LDA(At, 0, 0); PG8_STAGE(PG8_SA(1, 1), a1 + hstepA, voffA);
            PG8_WAIT_L(8); PG8_BAR; PG8_WAIT_L(0); PG8_MMA(0, 0, At, B0); PG8_BAR; PG8_SCHED;
            PG8_LDB(B1, 0, 1); PG8_STAGE(PG8_SB(0, 0), b2, voffB);
            PG8_BAR; PG8_WAIT_L(0); PG8_MMA(0, 1, At, B1); PG8_BAR;
            PG8_LDA(At, 0, 1); PG8_STAGE(PG8_SA(0, 0), a2, voffA);
            PG8_BAR; PG8_WAIT_L(0); PG8_MMA(1, 0, At, B0); PG8_BAR; PG8_SCHED;
            PG8_STAGE(PG8_SB(0, 1), b2 + hstepB, voffB);
            PG8_WAIT_V(6); PG8_BAR; PG8_MMA(1, 1, At, B1); PG8_BAR;
            PG8_LDB(B0, 1, 0); PG8_SCHED; PG8_LDA(At, 1, 0); PG8_STAGE(PG8_SA(0, 1), a2 + hstepA, voffA);
            PG8_WAIT_L(8); PG8_BAR; PG8_WAIT_L(0); PG8_MMA(0, 0, At, B0); PG8_BAR; PG8_SCHED;
            PG8_LDB(B1, 1, 1); PG8_STAGE(PG8_SB(1, 0), b3, voffB);
            PG8_BAR; PG8_WAIT_L(0); PG8_MMA(0, 1, At, B1); PG8_BAR;
            PG8_LDA(At, 1, 1); PG8_STAGE(PG8_SA(1, 0), a3, voffA);
            PG8_BAR; PG8_WAIT_L(0); PG8_MMA(1, 0, At, B0); PG8_BAR; PG8_SCHED;
            PG8_STAGE(PG8_SB(1, 1), b3 + hstepB, voffB);
            PG8_WAIT_V(6); PG8_BAR; PG8_MMA(1, 1, At, B1); PG8_BAR;
            }
        }
        if constexpr (ALIGN_EPI) { if (wr == 0) PG8_BAR; }
        E(acc, cur, wr, wc, fr, fq); S.done(cur);
        if (!has_next) break;
#pragma unroll
        for (int a = 0; a < 2; ++a)
#pragma unroll
            for (int b = 0; b < 2; ++b)
#pragma unroll
                for (int m = 0; m < 4; ++m)
#pragma unroll
                    for (int n = 0; n < 2; ++n) acc[a][b][m][n] = (f32x4){0.f, 0.f, 0.f, 0.f};
        cur = nxt; cA = nA; cB = nB; ++ui;
        if constexpr (ALIGN_EPI) { if (wr == 1) PG8_BAR; }
    }
    PG8_WAIT_V(0);
    if constexpr (!ALIGN_EPI) { if (wr == 0) PG8_BAR; }
    PG8_BAR;
#undef PG8_ATILE
#undef PG8_SA
#undef PG8_SB
#undef PG8_STAGE
#undef PG8_LDA
#undef PG8_LDB
#undef PG8_MMA
#undef PG8_WAIT_V
#undef PG8_WAIT_L
#undef PG8_BAR
#undef PG8_SCHED
}
}
constexpr int NWAVES = 8;
#ifndef MK_MULTI
#define MK_MULTI 0
#endif

constexpr int BATCH = 16, T = 2048, D = 1024, FF = 4096, DEPTH = 4;
constexpr int M = BATCH * T;
constexpr int MH = M / 2;
constexpr int NKV = 1536;
constexpr int NQG = 1280;
constexpr int NCMP = 127;
constexpr float EPS = 1e-6f;

constexpr size_t MiB = 1u << 20;
constexpr size_t WS_CTL = 0, CTL_ZERO_BYTES = 64 * 1024;
constexpr size_t WS_MOD = 1 * MiB;
constexpr size_t WS_CB1 = 3 * MiB;
constexpr size_t WS_GATE = 4 * MiB;
constexpr size_t WS_KCV = 10 * MiB;
constexpr size_t WS_CH = 16 * MiB;
constexpr size_t WS_W = 32 * MiB;
constexpr size_t WS_KV = 128 * MiB;
constexpr size_t WS_HB = 224 * MiB;
constexpr size_t WS_Y = 288 * MiB;
constexpr size_t WS_BIG = 352 * MiB;
constexpr size_t WS_END = 480 * MiB;
constexpr size_t WO_AIN = 0;
constexpr size_t WO_AOUT = WO_AIN + 2ull * 2048 * 1024;
constexpr size_t WO_KV = WO_AOUT + 2ull * 1024 * 1024;
constexpr size_t WO_BIN = WO_KV + 1536ull * 1024;
constexpr size_t WO_BOUT = WO_BIN + 2ull * 1280 * 1024;
constexpr size_t WO_FIN = WO_BOUT + 2ull * 1024 * 1024;
constexpr size_t WO_FOUT = WO_FIN + 4ull * 4096 * 1024;
constexpr size_t WO_C1 = WO_FOUT + 4ull * 4096 * 1024;
constexpr size_t WO_END = WO_C1 + 2ull * 256 * 2048;
static_assert(WO_END * 2 <= 96 * MiB, "weights fit");
constexpr int CW_BAR = 1024;

constexpr int RING_OFF = 0, RING_BYTES = 131072;
constexpr int LDSCTL_OFF = RING_BYTES, MISC_OFF = LDSCTL_OFF + 320;
constexpr int LDS_BYTES = 147456;

#define GAS __attribute__((address_space(1)))
#define LAS __attribute__((address_space(3)))
typedef unsigned short bf16;
typedef unsigned v4u __attribute__((ext_vector_type(4)));
typedef unsigned v2u __attribute__((ext_vector_type(2)));
typedef float f32x4 __attribute__((ext_vector_type(4)));
typedef GAS unsigned gu32;
#define RLX_AGENT __ATOMIC_RELAXED, __HIP_MEMORY_SCOPE_AGENT
#define LDS_WAIT() asm volatile("s_waitcnt lgkmcnt(0)" ::: "memory")
#define VM_WAIT() asm volatile("s_waitcnt vmcnt(0)" ::: "memory")
__device__ __forceinline__ unsigned f2bf(float f) { unsigned u = __builtin_bit_cast(unsigned, f); return (u + 0x7fffu + ((u >> 16) & 1u)) >> 16; }
__device__ __forceinline__ unsigned pk2(float lo, float hi) { return f2bf(lo) | (f2bf(hi) << 16); }
__device__ __forceinline__ float bf_lo(unsigned w) { return __builtin_bit_cast(float, w << 16); }
__device__ __forceinline__ float bf_hi(unsigned w) { return __builtin_bit_cast(float, w & 0xffff0000u); }
__device__ __forceinline__ float bf1(bf16 h) { return __builtin_bit_cast(float, (unsigned)h << 16); }
__device__ __forceinline__ float wave_sum(float v) {
#pragma unroll
    for (int o = 1; o < 64; o <<= 1) v += __shfl_xor(v, o);
    return v;
}
__device__ __forceinline__ float wave_max(float v) {
#pragma unroll
    for (int o = 1; o < 64; o <<= 1) v = fmaxf(v, __shfl_xor(v, o));
    return v;
}

#define XB_TMO      128
#define XB_XCNT(j)  (256  + 64 * (j))
#define XB_XSUB(j)  (1280 + 64 * (j))
#define XB_XGEN(j)  (2304 + 64 * (j))
#define XB_TOP      3328
#define XB_TOPGEN   3392
#define XCD_BAR_WORDS 3456
#define XB_SPIN_CAP (1u << 18)

__device__ __forceinline__ unsigned xb_ld(unsigned* p)              { return __hip_atomic_load(p, __ATOMIC_RELAXED, __HIP_MEMORY_SCOPE_AGENT); }
__device__ __forceinline__ unsigned xb_add(unsigned* p, unsigned v) { return __hip_atomic_fetch_add(p, v, __ATOMIC_RELAXED, __HIP_MEMORY_SCOPE_AGENT); }
__device__ __forceinline__ unsigned xb_xcc_id() { return (unsigned)__builtin_amdgcn_s_getreg((3 << 11) | 20) & 0xFu; }
#define XB_SPIN(cond, bar) do { unsigned _sp = 0; while (cond) { __builtin_amdgcn_s_sleep(1); \
    if ((++_sp & 255u) == 0u) { if (xb_ld(&(bar)[XB_TMO])) break; if (_sp > XB_SPIN_CAP) { atomicAdd(&(bar)[XB_TMO], 1u); break; } } } } while (0)

struct XcdBarrier {
    unsigned* bar; unsigned x;
    volatile LAS unsigned* st;
};
__device__ __forceinline__ XcdBarrier xcd_barrier_post(unsigned* bar, volatile LAS unsigned* st) {
    XcdBarrier b; b.bar = bar; b.x = xb_xcc_id(); b.st = st;
    if (threadIdx.x == 0) (void)xb_add(&bar[XB_XCNT(b.x)], 1u);
    return b;
}
__device__ __forceinline__ void xcd_barrier_complete(unsigned* bar, unsigned x, unsigned& nloc, unsigned& nx) {
    const unsigned G = gridDim.x * gridDim.y * gridDim.z;
    unsigned sum, cnt, mine, sp = 0u;
    for (;;) {
        sum = 0u; cnt = 0u; mine = 0u;
#pragma unroll
        for (unsigned j = 0; j < 16; ++j) { const unsigned c = xb_ld(&bar[XB_XCNT(j)]); sum += c; cnt += (c > 0u) ? 1u : 0u; mine = (j == x) ? c : mine; }
        if (sum == G) break;
        __builtin_amdgcn_s_sleep(1);
        if ((++sp & 255u) == 0u) { if (xb_ld(&bar[XB_TMO])) break; if (sp > XB_SPIN_CAP) { atomicAdd(&bar[XB_TMO], 1u); break; } }
    }
    nloc = mine > 0u ? mine : 1u; nx = cnt > 0u ? cnt : 1u;
}
__device__ __forceinline__ void xcd_barrier(const XcdBarrier& b) {
    asm volatile("s_waitcnt vmcnt(0)" ::: "memory");
    __syncthreads();
    if (threadIdx.x == 0) {
        unsigned* bar = b.bar;
        __builtin_amdgcn_s_waitcnt(0);
        unsigned nloc = b.st[0], nx = b.st[1];
        if (nloc == 0u) { xcd_barrier_complete(bar, b.x, nloc, nx); b.st[0] = nloc; b.st[1] = nx; }
        const unsigned old = xb_add(&bar[XB_XSUB(b.x)], 1u);
        const unsigned gen = old / nloc;
        if (old + 1u == (gen + 1u) * nloc) {
            __builtin_amdgcn_fence(__ATOMIC_RELEASE, "agent");
            asm volatile("s_waitcnt vmcnt(0)" ::: "memory");
            const unsigned og = xb_add(&bar[XB_TOP], 1u);
            const unsigned tg = og / nx;
            if (og + 1u == (tg + 1u) * nx) xb_add(&bar[XB_TOPGEN], 1u);
            else XB_SPIN(xb_ld(&bar[XB_TOPGEN]) == tg, bar);
            __builtin_amdgcn_fence(__ATOMIC_ACQUIRE, "agent");
            xb_add(&bar[XB_XGEN(b.x)], 1u);
            asm volatile("s_waitcnt vmcnt(0)" ::: "memory");
        } else {
            XB_SPIN(xb_ld(&bar[XB_XGEN(b.x)]) == gen, bar);
            __builtin_amdgcn_fence(__ATOMIC_ACQUIRE, "agent");
            asm volatile("s_waitcnt vmcnt(0)" ::: "memory");
        }
    }
    __syncthreads();
}

struct Frame {
    LAS unsigned char* lds;
    int tid, lane, wave;
    int vcu, G;
};
__device__ __forceinline__ void tr_item(const float* W, int K, int ldw, int nvalid, bf16* WT, int nblk, LAS float* scr, int item, int lane) {
    const int kb = item / nblk, nb = item % nblk, k0 = 64 * kb, n0 = 32 * nb;
    const int nn = n0 + (lane & 31); const bool ok = nn < nvalid;
#pragma unroll 8
    for (int i = 0; i < 32; ++i) { const int kk = 2 * i + (lane >> 5); scr[kk * 33 + (lane & 31)] = ok ? W[(size_t)(k0 + kk) * ldw + nn] : 0.f; }
    LDS_WAIT(); asm volatile("" ::: "memory");
    const int c = lane & 7;
#pragma unroll
    for (int j = 0; j < 4; ++j) { const int n = (lane >> 3) + 8 * j; const LAS float* s = scr + (8 * c) * 33 + n;
        v4u o; o.x = pk2(s[0 * 33], s[1 * 33]); o.y = pk2(s[2 * 33], s[3 * 33]); o.z = pk2(s[4 * 33], s[5 * 33]); o.w = pk2(s[6 * 33], s[7 * 33]);
        *(GAS v4u*)(WT + (size_t)(n0 + n) * K + k0 + 8 * c) = o; }
    LDS_WAIT(); asm volatile("" ::: "memory");
}

struct Args { const float* in[24]; float* out; unsigned char* ws; int ph_lo, ph_hi; };

__device__ __forceinline__ void p0_prologue(const Frame& F, const Args& a) {
    LAS float* scr = (LAS float*)(F.lds + RING_OFF + F.wave * 16384);
    bf16* WB = (bf16*)(a.ws + WS_W);
    const int gw = F.vcu * NWAVES + F.wave, NGW = F.G * NWAVES;
    constexpr int I_AIN = 16 * 64, I_AOUT = 16 * 32, I_KV = 16 * 48, I_BIN = 16 * 40, I_BOUT = 16 * 32, I_FIN = 16 * 128, I_FOUT = 64 * 32, I_C1 = 32 * 8;
    constexpr int NITEMS = 2 * I_AIN + 2 * I_AOUT + I_KV + 2 * I_BIN + 2 * I_BOUT + 4 * I_FIN + 4 * I_FOUT + 2 * I_C1;
    for (int it = gw; it < NITEMS; it += NGW) {
        int r = it;
        if (r < 2 * I_AIN) { const int l = r / I_AIN; tr_item(a.in[5] + (size_t)l * 1024 * 2048, 1024, 2048, 2048, WB + WO_AIN + (size_t)l * 2048 * 1024, 64, scr, r % I_AIN, F.lane); continue; } r -= 2 * I_AIN;
        if (r < 2 * I_AOUT) { const int l = r / I_AOUT; tr_item(a.in[10] + (size_t)l * 1024 * 1024, 1024, 1024, 1024, WB + WO_AOUT + (size_t)l * 1024 * 1024, 32, scr, r % I_AOUT, F.lane); continue; } r -= 2 * I_AOUT;
        if (r < I_KV) { tr_item(a.in[14], 1024, 1536, 1536, WB + WO_KV, 48, scr, r, F.lane); continue; } r -= I_KV;
        if (r < 2 * I_BIN) { const int l = r / I_BIN; tr_item(a.in[20] + (size_t)l * 1024 * 1072, 1024, 1072, 1072, WB + WO_BIN + (size_t)l * 1280 * 1024, 40, scr, r % I_BIN, F.lane); continue; } r -= 2 * I_BIN;
        if (r < 2 * I_BOUT) { const int l = r / I_BOUT; tr_item(a.in[21] + (size_t)l * 1024 * 1024, 1024, 1024, 1024, WB + WO_BOUT + (size_t)l * 1024 * 1024, 32, scr, r % I_BOUT, F.lane); continue; } r -= 2 * I_BOUT;
        if (r < 4 * I_FIN) { const int l = r / I_FIN; tr_item(a.in[22] + (size_t)l * 1024 * 4096, 1024, 4096, 4096, WB + WO_FIN + (size_t)l * 4096 * 1024, 128, scr, r % I_FIN, F.lane); continue; } r -= 4 * I_FIN;
        if (r < 4 * I_FOUT) { const int l = r / I_FOUT; tr_item(a.in[23] + (size_t)l * 4096 * 1024, 4096, 1024, 1024, WB + WO_FOUT + (size_t)l * 1024 * 4096, 32, scr, r % I_FOUT, F.lane); continue; } r -= 4 * I_FOUT;
        { const int l = r / I_C1; tr_item(a.in[16] + (size_t)l * 2048 * 256, 2048, 256, 256, WB + WO_C1 + (size_t)l * 256 * 2048, 8, scr, r % I_C1, F.lane); }
    }
    __syncthreads();
    if (F.vcu < 208) {
        LAS float* cact = (LAS float*)(F.lds);
        LAS float* red = (LAS float*)(F.lds + 65536);
        for (int i = F.tid; i < 16 * 1024; i += NWAVES * 64) { const float c = a.in[1][i]; cact[i] = c / (1.0f + __expf(-c)); }
        __syncthreads();
        const int grp = F.vcu; const float* W; const float* bias; float* out; int ldw, n0, ostride;
        float* MOD = (float*)(a.ws + WS_MOD);
        if (grp < 192) { const int L = grp / 48; n0 = (grp % 48) * 128; W = a.in[2] + (size_t)L * 1024 * 6144; ldw = 6144; bias = a.in[3] + L * 6144; out = MOD + (size_t)L * 16 * 6144; ostride = 6144; }
        else { n0 = (grp - 192) * 128; W = a.in[11]; ldw = 2048; bias = a.in[12]; out = MOD + (size_t)4 * 16 * 6144; ostride = 2048; }
        float acc0[16], acc1[16];
#pragma unroll
        for (int b = 0; b < 16; ++b) { acc0[b] = 0.f; acc1[b] = 0.f; }
        const int kbeg = F.wave * 128;
        for (int k = kbeg; k < kbeg + 128; ++k) {
            const float2 w = *(const float2*)(W + (size_t)k * ldw + n0 + 2 * F.lane);
#pragma unroll
            for (int b = 0; b < 16; ++b) { const float cv = cact[b * 1024 + k]; acc0[b] += cv * w.x; acc1[b] += cv * w.y; }
        }
#pragma unroll
        for (int b = 0; b < 16; ++b) { red[(F.wave * 16 + b) * 128 + 2 * F.lane] = acc0[b]; red[(F.wave * 16 + b) * 128 + 2 * F.lane + 1] = acc1[b]; }
        __syncthreads();
        for (int o = F.tid; o < 2048; o += NWAVES * 64) { const int b = o >> 7, n = o & 127; float s = bias[n0 + n];
#pragma unroll
            for (int w = 0; w < 8; ++w) s += red[(w * 16 + b) * 128 + n];
            out[(size_t)b * ostride + n0 + n] = s; }
    } else if (F.vcu == 208) {
        const int j = F.tid >> 8, n = F.tid & 255; float s = a.in[17][j * 256 + n];
        const float* pos = a.in[15] + j * 2048; const float* w1 = a.in[16] + (size_t)j * 2048 * 256 + n;
        for (int kk = 0; kk < 2048; ++kk) s += pos[kk] * w1[(size_t)kk * 256];
        ((float*)(a.ws + WS_CB1))[j * 256 + n] = s;
    }
}

template <bool HAS_Y, bool HAS_H, bool HAS_KV>
__device__ __forceinline__ void norm_phase(const Frame& F, const float* xin, float* xout, const bf16* Y, const float* gy, const float* gate  ,
                                           const float* gn, const float* sh, const float* sc, int mstride, bf16* H,
                                           const float* gkv, const float* shkv, const float* sckv, int kvstride, bf16* HKV) {
    const int gw = F.vcu * NWAVES + F.wave, NGW = F.G * NWAVES;
    for (int blk = gw; blk < M / 16; blk += NGW) {
        const int b = blk / (T / 16);
        f32x4 A1[4], A2[4], A3[4], K2[4], K3[4];
#pragma unroll
        for (int j = 0; j < 4; ++j) { const int col = 256 * j + 4 * F.lane;
            if (HAS_Y) A1[j] = *(const f32x4*)(gate + (size_t)b * mstride + col) * *(const f32x4*)(gy + col);
            if (HAS_H) { A2[j] = *(const f32x4*)(gn + col) * (*(const f32x4*)(sc + (size_t)b * mstride + col) + 1.0f); A3[j] = *(const f32x4*)(sh + (size_t)b * mstride + col); }
            if (HAS_KV) { K2[j] = *(const f32x4*)(gkv + col) * (*(const f32x4*)(sckv + (size_t)b * kvstride + col) + 1.0f); K3[j] = *(const f32x4*)(shkv + (size_t)b * kvstride + col); }
        }
        for (int r = 0; r < 16; ++r) {
            const size_t m = (size_t)blk * 16 + r;
            f32x4 xv[4];
#pragma unroll
            for (int j = 0; j < 4; ++j) xv[j] = *(const f32x4*)(xin + m * D + 256 * j + 4 * F.lane);
            if (HAS_Y) {
                f32x4 yv[4]; float s = 0.f;
#pragma unroll
                for (int j = 0; j < 4; ++j) { const v2u w = *(const v2u*)(Y + m * D + 256 * j + 4 * F.lane); yv[j] = (f32x4){bf_lo(w.x), bf_hi(w.x), bf_lo(w.y), bf_hi(w.y)};
                    s += (yv[j].x * yv[j].x + yv[j].y * yv[j].y) + (yv[j].z * yv[j].z + yv[j].w * yv[j].w); }
                const float rstd = 1.0f / sqrtf(wave_sum(s) * (1.0f / D) + EPS);
#pragma unroll
                for (int j = 0; j < 4; ++j) { xv[j] = xv[j] + A1[j] * (yv[j] * rstd); *(f32x4*)(xout + m * D + 256 * j + 4 * F.lane) = xv[j]; }
            }
            if (HAS_H || HAS_KV) {
                float s = 0.f;
#pragma unroll
                for (int j = 0; j < 4; ++j) s += (xv[j].x * xv[j].x + xv[j].y * xv[j].y) + (xv[j].z * xv[j].z + xv[j].w * xv[j].w);
                const float rstd = 1.0f / sqrtf(wave_sum(s) * (1.0f / D) + EPS);
#pragma unroll
                for (int j = 0; j < 4; ++j) { const f32x4 xn = xv[j] * rstd;
                    if (HAS_H) { const f32x4 h = xn * A2[j] + A3[j]; v2u w; w.x = pk2(h.x, h.y); w.y = pk2(h.z, h.w); *(v2u*)(H + m * D + 256 * j + 4 * F.lane) = w; }
                    if (HAS_KV) { const f32x4 h = xn * K2[j] + K3[j]; v2u w; w.x = pk2(h.x, h.y); w.y = pk2(h.z, h.w); *(v2u*)(HKV + m * D + 256 * j + 4 * F.lane) = w; } }
            }
        }
    }
}

__device__ __forceinline__ void sgu_phase_naive(const Frame& F, const bf16* U, const bf16* V, const float* lng, const float* lnb, const float* ws, const float* bs, bf16* GT) {
    LAS float* vt = (LAS float*)(F.lds);
    LAS float* wm = (LAS float*)(F.lds + 65536);
    LAS float* st = (LAS float*)(F.lds + 132096);
    for (int ch = F.vcu; ch < M / 128; ch += F.G) {
        const size_t m0 = (size_t)ch * 128;
        __syncthreads();
        for (int r = 0; r < 16; ++r) { const int row = F.wave * 16 + r; float s = 0.f, q = 0.f; float xv[16];
#pragma unroll
            for (int j = 0; j < 4; ++j) { const v2u w = *(const v2u*)(V + (m0 + row) * D + 256 * j + 4 * F.lane); xv[4 * j] = bf_lo(w.x); xv[4 * j + 1] = bf_hi(w.x); xv[4 * j + 2] = bf_lo(w.y); xv[4 * j + 3] = bf_hi(w.y); }
#pragma unroll
            for (int e = 0; e < 16; ++e) s += xv[e];
            const float mean = wave_sum(s) * (1.0f / D);
#pragma unroll
            for (int e = 0; e < 16; ++e) { const float d = xv[e] - mean; q += d * d; }
            const float rstd = 1.0f / sqrtf(wave_sum(q) * (1.0f / D) + EPS);
            if (F.lane == 0) { st[row * 2] = mean; st[row * 2 + 1] = rstd; } }
        __syncthreads();
        for (int g = 0; g < 8; ++g) {
            for (int i = F.tid; i < 128 * 128; i += NWAVES * 64) { const int s = i >> 7, d = i & 127; const int c = g * 128 + d;
                vt[i] = (bf1(V[(m0 + s) * D + c]) - st[s * 2]) * st[s * 2 + 1] * lng[c] + lnb[c];
                const int t = i >> 7, s2 = i & 127; wm[s2 * 128 + t] = (s2 <= t) ? ws[(size_t)g * 16384 + t * 128 + s2] : 0.f; }
            __syncthreads();
            const int d = F.tid & 127, tq = __builtin_amdgcn_readfirstlane(F.tid >> 7);
            float acc[32];
#pragma unroll
            for (int i = 0; i < 32; ++i) acc[i] = 0.f;
            for (int s = 0; s < 128; ++s) { const float vv = vt[s * 128 + d];
#pragma unroll
                for (int i4 = 0; i4 < 8; ++i4) { const f32x4 w4 = *(const LAS f32x4*)(wm + s * 128 + tq * 32 + i4 * 4);
                    acc[i4 * 4] += w4.x * vv; acc[i4 * 4 + 1] += w4.y * vv; acc[i4 * 4 + 2] += w4.z * vv; acc[i4 * 4 + 3] += w4.w * vv; } }
#pragma unroll
            for (int i = 0; i < 32; ++i) { const int t = tq * 32 + i; const size_t idx = (m0 + t) * D + g * 128 + d;
                GT[idx] = (bf16)f2bf(bf1(U[idx]) * (acc[i] + bs[g * 128 + t])); }
            __syncthreads();
        }
    }
}

__device__ __forceinline__ void cmp2_phase(const Frame& F, const bf16* CH, const float* w2, const float* b2, float* KCV) {
    const int gw = F.vcu * NWAVES + F.wave, NGW = F.G * NWAVES;
    for (int it = gw; it < 2 * 8192; it += NGW) {
        const int j = it >> 13, r = it & 8191;
        float s = b2[j * 64 + F.lane];
        const bf16* hrow = CH + ((size_t)j * 8192 + r) * 256; const float* w = w2 + (size_t)j * 256 * 64 + F.lane;
        for (int h = 0; h < 256; ++h) s += bf1(hrow[h]) * w[h * 64];
        if ((r & 127) == 127) s = 0.f;
        KCV[((size_t)j * 8192 + r) * 64 + F.lane] = s;
    }
}

__device__ __forceinline__ void attn_phase_naive(const Frame& F, const bf16* Q, const float* GATE, const float* KCV, const bf16* KV, bf16* O) {
    LAS float* wl = (LAS float*)(F.lds + F.wave * 4096);
    LAS float* qs = wl;
    LAS float* ps = wl + 256;
    LAS float* pc = wl + 512;
    LAS float* im = wl + 640;
    const int gw = F.vcu * NWAVES + F.wave, NGW = F.G * NWAVES, lane = F.lane;
    constexpr float L2E = 1.4426950408889634f;
    for (int it = gw; it < BATCH * 4 * T; it += NGW) {
        const int t = it & (T - 1), g = (it >> 11) & 3, b = it >> 13;
        const size_t m = (size_t)b * T + t;
#pragma unroll
        for (int hh = 0; hh < 4; ++hh) qs[hh * 64 + lane] = bf1(Q[m * 1024 + (g * 4 + hh) * 64 + lane]);
        float mx[4], ls[4], oa[4], outv[4];
#define ATT_SCORE_BF16(kp, sv) do { asm volatile("" ::: "memory"); sv[0] = sv[1] = sv[2] = sv[3] = 0.f; \
        _Pragma("unroll") for (int d8 = 0; d8 < 8; ++d8) { const v4u kk = *(const v4u*)((kp) + d8 * 8); float kf[8] = {bf_lo(kk.x), bf_hi(kk.x), bf_lo(kk.y), bf_hi(kk.y), bf_lo(kk.z), bf_hi(kk.z), bf_lo(kk.w), bf_hi(kk.w)}; \
            _Pragma("unroll") for (int hh = 0; hh < 4; ++hh) { const f32x4 q0 = *(const LAS f32x4*)(qs + hh * 64 + d8 * 8), q1 = *(const LAS f32x4*)(qs + hh * 64 + d8 * 8 + 4); \
                sv[hh] += (q0.x * kf[0] + q0.y * kf[1]) + (q0.z * kf[2] + q0.w * kf[3]) + (q1.x * kf[4] + q1.y * kf[5]) + (q1.z * kf[6] + q1.w * kf[7]); } } } while (0)
#define ATT_SCORE_F32(kp, sv) do { asm volatile("" ::: "memory"); sv[0] = sv[1] = sv[2] = sv[3] = 0.f; \
        _Pragma("unroll") for (int d4 = 0; d4 < 16; ++d4) { const f32x4 kk = *(const f32x4*)((kp) + d4 * 4); \
            _Pragma("unroll") for (int hh = 0; hh < 4; ++hh) { const f32x4 q0 = *(const LAS f32x4*)(qs + hh * 64 + d4 * 4); \
                sv[hh] += (q0.x * kk.x + q0.y * kk.y) + (q0.z * kk.z + q0.w * kk.w); } } } while (0)
#define ATT_SOFTMAX_STEP(sv, valid) do { \
        _Pragma("unroll") for (int hh = 0; hh < 4; ++hh) { const float s_ = (valid) ? sv[hh] : -INFINITY; const float bm = wave_max(s_); const float mn = fmaxf(mx[hh], bm); \
            const float scl = __builtin_amdgcn_exp2f((mx[hh] - mn) * L2E); const float p = __builtin_amdgcn_exp2f((s_ - mn) * L2E); \
            ls[hh] = ls[hh] * scl + wave_sum(p); oa[hh] *= scl; mx[hh] = mn; ps[lane * 4 + hh] = p; } } while (0)
        LDS_WAIT();
        const int ncv = (t >= 31) ? ((t - 31) >> 4) + 1 : 0;
        const float* kc = KCV + ((size_t)(b * 4 + g) * 128) * 64; const float* vc = KCV + (size_t)8192 * 64 + ((size_t)(b * 4 + g) * 128) * 64;
        float ocmp[4] = {0.f, 0.f, 0.f, 0.f};
        pc[lane] = 0.f; pc[64 + lane] = 0.f;
        if (ncv > 0) {
            float s0[4], s1[4];
            ATT_SCORE_F32(kc + (size_t)lane * 64, s0); ATT_SCORE_F32(kc + (size_t)(64 + lane) * 64, s1);
            float psum0 = 0.f, psum1 = 0.f; float p0[4], p1[4];
#pragma unroll
            for (int hh = 0; hh < 4; ++hh) { const float a0 = (lane < ncv) ? s0[hh] : -INFINITY, a1 = (64 + lane < ncv) ? s1[hh] : -INFINITY;
                const float mm = wave_max(fmaxf(a0, a1)); const float e0 = __builtin_amdgcn_exp2f((a0 - mm) * L2E), e1 = __builtin_amdgcn_exp2f((a1 - mm) * L2E);
                const float den = wave_sum(e0 + e1); p0[hh] = e0 / den; p1[hh] = e1 / den; psum0 += p0[hh]; psum1 += p1[hh]; }
            pc[lane] = psum0; pc[64 + lane] = psum1;
#pragma unroll
            for (int hh = 0; hh < 4; ++hh) ps[lane * 4 + hh] = p0[hh];
            LDS_WAIT();
            const int n0 = ncv < 64 ? ncv : 64;
            for (int key = 0; key < n0; ++key) { const f32x4 p4 = *(const LAS f32x4*)(ps + key * 4); const float vv = vc[(size_t)key * 64 + lane];
                ocmp[0] += p4.x * vv; ocmp[1] += p4.y * vv; ocmp[2] += p4.z * vv; ocmp[3] += p4.w * vv; }
            LDS_WAIT();
            if (ncv > 64) {
#pragma unroll
                for (int hh = 0; hh < 4; ++hh) ps[lane * 4 + hh] = p1[hh];
                LDS_WAIT();
                for (int key = 0; key < ncv - 64; ++key) { const f32x4 p4 = *(const LAS f32x4*)(ps + key * 4); const float vv = vc[(size_t)(64 + key) * 64 + lane];
                    ocmp[0] += p4.x * vv; ocmp[1] += p4.y * vv; ocmp[2] += p4.z * vv; ocmp[3] += p4.w * vv; }
            }
        }
        LDS_WAIT();
        const int cur = t >> 6;
        unsigned selmask;
        {
            float imp = 0.f; const int j = lane & 31;
#pragma unroll
            for (int c = -1; c <= 3; ++c) { const int cc = 4 * j + c; if (cc >= 0 && cc < NCMP) imp += pc[cc]; }
            if (j > cur) imp = -1.0f;
            if (j == 0 || j == cur || j == cur - 1) imp = 1e4f;
            im[j] = imp;
            LDS_WAIT();
            int rank = 0;
            for (int i = 0; i < 32; ++i) { const float o = im[i]; rank += (o > imp || (o == imp && i < j)) ? 1 : 0; }
            const unsigned long long bal = __ballot(rank < 16 && j <= cur);
            selmask = (unsigned)bal;
        }
#pragma unroll
        for (int hh = 0; hh < 4; ++hh) { mx[hh] = -INFINITY; ls[hh] = 0.f; oa[hh] = 0.f; }
        {
            const bf16* kb = KV + (size_t)b * T * NKV + 2 * 256 + g * 64; const bf16* vb = KV + (size_t)b * T * NKV + 3 * 256 + g * 64;
            for (int j = 0; j <= cur; ++j) {
                if (!((selmask >> j) & 1u)) continue;
                const int kpos = j * 64 + lane; float sv[4];
                ATT_SCORE_BF16(kb + (size_t)kpos * NKV, sv);
                LDS_WAIT();
                ATT_SOFTMAX_STEP(sv, kpos <= t);
                LDS_WAIT();
                for (int key = 0; key < 64; ++key) { const f32x4 p4 = *(const LAS f32x4*)(ps + key * 4); const float vv = bf1(vb[(size_t)(j * 64 + key) * NKV + lane]);
                    oa[0] += p4.x * vv; oa[1] += p4.y * vv; oa[2] += p4.z * vv; oa[3] += p4.w * vv; }
            }
        }
        const float* gt = GATE + m * 48 + g * 12;
#pragma unroll
        for (int hh = 0; hh < 4; ++hh) outv[hh] = gt[hh * 3 + 0] * ocmp[hh] + gt[hh * 3 + 1] * (oa[hh] / ls[hh]);
#pragma unroll
        for (int hh = 0; hh < 4; ++hh) { mx[hh] = -INFINITY; ls[hh] = 0.f; oa[hh] = 0.f; }
        {
            const bf16* kb = KV + (size_t)b * T * NKV + 4 * 256 + g * 64; const bf16* vb = KV + (size_t)b * T * NKV + 5 * 256 + g * 64;
            const int start = t - 511 > 0 ? t - 511 : 0;
            for (int k0 = start; k0 <= t; k0 += 64) {
                const int kpos = k0 + lane; const int kr = kpos <= t ? kpos : t; float sv[4];
                ATT_SCORE_BF16(kb + (size_t)kr * NKV, sv);
                LDS_WAIT();
                ATT_SOFTMAX_STEP(sv, kpos <= t);
                LDS_WAIT();
                const int nk = (t - k0 + 1) < 64 ? (t - k0 + 1) : 64;
                for (int key = 0; key < nk; ++key) { const f32x4 p4 = *(const LAS f32x4*)(ps + key * 4); const float vv = bf1(vb[(size_t)(k0 + key) * NKV + lane]);
                    oa[0] += p4.x * vv; oa[1] += p4.y * vv; oa[2] += p4.z * vv; oa[3] += p4.w * vv; }
            }
        }
#pragma unroll
        for (int hh = 0; hh < 4; ++hh) { outv[hh] += gt[hh * 3 + 2] * (oa[hh] / ls[hh]); O[m * 1024 + (g * 4 + hh) * 64 + lane] = (bf16)f2bf(outv[hh]); }
        LDS_WAIT();
#undef ATT_SCORE_BF16
#undef ATT_SCORE_F32
#undef ATT_SOFTMAX_STEP
    }
}
__global__ void __launch_bounds__(NWAVES * 64, 2) fwd(Args args) {
    extern __shared__ __attribute__((aligned(16))) unsigned char lds[];
    Frame F;
    F.lds = (LAS unsigned char*)lds;
    volatile LAS unsigned* MISC = (volatile LAS unsigned*)(F.lds + MISC_OFF);
    F.tid = threadIdx.x; F.lane = F.tid & 63; F.wave = __builtin_amdgcn_readfirstlane(F.tid >> 6);
    F.G = gridDim.x; { const int bx = blockIdx.x; F.vcu = (F.G % 8 == 0) ? (bx % 8) * (F.G / 8) + bx / 8 : bx; }
    unsigned char* ws = args.ws;
    gu32* ctl = (gu32*)(ws + WS_CTL);
    for (int u = F.tid; u < (LDS_BYTES - LDSCTL_OFF) / 4; u += NWAVES * 64) ((LAS unsigned*)(F.lds + LDSCTL_OFF))[u] = 0u;
    __syncthreads();
#if !MK_MULTI
    XcdBarrier bar = xcd_barrier_post((unsigned*)(ctl + CW_BAR), MISC + 8);
#define GRID_BAR() xcd_barrier(bar)
#else
#define GRID_BAR() do {} while (0)
#endif
    const int lo = args.ph_lo, hi = args.ph_hi;
    int ph = 0;
#define PH_BEGIN if (ph >= lo && ph < hi) { Frame Fp = F; asm volatile("" : "+v"(Fp.tid), "+v"(Fp.lane));
#define PH_END   if (ph + 1 < hi) GRID_BAR(); } ++ph;

    const float* x_in = args.in[0];
    float* xo = args.out;
    const float* norm_g = args.in[4];
    float* MOD = (float*)(ws + WS_MOD);
    float* KVMOD = MOD + (size_t)4 * 16 * 6144;
    float* CB1 = (float*)(ws + WS_CB1);
    float* GATE = (float*)(ws + WS_GATE);
    float* KCV = (float*)(ws + WS_KCV);
    bf16* CH = (bf16*)(ws + WS_CH);
    bf16* WB = (bf16*)(ws + WS_W);
    bf16* KV = (bf16*)(ws + WS_KV);
    bf16* HB = (bf16*)(ws + WS_HB);
    bf16* Y = (bf16*)(ws + WS_Y);
    bf16* BIG = (bf16*)(ws + WS_BIG);
    bf16* Ub = BIG; bf16* Vb = BIG + (size_t)M * D;
    bf16* Qb = BIG; bf16* Ob = BIG + (size_t)M * D; bf16* HKV = Ob;
    bf16* HID = BIG;
    LAS unsigned char* ring = F.lds + RING_OFF;
    const int bx = (int)blockIdx.x;

    PH_BEGIN
#ifndef NO_PRO
 p0_prologue(Fp, args);
#endif
 PH_END
    PH_BEGIN norm_phase<false, true, false>(Fp, x_in, nullptr, nullptr, nullptr, nullptr, norm_g, MOD + 0, MOD + 1024, 6144, HB, nullptr, nullptr, nullptr, 0, nullptr); PH_END

    for (int L = 0; L < DEPTH; ++L) {
        const float* modL = MOD + (size_t)L * 16 * 6144;
        const float* xcur = (L == 0) ? x_in : (const float*)xo;
        if (L < 2) {
            PH_BEGIN {
                pg8::Gemm g = pg8::make_gemm(HB, WB + WO_AIN + (size_t)L * 2048 * 1024, M, 2048, D); pg8::StaticOrder S; S.init(M, 2048, F.G, bx);
                pg8::EpiBf16<2> E{Ub, D, nullptr, 1024, (size_t)M * D, 1.f};
                pg8::gemm_phase<pg8::EpiBf16<2>, pg8::StaticOrder, true, true>(ring, g, S, E);
            } PH_END
            PH_BEGIN
#ifndef NO_SGU
 sgu_phase_naive(Fp, Ub, Vb, args.in[6] + L * 1024, args.in[7] + L * 1024, args.in[8] + (size_t)L * 8 * 128 * 128, args.in[9] + L * 8 * 128, HB);
#endif
 PH_END
            PH_BEGIN {
                pg8::Gemm g = pg8::make_gemm(HB, WB + WO_AOUT + (size_t)L * 1024 * 1024, M, D, D); pg8::StaticOrder S; S.init(M, D, F.G, bx);
                pg8::EpiBf16<0> E{Y, D, nullptr, 0, 0, 1.f};
                pg8::gemm_phase<pg8::EpiBf16<0>, pg8::StaticOrder, true, true>(ring, g, S, E);
            } PH_END
        } else {
            const int jb = L - 2;
            PH_BEGIN {
                if (L == 2) {
                    pg8::Gemm g = pg8::make_gemm(HKV, WB + WO_KV, M, NKV, D); pg8::StaticOrder S; S.init(M, NKV, F.G, bx);
                    pg8::EpiBf16<0> E{KV, NKV, nullptr, 0, 0, 1.f};
                    pg8::gemm_phase<pg8::EpiBf16<0>, pg8::StaticOrder, true, true>(ring, g, S, E);
                }
                {
                    pg8::Gemm g = pg8::make_gemm(HB, WB + WO_BIN + (size_t)jb * NQG * 1024, M, NQG, D); pg8::StaticOrder S; S.init(M, NQG, F.G, bx);
                    pg8::EpiQG E{Qb, GATE, 0.125f};
                    pg8::gemm_phase<pg8::EpiQG, pg8::StaticOrder, true, true>(ring, g, S, E);
                }
            } PH_END
            if (L == 2) {
                PH_BEGIN {
#pragma unroll 1
                    for (int j = 0; j < 2; ++j) {
                        pg8::Gemm g; g.A = KV + j * 256; g.Bt = WB + WO_C1 + (size_t)j * 256 * 2048; g.M = 8192; g.N = 256; g.K = 2048;
                        g.a_rs = 16u * NKV * 2u; g.a_hstep = 64 * 2; g.a_kstep = (size_t)NKV * 2; g.a_t1 = (size_t)T * NKV * 2; g.a_t0 = 128 * 2; g.a_sh = 1;
                        pg8::StaticOrder S; S.init(8192, 256, F.G, (bx + j * 128) % F.G);
                        pg8::EpiBf16<2> E{CH + (size_t)j * 8192 * 256, 256, CB1 + j * 256, 0, 0, 1.f};
                        pg8::gemm_phase<pg8::EpiBf16<2>, pg8::StaticOrder, true, true>(ring, g, S, E);
                    }
                } PH_END
                PH_BEGIN cmp2_phase(Fp, CH, args.in[18], args.in[19], KCV); PH_END
            }
            PH_BEGIN
#ifndef NO_ATTN
 attn_phase_naive(Fp, Qb, GATE, KCV, KV, Ob);
#endif
 PH_END
            PH_BEGIN {
                pg8::Gemm g = pg8::make_gemm(Ob, WB + WO_BOUT + (size_t)jb * 1024 * 1024, M, D, D); pg8::StaticOrder S; S.init(M, D, F.G, bx);
                pg8::EpiBf16<0> E{Y, D, nullptr, 0, 0, 1.f};
                pg8::gemm_phase<pg8::EpiBf16<0>, pg8::StaticOrder, true, true>(ring, g, S, E);
            } PH_END
        }
        PH_BEGIN norm_phase<true, true, false>(Fp, xcur, xo, Y, norm_g + (L * 4 + 1) * 1024, modL + 2 * 1024, norm_g + (L * 4 + 2) * 1024, modL + 3 * 1024, modL + 4 * 1024, 6144, HB, nullptr, nullptr, nullptr, 0, nullptr); PH_END
#pragma unroll 1
        for (int hf = 0; hf < 2; ++hf) {
            PH_BEGIN {
                pg8::Gemm g = pg8::make_gemm(HB + (size_t)hf * MH * D, WB + WO_FIN + (size_t)L * 4096 * 1024, MH, FF, D); pg8::StaticOrder S; S.init(MH, FF, F.G, bx);
                pg8::EpiBf16<3> E{HID, FF, nullptr, 0, 0, 1.f};
                pg8::gemm_phase<pg8::EpiBf16<3>, pg8::StaticOrder, true, true>(ring, g, S, E);
            } PH_END
            PH_BEGIN {
                pg8::Gemm g = pg8::make_gemm(HID, WB + WO_FOUT + (size_t)L * 1024 * 4096, MH, D, FF); pg8::StaticOrder S; S.init(MH, D, F.G, bx);
                pg8::EpiBf16<0> E{Y + (size_t)hf * MH * D, D, nullptr, 0, 0, 1.f};
                pg8::gemm_phase<pg8::EpiBf16<0>, pg8::StaticOrder, true, true>(ring, g, S, E);
            } PH_END
        }
        PH_BEGIN {
            const float* gy = norm_g + (L * 4 + 3) * 1024; const float* gate = modL + 5 * 1024;
            if (L == 3) norm_phase<true, false, false>(Fp, xo, xo, Y, gy, gate, nullptr, nullptr, nullptr, 6144, nullptr, nullptr, nullptr, nullptr, 0, nullptr);
            else { const float* modN = MOD + (size_t)(L + 1) * 16 * 6144; const float* gn = norm_g + ((L + 1) * 4 + 0) * 1024;
                if (L == 1) norm_phase<true, true, true>(Fp, xo, xo, Y, gy, gate, gn, modN + 0, modN + 1024, 6144, HB, args.in[13], KVMOD + 0, KVMOD + 1024, 2048, HKV);
                else norm_phase<true, true, false>(Fp, xo, xo, Y, gy, gate, gn, modN + 0, modN + 1024, 6144, HB, nullptr, nullptr, nullptr, 0, nullptr); }
        } PH_END
    }
#undef PH_BEGIN
#undef PH_END
#undef GRID_BAR
}

extern "C" void kernel_launch(void* const* d_in, const int* in_sizes, int n_in, void* d_out, int out_size, void* d_ws, size_t ws_size, hipStream_t stream) {
    static int grid = 0;
    if (grid == 0) {
        if (n_in != 24 || out_size != M * D || ws_size < WS_END) { fprintf(stderr, "kernel_launch: unexpected shapes (n_in %d, out %d, ws %zu)\n", n_in, out_size, ws_size); grid = -1; return; }
        int dev = 0, cus = 0, per_cu = 0;
        if (hipGetDevice(&dev) != hipSuccess || hipDeviceGetAttribute(&cus, hipDeviceAttributeMultiprocessorCount, dev) != hipSuccess) { grid = -1; return; }
        if (hipFuncSetAttribute((const void*)fwd, hipFuncAttributeMaxDynamicSharedMemorySize, LDS_BYTES) != hipSuccess) { grid = -1; return; }
        if (hipOccupancyMaxActiveBlocksPerMultiprocessor(&per_cu, (const void*)fwd, NWAVES * 64, LDS_BYTES) != hipSuccess || per_cu < 1)
            fprintf(stderr, "kernel_launch: occupancy query reports %d workgroups per CU\n", per_cu);
        (void)hipGetLastError();
        grid = cus;
    }
    if (grid < 0) return;
    if (hipMemsetAsync((char*)d_ws + WS_CTL, 0, CTL_ZERO_BYTES, stream) != hipSuccess) return;
    Args a{};
    for (int i = 0; i < 24; ++i) a.in[i] = (const float*)d_in[i];
    a.out = (float*)d_out; a.ws = (unsigned char*)d_ws;
#if MK_MULTI
    for (int p = 0; p < 40; ++p) { a.ph_lo = p; a.ph_hi = p + 1; hipLaunchKernelGGL(fwd, dim3(grid), dim3(NWAVES * 64), LDS_BYTES, stream, a); }
#else
    a.ph_lo = 0; a.ph_hi = 1000; hipLaunchKernelGGL(fwd, dim3(grid), dim3(NWAVES * 64), LDS_BYTES, stream, a);
#endif
}
```

```cpp
#include <hip/hip_runtime.h>
#include <cstdio>
#include <cstdint>
#include <cmath>
#define MK_MULTI 0
namespace pg8 {
#define PG8_LAS __attribute__((address_space(3)))
typedef unsigned short bf16_t;
typedef short bf16x8 __attribute__((ext_vector_type(8)));
typedef float f32x4 __attribute__((ext_vector_type(4)));
typedef unsigned u32x4 __attribute__((ext_vector_type(4)));
constexpr int BM = 256, BK = 64, HALF = 128, HTB = HALF * BK * 2  , STAGE_BYTES = 8 * HTB, NXCD = 8, WGM = 8;

__host__ __device__ __forceinline__ int lds_byte(int r, int c) { const int st = (r >> 4) * 2 + (c >> 5), rr = r & 15, cc = c & 31, ob = rr * 64 + cc * 2; return st * 1024 + (ob ^ (((ob >> 9) & 1) << 5)); }
__host__ __device__ __forceinline__ void stage_rc(int b, int& R, int& C) { const int st = b / 1024, sb = b % 1024, swz = sb ^ (((sb >> 9) & 1) << 5); R = (st >> 1) * 16 + swz / 64; C = (st & 1) * 32 + (swz % 64) / 2; }
__host__ __device__ __forceinline__ int perm32(int rho) { const int n = rho >> 4, i = rho & 15; return 8 * (i >> 2) + 4 * n + (i & 3); }

struct Unit { int pm, pn; };
struct Gemm { const bf16_t* A; const bf16_t* Bt; int M, N, K; unsigned a_rs; size_t a_hstep, a_kstep, a_t1, a_t0; int a_sh; };
__device__ __forceinline__ Gemm make_gemm(const bf16_t* A, const bf16_t* Bt, int M, int N, int K) {
    Gemm g; g.A = A; g.Bt = Bt; g.M = M; g.N = N; g.K = K; g.a_rs = (unsigned)K * 2u; g.a_hstep = (size_t)HALF * K * 2; g.a_kstep = BK * 2; g.a_t1 = (size_t)BM * K * 2; g.a_t0 = 0; g.a_sh = 0; return g; }

struct StaticOrder {
    int nM, nN, nwg, G, c;
    __host__ __device__ void init(int M, int N, int G_, int c_) { nM = M / BM; nN = N / BM; nwg = nM * nN; G = G_; c = c_; }
    __host__ __device__ bool next(int i, Unit& u) const {
        const long L = (long)i * G + c; if (L >= nwg) return false;
        int wgid = (int)L; { const int q = nwg / NXCD, r = nwg % NXCD, xcd = wgid % NXCD, off = wgid / NXCD; wgid = (xcd < r ? xcd * (q + 1) : r * (q + 1) + (xcd - r) * q) + off; }
        const int nig = WGM * nN, gid = wgid / nig, fm = gid * WGM, gsz = (nM - fm) < WGM ? (nM - fm) : WGM;
        u.pm = fm + ((wgid % nig) % gsz); u.pn = (wgid % nig) / gsz; return true;
    }
    __device__ __forceinline__ void a_ready(const Unit&) const {}
    __device__ __forceinline__ void done(const Unit&) const {}
};

__device__ __forceinline__ unsigned cvt_pk_bf16(float lo, float hi) { unsigned r; asm volatile("v_cvt_pk_bf16_f32 %0, %1, %2" : "=v"(r) : "v"(lo), "v"(hi)); return r; }
__device__ __forceinline__ float gelu_tanh(float v) {
    const float u = v * (0.7978845608028654f + 0.035677408136300125f * v * v);
    const float e = __builtin_amdgcn_exp2f(u * -2.8853900817779268f);
    return v * __builtin_amdgcn_rcpf(1.0f + e);
}
template <int ACT> __device__ __forceinline__ float act_fn(float v) {
    if (ACT == 2) return gelu_tanh(v);
    if (ACT == 3) { const float r = v > 0.f ? v : 0.f; return r * r; }
    return v;
}

template <int ACT  > struct EpiBf16 {
    static constexpr bool PERM = true, AFTER_DRAIN = false;
    bf16_t* O; int ldc; const float* bias; int split_cols; size_t split_stride; float scale0;
    __device__ __forceinline__ void operator()(const f32x4 (&acc)[2][2][4][2], const Unit& u, int wr, int wc, int fr, int fq) const {
        const int row0 = u.pm * BM + wr * 64 + fr; int colt = u.pn * BM; bf16_t* base = O;
        float sc = 1.f; if (split_cols) { const int t = colt / split_cols; base += (size_t)t * split_stride; colt -= t * split_cols; if (t == 0) sc = scale0; }
        const int col0 = colt + wc * 32 + 8 * fq, bcol0 = u.pn * BM + wc * 32 + 8 * fq;
        f32x4 bv[2][2];
#pragma unroll
        for (int bj = 0; bj < 2; ++bj)
#pragma unroll
            for (int n = 0; n < 2; ++n) bv[bj][n] = bias ? *(const f32x4*)(bias + bcol0 + bj * HALF + 4 * n) : (f32x4){0.f, 0.f, 0.f, 0.f};
#pragma unroll
        for (int ai = 0; ai < 2; ++ai)
#pragma unroll
            for (int m = 0; m < 4; ++m) { bf16_t* rowp = base + (size_t)(row0 + ai * HALF + m * 16) * ldc + col0;
#pragma unroll
                for (int bj = 0; bj < 2; ++bj) { f32x4 v0 = acc[ai][bj][m][0] + bv[bj][0], v1 = acc[ai][bj][m][1] + bv[bj][1];
                    if (ACT != 0) {
#pragma unroll
                        for (int e = 0; e < 4; ++e) { v0[e] = act_fn<ACT>(v0[e]); v1[e] = act_fn<ACT>(v1[e]); } }
                    v0 = v0 * sc; v1 = v1 * sc; u32x4 w; w.x = cvt_pk_bf16(v0[0], v0[1]); w.y = cvt_pk_bf16(v0[2], v0[3]); w.z = cvt_pk_bf16(v1[0], v1[1]); w.w = cvt_pk_bf16(v1[2], v1[3]);
                    *(u32x4*)(rowp + bj * HALF) = w; } }
    }
};
struct EpiQG {
    static constexpr bool PERM = true, AFTER_DRAIN = false;
    bf16_t* Q; float* G; float qscale;
    __device__ __forceinline__ void operator()(const f32x4 (&acc)[2][2][4][2], const Unit& u, int wr, int wc, int fr, int fq) const {
        const int row0 = u.pm * BM + wr * 64 + fr;
        if (u.pn < 4) {
            const int col0 = u.pn * BM + wc * 32 + 8 * fq;
#pragma unroll
            for (int ai = 0; ai < 2; ++ai)
#pragma unroll
                for (int m = 0; m < 4; ++m) { bf16_t* rowp = Q + (size_t)(row0 + ai * HALF + m * 16) * 1024 + col0;
#pragma unroll
                    for (int bj = 0; bj < 2; ++bj) { const f32x4 v0 = acc[ai][bj][m][0] * qscale, v1 = acc[ai][bj][m][1] * qscale;
                        u32x4 w; w.x = cvt_pk_bf16(v0[0], v0[1]); w.y = cvt_pk_bf16(v0[2], v0[3]); w.z = cvt_pk_bf16(v1[0], v1[1]); w.w = cvt_pk_bf16(v1[2], v1[3]);
                        *(u32x4*)(rowp + bj * HALF) = w; } }
        } else if (wc < 2) {
#pragma unroll
            for (int ai = 0; ai < 2; ++ai)
#pragma unroll
                for (int m = 0; m < 4; ++m) { float* rowp = G + (size_t)(row0 + ai * HALF + m * 16) * 48;
#pragma unroll
                    for (int n = 0; n < 2; ++n) { const int col = wc * 32 + 8 * fq + 4 * n;
                        if (col < 48) { f32x4 v = acc[ai][0][m][n];
#pragma unroll
                            for (int e = 0; e < 4; ++e) v[e] = __builtin_amdgcn_rcpf(1.0f + __builtin_amdgcn_exp2f(v[e] * -1.4426950408889634f));
                            *(f32x4*)(rowp + col) = v; } } }
        }
    }
};

template <class Epi, class Sched, bool ALIGN_EPI = false, bool SP2 = false>
__device__ __forceinline__ void gemm_phase(PG8_LAS unsigned char* lds, const Gemm g, const Sched& S, const Epi& E) {
    int tid_ = threadIdx.x; asm volatile("" : "+v"(tid_));
    const int tid = tid_, wid = __builtin_amdgcn_readfirstlane(tid >> 6), lane = tid & 63, wr = wid >> 2, wc = wid & 3, fr = lane & 15, fq = lane >> 4;
    const int K = g.K, nt = K / BK;
    unsigned voffA[2], voffB[2];
#pragma unroll
    for (int i = 0; i < 2; ++i) { int R, C; stage_rc(tid * 16 + i * 8192, R, C); const int Rb = Epi::PERM ? ((R & ~31) + perm32(R & 31)) : R;
        voffA[i] = (unsigned)R * g.a_rs + (unsigned)C * 2u; voffB[i] = (unsigned)(Rb * K + C) * 2u; }
    const size_t kstepA = g.a_kstep, kstepB = (size_t)(BK * 2);
    const size_t hstepA = g.a_hstep, hstepB = (size_t)HALF * K * 2;
    const size_t tstepB = 2 * hstepB;
    const int a_msk = (1 << g.a_sh) - 1;
#define PG8_ATILE(pm) ((const char*)g.A + (size_t)((pm) >> g.a_sh) * g.a_t1 + (size_t)((pm) & a_msk) * g.a_t0)
    const unsigned ldsw = (unsigned)wid * 1024u;
    const int aoff = lds_byte(wr * 64 + fr, fq * 8), boff = lds_byte(wc * 32 + fr, fq * 8);
#define PG8_SA(b, h) (((b) * 2 + (h)) * HTB)
#define PG8_SB(b, h) ((4 + (b) * 2 + (h)) * HTB)
#define PG8_STAGE(bufoff, gbase, voff) do { _Pragma("unroll") for (int _i = 0; _i < 2; ++_i) \
        __builtin_amdgcn_global_load_lds((const unsigned*)((const char*)(gbase) + (voff)[_i]), (PG8_LAS unsigned*)(lds + (bufoff) + ldsw + _i * 8192), 16, 0, 0); } while (0)
#define PG8_LDA(dst, b, h) do { _Pragma("unroll") for (int m = 0; m < 4; ++m) _Pragma("unroll") for (int k = 0; k < 2; ++k) dst[m][k] = *(const PG8_LAS bf16x8*)(lds + PG8_SA(b, h) + aoff + m * 2048 + k * 1024); } while (0)
#define PG8_LDB(dst, b, h) do { _Pragma("unroll") for (int n = 0; n < 2; ++n) _Pragma("unroll") for (int k = 0; k < 2; ++k) dst[n][k] = *(const PG8_LAS bf16x8*)(lds + PG8_SB(b, h) + boff + n * 2048 + k * 1024); } while (0)
#define PG8_MMA(ai, bj, At, Bt) do { __builtin_amdgcn_s_setprio(1); _Pragma("unroll") for (int m = 0; m < 4; ++m) _Pragma("unroll") for (int n = 0; n < 2; ++n) _Pragma("unroll") for (int k = 0; k < 2; ++k) \
        acc[ai][bj][m][n] = __builtin_amdgcn_mfma_f32_16x16x32_bf16(Bt[n][k], At[m][k], acc[ai][bj][m][n], 0, 0, 0); __builtin_amdgcn_s_setprio(0); } while (0)
#define PG8_WAIT_V(n) asm volatile("s_waitcnt vmcnt(" #n ")" ::: "memory")
#define PG8_WAIT_L(n) asm volatile("s_waitcnt lgkmcnt(" #n ")" ::: "memory")
#define PG8_BAR __builtin_amdgcn_s_barrier()
#define PG8_SCHED __builtin_amdgcn_sched_barrier(0)
    Unit cur, nxt; int ui = 0;
    if (!S.next(0, cur)) return;
    f32x4 acc[2][2][4][2];
#pragma unroll
    for (int a = 0; a < 2; ++a)
#pragma unroll
        for (int b = 0; b < 2; ++b)
#pragma unroll
            for (int m = 0; m < 4; ++m)
#pragma unroll
                for (int n = 0; n < 2; ++n) acc[a][b][m][n] = (f32x4){0.f, 0.f, 0.f, 0.f};
    bf16x8 At[4][2], B0[2][2], B1[2][2];
    const char* cA = PG8_ATILE(cur.pm); const char* cB = (const char*)g.Bt + (size_t)cur.pn * tstepB;
    S.a_ready(cur);
    if constexpr (SP2) {
        PG8_STAGE(PG8_SB(0, 0), cB, voffB); PG8_STAGE(PG8_SB(0, 1), cB + hstepB, voffB); PG8_STAGE(PG8_SA(0, 0), cA, voffA); PG8_STAGE(PG8_SA(0, 1), cA + hstepA, voffA);
        if (wr == 1) PG8_BAR;
        PG8_WAIT_V(2); PG8_BAR;
        PG8_STAGE(PG8_SB(1, 0), cB + kstepB, voffB); PG8_STAGE(PG8_SA(1, 0), cA + kstepA, voffA); PG8_STAGE(PG8_SB(1, 1), cB + hstepB + kstepB, voffB);
        PG8_WAIT_V(6); PG8_BAR;
    } else {
        PG8_STAGE(PG8_SB(0, 0), cB, voffB); PG8_STAGE(PG8_SA(0, 0), cA, voffA); PG8_STAGE(PG8_SB(0, 1), cB + hstepB, voffB); PG8_STAGE(PG8_SA(0, 1), cA + hstepA, voffA);
        if (wr == 1) PG8_BAR;
        PG8_WAIT_V(4); PG8_BAR;
        PG8_STAGE(PG8_SB(1, 0), cB + kstepB, voffB); PG8_STAGE(PG8_SA(1, 0), cA + kstepA, voffA); PG8_STAGE(PG8_SB(1, 1), cB + hstepB + kstepB, voffB);
        PG8_WAIT_V(6); PG8_BAR;
    }
    for (;;) {
        const bool has_next = S.next(ui + 1, nxt);
        const char* nA = has_next ? PG8_ATILE(nxt.pm) : cA; const char* nB = has_next ? (const char*)g.Bt + (size_t)nxt.pn * tstepB : cB;
        for (int t = 0; t < nt; t += 2) {
            const bool last = (t == nt - 2);
            const char* a1 = cA + (size_t)(t + 1) * kstepA;
            const char* a2 = last ? nA : cA + (size_t)(t + 2) * kstepA; const char* b2 = last ? nB : cB + (size_t)(t + 2) * kstepB;
            const char* a3 = a2 + kstepA; const char* b3 = b2 + kstepB;
            if (last && has_next) S.a_ready(nxt);
            if constexpr (SP2) {
            PG8_LDB(B0, 0, 0); PG8_LDB(B1, 0, 1); PG8_SCHED; PG8_LDA(At, 0, 0); PG8_STAGE(PG8_SA(1, 1), a1 + hstepA, voffA);
            PG8_WAIT_V(8); PG8_WAIT_L(0); PG8_BAR; PG8_MMA(0, 0, At, B0); PG8_MMA(0, 1, At, B1); PG8_BAR; PG8_SCHED;
            PG8_LDA(At, 0, 1); PG8_STAGE(PG8_SB(0, 0), b2, voffB); PG8_STAGE(PG8_SB(0, 1), b2 + hstepB, voffB); PG8_STAGE(PG8_SA(0, 0), a2, voffA);
            PG8_WAIT_V(8); PG8_WAIT_L(0); PG8_BAR; PG8_MMA(1, 0, At, B0); PG8_MMA(1, 1, At, B1); PG8_BAR; PG8_SCHED;
            PG8_LDB(B0, 1, 0); PG8_LDB(B1, 1, 1); PG8_SCHED; PG8_LDA(At, 1, 0); PG8_STAGE(PG8_SA(0, 1), a2 + hstepA, voffA);
            PG8_WAIT_V(8); PG8_WAIT_L(0); PG8_BAR; PG8_MMA(0, 0, At, B0); PG8_MMA(0, 1, At, B1); PG8_BAR; PG8_SCHED;
            PG8_LDA(At, 1, 1); PG8_STAGE(PG8_SB(1, 0), b3, voffB); PG8_STAGE(PG8_SB(1, 1), b3 + hstepB, voffB); PG8_STAGE(PG8_SA(1, 0), a3, voffA);
            PG8_WAIT_V(8); PG8_WAIT_L(0); PG8_BAR; PG8_MMA(1, 0, At, B0); PG8_MMA(1, 1, At, B1); PG8_BAR; PG8_SCHED;
            } else {
            PG8_LDB(B0, 0, 0); PG8_SCHED; PG8_LDA(At, 0, 0); PG8_STAGE(PG8_SA(1, 1), a1 + hstepA, voffA);
            PG8_WAIT_L(8); PG8_BAR; PG8_WAIT_L(0); PG8_MMA(0, 0, At, B0); PG8_BAR; PG8_SCHED;
            PG8_LDB(B1, 0, 1); PG8_STAGE(PG8_SB(0, 0), b2, voffB);
            PG8_BAR; PG8_WAIT_L(0); PG8_MMA(0, 1, At, B1); PG8_BAR;
            PG8_LDA(At, 0, 1); PG8_STAGE(PG8_SA(0, 0), a2, voffA);
            PG8_BAR; PG8_WAIT_L(0); PG8_MMA(1, 0, At, B0); PG8_BAR; PG8_SCHED;
            PG8_STAGE(PG8_SB(0, 1), b2 + hstepB, voffB);
            PG8_WAIT_V(6); PG8_BAR; PG8_MMA(1, 1, At, B1); PG8_BAR;
            PG8_LDB(B0, 1, 0); PG8_SCHED; PG8_LDA(At, 1, 0); PG8_STAGE(PG8_SA(0, 1), a2 + hstepA, voffA);
            PG8_WAIT_L(8); PG8_BAR; PG8_WAIT_L(0); PG8_MMA(0, 0, At, B0); PG8_BAR; PG8_SCHED;
            PG8_LDB(B1, 1, 1); PG8_STAGE(PG8_SB(1, 0), b3, voffB);
            PG8_BAR; PG8_WAIT_L(0); PG8_MMA(0, 1, At, B1); PG8_BAR;
            PG8_LDA(At, 1, 1); PG8_STAGE(PG8_SA(1, 0), a3, voffA);
            PG8_BAR; PG8_WAIT_L(0); PG8_MMA(1, 0, At, B0); PG8_BAR; PG8_SCHED;
            PG8_STAGE(PG8_SB(1, 1), b3 + hstepB, voffB);
            PG8_WAIT_V(6); PG8_BAR; PG8_MMA(1, 1, At, B1); PG8_BAR;
            }
        }
        if constexpr (ALIGN_EPI) { if (wr == 0) PG8_BAR; }
        E(acc, cur, wr, wc, fr, fq); S.done(cur);
        if (!has_next) break;
#pragma unroll
        for (int a = 0; a < 2; ++a)
#pragma unroll
            for (int b = 0; b < 2; ++b)
#pragma unroll
                for (int m = 0; m < 4; ++m)
#pragma unroll
                    for (int n = 0; n < 2; ++n) acc[a][b][m][n] = (f32x4){0.f, 0.f, 0.f, 0.f};
        cur = nxt; cA = nA; cB = nB; ++ui;
        if constexpr (ALIGN_EPI) { if (wr == 1) PG8_BAR; }
    }
    PG8_WAIT_V(0);
    if constexpr (!ALIGN_EPI) { if (wr == 0) PG8_BAR; }
    PG8_BAR;
#undef PG8_ATILE
#undef PG8_SA
#undef PG8_SB
#undef PG8_STAGE
#undef PG8_LDA
#undef PG8_LDB
#undef PG8_MMA
#undef PG8_WAIT_V
#undef PG8_WAIT_L
#undef PG8_BAR
#undef PG8_SCHED
}
}
constexpr int NWAVES = 8;
#ifndef MK_MULTI
#define MK_MULTI 0
#endif

constexpr int BATCH = 16, T = 2048, D = 1024, FF = 4096, DEPTH = 4;
constexpr int M = BATCH * T;
constexpr int MH = M / 2;
constexpr int NKV = 1536;
constexpr int NQG = 1280;
constexpr int NCMP = 127;
constexpr float EPS = 1e-6f;

constexpr size_t MiB = 1u << 20;
constexpr size_t WS_CTL = 0, CTL_ZERO_BYTES = 64 * 1024;
constexpr size_t WS_MOD = 1 * MiB;
constexpr size_t WS_CB1 = 3 * MiB;
constexpr size_t WS_GATE = 4 * MiB;
constexpr size_t WS_KCV = 10 * MiB;
constexpr size_t WS_CH = 16 * MiB;
constexpr size_t WS_W = 32 * MiB;
constexpr size_t WS_KV = 128 * MiB;
constexpr size_t WS_HB = 224 * MiB;
constexpr size_t WS_Y = 288 * MiB;
constexpr size_t WS_BIG = 352 * MiB;
constexpr size_t WS_END = 480 * MiB;
constexpr size_t WO_AIN = 0;
constexpr size_t WO_AOUT = WO_AIN + 2ull * 2048 * 1024;
constexpr size_t WO_KV = WO_AOUT + 2ull * 1024 * 1024;
constexpr size_t WO_BIN = WO_KV + 1536ull * 1024;
constexpr size_t WO_BOUT = WO_BIN + 2ull * 1280 * 1024;
constexpr size_t WO_FIN = WO_BOUT + 2ull * 1024 * 1024;
constexpr size_t WO_FOUT = WO_FIN + 4ull * 4096 * 1024;
constexpr size_t WO_C1 = WO_FOUT + 4ull * 4096 * 1024;
constexpr size_t WO_END = WO_C1 + 2ull * 256 * 2048;
static_assert(WO_END * 2 <= 96 * MiB, "weights fit");
constexpr int CW_BAR = 1024;

constexpr int RING_OFF = 0, RING_BYTES = 131072;
constexpr int LDSCTL_OFF = RING_BYTES, MISC_OFF = LDSCTL_OFF + 320;
constexpr int LDS_BYTES = 147456;

#define GAS __attribute__((address_space(1)))
#define LAS __attribute__((address_space(3)))
typedef unsigned short bf16;
typedef unsigned v4u __attribute__((ext_vector_type(4)));
typedef unsigned v2u __attribute__((ext_vector_type(2)));
typedef float f32x4 __attribute__((ext_vector_type(4)));
typedef GAS unsigned gu32;
#define RLX_AGENT __ATOMIC_RELAXED, __HIP_MEMORY_SCOPE_AGENT
#define LDS_WAIT() asm volatile("s_waitcnt lgkmcnt(0)" ::: "memory")
#define VM_WAIT() asm volatile("s_waitcnt vmcnt(0)" ::: "memory")
__device__ __forceinline__ unsigned f2bf(float f) { unsigned u = __builtin_bit_cast(unsigned, f); return (u + 0x7fffu + ((u >> 16) & 1u)) >> 16; }
__device__ __forceinline__ unsigned pk2(float lo, float hi) { return f2bf(lo) | (f2bf(hi) << 16); }
__device__ __forceinline__ float bf_lo(unsigned w) { return __builtin_bit_cast(float, w << 16); }
__device__ __forceinline__ float bf_hi(unsigned w) { return __builtin_bit_cast(float, w & 0xffff0000u); }
__device__ __forceinline__ float bf1(bf16 h) { return __builtin_bit_cast(float, (unsigned)h << 16); }
__device__ __forceinline__ float wave_sum(float v) {
#pragma unroll
    for (int o = 1; o < 64; o <<= 1) v += __shfl_xor(v, o);
    return v;
}
__device__ __forceinline__ float wave_max(float v) {
#pragma unroll
    for (int o = 1; o < 64; o <<= 1) v = fmaxf(v, __shfl_xor(v, o));
    return v;
}

#define XB_TMO      128
#define XB_XCNT(j)  (256  + 64 * (j))
#define XB_XSUB(j)  (1280 + 64 * (j))
#define XB_XGEN(j)  (2304 + 64 * (j))
#define XB_TOP      3328
#define XB_TOPGEN   3392
#define XCD_BAR_WORDS 3456
#define XB_SPIN_CAP (1u << 18)

__device__ __forceinline__ unsigned xb_ld(unsigned* p)              { return __hip_atomic_load(p, __ATOMIC_RELAXED, __HIP_MEMORY_SCOPE_AGENT); }
__device__ __forceinline__ unsigned xb_add(unsigned* p, unsigned v) { return __hip_atomic_fetch_add(p, v, __ATOMIC_RELAXED, __HIP_MEMORY_SCOPE_AGENT); }
__device__ __forceinline__ unsigned xb_xcc_id() { return (unsigned)__builtin_amdgcn_s_getreg((3 << 11) | 20) & 0xFu; }
#define XB_SPIN(cond, bar) do { unsigned _sp = 0; while (cond) { __builtin_amdgcn_s_sleep(1); \
    if ((++_sp & 255u) == 0u) { if (xb_ld(&(bar)[XB_TMO])) break; if (_sp > XB_SPIN_CAP) { atomicAdd(&(bar)[XB_TMO], 1u); break; } } } } while (0)

struct XcdBarrier {
    unsigned* bar; unsigned x;
    volatile LAS unsigned* st;
};
__device__ __forceinline__ XcdBarrier xcd_barrier_post(unsigned* bar, volatile LAS unsigned* st) {
    XcdBarrier b; b.bar = bar; b.x = xb_xcc_id(); b.st = st;
    if (threadIdx.x == 0) (void)xb_add(&bar[XB_XCNT(b.x)], 1u);
    return b;
}
__device__ __forceinline__ void xcd_barrier_complete(unsigned* bar, unsigned x, unsigned& nloc, unsigned& nx) {
    const unsigned G = gridDim.x * gridDim.y * gridDim.z;
    unsigned sum, cnt, mine, sp = 0u;
    for (;;) {
        sum = 0u; cnt = 0u; mine = 0u;
#pragma unroll
        for (unsigned j = 0; j < 16; ++j) { const unsigned c = xb_ld(&bar[XB_XCNT(j)]); sum += c; cnt += (c > 0u) ? 1u : 0u; mine = (j == x) ? c : mine; }
        if (sum == G) break;
        __builtin_amdgcn_s_sleep(1);
        if ((++sp & 255u) == 0u) { if (xb_ld(&bar[XB_TMO])) break; if (sp > XB_SPIN_CAP) { atomicAdd(&bar[XB_TMO], 1u); break; } }
    }
    nloc = mine > 0u ? mine : 1u; nx = cnt > 0u ? cnt : 1u;
}
__device__ __forceinline__ void xcd_barrier(const XcdBarrier& b) {
    asm volatile("s_waitcnt vmcnt(0)" ::: "memory");
    __syncthreads();
    if (threadIdx.x == 0) {
        unsigned* bar = b.bar;
        __builtin_amdgcn_s_waitcnt(0);
        unsigned nloc = b.st[0], nx = b.st[1];
        if (nloc == 0u) { xcd_barrier_complete(bar, b.x, nloc, nx); b.st[0] = nloc; b.st[1] = nx; }
        const unsigned old = xb_add(&bar[XB_XSUB(b.x)], 1u);
        const unsigned gen = old / nloc;
        if (old + 1u == (gen + 1u) * nloc) {
            __builtin_amdgcn_fence(__ATOMIC_RELEASE, "agent");
            asm volatile("s_waitcnt vmcnt(0)" ::: "memory");
            const unsigned og = xb_add(&bar[XB_TOP], 1u);
            const unsigned tg = og / nx;
            if (og + 1u == (tg + 1u) * nx) xb_add(&bar[XB_TOPGEN], 1u);
            else XB_SPIN(xb_ld(&bar[XB_TOPGEN]) == tg, bar);
            __builtin_amdgcn_fence(__ATOMIC_ACQUIRE, "agent");
            xb_add(&bar[XB_XGEN(b.x)], 1u);
            asm volatile("s_waitcnt vmcnt(0)" ::: "memory");
        } else {
            XB_SPIN(xb_ld(&bar[XB_XGEN(b.x)]) == gen, bar);
            __builtin_amdgcn_fence(__ATOMIC_ACQUIRE, "agent");
            asm volatile("s_waitcnt vmcnt(0)" ::: "memory");
        }
    }
    __syncthreads();
}

struct Frame {
    LAS unsigned char* lds;
    int tid, lane, wave;
    int vcu, G;
};
__device__ __forceinline__ void tr_item(const float* W, int K, int ldw, int nvalid, bf16* WT, int nblk, LAS float* scr, int item, int lane) {
    const int kb = item / nblk, nb = item % nblk, k0 = 64 * kb, n0 = 32 * nb;
    const int nn = n0 + (lane & 31); const bool ok = nn < nvalid;
#pragma unroll 8
    for (int i = 0; i < 32; ++i) { const int kk = 2 * i + (lane >> 5); scr[kk * 33 + (lane & 31)] = ok ? W[(size_t)(k0 + kk) * ldw + nn] : 0.f; }
    LDS_WAIT(); asm volatile("" ::: "memory");
    const int c = lane & 7;
#pragma unroll
    for (int j = 0; j < 4; ++j) { const int n = (lane >> 3) + 8 * j; const LAS float* s = scr + (8 * c) * 33 + n;
        v4u o; o.x = pk2(s[0 * 33], s[1 * 33]); o.y = pk2(s[2 * 33], s[3 * 33]); o.z = pk2(s[4 * 33], s[5 * 33]); o.w = pk2(s[6 * 33], s[7 * 33]);
        *(GAS v4u*)(WT + (size_t)(n0 + n) * K + k0 + 8 * c) = o; }
    LDS_WAIT(); asm volatile("" ::: "memory");
}

struct Args { const float* in[24]; float* out; unsigned char* ws; int ph_lo, ph_hi; };
typedef const __attribute__((address_space(4))) Args* kargs_t;

__device__ __forceinline__ void p0_prologue(const Frame& F, kargs_t a) {
    LAS float* scr = (LAS float*)(F.lds + RING_OFF + F.wave * 16384);
    bf16* WB = (bf16*)(a->ws + WS_W);
    const int gw = F.vcu * NWAVES + F.wave, NGW = F.G * NWAVES;
    constexpr int I_AIN = 16 * 64, I_AOUT = 16 * 32, I_KV = 16 * 48, I_BIN = 16 * 40, I_BOUT = 16 * 32, I_FIN = 16 * 128, I_FOUT = 64 * 32, I_C1 = 32 * 8;
    constexpr int NITEMS = 2 * I_AIN + 2 * I_AOUT + I_KV + 2 * I_BIN + 2 * I_BOUT + 4 * I_FIN + 4 * I_FOUT + 2 * I_C1;
    for (int it = gw; it < NITEMS; it += NGW) {
        int r = it;
        if (r < 2 * I_AIN) { const int l = r / I_AIN; tr_item(a->in[5] + (size_t)l * 1024 * 2048, 1024, 2048, 2048, WB + WO_AIN + (size_t)l * 2048 * 1024, 64, scr, r % I_AIN, F.lane); continue; } r -= 2 * I_AIN;
        if (r < 2 * I_AOUT) { const int l = r / I_AOUT; tr_item(a->in[10] + (size_t)l * 1024 * 1024, 1024, 1024, 1024, WB + WO_AOUT + (size_t)l * 1024 * 1024, 32, scr, r % I_AOUT, F.lane); continue; } r -= 2 * I_AOUT;
        if (r < I_KV) { tr_item(a->in[14], 1024, 1536, 1536, WB + WO_KV, 48, scr, r, F.lane); continue; } r -= I_KV;
        if (r < 2 * I_BIN) { const int l = r / I_BIN; tr_item(a->in[20] + (size_t)l * 1024 * 1072, 1024, 1072, 1072, WB + WO_BIN + (size_t)l * 1280 * 1024, 40, scr, r % I_BIN, F.lane); continue; } r -= 2 * I_BIN;
        if (r < 2 * I_BOUT) { const int l = r / I_BOUT; tr_item(a->in[21] + (size_t)l * 1024 * 1024, 1024, 1024, 1024, WB + WO_BOUT + (size_t)l * 1024 * 1024, 32, scr, r % I_BOUT, F.lane); continue; } r -= 2 * I_BOUT;
        if (r < 4 * I_FIN) { const int l = r / I_FIN; tr_item(a->in[22] + (size_t)l * 1024 * 4096, 1024, 4096, 4096, WB + WO_FIN + (size_t)l * 4096 * 1024, 128, scr, r % I_FIN, F.lane); continue; } r -= 4 * I_FIN;
        if (r < 4 * I_FOUT) { const int l = r / I_FOUT; tr_item(a->in[23] + (size_t)l * 4096 * 1024, 4096, 1024, 1024, WB + WO_FOUT + (size_t)l * 1024 * 4096, 32, scr, r % I_FOUT, F.lane); continue; } r -= 4 * I_FOUT;
        { const int l = r / I_C1; tr_item(a->in[16] + (size_t)l * 2048 * 256, 2048, 256, 256, WB + WO_C1 + (size_t)l * 256 * 2048, 8, scr, r % I_C1, F.lane); }
    }
    __syncthreads();
    if (F.vcu < 208) {
        LAS float* cact = (LAS float*)(F.lds);
        LAS float* red = (LAS float*)(F.lds + 65536);
        for (int i = F.tid; i < 16 * 1024; i += NWAVES * 64) { const float c = a->in[1][i]; cact[i] = c / (1.0f + __expf(-c)); }
        __syncthreads();
        const int grp = F.vcu; const float* W; const float* bias; float* out; int ldw, n0, ostride;
        float* MOD = (float*)(a->ws + WS_MOD);
        if (grp < 192) { const int L = grp / 48; n0 = (grp % 48) * 128; W = a->in[2] + (size_t)L * 1024 * 6144; ldw = 6144; bias = a->in[3] + L * 6144; out = MOD + (size_t)L * 16 * 6144; ostride = 6144; }
        else { n0 = (grp - 192) * 128; W = a->in[11]; ldw = 2048; bias = a->in[12]; out = MOD + (size_t)4 * 16 * 6144; ostride = 2048; }
        float acc0[16], acc1[16];
#pragma unroll
        for (int b = 0; b < 16; ++b) { acc0[b] = 0.f; acc1[b] = 0.f; }
        const int kbeg = F.wave * 128;
        for (int k = kbeg; k < kbeg + 128; ++k) {
            const float2 w = *(const float2*)(W + (size_t)k * ldw + n0 + 2 * F.lane);
#pragma unroll
            for (int b = 0; b < 16; ++b) { const float cv = cact[b * 1024 + k]; acc0[b] += cv * w.x; acc1[b] += cv * w.y; }
        }
#pragma unroll
        for (int b = 0; b < 16; ++b) { red[(F.wave * 16 + b) * 128 + 2 * F.lane] = acc0[b]; red[(F.wave * 16 + b) * 128 + 2 * F.lane + 1] = acc1[b]; }
        __syncthreads();
        for (int o = F.tid; o < 2048; o += NWAVES * 64) { const int b = o >> 7, n = o & 127; float s = bias[n0 + n];
#pragma unroll
            for (int w = 0; w < 8; ++w) s += red[(w * 16 + b) * 128 + n];
            out[(size_t)b * ostride + n0 + n] = s; }
    } else if (F.vcu == 208) {
        const int j = F.tid >> 8, n = F.tid & 255; float s = a->in[17][j * 256 + n];
        const float* pos = a->in[15] + j * 2048; const float* w1 = a->in[16] + (size_t)j * 2048 * 256 + n;
        for (int kk = 0; kk < 2048; ++kk) s += pos[kk] * w1[(size_t)kk * 256];
        ((float*)(a->ws + WS_CB1))[j * 256 + n] = s;
    }
}

template <bool HAS_Y, bool HAS_H, bool HAS_KV>
__device__ __forceinline__ void norm_phase(const Frame& F, const float* xin, float* xout, const bf16* Y, const float* gy, const float* gate  ,
                                           const float* gn, const float* sh, const float* sc, int mstride, bf16* H,
                                           const float* gkv, const float* shkv, const float* sckv, int kvstride, bf16* HKV) {
    const int gw = F.vcu * NWAVES + F.wave, NGW = F.G * NWAVES;
    for (int blk = gw; blk < M / 16; blk += NGW) {
        const int b = blk / (T / 16);
        f32x4 A1[4], A2[4], A3[4], K2[4], K3[4];
#pragma unroll
        for (int j = 0; j < 4; ++j) { const int col = 256 * j + 4 * F.lane;
            if (HAS_Y) A1[j] = *(const f32x4*)(gate + (size_t)b * mstride + col) * *(const f32x4*)(gy + col);
            if (HAS_H) { A2[j] = *(const f32x4*)(gn + col) * (*(const f32x4*)(sc + (size_t)b * mstride + col) + 1.0f); A3[j] = *(const f32x4*)(sh + (size_t)b * mstride + col); }
            if (HAS_KV) { K2[j] = *(const f32x4*)(gkv + col) * (*(const f32x4*)(sckv + (size_t)b * kvstride + col) + 1.0f); K3[j] = *(const f32x4*)(shkv + (size_t)b * kvstride + col); }
        }
        for (int r = 0; r < 16; ++r) {
            const size_t m = (size_t)blk * 16 + r;
            f32x4 xv[4];
#pragma unroll
            for (int j = 0; j < 4; ++j) xv[j] = *(const f32x4*)(xin + m * D + 256 * j + 4 * F.lane);
            if (HAS_Y) {
                f32x4 yv[4]; float s = 0.f;
#pragma unroll
                for (int j = 0; j < 4; ++j) { const v2u w = *(const v2u*)(Y + m * D + 256 * j + 4 * F.lane); yv[j] = (f32x4){bf_lo(w.x), bf_hi(w.x), bf_lo(w.y), bf_hi(w.y)};
                    s += (yv[j].x * yv[j].x + yv[j].y * yv[j].y) + (yv[j].z * yv[j].z + yv[j].w * yv[j].w); }
                const float rstd = 1.0f / sqrtf(wave_sum(s) * (1.0f / D) + EPS);
#pragma unroll
                for (int j = 0; j < 4; ++j) { xv[j] = xv[j] + A1[j] * (yv[j] * rstd); *(f32x4*)(xout + m * D + 256 * j + 4 * F.lane) = xv[j]; }
            }
            if (HAS_H || HAS_KV) {
                float s = 0.f;
#pragma unroll
                for (int j = 0; j < 4; ++j) s += (xv[j].x * xv[j].x + xv[j].y * xv[j].y) + (xv[j].z * xv[j].z + xv[j].w * xv[j].w);
                const float rstd = 1.0f / sqrtf(wave_sum(s) * (1.0f / D) + EPS);
#pragma unroll
                for (int j = 0; j < 4; ++j) { const f32x4 xn = xv[j] * rstd;
                    if (HAS_H) { const f32x4 h = xn * A2[j] + A3[j]; v2u w; w.x = pk2(h.x, h.y); w.y = pk2(h.z, h.w); *(v2u*)(H + m * D + 256 * j + 4 * F.lane) = w; }
                    if (HAS_KV) { const f32x4 h = xn * K2[j] + K3[j]; v2u w; w.x = pk2(h.x, h.y); w.y = pk2(h.z, h.w); *(v2u*)(HKV + m * D + 256 * j + 4 * F.lane) = w; } }
            }
        }
    }
}

__device__ __forceinline__ void sgu_phase_naive(const Frame& F, const bf16* U, const bf16* V, const float* lng, const float* lnb, const float* ws, const float* bs, bf16* GT) {
    LAS float* vt = (LAS float*)(F.lds);
    LAS float* wm = (LAS float*)(F.lds + 65536);
    LAS float* st = (LAS float*)(F.lds + 132096);
    for (int ch = F.vcu; ch < M / 128; ch += F.G) {
        const size_t m0 = (size_t)ch * 128;
        __syncthreads();
        for (int r = 0; r < 16; ++r) { const int row = F.wave * 16 + r; float s = 0.f, q = 0.f; float xv[16];
#pragma unroll
            for (int j = 0; j < 4; ++j) { const v2u w = *(const v2u*)(V + (m0 + row) * D + 256 * j + 4 * F.lane); xv[4 * j] = bf_lo(w.x); xv[4 * j + 1] = bf_hi(w.x); xv[4 * j + 2] = bf_lo(w.y); xv[4 * j + 3] = bf_hi(w.y); }
#pragma unroll
            for (int e = 0; e < 16; ++e) s += xv[e];
            const float mean = wave_sum(s) * (1.0f / D);
#pragma unroll
            for (int e = 0; e < 16; ++e) { const float d = xv[e] - mean; q += d * d; }
            const float rstd = 1.0f / sqrtf(wave_sum(q) * (1.0f / D) + EPS);
            if (F.lane == 0) { st[row * 2] = mean; st[row * 2 + 1] = rstd; } }
        __syncthreads();
        for (int g = 0; g < 8; ++g) {
            for (int i = F.tid; i < 128 * 128; i += NWAVES * 64) { const int s = i >> 7, d = i & 127; const int c = g * 128 + d;
                vt[i] = (bf1(V[(m0 + s) * D + c]) - st[s * 2]) * st[s * 2 + 1] * lng[c] + lnb[c];
                const int t = i >> 7, s2 = i & 127; wm[s2 * 128 + t] = (s2 <= t) ? ws[(size_t)g * 16384 + t * 128 + s2] : 0.f; }
            __syncthreads();
            const int d = F.tid & 127, tq = __builtin_amdgcn_readfirstlane(F.tid >> 7);
            float acc[32];
#pragma unroll
            for (int i = 0; i < 32; ++i) acc[i] = 0.f;
            for (int s = 0; s < 128; ++s) { const float vv = vt[s * 128 + d];
#pragma unroll
                for (int i4 = 0; i4 < 8; ++i4) { const f32x4 w4 = *(const LAS f32x4*)(wm + s * 128 + tq * 32 + i4 * 4);
                    acc[i4 * 4] += w4.x * vv; acc[i4 * 4 + 1] += w4.y * vv; acc[i4 * 4 + 2] += w4.z * vv; acc[i4 * 4 + 3] += w4.w * vv; } }
#pragma unroll
            for (int i = 0; i < 32; ++i) { const int t = tq * 32 + i; const size_t idx = (m0 + t) * D + g * 128 + d;
                GT[idx] = (bf16)f2bf(bf1(U[idx]) * (acc[i] + bs[g * 128 + t])); }
            __syncthreads();
        }
    }
}

__device__ __forceinline__ void cmp2_phase(const Frame& F, const bf16* CH, const float* w2, const float* b2, bf16* KCV) {
    const int gw = F.vcu * NWAVES + F.wave, NGW = F.G * NWAVES;
    for (int it = gw; it < 2 * 8192; it += NGW) {
        const int j = it >> 13, r = it & 8191;
        float s = b2[j * 64 + F.lane];
        const bf16* hrow = CH + ((size_t)j * 8192 + r) * 256; const float* w = w2 + (size_t)j * 256 * 64 + F.lane;
        for (int h = 0; h < 256; ++h) s += bf1(hrow[h]) * w[h * 64];
        if ((r & 127) == 127) s = 0.f;
        KCV[((size_t)j * 8192 + r) * 64 + F.lane] = (bf16)f2bf(s);
    }
}

#if 0
__device__ __forceinline__ void attn_phase_naive(const Frame& F, const bf16* Q, const float* GATE, const float* KCV, const bf16* KV, bf16* O) {
    LAS float* wl = (LAS float*)(F.lds + F.wave * 4096);
    LAS float* qs = wl;
    LAS float* ps = wl + 256;
    LAS float* pc = wl + 512;
    LAS float* im = wl + 640;
    const int gw = F.vcu * NWAVES + F.wave, NGW = F.G * NWAVES, lane = F.lane;
    constexpr float L2E = 1.4426950408889634f;
    for (int it = gw; it < BATCH * 4 * T; it += NGW) {
        const int t = it & (T - 1), g = (it >> 11) & 3, b = it >> 13;
        const size_t m = (size_t)b * T + t;
#pragma unroll
        for (int hh = 0; hh < 4; ++hh) qs[hh * 64 + lane] = bf1(Q[m * 1024 + (g * 4 + hh) * 64 + lane]);
        float mx[4], ls[4], oa[4], outv[4];
#define ATT_SCORE_BF16(kp, sv) do { asm volatile("" ::: "memory"); sv[0] = sv[1] = sv[2] = sv[3] = 0.f; \
        _Pragma("unroll") for (int d8 = 0; d8 < 8; ++d8) { const v4u kk = *(const v4u*)((kp) + d8 * 8); float kf[8] = {bf_lo(kk.x), bf_hi(kk.x), bf_lo(kk.y), bf_hi(kk.y), bf_lo(kk.z), bf_hi(kk.z), bf_lo(kk.w), bf_hi(kk.w)}; \
            _Pragma("unroll") for (int hh = 0; hh < 4; ++hh) { const f32x4 q0 = *(const LAS f32x4*)(qs + hh * 64 + d8 * 8), q1 = *(const LAS f32x4*)(qs + hh * 64 + d8 * 8 + 4); \
                sv[hh] += (q0.x * kf[0] + q0.y * kf[1]) + (q0.z * kf[2] + q0.w * kf[3]) + (q1.x * kf[4] + q1.y * kf[5]) + (q1.z * kf[6] + q1.w * kf[7]); } } } while (0)
#define ATT_SCORE_F32(kp, sv) do { asm volatile("" ::: "memory"); sv[0] = sv[1] = sv[2] = sv[3] = 0.f; \
        _Pragma("unroll") for (int d4 = 0; d4 < 16; ++d4) { const f32x4 kk = *(const f32x4*)((kp) + d4 * 4); \
            _Pragma("unroll") for (int hh = 0; hh < 4; ++hh) { const f32x4 q0 = *(const LAS f32x4*)(qs + hh * 64 + d4 * 4); \
                sv[hh] += (q0.x * kk.x + q0.y * kk.y) + (q0.z * kk.z + q0.w * kk.w); } } } while (0)
#define ATT_SOFTMAX_STEP(sv, valid) do { \
        _Pragma("unroll") for (int hh = 0; hh < 4; ++hh) { const float s_ = (valid) ? sv[hh] : -INFINITY; const float bm = wave_max(s_); const float mn = fmaxf(mx[hh], bm); \
            const float scl = __builtin_amdgcn_exp2f((mx[hh] - mn) * L2E); const float p = __builtin_amdgcn_exp2f((s_ - mn) * L2E); \
            ls[hh] = ls[hh] * scl + wave_sum(p); oa[hh] *= scl; mx[hh] = mn; ps[lane * 4 + hh] = p; } } while (0)
        LDS_WAIT();
        const int ncv = (t >= 31) ? ((t - 31) >> 4) + 1 : 0;
        const float* kc = KCV + ((size_t)(b * 4 + g) * 128) * 64; const float* vc = KCV + (size_t)8192 * 64 + ((size_t)(b * 4 + g) * 128) * 64;
        float ocmp[4] = {0.f, 0.f, 0.f, 0.f};
        pc[lane] = 0.f; pc[64 + lane] = 0.f;
        if (ncv > 0) {
            float s0[4], s1[4];
            ATT_SCORE_F32(kc + (size_t)lane * 64, s0); ATT_SCORE_F32(kc + (size_t)(64 + lane) * 64, s1);
            float psum0 = 0.f, psum1 = 0.f; float p0[4], p1[4];
#pragma unroll
            for (int hh = 0; hh < 4; ++hh) { const float a0 = (lane < ncv) ? s0[hh] : -INFINITY, a1 = (64 + lane < ncv) ? s1[hh] : -INFINITY;
                const float mm = wave_max(fmaxf(a0, a1)); const float e0 = __builtin_amdgcn_exp2f((a0 - mm) * L2E), e1 = __builtin_amdgcn_exp2f((a1 - mm) * L2E);
                const float den = wave_sum(e0 + e1); p0[hh] = e0 / den; p1[hh] = e1 / den; psum0 += p0[hh]; psum1 += p1[hh]; }
            pc[lane] = psum0; pc[64 + lane] = psum1;
#pragma unroll
            for (int hh = 0; hh < 4; ++hh) ps[lane * 4 + hh] = p0[hh];
            LDS_WAIT();
            const int n0 = ncv < 64 ? ncv : 64;
            for (int key = 0; key < n0; ++key) { const f32x4 p4 = *(const LAS f32x4*)(ps + key * 4); const float vv = vc[(size_t)key * 64 + lane];
                ocmp[0] += p4.x * vv; ocmp[1] += p4.y * vv; ocmp[2] += p4.z * vv; ocmp[3] += p4.w * vv; }
            LDS_WAIT();
            if (ncv > 64) {
#pragma unroll
                for (int hh = 0; hh < 4; ++hh) ps[lane * 4 + hh] = p1[hh];
                LDS_WAIT();
                for (int key = 0; key < ncv - 64; ++key) { const f32x4 p4 = *(const LAS f32x4*)(ps + key * 4); const float vv = vc[(size_t)(64 + key) * 64 + lane];
                    ocmp[0] += p4.x * vv; ocmp[1] += p4.y * vv; ocmp[2] += p4.z * vv; ocmp[3] += p4.w * vv; }
            }
        }
        LDS_WAIT();
        const int cur = t >> 6;
        unsigned selmask;
        {
            float imp = 0.f; const int j = lane & 31;
#pragma unroll
            for (int c = -1; c <= 3; ++c) { const int cc = 4 * j + c; if (cc >= 0 && cc < NCMP) imp += pc[cc]; }
            if (j > cur) imp = -1.0f;
            if (j == 0 || j == cur || j == cur - 1) imp = 1e4f;
            im[j] = imp;
            LDS_WAIT();
            int rank = 0;
            for (int i = 0; i < 32; ++i) { const float o = im[i]; rank += (o > imp || (o == imp && i < j)) ? 1 : 0; }
            const unsigned long long bal = __ballot(rank < 16 && j <= cur);
            selmask = (unsigned)bal;
        }
#pragma unroll
        for (int hh = 0; hh < 4; ++hh) { mx[hh] = -INFINITY; ls[hh] = 0.f; oa[hh] = 0.f; }
        {
            const bf16* kb = KV + (size_t)b * T * NKV + 2 * 256 + g * 64; const bf16* vb = KV + (size_t)b * T * NKV + 3 * 256 + g * 64;
            for (int j = 0; j <= cur; ++j) {
                if (!((selmask >> j) & 1u)) continue;
                const int kpos = j * 64 + lane; float sv[4];
                ATT_SCORE_BF16(kb + (size_t)kpos * NKV, sv);
                LDS_WAIT();
                ATT_SOFTMAX_STEP(sv, kpos <= t);
                LDS_WAIT();
                for (int key = 0; key < 64; ++key) { const f32x4 p4 = *(const LAS f32x4*)(ps + key * 4); const float vv = bf1(vb[(size_t)(j * 64 + key) * NKV + lane]);
                    oa[0] += p4.x * vv; oa[1] += p4.y * vv; oa[2] += p4.z * vv; oa[3] += p4.w * vv; }
            }
        }
        const float* gt = GATE + m * 48 + g * 12;
#pragma unroll
        for (int hh = 0; hh < 4; ++hh) outv[hh] = gt[hh * 3 + 0] * ocmp[hh] + gt[hh * 3 + 1] * (oa[hh] / ls[hh]);
#pragma unroll
        for (int hh = 0; hh < 4; ++hh) { mx[hh] = -INFINITY; ls[hh] = 0.f; oa[hh] = 0.f; }
        {
            const bf16* kb = KV + (size_t)b * T * NKV + 4 * 256 + g * 64; const bf16* vb = KV + (size_t)b * T * NKV + 5 * 256 + g * 64;
            const int start = t - 511 > 0 ? t - 511 : 0;
            for (int k0 = start; k0 <= t; k0 += 64) {
                const int kpos = k0 + lane; const int kr = kpos <= t ? kpos : t; float sv[4];
                ATT_SCORE_BF16(kb + (size_t)kr * NKV, sv);
                LDS_WAIT();
                ATT_SOFTMAX_STEP(sv, kpos <= t);
                LDS_WAIT();
                const int nk = (t - k0 + 1) < 64 ? (t - k0 + 1) : 64;
                for (int key = 0; key < nk; ++key) { const f32x4 p4 = *(const LAS f32x4*)(ps + key * 4); const float vv = bf1(vb[(size_t)(k0 + key) * NKV + lane]);
                    oa[0] += p4.x * vv; oa[1] += p4.y * vv; oa[2] += p4.z * vv; oa[3] += p4.w * vv; }
            }
        }
#pragma unroll
        for (int hh = 0; hh < 4; ++hh) { outv[hh] += gt[hh * 3 + 2] * (oa[hh] / ls[hh]); O[m * 1024 + (g * 4 + hh) * 64 + lane] = (bf16)f2bf(outv[hh]); }
        LDS_WAIT();
#undef ATT_SCORE_BF16
#undef ATT_SCORE_F32
#undef ATT_SOFTMAX_STEP
    }
}
#endif
namespace nsa {
using bf16x8 = __attribute__((ext_vector_type(8))) short;
using s16x4 = __attribute__((ext_vector_type(4))) short;
using f32x16 = __attribute__((ext_vector_type(16))) float;
using u32x4 = __attribute__((ext_vector_type(4))) unsigned;
typedef __attribute__((address_space(3))) const char* lds_cptr;
typedef __attribute__((address_space(3))) char* lds_ptr;
constexpr int NSLOT = 3, SLOTB = 8192;
constexpr int LDS_K = 0, LDS_V = NSLOT * SLOTB, LDS_WS = 2 * NSLOT * SLOTB  , LDS_OST = LDS_WS + 8 * 512  ,
              LDS_PI = LDS_OST + 8 * 4096  , LDS_IMP = LDS_PI + 32768  , LDS_SELM = LDS_IMP + 8192  , LDS_END = LDS_SELM + 256;
static_assert(LDS_END <= 131072, "attention LDS map");
constexpr int THR = 8;
__device__ __forceinline__ int crow(int r, int hi) { return (r & 3) + 8 * (r >> 2) + 4 * hi; }
#define NSA_SBAR() __builtin_amdgcn_sched_barrier(0)
__device__ __forceinline__ void glds16(const void* gsrc, unsigned lds_dst) { unsigned keep;
    asm volatile("s_mov_b32 %0, m0\n\ts_mov_b32 m0, %2\n\ts_nop 0\n\tglobal_load_lds_dwordx4 %1, off\n\ts_mov_b32 m0, %0" : "=&s"(keep) : "v"(gsrc), "s"(lds_dst) : "memory"); }
typedef float f32x2_t __attribute__((ext_vector_type(2))); typedef __bf16 bf16x2_t __attribute__((ext_vector_type(2)));
__device__ __forceinline__ unsigned cvtpk_s(float lo, float hi) { f32x2_t v = {lo, hi}; bf16x2_t b = __builtin_convertvector(v, bf16x2_t); return __builtin_bit_cast(unsigned, b); }
#define NSA_WAIT_BAR(N) asm volatile("s_waitcnt vmcnt(" #N ") lgkmcnt(0)\n\ts_barrier" ::: "memory")

__device__ __forceinline__ void qkt(f32x16& p0, f32x16& p1, lds_cptr Kslot, const bf16x8* qr, const f32x16& cinit, int r32, int hi) {
    lds_cptr kb = Kslot + hi * 1024 + r32 * 16;
#pragma unroll
    for (int d0 = 0; d0 < 4; ++d0) {
        const bf16x8 b0 = *(const __attribute__((address_space(3))) bf16x8*)(kb + d0 * 2048);
        const bf16x8 b1 = *(const __attribute__((address_space(3))) bf16x8*)(kb + d0 * 2048 + 512);
        if (d0 == 0) { p0 = __builtin_amdgcn_mfma_f32_32x32x16_bf16(b0, qr[0], cinit, 0, 0, 0); p1 = __builtin_amdgcn_mfma_f32_32x32x16_bf16(b1, qr[0], cinit, 0, 0, 0); }
        else { p0 = __builtin_amdgcn_mfma_f32_32x32x16_bf16(b0, qr[d0], p0, 0, 0, 0); p1 = __builtin_amdgcn_mfma_f32_32x32x16_bf16(b1, qr[d0], p1, 0, 0, 0); } }
}
__device__ __forceinline__ float rowmax(const f32x16& p0, const f32x16& p1) {
    float a = fmaxf(fmaxf(p0[0], p0[1]), p1[0]), b = fmaxf(fmaxf(p0[2], p0[3]), p1[1]); a = fmaxf(fmaxf(a, p1[2]), p1[3]);
#pragma unroll
    for (int r = 4; r < 16; r += 4) { a = fmaxf(fmaxf(a, p0[r]), p0[r + 1]); b = fmaxf(fmaxf(b, p0[r + 2]), p0[r + 3]); a = fmaxf(fmaxf(a, p1[r]), p1[r + 1]); b = fmaxf(fmaxf(b, p1[r + 2]), p1[r + 3]); }
    const float m = fmaxf(a, b);
    auto rr = __builtin_amdgcn_permlane32_swap(__float_as_uint(m), __float_as_uint(m), false, false);
    return fmaxf(__uint_as_float(rr[0]), __uint_as_float(rr[1]));
}
__device__ __forceinline__ float xhalf_sum(float v) { auto rr = __builtin_amdgcn_permlane32_swap(__float_as_uint(v), __float_as_uint(v), false, false); return __uint_as_float(rr[0]) + __uint_as_float(rr[1]); }
__device__ __forceinline__ float xhalf_other(float v, int hi) { auto rr = __builtin_amdgcn_permlane32_swap(__float_as_uint(v), __float_as_uint(v), false, false); return hi ? __uint_as_float(rr[0]) : __uint_as_float(rr[1]); }
__device__ __forceinline__ void pv(f32x16* o, int vb, bf16x8 pa0, bf16x8 pa1, bf16x8 pa2, bf16x8 pa3) {
#pragma unroll
    for (int d0 = 0; d0 < 2; ++d0) { s16x4 lo[4], hi[4];
#pragma unroll
        for (int ks = 0; ks < 4; ++ks) {
            asm volatile("ds_read_b64_tr_b16 %0,%1 offset:%c2" : "=&v"(lo[ks]) : "v"(vb), "i"(d0 * 4096 + ks * 1024) : "memory");
            asm volatile("ds_read_b64_tr_b16 %0,%1 offset:%c2" : "=&v"(hi[ks]) : "v"(vb), "i"(d0 * 4096 + ks * 1024 + 512) : "memory"); }
        asm volatile("s_waitcnt lgkmcnt(0)" ::: "memory"); NSA_SBAR();
#define NSA_PK(k) (bf16x8){lo[k][0], lo[k][1], lo[k][2], lo[k][3], hi[k][0], hi[k][1], hi[k][2], hi[k][3]}
        o[d0] = __builtin_amdgcn_mfma_f32_32x32x16_bf16(pa0, NSA_PK(0), o[d0], 0, 0, 0);
        o[d0] = __builtin_amdgcn_mfma_f32_32x32x16_bf16(pa1, NSA_PK(1), o[d0], 0, 0, 0);
        o[d0] = __builtin_amdgcn_mfma_f32_32x32x16_bf16(pa2, NSA_PK(2), o[d0], 0, 0, 0);
        o[d0] = __builtin_amdgcn_mfma_f32_32x32x16_bf16(pa3, NSA_PK(3), o[d0], 0, 0, 0);
#undef NSA_PK
    }
}
__device__ __forceinline__ void mask_range(f32x16& p, int kb, int lo, int hi_) {
#pragma unroll
    for (int r = 0; r < 16; ++r) { const int kk = kb + (r & 3) + 8 * (r >> 2); if (kk < lo || kk > hi_) p[r] = -INFINITY; }
}
#define NSA_PACK(P0, P1) do { pw0 = (u32x4){cvtpk_s(P0[0], P0[1]), cvtpk_s(P0[2], P0[3]), cvtpk_s(P0[4], P0[5]), cvtpk_s(P0[6], P0[7])}; \
    pw1 = (u32x4){cvtpk_s(P0[8], P0[9]), cvtpk_s(P0[10], P0[11]), cvtpk_s(P0[12], P0[13]), cvtpk_s(P0[14], P0[15])}; \
    pw2 = (u32x4){cvtpk_s(P1[0], P1[1]), cvtpk_s(P1[2], P1[3]), cvtpk_s(P1[4], P1[5]), cvtpk_s(P1[6], P1[7])}; \
    pw3 = (u32x4){cvtpk_s(P1[8], P1[9]), cvtpk_s(P1[10], P1[11]), cvtpk_s(P1[12], P1[13]), cvtpk_s(P1[14], P1[15])}; } while (0)
#define NSA_PAF(k) __builtin_bit_cast(bf16x8, pw##k)

struct Tensors { const bf16* Q; const float* GATE; const bf16* KCV; const bf16* KV; bf16* O; };

template <int MODE>
__device__ __forceinline__ void flash_pass(lds_ptr shm, unsigned lds0, const bf16* Kh, const bf16* Vh, int qt, const bf16x8* qr, unsigned selmask, int tq, float gate,
                                           f32x16* otot, int wid, int lane, int r32, int hi) {
    constexpr int PITCH = NKV;
    const bf16* ksrc = Kh + (size_t)lane * PITCH + wid * 8;
    const bf16* vsrc = Vh + (size_t)(16 * (wid & 3) + (lane >> 2)) * PITCH + (wid >> 2) * 32 + (lane & 3) * 8;
    const unsigned kdst = lds0 + LDS_K + wid * 1024, vdst = lds0 + LDS_V + wid * 1024;
    __attribute__((address_space(3))) float* wsf = (__attribute__((address_space(3))) float*)(shm + LDS_WS) + wid * 128;
    const int vb0 = (int)(lds0 + LDS_V) + ((lane >> 4) & 1) * 32 + (lane & 3) * 8 + (4 * hi + ((lane & 15) >> 2)) * 64;
    const int NT = (MODE == 1) ? qt + 1 : (qt < 8 ? qt + 1 : 9);
#define NSA_TIX(i) ((MODE == 1) ? (i) : (qt - (i)))
#define NSA_DMA(i, slot) do { const int t_ = NSA_TIX(i); glds16(ksrc + (size_t)t_ * 64 * PITCH, (unsigned)__builtin_amdgcn_readfirstlane(kdst + (slot))); glds16(vsrc + (size_t)t_ * 64 * PITCH, (unsigned)__builtin_amdgcn_readfirstlane(vdst + (slot))); } while (0)
    NSA_DMA(0, 0);
    if (NT > 1) NSA_DMA(1, SLOTB);
    float mhat = 0.f, l_reg = 0.f; f32x16 o[2]; o[0] = f32x16{}; o[1] = f32x16{};
    int sl_cur = 0;
    for (int i = 0; i < NT; ++i) {
        if (i + 1 < NT) NSA_WAIT_BAR(2); else NSA_WAIT_BAR(0);
        { const int sl2 = (sl_cur >= SLOTB) ? sl_cur - SLOTB : sl_cur + 2 * SLOTB; if (i + 2 < NT) NSA_DMA(i + 2, sl2); }
        const int t = NSA_TIX(i);
        float cval = -mhat;
        if (MODE == 1) { if (!((selmask >> t) & 1u)) cval = -INFINITY; }
        f32x16 cin;
#pragma unroll
        for (int r = 0; r < 16; ++r) cin[r] = cval;
        f32x16 p0, p1;
        qkt(p0, p1, (lds_cptr)(shm + LDS_K + sl_cur), qr, cin, r32, hi);
        if (t == qt) { mask_range(p0, 4 * hi, 0, tq); mask_range(p1, 32 + 4 * hi, 0, tq); }
        if (MODE == 2) { if (t == qt - 8) { mask_range(p0, 4 * hi, tq + 1, 63); mask_range(p1, 32 + 4 * hi, tq + 1, 63); } }
        const float rm = rowmax(p0, p1);
        bool resc = false;
        if (i == 0 || __any(rm > (float)THR)) {
            const float dl = (i == 0) ? fmaxf(rm, -1e30f) : fmaxf(rm, 0.f); mhat += dl;
#pragma unroll
            for (int r = 0; r < 16; ++r) { p0[r] -= dl; p1[r] -= dl; }
            const float f = __builtin_amdgcn_exp2f(-dl); l_reg *= f; if (hi == 0) wsf[r32] = f; resc = (i != 0);
        }
        float sacc = 0.f;
#pragma unroll
        for (int r = 0; r < 16; ++r) { p0[r] = __builtin_amdgcn_exp2f(p0[r]); p1[r] = __builtin_amdgcn_exp2f(p1[r]); sacc += p0[r] + p1[r]; }
        l_reg += sacc;
        u32x4 pw0, pw1, pw2, pw3; NSA_PACK(p0, p1);
        if (resc) { asm volatile("s_waitcnt lgkmcnt(0)" ::: "memory");
#pragma unroll
            for (int d = 0; d < 2; ++d)
#pragma unroll
                for (int r = 0; r < 16; ++r) o[d][r] *= wsf[crow(r, hi)]; }
        pv(o, vb0 + sl_cur, NSA_PAF(0), NSA_PAF(1), NSA_PAF(2), NSA_PAF(3));
        sl_cur = (sl_cur == (NSLOT - 1) * SLOTB) ? 0 : sl_cur + SLOTB;
    }
    const float l = xhalf_sum(l_reg);
    asm volatile("s_waitcnt lgkmcnt(0)" ::: "memory");
    if (hi == 0) wsf[r32] = gate / l;
    asm volatile("s_waitcnt lgkmcnt(0)" ::: "memory");
#pragma unroll
    for (int r = 0; r < 16; ++r) { const float w = wsf[crow(r, hi)]; otot[0][r] += o[0][r] * w; otot[1][r] += o[1][r] * w; }
    asm volatile("s_waitcnt lgkmcnt(0)\n\ts_barrier" ::: "memory");
#undef NSA_TIX
#undef NSA_DMA
}

__device__ __forceinline__ void attn_unit(int b, int g, int qt, const Tensors& T_, lds_ptr shm, int tid_) {
    int tid = tid_; asm volatile("" : "+v"(tid));
    const int lane = tid & 63, r32 = lane & 31, hi = lane >> 5; const int wid = __builtin_amdgcn_readfirstlane(tid >> 6);
    const int hh = wid & 3, ts = wid >> 2, tq = ts * 32 + r32;
    const size_t m0 = (size_t)b * T + (size_t)qt * 64;
    const unsigned lds0 = (unsigned)(uintptr_t)shm;
    __attribute__((address_space(3))) float* wsf = (__attribute__((address_space(3))) float*)(shm + LDS_WS) + wid * 128;
    {
        const bf16* Kc = T_.KCV + (size_t)(b * 4 + g) * 128 * 64; const bf16* Vc = Kc + (size_t)8192 * 64;
        const bf16* ksrc = Kc + (size_t)lane * 64 + wid * 8;
        const bf16* vsrc = Vc + (size_t)(16 * (wid & 3) + (lane >> 2)) * 64 + (wid >> 2) * 32 + (lane & 3) * 8;
        const unsigned kdst = lds0 + LDS_K + wid * 1024, vdst = lds0 + LDS_V + wid * 1024;
        glds16(ksrc, (unsigned)__builtin_amdgcn_readfirstlane(kdst)); glds16(vsrc, (unsigned)__builtin_amdgcn_readfirstlane(vdst));
        glds16(ksrc + 64 * 64, (unsigned)__builtin_amdgcn_readfirstlane(kdst + SLOTB)); glds16(vsrc + 64 * 64, (unsigned)__builtin_amdgcn_readfirstlane(vdst + SLOTB));
    }
    bf16x8 qr[4];
    {
        const bf16* Qw = T_.Q + (m0 + ts * 32) * 1024 + (g * 4 + hh) * 64;
#pragma unroll
        for (int d0 = 0; d0 < 4; ++d0) qr[d0] = *reinterpret_cast<const bf16x8*>(&Qw[(size_t)r32 * 1024 + d0 * 16 + hi * 8]);
    }
    const float* gp = T_.GATE + (m0 + tq) * 48 + (g * 4 + hh) * 3;
    const float g_cmp = gp[0], g_sel = gp[1], g_win = gp[2];
    f32x16 otot[2];
    NSA_WAIT_BAR(0);
    {
        const int t = qt * 64 + tq;
        const int ncv = (t >= 31) ? ((t - 31) >> 4) + 1 : 0;
        f32x16 zero = f32x16{}; f32x16 pA0, pA1, pB0, pB1;
        qkt(pA0, pA1, (lds_cptr)(shm + LDS_K), qr, zero, r32, hi);
        qkt(pB0, pB1, (lds_cptr)(shm + LDS_K + SLOTB), qr, zero, r32, hi);
        mask_range(pA0, 4 * hi, 0, ncv - 1); mask_range(pA1, 32 + 4 * hi, 0, ncv - 1); mask_range(pB0, 64 + 4 * hi, 0, ncv - 1); mask_range(pB1, 96 + 4 * hi, 0, ncv - 1);
        const float m = fmaxf(fmaxf(rowmax(pA0, pA1), rowmax(pB0, pB1)), -1e30f);
        float sacc = 0.f;
#pragma unroll
        for (int r = 0; r < 16; ++r) { pA0[r] = __builtin_amdgcn_exp2f(pA0[r] - m); pA1[r] = __builtin_amdgcn_exp2f(pA1[r] - m); pB0[r] = __builtin_amdgcn_exp2f(pB0[r] - m); pB1[r] = __builtin_amdgcn_exp2f(pB1[r] - m);
            sacc += (pA0[r] + pA1[r]) + (pB0[r] + pB1[r]); }
        const float l = xhalf_sum(sacc); const float inv = l > 0.f ? 1.0f / l : 0.f;
#pragma unroll
        for (int r = 0; r < 16; ++r) { pA0[r] *= inv; pA1[r] *= inv; pB0[r] *= inv; pB1[r] *= inv; }
        {
            __attribute__((address_space(3))) float* PI = (__attribute__((address_space(3))) float*)(shm + LDS_PI) + (hh * 64 + tq) * 32;
            float prev_oth = 0.f;
#define NSA_GRP(P, blk) _Pragma("unroll") for (int q4 = 0; q4 < 4; ++q4) { const int k = (blk) * 4 + q4; const float Gs = (P[4 * q4] + P[4 * q4 + 1]) + (P[4 * q4 + 2] + P[4 * q4 + 3]); \
                const float oth = xhalf_other(P[4 * q4 + 3], hi); PI[2 * k + hi] = Gs + (hi ? oth : prev_oth); prev_oth = oth; }
            NSA_GRP(pA0, 0) NSA_GRP(pA1, 1) NSA_GRP(pB0, 2) NSA_GRP(pB1, 3)
#undef NSA_GRP
        }
        otot[0] = f32x16{}; otot[1] = f32x16{};
        const int vb0 = (int)(lds0 + LDS_V) + ((lane >> 4) & 1) * 32 + (lane & 3) * 8 + (4 * hi + ((lane & 15) >> 2)) * 64;
        u32x4 pw0, pw1, pw2, pw3;
        NSA_PACK(pA0, pA1); pv(otot, vb0, NSA_PAF(0), NSA_PAF(1), NSA_PAF(2), NSA_PAF(3));
        NSA_PACK(pB0, pB1); pv(otot, vb0 + SLOTB, NSA_PAF(0), NSA_PAF(1), NSA_PAF(2), NSA_PAF(3));
        if (hi == 0) wsf[r32] = g_cmp;
        asm volatile("s_waitcnt lgkmcnt(0)" ::: "memory");
#pragma unroll
        for (int r = 0; r < 16; ++r) { const float w = wsf[crow(r, hi)]; otot[0][r] *= w; otot[1][r] *= w; }
    }
    asm volatile("s_waitcnt lgkmcnt(0)\n\ts_barrier" ::: "memory");
    {
        const __attribute__((address_space(3))) float* PI = (const __attribute__((address_space(3))) float*)(shm + LDS_PI);
        __attribute__((address_space(3))) float* IMP = (__attribute__((address_space(3))) float*)(shm + LDS_IMP);
        __attribute__((address_space(3))) unsigned* SELM = (__attribute__((address_space(3))) unsigned*)(shm + LDS_SELM);
#pragma unroll
        for (int it = 0; it < 4; ++it) { const int idx = tid + it * 512, tok = idx >> 5, j = idx & 31;
            float imp = ((PI[(0 * 64 + tok) * 32 + j] + PI[(1 * 64 + tok) * 32 + j]) + PI[(2 * 64 + tok) * 32 + j]) + PI[(3 * 64 + tok) * 32 + j];
            if (j > qt) imp = -1.0f;
            if (j == 0 || j == qt || j == qt - 1) imp = 1e4f;
            IMP[idx] = imp; }
        asm volatile("s_waitcnt lgkmcnt(0)\n\ts_barrier" ::: "memory");
#pragma unroll
        for (int it = 0; it < 4; ++it) { const int idx = tid + it * 512, tok = idx >> 5, j = idx & 31;
            const float mine = IMP[idx]; int rank = 0;
#pragma unroll
            for (int i4 = 0; i4 < 8; ++i4) { const f32x4 o4 = *(const __attribute__((address_space(3))) f32x4*)(IMP + tok * 32 + i4 * 4);
                rank += (o4.x > mine || (o4.x == mine && i4 * 4 + 0 < j)) ? 1 : 0; rank += (o4.y > mine || (o4.y == mine && i4 * 4 + 1 < j)) ? 1 : 0;
                rank += (o4.z > mine || (o4.z == mine && i4 * 4 + 2 < j)) ? 1 : 0; rank += (o4.w > mine || (o4.w == mine && i4 * 4 + 3 < j)) ? 1 : 0; }
            const unsigned long long bal = __ballot(rank < 16 && j <= qt);
            if (lane == 0) SELM[tok] = (unsigned)bal;
            if (lane == 32) SELM[tok] = (unsigned)(bal >> 32); }
        asm volatile("s_waitcnt lgkmcnt(0)\n\ts_barrier" ::: "memory");
    }
    const unsigned selmask = ((const __attribute__((address_space(3))) unsigned*)(shm + LDS_SELM))[tq];
    const bf16* KVb = T_.KV + (size_t)b * T * NKV + g * 64;
    flash_pass<1>(shm, lds0, KVb + 2 * 256, KVb + 3 * 256, qt, qr, selmask, tq, g_sel, otot, wid, lane, r32, hi);
    flash_pass<2>(shm, lds0, KVb + 4 * 256, KVb + 5 * 256, qt, qr, 0u, tq, g_win, otot, wid, lane, r32, hi);
    {
        bf16* Ow = T_.O + (m0 + ts * 32) * 1024 + (g * 4 + hh) * 64;
        __attribute__((address_space(3))) bf16* stg = (__attribute__((address_space(3))) bf16*)(shm + LDS_OST) + wid * 2048;
#pragma unroll
        for (int r = 0; r < 16; ++r) { const int orow = crow(r, hi);
#pragma unroll
            for (int d0 = 0; d0 < 2; ++d0) stg[orow * 64 + d0 * 32 + r32] = (bf16)f2bf(otot[d0][r]); }
        asm volatile("s_waitcnt lgkmcnt(0)" ::: "memory");
#pragma unroll
        for (int i = 0; i < 4; ++i) { const int row = i * 8 + (lane >> 3), ch = lane & 7; const u32x4 v = *(const __attribute__((address_space(3))) u32x4*)(stg + row * 64 + ch * 8); *(u32x4*)(Ow + (size_t)row * 1024 + ch * 8) = v; }
    }
    asm volatile("s_waitcnt lgkmcnt(0)\n\ts_barrier" ::: "memory");
}

__device__ __forceinline__ void attn_phase(const Frame& F, const Tensors& T_) {
    lds_ptr shm = (lds_ptr)(F.lds + RING_OFF);
    for (int v = F.vcu; v < BATCH * 4 * 4; v += F.G) {
        const int bg = v >> 2, s = v & 3;
#pragma unroll 1
        for (int i = 0; i < 8; ++i) { const int qt = (i & 1) ? (8 * (i >> 1) + 7 - s) : (8 * (i >> 1) + s);
            attn_unit(bg >> 2, bg & 3, qt, T_, shm, F.tid); }
    }
}
#undef NSA_SBAR
#undef NSA_WAIT_BAR
#undef NSA_PACK
#undef NSA_PAF
}
__global__ void __launch_bounds__(NWAVES * 64, 2) fwd(Args args) {
    extern __shared__ __attribute__((aligned(16))) unsigned char lds[];
    Frame F;
    F.lds = (LAS unsigned char*)lds;
    volatile LAS unsigned* MISC = (volatile LAS unsigned*)(F.lds + MISC_OFF);
    F.tid = threadIdx.x; F.lane = F.tid & 63; F.wave = __builtin_amdgcn_readfirstlane(F.tid >> 6);
    F.G = gridDim.x; { const int bx = blockIdx.x; F.vcu = (F.G % 8 == 0) ? (bx % 8) * (F.G / 8) + bx / 8 : bx; }
    for (int u = F.tid; u < (LDS_BYTES - LDSCTL_OFF) / 4; u += NWAVES * 64) ((LAS unsigned*)(F.lds + LDSCTL_OFF))[u] = 0u;
    __syncthreads();
#if !MK_MULTI
    XcdBarrier bar = xcd_barrier_post((unsigned*)(args.ws + WS_CTL) + CW_BAR, MISC + 8);
#define GRID_BAR() xcd_barrier(bar)
#else
#define GRID_BAR() do {} while (0)
#endif
    const int lo = args.ph_lo, hi = args.ph_hi;
    int ph = 0;
#define PH_BEGIN if (ph >= lo && ph < hi) { Frame Fp = F; asm volatile("" : "+v"(Fp.tid), "+v"(Fp.lane)); \
        kargs_t KA = (kargs_t)__builtin_amdgcn_kernarg_segment_ptr(); asm volatile("" : "+s"(KA)); \
        unsigned char* const ws = KA->ws; LAS unsigned char* const ring = Fp.lds + RING_OFF; const int bx = (int)blockIdx.x; (void)ws; (void)ring; (void)bx;
#define PH_END   if (ph + 1 < hi) GRID_BAR(); } ++ph;
#define P_MOD   ((float*)(ws + WS_MOD))
#define P_KVMOD (P_MOD + (size_t)4 * 16 * 6144)
#define P_CB1   ((float*)(ws + WS_CB1))
#define P_GATE  ((float*)(ws + WS_GATE))
#define P_KCV   ((bf16*)(ws + WS_KCV))
#define P_CH    ((bf16*)(ws + WS_CH))
#define P_WB    ((bf16*)(ws + WS_W))
#define P_KV    ((bf16*)(ws + WS_KV))
#define P_HB    ((bf16*)(ws + WS_HB))
#define P_Y     ((bf16*)(ws + WS_Y))
#define P_BIG   ((bf16*)(ws + WS_BIG))
#define P_U     P_BIG
#define P_V     (P_BIG + (size_t)M * D)
#define P_Q     P_BIG
#define P_O     (P_BIG + (size_t)M * D)
#define P_HKV   P_O
#define P_HID   P_BIG
#define P_NG(L, i) (KA->in[4] + ((L) * 4 + (i)) * 1024)

    PH_BEGIN p0_prologue(Fp, KA); PH_END
    PH_BEGIN norm_phase<false, true, false>(Fp, KA->in[0], nullptr, nullptr, nullptr, nullptr, P_NG(0, 0), P_MOD + 0, P_MOD + 1024, 6144, P_HB, nullptr, nullptr, nullptr, 0, nullptr); PH_END

#pragma unroll 1
    for (int L = 0; L < DEPTH; ++L) {
        if (L < 2) {
            PH_BEGIN {
                pg8::Gemm g = pg8::make_gemm(P_HB, P_WB + WO_AIN + (size_t)L * 2048 * 1024, M, 2048, D); pg8::StaticOrder S; S.init(M, 2048, Fp.G, bx);
                pg8::EpiBf16<2> E{P_U, D, nullptr, 1024, (size_t)M * D, 1.f};
                pg8::gemm_phase<pg8::EpiBf16<2>, pg8::StaticOrder, true, true>(ring, g, S, E);
            } PH_END
            PH_BEGIN sgu_phase_naive(Fp, P_U, P_V, KA->in[6] + L * 1024, KA->in[7] + L * 1024, KA->in[8] + (size_t)L * 8 * 128 * 128, KA->in[9] + L * 8 * 128, P_HB); PH_END
            PH_BEGIN {
                pg8::Gemm g = pg8::make_gemm(P_HB, P_WB + WO_AOUT + (size_t)L * 1024 * 1024, M, D, D); pg8::StaticOrder S; S.init(M, D, Fp.G, bx);
                pg8::EpiBf16<0> E{P_Y, D, nullptr, 0, 0, 1.f};
                pg8::gemm_phase<pg8::EpiBf16<0>, pg8::StaticOrder, true, true>(ring, g, S, E);
            } PH_END
        } else {
            PH_BEGIN {
                if (L == 2) {
                    pg8::Gemm g = pg8::make_gemm(P_HKV, P_WB + WO_KV, M, NKV, D); pg8::StaticOrder S; S.init(M, NKV, Fp.G, bx);
                    pg8::EpiBf16<0> E{P_KV, NKV, nullptr, 0, 0, 1.f};
                    pg8::gemm_phase<pg8::EpiBf16<0>, pg8::StaticOrder, true, true>(ring, g, S, E);
                }
                {
                    pg8::Gemm g = pg8::make_gemm(P_HB, P_WB + WO_BIN + (size_t)(L - 2) * NQG * 1024, M, NQG, D); pg8::StaticOrder S; S.init(M, NQG, Fp.G, bx);
                    pg8::EpiQG E{P_Q, P_GATE, 0.125f * 1.4426950408889634f};
                    pg8::gemm_phase<pg8::EpiQG, pg8::StaticOrder, true, true>(ring, g, S, E);
                }
            } PH_END
            if (L == 2) {
                PH_BEGIN {
#pragma unroll 1
                    for (int j = 0; j < 2; ++j) {
                        pg8::Gemm g; g.A = P_KV + j * 256; g.Bt = P_WB + WO_C1 + (size_t)j * 256 * 2048; g.M = 8192; g.N = 256; g.K = 2048;
                        g.a_rs = 16u * NKV * 2u; g.a_hstep = 64 * 2; g.a_kstep = (size_t)NKV * 2; g.a_t1 = (size_t)T * NKV * 2; g.a_t0 = 128 * 2; g.a_sh = 1;
                        pg8::StaticOrder S; S.init(8192, 256, Fp.G, (bx + j * 128) % Fp.G);
                        pg8::EpiBf16<2> E{P_CH + (size_t)j * 8192 * 256, 256, P_CB1 + j * 256, 0, 0, 1.f};
                        pg8::gemm_phase<pg8::EpiBf16<2>, pg8::StaticOrder, true, true>(ring, g, S, E);
                    }
                } PH_END
                PH_BEGIN cmp2_phase(Fp, P_CH, KA->in[18], KA->in[19], P_KCV); PH_END
            }
            PH_BEGIN { const nsa::Tensors AT{P_Q, P_GATE, P_KCV, P_KV, P_O}; nsa::attn_phase(Fp, AT); } PH_END
            PH_BEGIN {
                pg8::Gemm g = pg8::make_gemm(P_O, P_WB + WO_BOUT + (size_t)(L - 2) * 1024 * 1024, M, D, D); pg8::StaticOrder S; S.init(M, D, Fp.G, bx);
                pg8::EpiBf16<0> E{P_Y, D, nullptr, 0, 0, 1.f};
                pg8::gemm_phase<pg8::EpiBf16<0>, pg8::StaticOrder, true, true>(ring, g, S, E);
            } PH_END
        }
        PH_BEGIN { const float* modL = P_MOD + (size_t)L * 16 * 6144; const float* xcur = (L == 0) ? KA->in[0] : (const float*)KA->out;
            norm_phase<true, true, false>(Fp, xcur, KA->out, P_Y, P_NG(L, 1), modL + 2 * 1024, P_NG(L, 2), modL + 3 * 1024, modL + 4 * 1024, 6144, P_HB, nullptr, nullptr, nullptr, 0, nullptr); } PH_END
#pragma unroll 1
        for (int hf = 0; hf < 2; ++hf) {
            PH_BEGIN {
                pg8::Gemm g = pg8::make_gemm(P_HB + (size_t)hf * MH * D, P_WB + WO_FIN + (size_t)L * 4096 * 1024, MH, FF, D); pg8::StaticOrder S; S.init(MH, FF, Fp.G, bx);
                pg8::EpiBf16<3> E{P_HID, FF, nullptr, 0, 0, 1.f};
                pg8::gemm_phase<pg8::EpiBf16<3>, pg8::StaticOrder, true, true>(ring, g, S, E);
            } PH_END
            PH_BEGIN {
                pg8::Gemm g = pg8::make_gemm(P_HID, P_WB + WO_FOUT + (size_t)L * 1024 * 4096, MH, D, FF); pg8::StaticOrder S; S.init(MH, D, Fp.G, bx);
                pg8::EpiBf16<0> E{P_Y + (size_t)hf * MH * D, D, nullptr, 0, 0, 1.f};
                pg8::gemm_phase<pg8::EpiBf16<0>, pg8::StaticOrder, true, true>(ring, g, S, E);
            } PH_END
        }
        PH_BEGIN {
            const float* modL = P_MOD + (size_t)L * 16 * 6144; float* xo = KA->out;
            const float* gy = P_NG(L, 3); const float* gate = modL + 5 * 1024;
            if (L == 3) norm_phase<true, false, false>(Fp, xo, xo, P_Y, gy, gate, nullptr, nullptr, nullptr, 6144, nullptr, nullptr, nullptr, nullptr, 0, nullptr);
            else { const float* modN = P_MOD + (size_t)(L + 1) * 16 * 6144; const float* gn = P_NG(L + 1, 0);
                if (L == 1) norm_phase<true, true, true>(Fp, xo, xo, P_Y, gy, gate, gn, modN + 0, modN + 1024, 6144, P_HB, KA->in[13], P_KVMOD + 0, P_KVMOD + 1024, 2048, P_HKV);
                else norm_phase<true, true, false>(Fp, xo, xo, P_Y, gy, gate, gn, modN + 0, modN + 1024, 6144, P_HB, nullptr, nullptr, nullptr, 0, nullptr); }
        } PH_END
    }
#undef PH_BEGIN
#undef PH_END
#undef GRID_BAR
}

extern "C" void kernel_launch(void* const* d_in, const int* in_sizes, int n_in, void* d_out, int out_size, void* d_ws, size_t ws_size, hipStream_t stream) {
    static int grid = 0;
    if (grid == 0) {
        if (n_in != 24 || out_size != M * D || ws_size < WS_END) { fprintf(stderr, "kernel_launch: unexpected shapes (n_in %d, out %d, ws %zu)\n", n_in, out_size, ws_size); grid = -1; return; }
        int dev = 0, cus = 0, per_cu = 0;
        if (hipGetDevice(&dev) != hipSuccess || hipDeviceGetAttribute(&cus, hipDeviceAttributeMultiprocessorCount, dev) != hipSuccess) { grid = -1; return; }
        if (hipFuncSetAttribute((const void*)fwd, hipFuncAttributeMaxDynamicSharedMemorySize, LDS_BYTES) != hipSuccess) { grid = -1; return; }
        if (hipOccupancyMaxActiveBlocksPerMultiprocessor(&per_cu, (const void*)fwd, NWAVES * 64, LDS_BYTES) != hipSuccess || per_cu < 1)
            fprintf(stderr, "kernel_launch: occupancy query reports %d workgroups per CU\n", per_cu);
        (void)hipGetLastError();
        grid = cus;
    }
    if (grid < 0) return;
    if (hipMemsetAsync((char*)d_ws + WS_CTL, 0, CTL_ZERO_BYTES, stream) != hipSuccess) return;
    Args a{};
    for (int i = 0; i < 24; ++i) a.in[i] = (const float*)d_in[i];
    a.out = (float*)d_out; a.ws = (unsigned char*)d_ws;
#if MK_MULTI
    for (int p = 0; p < 40; ++p) { a.ph_lo = p; a.ph_hi = p + 1; hipLaunchKernelGGL(fwd, dim3(grid), dim3(NWAVES * 64), LDS_BYTES, stream, a); }
#else
    a.ph_lo = 0; a.ph_hi = 1000; hipLaunchKernelGGL(fwd, dim3(grid), dim3(NWAVES * 64), LDS_BYTES, stream, a);
#endif
}
```

```cpp
#include <hip/hip_runtime.h>
#include <cstdio>
#include <cstdint>
#include <cmath>
#define MK_MULTI 0
namespace pg8 {
#define PG8_LAS __attribute__((address_space(3)))
typedef unsigned short bf16_t;
typedef short bf16x8 __attribute__((ext_vector_type(8)));
typedef float f32x4 __attribute__((ext_vector_type(4)));
typedef unsigned u32x4 __attribute__((ext_vector_type(4)));
constexpr int BM = 256, BK = 64, HALF = 128, HTB = HALF * BK * 2  , STAGE_BYTES = 8 * HTB, NXCD = 8, WGM = 8;

__host__ __device__ __forceinline__ int lds_byte(int r, int c) { const int st = (r >> 4) * 2 + (c >> 5), rr = r & 15, cc = c & 31, ob = rr * 64 + cc * 2; return st * 1024 + (ob ^ (((ob >> 9) & 1) << 5)); }
__host__ __device__ __forceinline__ void stage_rc(int b, int& R, int& C) { const int st = b / 1024, sb = b % 1024, swz = sb ^ (((sb >> 9) & 1) << 5); R = (st >> 1) * 16 + swz / 64; C = (st & 1) * 32 + (swz % 64) / 2; }
__host__ __device__ __forceinline__ int perm32(int rho) { const int n = rho >> 4, i = rho & 15; return 8 * (i >> 2) + 4 * n + (i & 3); }

struct Unit { int pm, pn; };
struct Gemm { const bf16_t* A; const bf16_t* Bt; int M, N, K; unsigned a_rs; size_t a_hstep, a_kstep, a_t1, a_t0; int a_sh; };
__device__ __forceinline__ Gemm make_gemm(const bf16_t* A, const bf16_t* Bt, int M, int N, int K) {
    Gemm g; g.A = A; g.Bt = Bt; g.M = M; g.N = N; g.K = K; g.a_rs = (unsigned)K * 2u; g.a_hstep = (size_t)HALF * K * 2; g.a_kstep = BK * 2; g.a_t1 = (size_t)BM * K * 2; g.a_t0 = 0; g.a_sh = 0; return g; }

struct StaticOrder {
    int nM, nN, nwg, G, c;
    __host__ __device__ void init(int M, int N, int G_, int c_) { nM = M / BM; nN = N / BM; nwg = nM * nN; G = G_; c = c_; }
    __host__ __device__ bool next(int i, Unit& u) const {
        const long L = (long)i * G + c; if (L >= nwg) return false;
        int wgid = (int)L; { const int q = nwg / NXCD, r = nwg % NXCD, xcd = wgid % NXCD, off = wgid / NXCD; wgid = (xcd < r ? xcd * (q + 1) : r * (q + 1) + (xcd - r) * q) + off; }
        const int nig = WGM * nN, gid = wgid / nig, fm = gid * WGM, gsz = (nM - fm) < WGM ? (nM - fm) : WGM;
        u.pm = fm + ((wgid % nig) % gsz); u.pn = (wgid % nig) / gsz; return true;
    }
    __device__ __forceinline__ void a_ready(const Unit&) const {}
    __device__ __forceinline__ void done(const Unit&) const {}
};

__device__ __forceinline__ unsigned cvt_pk_bf16(float lo, float hi) { unsigned r; asm volatile("v_cvt_pk_bf16_f32 %0, %1, %2" : "=v"(r) : "v"(lo), "v"(hi)); return r; }
__device__ __forceinline__ float gelu_tanh(float v) {
    const float u = v * (0.7978845608028654f + 0.035677408136300125f * v * v);
    const float e = __builtin_amdgcn_exp2f(u * -2.8853900817779268f);
    return v * __builtin_amdgcn_rcpf(1.0f + e);
}
template <int ACT> __device__ __forceinline__ float act_fn(float v) {
    if (ACT == 2) return gelu_tanh(v);
    if (ACT == 3) { const float r = v > 0.f ? v : 0.f; return r * r; }
    return v;
}

template <int ACT  > struct EpiBf16 {
    static constexpr bool PERM = true, AFTER_DRAIN = false;
    bf16_t* O; int ldc; const float* bias; int split_cols; size_t split_stride; float scale0;
    __device__ __forceinline__ void operator()(const f32x4 (&acc)[2][2][4][2], const Unit& u, int wr, int wc, int fr, int fq) const {
        const int row0 = u.pm * BM + wr * 64 + fr; int colt = u.pn * BM; bf16_t* base = O;
        float sc = 1.f; if (split_cols) { const int t = colt / split_cols; base += (size_t)t * split_stride; colt -= t * split_cols; if (t == 0) sc = scale0; }
        const int col0 = colt + wc * 32 + 8 * fq, bcol0 = u.pn * BM + wc * 32 + 8 * fq;
        f32x4 bv[2][2];
#pragma unroll
        for (int bj = 0; bj < 2; ++bj)
#pragma unroll
            for (int n = 0; n < 2; ++n) bv[bj][n] = bias ? *(const f32x4*)(bias + bcol0 + bj * HALF + 4 * n) : (f32x4){0.f, 0.f, 0.f, 0.f};
#pragma unroll
        for (int ai = 0; ai < 2; ++ai)
#pragma unroll
            for (int m = 0; m < 4; ++m) { bf16_t* rowp = base + (size_t)(row0 + ai * HALF + m * 16) * ldc + col0;
#pragma unroll
                for (int bj = 0; bj < 2; ++bj) { f32x4 v0 = acc[ai][bj][m][0] + bv[bj][0], v1 = acc[ai][bj][m][1] + bv[bj][1];
                    if (ACT != 0) {
#pragma unroll
                        for (int e = 0; e < 4; ++e) { v0[e] = act_fn<ACT>(v0[e]); v1[e] = act_fn<ACT>(v1[e]); } }
                    v0 = v0 * sc; v1 = v1 * sc; u32x4 w; w.x = cvt_pk_bf16(v0[0], v0[1]); w.y = cvt_pk_bf16(v0[2], v0[3]); w.z = cvt_pk_bf16(v1[0], v1[1]); w.w = cvt_pk_bf16(v1[2], v1[3]);
                    *(u32x4*)(rowp + bj * HALF) = w; } }
    }
};
struct EpiQG {
    static constexpr bool PERM = true, AFTER_DRAIN = false;
    bf16_t* Q; float* G; float qscale;
    __device__ __forceinline__ void operator()(const f32x4 (&acc)[2][2][4][2], const Unit& u, int wr, int wc, int fr, int fq) const {
        const int row0 = u.pm * BM + wr * 64 + fr;
        if (u.pn < 4) {
            const int col0 = u.pn * BM + wc * 32 + 8 * fq;
#pragma unroll
            for (int ai = 0; ai < 2; ++ai)
#pragma unroll
                for (int m = 0; m < 4; ++m) { bf16_t* rowp = Q + (size_t)(row0 + ai * HALF + m * 16) * 1024 + col0;
#pragma unroll
                    for (int bj = 0; bj < 2; ++bj) { const f32x4 v0 = acc[ai][bj][m][0] * qscale, v1 = acc[ai][bj][m][1] * qscale;
                        u32x4 w; w.x = cvt_pk_bf16(v0[0], v0[1]); w.y = cvt_pk_bf16(v0[2], v0[3]); w.z = cvt_pk_bf16(v1[0], v1[1]); w.w = cvt_pk_bf16(v1[2], v1[3]);
                        *(u32x4*)(rowp + bj * HALF) = w; } }
        } else if (wc < 2) {
#pragma unroll
            for (int ai = 0; ai < 2; ++ai)
#pragma unroll
                for (int m = 0; m < 4; ++m) { float* rowp = G + (size_t)(row0 + ai * HALF + m * 16) * 48;
#pragma unroll
                    for (int n = 0; n < 2; ++n) { const int col = wc * 32 + 8 * fq + 4 * n;
                        if (col < 48) { f32x4 v = acc[ai][0][m][n];
#pragma unroll
                            for (int e = 0; e < 4; ++e) v[e] = __builtin_amdgcn_rcpf(1.0f + __builtin_amdgcn_exp2f(v[e] * -1.4426950408889634f));
                            *(f32x4*)(rowp + col) = v; } } }
        }
    }
};

template <class Epi, class Sched, bool ALIGN_EPI = false, bool SP2 = false>
__device__ __forceinline__ void gemm_phase(PG8_LAS unsigned char* lds, const Gemm g, const Sched& S, const Epi& E) {
    int tid_ = threadIdx.x; asm volatile("" : "+v"(tid_));
    const int tid = tid_, wid = __builtin_amdgcn_readfirstlane(tid >> 6), lane = tid & 63, wr = wid >> 2, wc = wid & 3, fr = lane & 15, fq = lane >> 4;
    const int K = g.K, nt = K / BK;
    unsigned voffA[2], voffB[2];
#pragma unroll
    for (int i = 0; i < 2; ++i) { int R, C; stage_rc(tid * 16 + i * 8192, R, C); const int Rb = Epi::PERM ? ((R & ~31) + perm32(R & 31)) : R;
        voffA[i] = (unsigned)R * g.a_rs + (unsigned)C * 2u; voffB[i] = (unsigned)(Rb * K + C) * 2u; }
    const size_t kstepA = g.a_kstep, kstepB = (size_t)(BK * 2);
    const size_t hstepA = g.a_hstep, hstepB = (size_t)HALF * K * 2;
    const size_t tstepB = 2 * hstepB;
    const int a_msk = (1 << g.a_sh) - 1;
#define PG8_ATILE(pm) ((const char*)g.A + (size_t)((pm) >> g.a_sh) * g.a_t1 + (size_t)((pm) & a_msk) * g.a_t0)
    const unsigned ldsw = (unsigned)wid * 1024u;
    const int aoff = lds_byte(wr * 64 + fr, fq * 8), boff = lds_byte(wc * 32 + fr, fq * 8);
#define PG8_SA(b, h) (((b) * 2 + (h)) * HTB)
#define PG8_SB(b, h) ((4 + (b) * 2 + (h)) * HTB)
#define PG8_STAGE(bufoff, gbase, voff) do { _Pragma("unroll") for (int _i = 0; _i < 2; ++_i) \
        __builtin_amdgcn_global_load_lds((const unsigned*)((const char*)(gbase) + (voff)[_i]), (PG8_LAS unsigned*)(lds + (bufoff) + ldsw + _i * 8192), 16, 0, 0); } while (0)
#define PG8_LDA(dst, b, h) do { _Pragma("unroll") for (int m = 0; m < 4; ++m) _Pragma("unroll") for (int k = 0; k < 2; ++k) dst[m][k] = *(const PG8_LAS bf16x8*)(lds + PG8_SA(b, h) + aoff + m * 2048 + k * 1024); } while (0)
#define PG8_LDB(dst, b, h) do { _Pragma("unroll") for (int n = 0; n < 2; ++n) _Pragma("unroll") for (int k = 0; k < 2; ++k) dst[n][k] = *(const PG8_LAS bf16x8*)(lds + PG8_SB(b, h) + boff + n * 2048 + k * 1024); } while (0)
#define PG8_MMA(ai, bj, At, Bt) do { __builtin_amdgcn_s_setprio(1); _Pragma("unroll") for (int m = 0; m < 4; ++m) _Pragma("unroll") for (int n = 0; n < 2; ++n) _Pragma("unroll") for (int k = 0; k < 2; ++k) \
        acc[ai][bj][m][n] = __builtin_amdgcn_mfma_f32_16x16x32_bf16(Bt[n][k], At[m][k], acc[ai][bj][m][n], 0, 0, 0); __builtin_amdgcn_s_setprio(0); } while (0)
#define PG8_WAIT_V(n) asm volatile("s_waitcnt vmcnt(" #n ")" ::: "memory")
#define PG8_WAIT_L(n) asm volatile("s_waitcnt lgkmcnt(" #n ")" ::: "memory")
#define PG8_BAR __builtin_amdgcn_s_barrier()
#define PG8_SCHED __builtin_amdgcn_sched_barrier(0)
    Unit cur, nxt; int ui = 0;
    if (!S.next(0, cur)) return;
    f32x4 acc[2][2][4][2];
#pragma unroll
    for (int a = 0; a < 2; ++a)
#pragma unroll
        for (int b = 0; b < 2; ++b)
#pragma unroll
            for (int m = 0; m < 4; ++m)
#pragma unroll
                for (int n = 0; n < 2; ++n) acc[a][b][m][n] = (f32x4){0.f, 0.f, 0.f, 0.f};
    bf16x8 At[4][2], B0[2][2], B1[2][2];
    const char* cA = PG8_ATILE(cur.pm); const char* cB = (const char*)g.Bt + (size_t)cur.pn * tstepB;
    S.a_ready(cur);
    if constexpr (SP2) {
        PG8_STAGE(PG8_SB(0, 0), cB, voffB); PG8_STAGE(PG8_SB(0, 1), cB + hstepB, voffB); PG8_STAGE(PG8_SA(0, 0), cA, voffA); PG8_STAGE(PG8_SA(0, 1), cA + hstepA, voffA);
        if (wr == 1) PG8_BAR;
        PG8_WAIT_V(2); PG8_BAR;
        PG8_STAGE(PG8_SB(1, 0), cB + kstepB, voffB); PG8_STAGE(PG8_SA(1, 0), cA + kstepA, voffA); PG8_STAGE(PG8_SB(1, 1), cB + hstepB + kstepB, voffB);
        PG8_WAIT_V(6); PG8_BAR;
    } else {
        PG8_STAGE(PG8_SB(0, 0), cB, voffB); PG8_STAGE(PG8_SA(0, 0), cA, voffA); PG8_STAGE(PG8_SB(0, 1), cB + hstepB, voffB); PG8_STAGE(PG8_SA(0, 1), cA + hstepA, voffA);
        if (wr == 1) PG8_BAR;
        PG8_WAIT_V(4); PG8_BAR;
        PG8_STAGE(PG8_SB(1, 0), cB + kstepB, voffB); PG8_STAGE(PG8_SA(1, 0), cA + kstepA, voffA); PG8_STAGE(PG8_SB(1, 1), cB + hstepB + kstepB, voffB);
        PG8_WAIT_V(6); PG8_BAR;
    }
    for (;;) {
        const bool has_next = S.next(ui + 1, nxt);
        const char* nA = has_next ? PG8_ATILE(nxt.pm) : cA; const char* nB = has_next ? (const char*)g.Bt + (size_t)nxt.pn * tstepB : cB;
        for (int t = 0; t < nt; t += 2) {
            const bool last = (t == nt - 2);
            const char* a1 = cA + (size_t)(t + 1) * kstepA;
            const char* a2 = last ? nA : cA + (size_t)(t + 2) * kstepA; const char* b2 = last ? nB : cB + (size_t)(t + 2) * kstepB;
            const char* a3 = a2 + kstepA; const char* b3 = b2 + kstepB;
            if (last && has_next) S.a_ready(nxt);
            if constexpr (SP2) {
            PG8_LDB(B0, 0, 0); PG8_LDB(B1, 0, 1); PG8_SCHED; PG8_LDA(At, 0, 0); PG8_STAGE(PG8_SA(1, 1), a1 + hstepA, voffA);
            PG8_WAIT_V(8); PG8_WAIT_L(0); PG8_BAR; PG8_MMA(0, 0, At, B0); PG8_MMA(0, 1, At, B1); PG8_BAR; PG8_SCHED;
            PG8_LDA(At, 0, 1); PG8_STAGE(PG8_SB(0, 0), b2, voffB); PG8_STAGE(PG8_SB(0, 1), b2 + hstepB, voffB); PG8_STAGE(PG8_SA(0, 0), a2, voffA);
            PG8_WAIT_V(8); PG8_WAIT_L(0); PG8_BAR; PG8_MMA(1, 0, At, B0); PG8_MMA(1, 1, At, B1); PG8_BAR; PG8_SCHED;
            PG8_LDB(B0, 1, 0); PG8_LDB(B1, 1, 1); PG8_SCHED; PG8_LDA(At, 1, 0); PG8_STAGE(PG8_SA(0, 1), a2 + hstepA, voffA);
            PG8_WAIT_V(8); PG8_WAIT_L(0); PG8_BAR; PG8_MMA(0, 0, At, B0); PG8_MMA(0, 1, At, B1); PG8_BAR; PG8_SCHED;
            PG8_LDA(At, 1, 1); PG8_STAGE(PG8_SB(1, 0), b3, voffB); PG8_STAGE(PG8_SB(1, 1), b3 + hstepB, voffB); PG8_STAGE(PG8_SA(1, 0), a3, voffA);
            PG8_WAIT_V(8); PG8_WAIT_L(0); PG8_BAR; PG8_MMA(1, 0, At, B0); PG8_MMA(1, 1, At, B1); PG8_BAR; PG8_SCHED;
            } else {
            PG8_LDB(B0, 0, 0); PG8_SCHED; PG8_LDA(At, 0, 0); PG8_STAGE(PG8_SA(1, 1), a1 + hstepA, voffA);
            PG8_WAIT_L(8); PG8_BAR; PG8_WAIT_L(0); PG8_MMA(0, 0, At, B0); PG8_BAR; PG8_SCHED;
            PG8_LDB(B1, 0, 1); PG8_STAGE(PG8_SB(0, 0), b2, voffB);
            PG8_BAR; PG8_WAIT_L(0); PG8_MMA(0, 1, At, B1); PG8_BAR;
            PG8_LDA(At, 0, 1); PG8_STAGE(PG8_SA(0, 0), a2, voffA);
            PG8_BAR; PG8_WAIT_L(0); PG8_MMA(1, 0, At, B0); PG8_BAR; PG8_SCHED;
            PG8_STAGE(PG8_SB(0, 1), b2 + hstepB, voffB);
            PG8_WAIT_V(6); PG8_BAR; PG8_MMA(1, 1, At, B1); PG8_BAR;
            PG8_LDB(B0, 1, 0); PG8_SCHED; PG8_LDA(At, 1, 0); PG8_STAGE(PG8_SA(0, 1), a2 + hstepA, voffA);
            PG8_WAIT_L(8); PG8_BAR; PG8_WAIT_L(0); PG8_MMA(0, 0, At, B0); PG8_BAR; PG8_SCHED;
            PG8_LDB(B1, 1, 1); PG8_STAGE(PG8_SB(1, 0), b3, voffB);
            PG8_BAR; PG8_WAIT_L(0); PG8_MMA(0, 1, At, B1); PG8_BAR;
            PG8_LDA(At, 1, 1); PG8_STAGE(PG8_SA(1, 0), a3, voffA);
            PG8_BAR; PG8_WAIT_L(0); PG8_MMA(1, 0, At, B0); PG8_BAR; PG8_SCHED;
            PG8_STAGE(PG8_SB(1, 1), b3 + hstepB, voffB);
            PG8_WAIT_V(6); PG8_BAR; PG8_MMA(1, 1, At, B1); PG8_BAR;
            }
        }
        if constexpr (ALIGN_EPI) { if (wr == 0) PG8_BAR; }
        E(acc, cur, wr, wc, fr, fq); S.done(cur);
        if (!has_next) break;
#pragma unroll
        for (int a = 0; a < 2; ++a)
#pragma unroll
            for (int b = 0; b < 2; ++b)
#pragma unroll
                for (int m = 0; m < 4; ++m)
#pragma unroll
                    for (int n = 0; n < 2; ++n) acc[a][b][m][n] = (f32x4){0.f, 0.f, 0.f, 0.f};
        cur = nxt; cA = nA; cB = nB; ++ui;
        if constexpr (ALIGN_EPI) { if (wr == 1) PG8_BAR; }
    }
    PG8_WAIT_V(0);
    if constexpr (!ALIGN_EPI) { if (wr == 0) PG8_BAR; }
    PG8_BAR;
#undef PG8_ATILE
#undef PG8_SA
#undef PG8_SB
#undef PG8_STAGE
#undef PG8_LDA
#undef PG8_LDB
#undef PG8_MMA
#undef PG8_WAIT_V
#undef PG8_WAIT_L
#undef PG8_BAR
#undef PG8_SCHED
}
}
constexpr int NWAVES = 8;
#ifndef MK_MULTI
#define MK_MULTI 0
#endif

constexpr int BATCH = 16, T = 2048, D = 1024, FF = 4096, DEPTH = 4;
constexpr int M = BATCH * T;
constexpr int MH = M / 2;
constexpr int NKV = 1536;
constexpr int NQG = 1280;
constexpr int NCMP = 127;
constexpr float EPS = 1e-6f;

constexpr size_t MiB = 1u << 20;
constexpr size_t WS_CTL = 0, CTL_ZERO_BYTES = 64 * 1024;
constexpr size_t WS_MOD = 1 * MiB;
constexpr size_t WS_CB1 = 3 * MiB;
constexpr size_t WS_GATE = 4 * MiB;
constexpr size_t WS_KCV = 10 * MiB;
constexpr size_t WS_CH = 16 * MiB;
constexpr size_t WS_W = 32 * MiB;
constexpr size_t WS_KV = 128 * MiB;
constexpr size_t WS_HB = 224 * MiB;
constexpr size_t WS_Y = 288 * MiB;
constexpr size_t WS_BIG = 352 * MiB;
constexpr size_t WS_END = 480 * MiB;
constexpr size_t WO_AIN = 0;
constexpr size_t WO_AOUT = WO_AIN + 2ull * 2048 * 1024;
constexpr size_t WO_KV = WO_AOUT + 2ull * 1024 * 1024;
constexpr size_t WO_BIN = WO_KV + 1536ull * 1024;
constexpr size_t WO_BOUT = WO_BIN + 2ull * 1280 * 1024;
constexpr size_t WO_FIN = WO_BOUT + 2ull * 1024 * 1024;
constexpr size_t WO_FOUT = WO_FIN + 4ull * 4096 * 1024;
constexpr size_t WO_C1 = WO_FOUT + 4ull * 4096 * 1024;
constexpr size_t WO_WS = WO_C1 + 2ull * 256 * 2048;
constexpr size_t WO_END = WO_WS + 2ull * 8 * 128 * 128;
static_assert(WO_END * 2 <= 96 * MiB, "weights fit");
constexpr int CW_BAR = 1024;

constexpr int RING_OFF = 0, RING_BYTES = 131072;
constexpr int LDSCTL_OFF = RING_BYTES, MISC_OFF = LDSCTL_OFF + 320;
constexpr int LDS_BYTES = 147456;

#define GAS __attribute__((address_space(1)))
#define LAS __attribute__((address_space(3)))
typedef unsigned short bf16;
typedef unsigned v4u __attribute__((ext_vector_type(4)));
typedef unsigned v2u __attribute__((ext_vector_type(2)));
typedef float f32x4 __attribute__((ext_vector_type(4)));
typedef GAS unsigned gu32;
#define RLX_AGENT __ATOMIC_RELAXED, __HIP_MEMORY_SCOPE_AGENT
#define LDS_WAIT() asm volatile("s_waitcnt lgkmcnt(0)" ::: "memory")
#define VM_WAIT() asm volatile("s_waitcnt vmcnt(0)" ::: "memory")
__device__ __forceinline__ unsigned f2bf(float f) { unsigned u = __builtin_bit_cast(unsigned, f); return (u + 0x7fffu + ((u >> 16) & 1u)) >> 16; }
__device__ __forceinline__ unsigned pk2(float lo, float hi) { return f2bf(lo) | (f2bf(hi) << 16); }
__device__ __forceinline__ float bf_lo(unsigned w) { return __builtin_bit_cast(float, w << 16); }
__device__ __forceinline__ float bf_hi(unsigned w) { return __builtin_bit_cast(float, w & 0xffff0000u); }
__device__ __forceinline__ float bf1(bf16 h) { return __builtin_bit_cast(float, (unsigned)h << 16); }
__device__ __forceinline__ float wave_sum(float v) {
#pragma unroll
    for (int o = 1; o < 64; o <<= 1) v += __shfl_xor(v, o);
    return v;
}
__device__ __forceinline__ float wave_max(float v) {
#pragma unroll
    for (int o = 1; o < 64; o <<= 1) v = fmaxf(v, __shfl_xor(v, o));
    return v;
}

#define XB_TMO      128
#define XB_XCNT(j)  (256  + 64 * (j))
#define XB_XSUB(j)  (1280 + 64 * (j))
#define XB_XGEN(j)  (2304 + 64 * (j))
#define XB_TOP      3328
#define XB_TOPGEN   3392
#define XCD_BAR_WORDS 3456
#define XB_SPIN_CAP (1u << 18)

__device__ __forceinline__ unsigned xb_ld(unsigned* p)              { return __hip_atomic_load(p, __ATOMIC_RELAXED, __HIP_MEMORY_SCOPE_AGENT); }
__device__ __forceinline__ unsigned xb_add(unsigned* p, unsigned v) { return __hip_atomic_fetch_add(p, v, __ATOMIC_RELAXED, __HIP_MEMORY_SCOPE_AGENT); }
__device__ __forceinline__ unsigned xb_xcc_id() { return (unsigned)__builtin_amdgcn_s_getreg((3 << 11) | 20) & 0xFu; }
#define XB_SPIN(cond, bar) do { unsigned _sp = 0; while (cond) { __builtin_amdgcn_s_sleep(1); \
    if ((++_sp & 255u) == 0u) { if (xb_ld(&(bar)[XB_TMO])) break; if (_sp > XB_SPIN_CAP) { atomicAdd(&(bar)[XB_TMO], 1u); break; } } } } while (0)

struct XcdBarrier {
    unsigned* bar; unsigned x;
    volatile LAS unsigned* st;
};
__device__ __forceinline__ XcdBarrier xcd_barrier_post(unsigned* bar, volatile LAS unsigned* st) {
    XcdBarrier b; b.bar = bar; b.x = xb_xcc_id(); b.st = st;
    if (threadIdx.x == 0) (void)xb_add(&bar[XB_XCNT(b.x)], 1u);
    return b;
}
__device__ __forceinline__ void xcd_barrier_complete(unsigned* bar, unsigned x, unsigned& nloc, unsigned& nx) {
    const unsigned G = gridDim.x * gridDim.y * gridDim.z;
    unsigned sum, cnt, mine, sp = 0u;
    for (;;) {
        sum = 0u; cnt = 0u; mine = 0u;
#pragma unroll
        for (unsigned j = 0; j < 16; ++j) { const unsigned c = xb_ld(&bar[XB_XCNT(j)]); sum += c; cnt += (c > 0u) ? 1u : 0u; mine = (j == x) ? c : mine; }
        if (sum == G) break;
        __builtin_amdgcn_s_sleep(1);
        if ((++sp & 255u) == 0u) { if (xb_ld(&bar[XB_TMO])) break; if (sp > XB_SPIN_CAP) { atomicAdd(&bar[XB_TMO], 1u); break; } }
    }
    nloc = mine > 0u ? mine : 1u; nx = cnt > 0u ? cnt : 1u;
}
__device__ __forceinline__ void xcd_barrier(const XcdBarrier& b) {
    asm volatile("s_waitcnt vmcnt(0)" ::: "memory");
    __syncthreads();
    if (threadIdx.x == 0) {
        unsigned* bar = b.bar;
        __builtin_amdgcn_s_waitcnt(0);
        unsigned nloc = b.st[0], nx = b.st[1];
        if (nloc == 0u) { xcd_barrier_complete(bar, b.x, nloc, nx); b.st[0] = nloc; b.st[1] = nx; }
        const unsigned old = xb_add(&bar[XB_XSUB(b.x)], 1u);
        const unsigned gen = old / nloc;
        if (old + 1u == (gen + 1u) * nloc) {
            __builtin_amdgcn_fence(__ATOMIC_RELEASE, "agent");
            asm volatile("s_waitcnt vmcnt(0)" ::: "memory");
            const unsigned og = xb_add(&bar[XB_TOP], 1u);
            const unsigned tg = og / nx;
            if (og + 1u == (tg + 1u) * nx) xb_add(&bar[XB_TOPGEN], 1u);
            else XB_SPIN(xb_ld(&bar[XB_TOPGEN]) == tg, bar);
            __builtin_amdgcn_fence(__ATOMIC_ACQUIRE, "agent");
            xb_add(&bar[XB_XGEN(b.x)], 1u);
            asm volatile("s_waitcnt vmcnt(0)" ::: "memory");
        } else {
            XB_SPIN(xb_ld(&bar[XB_XGEN(b.x)]) == gen, bar);
            __builtin_amdgcn_fence(__ATOMIC_ACQUIRE, "agent");
            asm volatile("s_waitcnt vmcnt(0)" ::: "memory");
        }
    }
    __syncthreads();
}

struct Frame {
    LAS unsigned char* lds;
    int tid, lane, wave;
    int vcu, G;
};
__device__ __forceinline__ void tr_item(const float* W, int K, int ldw, int nvalid, bf16* WT, int nblk, LAS float* scr, int item, int lane) {
    const int kb = item / nblk, nb = item % nblk, k0 = 64 * kb, n0 = 32 * nb;
    const int nn = n0 + (lane & 31); const bool ok = nn < nvalid;
#pragma unroll 8
    for (int i = 0; i < 32; ++i) { const int kk = 2 * i + (lane >> 5); scr[kk * 33 + (lane & 31)] = ok ? W[(size_t)(k0 + kk) * ldw + nn] : 0.f; }
    LDS_WAIT(); asm volatile("" ::: "memory");
    const int c = lane & 7;
#pragma unroll
    for (int j = 0; j < 4; ++j) { const int n = (lane >> 3) + 8 * j; const LAS float* s = scr + (8 * c) * 33 + n;
        v4u o; o.x = pk2(s[0 * 33], s[1 * 33]); o.y = pk2(s[2 * 33], s[3 * 33]); o.z = pk2(s[4 * 33], s[5 * 33]); o.w = pk2(s[6 * 33], s[7 * 33]);
        *(GAS v4u*)(WT + (size_t)(n0 + n) * K + k0 + 8 * c) = o; }
    LDS_WAIT(); asm volatile("" ::: "memory");
}

struct Args { const float* in[24]; float* out; unsigned char* ws; int ph_lo, ph_hi; };
typedef const __attribute__((address_space(4))) Args* kargs_t;

__device__ __forceinline__ void p0_prologue(const Frame& F, kargs_t a) {
    LAS float* scr = (LAS float*)(F.lds + RING_OFF + F.wave * 16384);
    bf16* WB = (bf16*)(a->ws + WS_W);
    const int gw = F.vcu * NWAVES + F.wave, NGW = F.G * NWAVES;
    constexpr int I_AIN = 16 * 64, I_AOUT = 16 * 32, I_KV = 16 * 48, I_BIN = 16 * 40, I_BOUT = 16 * 32, I_FIN = 16 * 128, I_FOUT = 64 * 32, I_C1 = 32 * 8;
    constexpr int NITEMS = 2 * I_AIN + 2 * I_AOUT + I_KV + 2 * I_BIN + 2 * I_BOUT + 4 * I_FIN + 4 * I_FOUT + 2 * I_C1;
    for (int it = gw; it < NITEMS; it += NGW) {
        int r = it;
        if (r < 2 * I_AIN) { const int l = r / I_AIN; tr_item(a->in[5] + (size_t)l * 1024 * 2048, 1024, 2048, 2048, WB + WO_AIN + (size_t)l * 2048 * 1024, 64, scr, r % I_AIN, F.lane); continue; } r -= 2 * I_AIN;
        if (r < 2 * I_AOUT) { const int l = r / I_AOUT; tr_item(a->in[10] + (size_t)l * 1024 * 1024, 1024, 1024, 1024, WB + WO_AOUT + (size_t)l * 1024 * 1024, 32, scr, r % I_AOUT, F.lane); continue; } r -= 2 * I_AOUT;
        if (r < I_KV) { tr_item(a->in[14], 1024, 1536, 1536, WB + WO_KV, 48, scr, r, F.lane); continue; } r -= I_KV;
        if (r < 2 * I_BIN) { const int l = r / I_BIN; tr_item(a->in[20] + (size_t)l * 1024 * 1072, 1024, 1072, 1072, WB + WO_BIN + (size_t)l * 1280 * 1024, 40, scr, r % I_BIN, F.lane); continue; } r -= 2 * I_BIN;
        if (r < 2 * I_BOUT) { const int l = r / I_BOUT; tr_item(a->in[21] + (size_t)l * 1024 * 1024, 1024, 1024, 1024, WB + WO_BOUT + (size_t)l * 1024 * 1024, 32, scr, r % I_BOUT, F.lane); continue; } r -= 2 * I_BOUT;
        if (r < 4 * I_FIN) { const int l = r / I_FIN; tr_item(a->in[22] + (size_t)l * 1024 * 4096, 1024, 4096, 4096, WB + WO_FIN + (size_t)l * 4096 * 1024, 128, scr, r % I_FIN, F.lane); continue; } r -= 4 * I_FIN;
        if (r < 4 * I_FOUT) { const int l = r / I_FOUT; tr_item(a->in[23] + (size_t)l * 4096 * 1024, 4096, 1024, 1024, WB + WO_FOUT + (size_t)l * 1024 * 4096, 32, scr, r % I_FOUT, F.lane); continue; } r -= 4 * I_FOUT;
        { const int l = r / I_C1; tr_item(a->in[16] + (size_t)l * 2048 * 256, 2048, 256, 256, WB + WO_C1 + (size_t)l * 256 * 2048, 8, scr, r % I_C1, F.lane); }
    }
    for (int i = gw * 64 + F.lane; i < 2 * 8 * 128 * 128; i += NGW * 64) { const int s = i & 127, t = (i >> 7) & 127; WB[WO_WS + i] = (s <= t) ? (bf16)f2bf(a->in[8][i]) : (bf16)0; }
    __syncthreads();
    if (F.vcu < 208) {
        LAS float* cact = (LAS float*)(F.lds);
        LAS float* red = (LAS float*)(F.lds + 65536);
        for (int i = F.tid; i < 16 * 1024; i += NWAVES * 64) { const float c = a->in[1][i]; cact[i] = c / (1.0f + __expf(-c)); }
        __syncthreads();
        const int grp = F.vcu; const float* W; const float* bias; float* out; int ldw, n0, ostride;
        float* MOD = (float*)(a->ws + WS_MOD);
        if (grp < 192) { const int L = grp / 48; n0 = (grp % 48) * 128; W = a->in[2] + (size_t)L * 1024 * 6144; ldw = 6144; bias = a->in[3] + L * 6144; out = MOD + (size_t)L * 16 * 6144; ostride = 6144; }
        else { n0 = (grp - 192) * 128; W = a->in[11]; ldw = 2048; bias = a->in[12]; out = MOD + (size_t)4 * 16 * 6144; ostride = 2048; }
        float acc0[16], acc1[16];
#pragma unroll
        for (int b = 0; b < 16; ++b) { acc0[b] = 0.f; acc1[b] = 0.f; }
        const int kbeg = F.wave * 128;
        for (int k = kbeg; k < kbeg + 128; ++k) {
            const float2 w = *(const float2*)(W + (size_t)k * ldw + n0 + 2 * F.lane);
#pragma unroll
            for (int b = 0; b < 16; ++b) { const float cv = cact[b * 1024 + k]; acc0[b] += cv * w.x; acc1[b] += cv * w.y; }
        }
#pragma unroll
        for (int b = 0; b < 16; ++b) { red[(F.wave * 16 + b) * 128 + 2 * F.lane] = acc0[b]; red[(F.wave * 16 + b) * 128 + 2 * F.lane + 1] = acc1[b]; }
        __syncthreads();
        for (int o = F.tid; o < 2048; o += NWAVES * 64) { const int b = o >> 7, n = o & 127; float s = bias[n0 + n];
#pragma unroll
            for (int w = 0; w < 8; ++w) s += red[(w * 16 + b) * 128 + n];
            out[(size_t)b * ostride + n0 + n] = s; }
    } else if (F.vcu == 208) {
        const int j = F.tid >> 8, n = F.tid & 255; float s = a->in[17][j * 256 + n];
        const float* pos = a->in[15] + j * 2048; const float* w1 = a->in[16] + (size_t)j * 2048 * 256 + n;
        for (int kk = 0; kk < 2048; ++kk) s += pos[kk] * w1[(size_t)kk * 256];
        ((float*)(a->ws + WS_CB1))[j * 256 + n] = s;
    }
}

template <bool HAS_Y, bool HAS_H, bool HAS_KV>
__device__ __forceinline__ void norm_phase(const Frame& F, const float* xin, float* xout, const bf16* Y, const float* gy, const float* gate  ,
                                           const float* gn, const float* sh, const float* sc, int mstride, bf16* H,
                                           const float* gkv, const float* shkv, const float* sckv, int kvstride, bf16* HKV) {
    const int gw = F.vcu * NWAVES + F.wave, NGW = F.G * NWAVES;
    for (int blk = gw; blk < M / 16; blk += NGW) {
        const int b = blk / (T / 16);
        f32x4 A1[4], A2[4], A3[4], K2[4], K3[4];
#pragma unroll
        for (int j = 0; j < 4; ++j) { const int col = 256 * j + 4 * F.lane;
            if (HAS_Y) A1[j] = *(const f32x4*)(gate + (size_t)b * mstride + col) * *(const f32x4*)(gy + col);
            if (HAS_H) { A2[j] = *(const f32x4*)(gn + col) * (*(const f32x4*)(sc + (size_t)b * mstride + col) + 1.0f); A3[j] = *(const f32x4*)(sh + (size_t)b * mstride + col); }
            if (HAS_KV) { K2[j] = *(const f32x4*)(gkv + col) * (*(const f32x4*)(sckv + (size_t)b * kvstride + col) + 1.0f); K3[j] = *(const f32x4*)(shkv + (size_t)b * kvstride + col); }
        }
        for (int r = 0; r < 16; ++r) {
            const size_t m = (size_t)blk * 16 + r;
            f32x4 xv[4];
#pragma unroll
            for (int j = 0; j < 4; ++j) xv[j] = *(const f32x4*)(xin + m * D + 256 * j + 4 * F.lane);
            if (HAS_Y) {
                f32x4 yv[4]; float s = 0.f;
#pragma unroll
                for (int j = 0; j < 4; ++j) { const v2u w = *(const v2u*)(Y + m * D + 256 * j + 4 * F.lane); yv[j] = (f32x4){bf_lo(w.x), bf_hi(w.x), bf_lo(w.y), bf_hi(w.y)};
                    s += (yv[j].x * yv[j].x + yv[j].y * yv[j].y) + (yv[j].z * yv[j].z + yv[j].w * yv[j].w); }
                const float rstd = 1.0f / sqrtf(wave_sum(s) * (1.0f / D) + EPS);
#pragma unroll
                for (int j = 0; j < 4; ++j) { xv[j] = xv[j] + A1[j] * (yv[j] * rstd); *(f32x4*)(xout + m * D + 256 * j + 4 * F.lane) = xv[j]; }
            }
            if (HAS_H || HAS_KV) {
                float s = 0.f;
#pragma unroll
                for (int j = 0; j < 4; ++j) s += (xv[j].x * xv[j].x + xv[j].y * xv[j].y) + (xv[j].z * xv[j].z + xv[j].w * xv[j].w);
                const float rstd = 1.0f / sqrtf(wave_sum(s) * (1.0f / D) + EPS);
#pragma unroll
                for (int j = 0; j < 4; ++j) { const f32x4 xn = xv[j] * rstd;
                    if (HAS_H) { const f32x4 h = xn * A2[j] + A3[j]; v2u w; w.x = pk2(h.x, h.y); w.y = pk2(h.z, h.w); *(v2u*)(H + m * D + 256 * j + 4 * F.lane) = w; }
                    if (HAS_KV) { const f32x4 h = xn * K2[j] + K3[j]; v2u w; w.x = pk2(h.x, h.y); w.y = pk2(h.z, h.w); *(v2u*)(HKV + m * D + 256 * j + 4 * F.lane) = w; } }
            }
        }
    }
}

#if 0
__device__ __forceinline__ void sgu_phase_naive(const Frame& F, const bf16* U, const bf16* V, const float* lng, const float* lnb, const float* ws, const float* bs, bf16* GT) {
    LAS float* vt = (LAS float*)(F.lds);
    LAS float* wm = (LAS float*)(F.lds + 65536);
    LAS float* st = (LAS float*)(F.lds + 132096);
    for (int ch = F.vcu; ch < M / 128; ch += F.G) {
        const size_t m0 = (size_t)ch * 128;
        __syncthreads();
        for (int r = 0; r < 16; ++r) { const int row = F.wave * 16 + r; float s = 0.f, q = 0.f; float xv[16];
#pragma unroll
            for (int j = 0; j < 4; ++j) { const v2u w = *(const v2u*)(V + (m0 + row) * D + 256 * j + 4 * F.lane); xv[4 * j] = bf_lo(w.x); xv[4 * j + 1] = bf_hi(w.x); xv[4 * j + 2] = bf_lo(w.y); xv[4 * j + 3] = bf_hi(w.y); }
#pragma unroll
            for (int e = 0; e < 16; ++e) s += xv[e];
            const float mean = wave_sum(s) * (1.0f / D);
#pragma unroll
            for (int e = 0; e < 16; ++e) { const float d = xv[e] - mean; q += d * d; }
            const float rstd = 1.0f / sqrtf(wave_sum(q) * (1.0f / D) + EPS);
            if (F.lane == 0) { st[row * 2] = mean; st[row * 2 + 1] = rstd; } }
        __syncthreads();
        for (int g = 0; g < 8; ++g) {
            for (int i = F.tid; i < 128 * 128; i += NWAVES * 64) { const int s = i >> 7, d = i & 127; const int c = g * 128 + d;
                vt[i] = (bf1(V[(m0 + s) * D + c]) - st[s * 2]) * st[s * 2 + 1] * lng[c] + lnb[c];
                const int t = i >> 7, s2 = i & 127; wm[s2 * 128 + t] = (s2 <= t) ? ws[(size_t)g * 16384 + t * 128 + s2] : 0.f; }
            __syncthreads();
            const int d = F.tid & 127, tq = __builtin_amdgcn_readfirstlane(F.tid >> 7);
            float acc[32];
#pragma unroll
            for (int i = 0; i < 32; ++i) acc[i] = 0.f;
            for (int s = 0; s < 128; ++s) { const float vv = vt[s * 128 + d];
#pragma unroll
                for (int i4 = 0; i4 < 8; ++i4) { const f32x4 w4 = *(const LAS f32x4*)(wm + s * 128 + tq * 32 + i4 * 4);
                    acc[i4 * 4] += w4.x * vv; acc[i4 * 4 + 1] += w4.y * vv; acc[i4 * 4 + 2] += w4.z * vv; acc[i4 * 4 + 3] += w4.w * vv; } }
#pragma unroll
            for (int i = 0; i < 32; ++i) { const int t = tq * 32 + i; const size_t idx = (m0 + t) * D + g * 128 + d;
                GT[idx] = (bf16)f2bf(bf1(U[idx]) * (acc[i] + bs[g * 128 + t])); }
            __syncthreads();
        }
    }
}

#endif
__device__ __forceinline__ void cmp2_phase(const Frame& F, const bf16* CH, const float* w2, const float* b2, bf16* KCV) {
    const int gw = F.vcu * NWAVES + F.wave, NGW = F.G * NWAVES;
    for (int it = gw; it < 2 * 8192; it += NGW) {
        const int j = it >> 13, r = it & 8191;
        float s = b2[j * 64 + F.lane];
        const bf16* hrow = CH + ((size_t)j * 8192 + r) * 256; const float* w = w2 + (size_t)j * 256 * 64 + F.lane;
        for (int h = 0; h < 256; ++h) s += bf1(hrow[h]) * w[h * 64];
        if ((r & 127) == 127) s = 0.f;
        KCV[((size_t)j * 8192 + r) * 64 + F.lane] = (bf16)f2bf(s);
    }
}

#if 0
__device__ __forceinline__ void attn_phase_naive(const Frame& F, const bf16* Q, const float* GATE, const float* KCV, const bf16* KV, bf16* O) {
    LAS float* wl = (LAS float*)(F.lds + F.wave * 4096);
    LAS float* qs = wl;
    LAS float* ps = wl + 256;
    LAS float* pc = wl + 512;
    LAS float* im = wl + 640;
    const int gw = F.vcu * NWAVES + F.wave, NGW = F.G * NWAVES, lane = F.lane;
    constexpr float L2E = 1.4426950408889634f;
    for (int it = gw; it < BATCH * 4 * T; it += NGW) {
        const int t = it & (T - 1), g = (it >> 11) & 3, b = it >> 13;
        const size_t m = (size_t)b * T + t;
#pragma unroll
        for (int hh = 0; hh < 4; ++hh) qs[hh * 64 + lane] = bf1(Q[m * 1024 + (g * 4 + hh) * 64 + lane]);
        float mx[4], ls[4], oa[4], outv[4];
#define ATT_SCORE_BF16(kp, sv) do { asm volatile("" ::: "memory"); sv[0] = sv[1] = sv[2] = sv[3] = 0.f; \
        _Pragma("unroll") for (int d8 = 0; d8 < 8; ++d8) { const v4u kk = *(const v4u*)((kp) + d8 * 8); float kf[8] = {bf_lo(kk.x), bf_hi(kk.x), bf_lo(kk.y), bf_hi(kk.y), bf_lo(kk.z), bf_hi(kk.z), bf_lo(kk.w), bf_hi(kk.w)}; \
            _Pragma("unroll") for (int hh = 0; hh < 4; ++hh) { const f32x4 q0 = *(const LAS f32x4*)(qs + hh * 64 + d8 * 8), q1 = *(const LAS f32x4*)(qs + hh * 64 + d8 * 8 + 4); \
                sv[hh] += (q0.x * kf[0] + q0.y * kf[1]) + (q0.z * kf[2] + q0.w * kf[3]) + (q1.x * kf[4] + q1.y * kf[5]) + (q1.z * kf[6] + q1.w * kf[7]); } } } while (0)
#define ATT_SCORE_F32(kp, sv) do { asm volatile("" ::: "memory"); sv[0] = sv[1] = sv[2] = sv[3] = 0.f; \
        _Pragma("unroll") for (int d4 = 0; d4 < 16; ++d4) { const f32x4 kk = *(const f32x4*)((kp) + d4 * 4); \
            _Pragma("unroll") for (int hh = 0; hh < 4; ++hh) { const f32x4 q0 = *(const LAS f32x4*)(qs + hh * 64 + d4 * 4); \
                sv[hh] += (q0.x * kk.x + q0.y * kk.y) + (q0.z * kk.z + q0.w * kk.w); } } } while (0)
#define ATT_SOFTMAX_STEP(sv, valid) do { \
        _Pragma("unroll") for (int hh = 0; hh < 4; ++hh) { const float s_ = (valid) ? sv[hh] : -INFINITY; const float bm = wave_max(s_); const float mn = fmaxf(mx[hh], bm); \
            const float scl = __builtin_amdgcn_exp2f((mx[hh] - mn) * L2E); const float p = __builtin_amdgcn_exp2f((s_ - mn) * L2E); \
            ls[hh] = ls[hh] * scl + wave_sum(p); oa[hh] *= scl; mx[hh] = mn; ps[lane * 4 + hh] = p; } } while (0)
        LDS_WAIT();
        const int ncv = (t >= 31) ? ((t - 31) >> 4) + 1 : 0;
        const float* kc = KCV + ((size_t)(b * 4 + g) * 128) * 64; const float* vc = KCV + (size_t)8192 * 64 + ((size_t)(b * 4 + g) * 128) * 64;
        float ocmp[4] = {0.f, 0.f, 0.f, 0.f};
        pc[lane] = 0.f; pc[64 + lane] = 0.f;
        if (ncv > 0) {
            float s0[4], s1[4];
            ATT_SCORE_F32(kc + (size_t)lane * 64, s0); ATT_SCORE_F32(kc + (size_t)(64 + lane) * 64, s1);
            float psum0 = 0.f, psum1 = 0.f; float p0[4], p1[4];
#pragma unroll
            for (int hh = 0; hh < 4; ++hh) { const float a0 = (lane < ncv) ? s0[hh] : -INFINITY, a1 = (64 + lane < ncv) ? s1[hh] : -INFINITY;
                const float mm = wave_max(fmaxf(a0, a1)); const float e0 = __builtin_amdgcn_exp2f((a0 - mm) * L2E), e1 = __builtin_amdgcn_exp2f((a1 - mm) * L2E);
                const float den = wave_sum(e0 + e1); p0[hh] = e0 / den; p1[hh] = e1 / den; psum0 += p0[hh]; psum1 += p1[hh]; }
            pc[lane] = psum0; pc[64 + lane] = psum1;
#pragma unroll
            for (int hh = 0; hh < 4; ++hh) ps[lane * 4 + hh] = p0[hh];
            LDS_WAIT();
            const int n0 = ncv < 64 ? ncv : 64;
            for (int key = 0; key < n0; ++key) { const f32x4 p4 = *(const LAS f32x4*)(ps + key * 4); const float vv = vc[(size_t)key * 64 + lane];
                ocmp[0] += p4.x * vv; ocmp[1] += p4.y * vv; ocmp[2] += p4.z * vv; ocmp[3] += p4.w * vv; }
            LDS_WAIT();
            if (ncv > 64) {
#pragma unroll
                for (int hh = 0; hh < 4; ++hh) ps[lane * 4 + hh] = p1[hh];
                LDS_WAIT();
                for (int key = 0; key < ncv - 64; ++key) { const f32x4 p4 = *(const LAS f32x4*)(ps + key * 4); const float vv = vc[(size_t)(64 + key) * 64 + lane];
                    ocmp[0] += p4.x * vv; ocmp[1] += p4.y * vv; ocmp[2] += p4.z * vv; ocmp[3] += p4.w * vv; }
            }
        }
        LDS_WAIT();
        const int cur = t >> 6;
        unsigned selmask;
        {
            float imp = 0.f; const int j = lane & 31;
#pragma unroll
            for (int c = -1; c <= 3; ++c) { const int cc = 4 * j + c; if (cc >= 0 && cc < NCMP) imp += pc[cc]; }
            if (j > cur) imp = -1.0f;
            if (j == 0 || j == cur || j == cur - 1) imp = 1e4f;
            im[j] = imp;
            LDS_WAIT();
            int rank = 0;
            for (int i = 0; i < 32; ++i) { const float o = im[i]; rank += (o > imp || (o == imp && i < j)) ? 1 : 0; }
            const unsigned long long bal = __ballot(rank < 16 && j <= cur);
            selmask = (unsigned)bal;
        }
#pragma unroll
        for (int hh = 0; hh < 4; ++hh) { mx[hh] = -INFINITY; ls[hh] = 0.f; oa[hh] = 0.f; }
        {
            const bf16* kb = KV + (size_t)b * T * NKV + 2 * 256 + g * 64; const bf16* vb = KV + (size_t)b * T * NKV + 3 * 256 + g * 64;
            for (int j = 0; j <= cur; ++j) {
                if (!((selmask >> j) & 1u)) continue;
                const int kpos = j * 64 + lane; float sv[4];
                ATT_SCORE_BF16(kb + (size_t)kpos * NKV, sv);
                LDS_WAIT();
                ATT_SOFTMAX_STEP(sv, kpos <= t);
                LDS_WAIT();
                for (int key = 0; key < 64; ++key) { const f32x4 p4 = *(const LAS f32x4*)(ps + key * 4); const float vv = bf1(vb[(size_t)(j * 64 + key) * NKV + lane]);
                    oa[0] += p4.x * vv; oa[1] += p4.y * vv; oa[2] += p4.z * vv; oa[3] += p4.w * vv; }
            }
        }
        const float* gt = GATE + m * 48 + g * 12;
#pragma unroll
        for (int hh = 0; hh < 4; ++hh) outv[hh] = gt[hh * 3 + 0] * ocmp[hh] + gt[hh * 3 + 1] * (oa[hh] / ls[hh]);
#pragma unroll
        for (int hh = 0; hh < 4; ++hh) { mx[hh] = -INFINITY; ls[hh] = 0.f; oa[hh] = 0.f; }
        {
            const bf16* kb = KV + (size_t)b * T * NKV + 4 * 256 + g * 64; const bf16* vb = KV + (size_t)b * T * NKV + 5 * 256 + g * 64;
            const int start = t - 511 > 0 ? t - 511 : 0;
            for (int k0 = start; k0 <= t; k0 += 64) {
                const int kpos = k0 + lane; const int kr = kpos <= t ? kpos : t; float sv[4];
                ATT_SCORE_BF16(kb + (size_t)kr * NKV, sv);
                LDS_WAIT();
                ATT_SOFTMAX_STEP(sv, kpos <= t);
                LDS_WAIT();
                const int nk = (t - k0 + 1) < 64 ? (t - k0 + 1) : 64;
                for (int key = 0; key < nk; ++key) { const f32x4 p4 = *(const LAS f32x4*)(ps + key * 4); const float vv = bf1(vb[(size_t)(k0 + key) * NKV + lane]);
                    oa[0] += p4.x * vv; oa[1] += p4.y * vv; oa[2] += p4.z * vv; oa[3] += p4.w * vv; }
            }
        }
#pragma unroll
        for (int hh = 0; hh < 4; ++hh) { outv[hh] += gt[hh * 3 + 2] * (oa[hh] / ls[hh]); O[m * 1024 + (g * 4 + hh) * 64 + lane] = (bf16)f2bf(outv[hh]); }
        LDS_WAIT();
#undef ATT_SCORE_BF16
#undef ATT_SCORE_F32
#undef ATT_SOFTMAX_STEP
    }
}
#endif
namespace nsa {
using bf16x8 = __attribute__((ext_vector_type(8))) short;
using s16x4 = __attribute__((ext_vector_type(4))) short;
using f32x16 = __attribute__((ext_vector_type(16))) float;
using u32x4 = __attribute__((ext_vector_type(4))) unsigned;
typedef __attribute__((address_space(3))) const char* lds_cptr;
typedef __attribute__((address_space(3))) char* lds_ptr;
constexpr int NSLOT = 3, SLOTB = 8192;
constexpr int LDS_K = 0, LDS_V = NSLOT * SLOTB, LDS_WS = 2 * NSLOT * SLOTB  , LDS_OST = LDS_WS + 8 * 512  ,
              LDS_PI = LDS_OST + 8 * 4096  , LDS_IMP = LDS_PI + 32768  , LDS_SELM = LDS_IMP + 8192  , LDS_END = LDS_SELM + 256;
static_assert(LDS_END <= 131072, "attention LDS map");
constexpr int THR = 8;
__device__ __forceinline__ int crow(int r, int hi) { return (r & 3) + 8 * (r >> 2) + 4 * hi; }
#define NSA_SBAR() __builtin_amdgcn_sched_barrier(0)
__device__ __forceinline__ void glds16(const void* gsrc, unsigned lds_dst) { unsigned keep;
    asm volatile("s_mov_b32 %0, m0\n\ts_mov_b32 m0, %2\n\ts_nop 0\n\tglobal_load_lds_dwordx4 %1, off\n\ts_mov_b32 m0, %0" : "=&s"(keep) : "v"(gsrc), "s"(lds_dst) : "memory"); }
typedef float f32x2_t __attribute__((ext_vector_type(2))); typedef __bf16 bf16x2_t __attribute__((ext_vector_type(2)));
__device__ __forceinline__ unsigned cvtpk_s(float lo, float hi) { f32x2_t v = {lo, hi}; bf16x2_t b = __builtin_convertvector(v, bf16x2_t); return __builtin_bit_cast(unsigned, b); }
#define NSA_WAIT_BAR(N) asm volatile("s_waitcnt vmcnt(" #N ") lgkmcnt(0)\n\ts_barrier" ::: "memory")

__device__ __forceinline__ void qkt(f32x16& p0, f32x16& p1, lds_cptr Kslot, const bf16x8* qr, const f32x16& cinit, int r32, int hi) {
    lds_cptr kb = Kslot + hi * 1024 + r32 * 16;
#pragma unroll
    for (int d0 = 0; d0 < 4; ++d0) {
        const bf16x8 b0 = *(const __attribute__((address_space(3))) bf16x8*)(kb + d0 * 2048);
        const bf16x8 b1 = *(const __attribute__((address_space(3))) bf16x8*)(kb + d0 * 2048 + 512);
        if (d0 == 0) { p0 = __builtin_amdgcn_mfma_f32_32x32x16_bf16(b0, qr[0], cinit, 0, 0, 0); p1 = __builtin_amdgcn_mfma_f32_32x32x16_bf16(b1, qr[0], cinit, 0, 0, 0); }
        else { p0 = __builtin_amdgcn_mfma_f32_32x32x16_bf16(b0, qr[d0], p0, 0, 0, 0); p1 = __builtin_amdgcn_mfma_f32_32x32x16_bf16(b1, qr[d0], p1, 0, 0, 0); } }
}
__device__ __forceinline__ float rowmax(const f32x16& p0, const f32x16& p1) {
    float a = fmaxf(fmaxf(p0[0], p0[1]), p1[0]), b = fmaxf(fmaxf(p0[2], p0[3]), p1[1]); a = fmaxf(fmaxf(a, p1[2]), p1[3]);
#pragma unroll
    for (int r = 4; r < 16; r += 4) { a = fmaxf(fmaxf(a, p0[r]), p0[r + 1]); b = fmaxf(fmaxf(b, p0[r + 2]), p0[r + 3]); a = fmaxf(fmaxf(a, p1[r]), p1[r + 1]); b = fmaxf(fmaxf(b, p1[r + 2]), p1[r + 3]); }
    const float m = fmaxf(a, b);
    auto rr = __builtin_amdgcn_permlane32_swap(__float_as_uint(m), __float_as_uint(m), false, false);
    return fmaxf(__uint_as_float(rr[0]), __uint_as_float(rr[1]));
}
__device__ __forceinline__ float xhalf_sum(float v) { auto rr = __builtin_amdgcn_permlane32_swap(__float_as_uint(v), __float_as_uint(v), false, false); return __uint_as_float(rr[0]) + __uint_as_float(rr[1]); }
__device__ __forceinline__ float xhalf_other(float v, int hi) { auto rr = __builtin_amdgcn_permlane32_swap(__float_as_uint(v), __float_as_uint(v), false, false); return hi ? __uint_as_float(rr[0]) : __uint_as_float(rr[1]); }
__device__ __forceinline__ void pv(f32x16* o, int vb, bf16x8 pa0, bf16x8 pa1, bf16x8 pa2, bf16x8 pa3) {
#pragma unroll
    for (int d0 = 0; d0 < 2; ++d0) { s16x4 lo[4], hi[4];
#pragma unroll
        for (int ks = 0; ks < 4; ++ks) {
            asm volatile("ds_read_b64_tr_b16 %0,%1 offset:%c2" : "=&v"(lo[ks]) : "v"(vb), "i"(d0 * 4096 + ks * 1024) : "memory");
            asm volatile("ds_read_b64_tr_b16 %0,%1 offset:%c2" : "=&v"(hi[ks]) : "v"(vb), "i"(d0 * 4096 + ks * 1024 + 512) : "memory"); }
        asm volatile("s_waitcnt lgkmcnt(0)" ::: "memory"); NSA_SBAR();
#define NSA_PK(k) (bf16x8){lo[k][0], lo[k][1], lo[k][2], lo[k][3], hi[k][0], hi[k][1], hi[k][2], hi[k][3]}
        o[d0] = __builtin_amdgcn_mfma_f32_32x32x16_bf16(pa0, NSA_PK(0), o[d0], 0, 0, 0);
        o[d0] = __builtin_amdgcn_mfma_f32_32x32x16_bf16(pa1, NSA_PK(1), o[d0], 0, 0, 0);
        o[d0] = __builtin_amdgcn_mfma_f32_32x32x16_bf16(pa2, NSA_PK(2), o[d0], 0, 0, 0);
        o[d0] = __builtin_amdgcn_mfma_f32_32x32x16_bf16(pa3, NSA_PK(3), o[d0], 0, 0, 0);
#undef NSA_PK
    }
}
__device__ __forceinline__ void mask_range(f32x16& p, int kb, int lo, int hi_) {
#pragma unroll
    for (int r = 0; r < 16; ++r) { const int kk = kb + (r & 3) + 8 * (r >> 2); if (kk < lo || kk > hi_) p[r] = -INFINITY; }
}
#define NSA_PACK(P0, P1) do { pw0 = (u32x4){cvtpk_s(P0[0], P0[1]), cvtpk_s(P0[2], P0[3]), cvtpk_s(P0[4], P0[5]), cvtpk_s(P0[6], P0[7])}; \
    pw1 = (u32x4){cvtpk_s(P0[8], P0[9]), cvtpk_s(P0[10], P0[11]), cvtpk_s(P0[12], P0[13]), cvtpk_s(P0[14], P0[15])}; \
    pw2 = (u32x4){cvtpk_s(P1[0], P1[1]), cvtpk_s(P1[2], P1[3]), cvtpk_s(P1[4], P1[5]), cvtpk_s(P1[6], P1[7])}; \
    pw3 = (u32x4){cvtpk_s(P1[8], P1[9]), cvtpk_s(P1[10], P1[11]), cvtpk_s(P1[12], P1[13]), cvtpk_s(P1[14], P1[15])}; } while (0)
#define NSA_PAF(k) __builtin_bit_cast(bf16x8, pw##k)

struct Tensors { const bf16* Q; const float* GATE; const bf16* KCV; const bf16* KV; bf16* O; };

template <int MODE>
__device__ __forceinline__ void flash_pass(lds_ptr shm, unsigned lds0, const bf16* Kh, const bf16* Vh, int qt, const bf16x8* qr, unsigned selmask, int tq, float gate,
                                           f32x16* otot, int wid, int lane, int r32, int hi) {
    constexpr int PITCH = NKV;
    const bf16* ksrc = Kh + (size_t)lane * PITCH + wid * 8;
    const bf16* vsrc = Vh + (size_t)(16 * (wid & 3) + (lane >> 2)) * PITCH + (wid >> 2) * 32 + (lane & 3) * 8;
    const unsigned kdst = lds0 + LDS_K + wid * 1024, vdst = lds0 + LDS_V + wid * 1024;
    __attribute__((address_space(3))) float* wsf = (__attribute__((address_space(3))) float*)(shm + LDS_WS) + wid * 128;
    const int vb0 = (int)(lds0 + LDS_V) + ((lane >> 4) & 1) * 32 + (lane & 3) * 8 + (4 * hi + ((lane & 15) >> 2)) * 64;
    const int NT = (MODE == 1) ? qt + 1 : (qt < 8 ? qt + 1 : 9);
#define NSA_TIX(i) ((MODE == 1) ? (i) : (qt - (i)))
#define NSA_DMA(i, slot) do { const int t_ = NSA_TIX(i); glds16(ksrc + (size_t)t_ * 64 * PITCH, (unsigned)__builtin_amdgcn_readfirstlane(kdst + (slot))); glds16(vsrc + (size_t)t_ * 64 * PITCH, (unsigned)__builtin_amdgcn_readfirstlane(vdst + (slot))); } while (0)
    NSA_DMA(0, 0);
    if (NT > 1) NSA_DMA(1, SLOTB);
    float mhat = 0.f, l_reg = 0.f; f32x16 o[2]; o[0] = f32x16{}; o[1] = f32x16{};
    int sl_cur = 0;
    for (int i = 0; i < NT; ++i) {
        if (i + 1 < NT) NSA_WAIT_BAR(2); else NSA_WAIT_BAR(0);
        { const int sl2 = (sl_cur >= SLOTB) ? sl_cur - SLOTB : sl_cur + 2 * SLOTB; if (i + 2 < NT) NSA_DMA(i + 2, sl2); }
        const int t = NSA_TIX(i);
        float cval = -mhat;
        if (MODE == 1) { if (!((selmask >> t) & 1u)) cval = -INFINITY; }
        f32x16 cin;
#pragma unroll
        for (int r = 0; r < 16; ++r) cin[r] = cval;
        f32x16 p0, p1;
        qkt(p0, p1, (lds_cptr)(shm + LDS_K + sl_cur), qr, cin, r32, hi);
        if (t == qt) { mask_range(p0, 4 * hi, 0, tq); mask_range(p1, 32 + 4 * hi, 0, tq); }
        if (MODE == 2) { if (t == qt - 8) { mask_range(p0, 4 * hi, tq + 1, 63); mask_range(p1, 32 + 4 * hi, tq + 1, 63); } }
        const float rm = rowmax(p0, p1);
        bool resc = false;
        if (i == 0 || __any(rm > (float)THR)) {
            const float dl = (i == 0) ? fmaxf(rm, -1e30f) : fmaxf(rm, 0.f); mhat += dl;
#pragma unroll
            for (int r = 0; r < 16; ++r) { p0[r] -= dl; p1[r] -= dl; }
            const float f = __builtin_amdgcn_exp2f(-dl); l_reg *= f; if (hi == 0) wsf[r32] = f; resc = (i != 0);
        }
        float sacc = 0.f;
#pragma unroll
        for (int r = 0; r < 16; ++r) { p0[r] = __builtin_amdgcn_exp2f(p0[r]); p1[r] = __builtin_amdgcn_exp2f(p1[r]); sacc += p0[r] + p1[r]; }
        l_reg += sacc;
        u32x4 pw0, pw1, pw2, pw3; NSA_PACK(p0, p1);
        if (resc) { asm volatile("s_waitcnt lgkmcnt(0)" ::: "memory");
#pragma unroll
            for (int d = 0; d < 2; ++d)
#pragma unroll
                for (int r = 0; r < 16; ++r) o[d][r] *= wsf[crow(r, hi)]; }
        pv(o, vb0 + sl_cur, NSA_PAF(0), NSA_PAF(1), NSA_PAF(2), NSA_PAF(3));
        sl_cur = (sl_cur == (NSLOT - 1) * SLOTB) ? 0 : sl_cur + SLOTB;
    }
    const float l = xhalf_sum(l_reg);
    asm volatile("s_waitcnt lgkmcnt(0)" ::: "memory");
    if (hi == 0) wsf[r32] = gate / l;
    asm volatile("s_waitcnt lgkmcnt(0)" ::: "memory");
#pragma unroll
    for (int r = 0; r < 16; ++r) { const float w = wsf[crow(r, hi)]; otot[0][r] += o[0][r] * w; otot[1][r] += o[1][r] * w; }
    asm volatile("s_waitcnt lgkmcnt(0)\n\ts_barrier" ::: "memory");
#undef NSA_TIX
#undef NSA_DMA
}

__device__ __forceinline__ void attn_unit(int b, int g, int qt, const Tensors& T_, lds_ptr shm, int tid_) {
    int tid = tid_; asm volatile("" : "+v"(tid));
    const int lane = tid & 63, r32 = lane & 31, hi = lane >> 5; const int wid = __builtin_amdgcn_readfirstlane(tid >> 6);
    const int hh = wid & 3, ts = wid >> 2, tq = ts * 32 + r32;
    const size_t m0 = (size_t)b * T + (size_t)qt * 64;
    const unsigned lds0 = (unsigned)(uintptr_t)shm;
    __attribute__((address_space(3))) float* wsf = (__attribute__((address_space(3))) float*)(shm + LDS_WS) + wid * 128;
    {
        const bf16* Kc = T_.KCV + (size_t)(b * 4 + g) * 128 * 64; const bf16* Vc = Kc + (size_t)8192 * 64;
        const bf16* ksrc = Kc + (size_t)lane * 64 + wid * 8;
        const bf16* vsrc = Vc + (size_t)(16 * (wid & 3) + (lane >> 2)) * 64 + (wid >> 2) * 32 + (lane & 3) * 8;
        const unsigned kdst = lds0 + LDS_K + wid * 1024, vdst = lds0 + LDS_V + wid * 1024;
        glds16(ksrc, (unsigned)__builtin_amdgcn_readfirstlane(kdst)); glds16(vsrc, (unsigned)__builtin_amdgcn_readfirstlane(vdst));
        glds16(ksrc + 64 * 64, (unsigned)__builtin_amdgcn_readfirstlane(kdst + SLOTB)); glds16(vsrc + 64 * 64, (unsigned)__builtin_amdgcn_readfirstlane(vdst + SLOTB));
    }
    bf16x8 qr[4];
    {
        const bf16* Qw = T_.Q + (m0 + ts * 32) * 1024 + (g * 4 + hh) * 64;
#pragma unroll
        for (int d0 = 0; d0 < 4; ++d0) qr[d0] = *reinterpret_cast<const bf16x8*>(&Qw[(size_t)r32 * 1024 + d0 * 16 + hi * 8]);
    }
    const float* gp = T_.GATE + (m0 + tq) * 48 + (g * 4 + hh) * 3;
    const float g_cmp = gp[0], g_sel = gp[1], g_win = gp[2];
    f32x16 otot[2];
    NSA_WAIT_BAR(0);
    {
        const int t = qt * 64 + tq;
        const int ncv = (t >= 31) ? ((t - 31) >> 4) + 1 : 0;
        f32x16 zero = f32x16{}; f32x16 pA0, pA1, pB0, pB1;
        qkt(pA0, pA1, (lds_cptr)(shm + LDS_K), qr, zero, r32, hi);
        qkt(pB0, pB1, (lds_cptr)(shm + LDS_K + SLOTB), qr, zero, r32, hi);
        mask_range(pA0, 4 * hi, 0, ncv - 1); mask_range(pA1, 32 + 4 * hi, 0, ncv - 1); mask_range(pB0, 64 + 4 * hi, 0, ncv - 1); mask_range(pB1, 96 + 4 * hi, 0, ncv - 1);
        const float m = fmaxf(fmaxf(rowmax(pA0, pA1), rowmax(pB0, pB1)), -1e30f);
        float sacc = 0.f;
#pragma unroll
        for (int r = 0; r < 16; ++r) { pA0[r] = __builtin_amdgcn_exp2f(pA0[r] - m); pA1[r] = __builtin_amdgcn_exp2f(pA1[r] - m); pB0[r] = __builtin_amdgcn_exp2f(pB0[r] - m); pB1[r] = __builtin_amdgcn_exp2f(pB1[r] - m);
            sacc += (pA0[r] + pA1[r]) + (pB0[r] + pB1[r]); }
        const float l = xhalf_sum(sacc); const float inv = l > 0.f ? 1.0f / l : 0.f;
#pragma unroll
        for (int r = 0; r < 16; ++r) { pA0[r] *= inv; pA1[r] *= inv; pB0[r] *= inv; pB1[r] *= inv; }
        {
            __attribute__((address_space(3))) float* PI = (__attribute__((address_space(3))) float*)(shm + LDS_PI) + (hh * 64 + tq) * 32;
            float prev_oth = 0.f;
#define NSA_GRP(P, blk) _Pragma("unroll") for (int q4 = 0; q4 < 4; ++q4) { const int k = (blk) * 4 + q4; const float Gs = (P[4 * q4] + P[4 * q4 + 1]) + (P[4 * q4 + 2] + P[4 * q4 + 3]); \
                const float oth = xhalf_other(P[4 * q4 + 3], hi); PI[2 * k + hi] = Gs + (hi ? oth : prev_oth); prev_oth = oth; }
            NSA_GRP(pA0, 0) NSA_GRP(pA1, 1) NSA_GRP(pB0, 2) NSA_GRP(pB1, 3)
#undef NSA_GRP
        }
        otot[0] = f32x16{}; otot[1] = f32x16{};
        const int vb0 = (int)(lds0 + LDS_V) + ((lane >> 4) & 1) * 32 + (lane & 3) * 8 + (4 * hi + ((lane & 15) >> 2)) * 64;
        u32x4 pw0, pw1, pw2, pw3;
        NSA_PACK(pA0, pA1); pv(otot, vb0, NSA_PAF(0), NSA_PAF(1), NSA_PAF(2), NSA_PAF(3));
        NSA_PACK(pB0, pB1); pv(otot, vb0 + SLOTB, NSA_PAF(0), NSA_PAF(1), NSA_PAF(2), NSA_PAF(3));
        if (hi == 0) wsf[r32] = g_cmp;
        asm volatile("s_waitcnt lgkmcnt(0)" ::: "memory");
#pragma unroll
        for (int r = 0; r < 16; ++r) { const float w = wsf[crow(r, hi)]; otot[0][r] *= w; otot[1][r] *= w; }
    }
    asm volatile("s_waitcnt lgkmcnt(0)\n\ts_barrier" ::: "memory");
    {
        const __attribute__((address_space(3))) float* PI = (const __attribute__((address_space(3))) float*)(shm + LDS_PI);
        __attribute__((address_space(3))) float* IMP = (__attribute__((address_space(3))) float*)(shm + LDS_IMP);
        __attribute__((address_space(3))) unsigned* SELM = (__attribute__((address_space(3))) unsigned*)(shm + LDS_SELM);
#pragma unroll
        for (int it = 0; it < 4; ++it) { const int idx = tid + it * 512, tok = idx >> 5, j = idx & 31;
            float imp = ((PI[(0 * 64 + tok) * 32 + j] + PI[(1 * 64 + tok) * 32 + j]) + PI[(2 * 64 + tok) * 32 + j]) + PI[(3 * 64 + tok) * 32 + j];
            if (j > qt) imp = -1.0f;
            if (j == 0 || j == qt || j == qt - 1) imp = 1e4f;
            IMP[idx] = imp; }
        asm volatile("s_waitcnt lgkmcnt(0)\n\ts_barrier" ::: "memory");
#pragma unroll
        for (int it = 0; it < 4; ++it) { const int idx = tid + it * 512, tok = idx >> 5, j = idx & 31;
            const float mine = IMP[idx]; int rank = 0;
#pragma unroll
            for (int i4 = 0; i4 < 8; ++i4) { const f32x4 o4 = *(const __attribute__((address_space(3))) f32x4*)(IMP + tok * 32 + i4 * 4);
                rank += (o4.x > mine || (o4.x == mine && i4 * 4 + 0 < j)) ? 1 : 0; rank += (o4.y > mine || (o4.y == mine && i4 * 4 + 1 < j)) ? 1 : 0;
                rank += (o4.z > mine || (o4.z == mine && i4 * 4 + 2 < j)) ? 1 : 0; rank += (o4.w > mine || (o4.w == mine && i4 * 4 + 3 < j)) ? 1 : 0; }
            const unsigned long long bal = __ballot(rank < 16 && j <= qt);
            if (lane == 0) SELM[tok] = (unsigned)bal;
            if (lane == 32) SELM[tok] = (unsigned)(bal >> 32); }
        asm volatile("s_waitcnt lgkmcnt(0)\n\ts_barrier" ::: "memory");
    }
    const unsigned selmask = ((const __attribute__((address_space(3))) unsigned*)(shm + LDS_SELM))[tq];
    const bf16* KVb = T_.KV + (size_t)b * T * NKV + g * 64;
    flash_pass<1>(shm, lds0, KVb + 2 * 256, KVb + 3 * 256, qt, qr, selmask, tq, g_sel, otot, wid, lane, r32, hi);
    flash_pass<2>(shm, lds0, KVb + 4 * 256, KVb + 5 * 256, qt, qr, 0u, tq, g_win, otot, wid, lane, r32, hi);
    {
        bf16* Ow = T_.O + (m0 + ts * 32) * 1024 + (g * 4 + hh) * 64;
        __attribute__((address_space(3))) bf16* stg = (__attribute__((address_space(3))) bf16*)(shm + LDS_OST) + wid * 2048;
#pragma unroll
        for (int r = 0; r < 16; ++r) { const int orow = crow(r, hi);
#pragma unroll
            for (int d0 = 0; d0 < 2; ++d0) stg[orow * 64 + d0 * 32 + r32] = (bf16)f2bf(otot[d0][r]); }
        asm volatile("s_waitcnt lgkmcnt(0)" ::: "memory");
#pragma unroll
        for (int i = 0; i < 4; ++i) { const int row = i * 8 + (lane >> 3), ch = lane & 7; const u32x4 v = *(const __attribute__((address_space(3))) u32x4*)(stg + row * 64 + ch * 8); *(u32x4*)(Ow + (size_t)row * 1024 + ch * 8) = v; }
    }
    asm volatile("s_waitcnt lgkmcnt(0)\n\ts_barrier" ::: "memory");
}

__device__ __forceinline__ void attn_phase(const Frame& F, const Tensors& T_) {
    lds_ptr shm = (lds_ptr)(F.lds + RING_OFF);
    for (int v = F.vcu; v < BATCH * 4 * 4; v += F.G) {
        const int bg = v >> 2, s = v & 3;
#pragma unroll 1
        for (int i = 0; i < 8; ++i) { const int qt = (i & 1) ? (8 * (i >> 1) + 7 - s) : (8 * (i >> 1) + s);
            attn_unit(bg >> 2, bg & 3, qt, T_, shm, F.tid); }
    }
}
#undef NSA_SBAR
#undef NSA_WAIT_BAR
#undef NSA_PACK
#undef NSA_PAF
}
namespace sgu {
using nsa::bf16x8; using nsa::s16x4; using nsa::f32x16; using nsa::u32x4;
constexpr int LDS_VT = 0  , LDS_ST = 32768  , LDS_OST = 34816  , LDS_END = LDS_OST + 8 * 4096;
__device__ __forceinline__ void sgu_phase(const Frame& F, const bf16* U, const bf16* V, const float* lng, const float* lnb, const bf16* WS16, const float* bs, bf16* GT) {
    typedef __attribute__((address_space(3))) char* lptr;
    lptr shm = (lptr)(F.lds + RING_OFF);
    __attribute__((address_space(3))) float* st = (__attribute__((address_space(3))) float*)(shm + LDS_ST);
    const unsigned lds0 = (unsigned)(uintptr_t)shm;
    for (int ch = F.vcu; ch < M / 128; ch += F.G) {
        int tid = F.tid; asm volatile("" : "+v"(tid));
        const int lane = tid & 63, r32 = lane & 31, hi = lane >> 5; const int wid = __builtin_amdgcn_readfirstlane(tid >> 6);
        const size_t m0 = (size_t)ch * 128;
        for (int r = 0; r < 16; ++r) { const int row = wid * 16 + r; const v4u* vp = (const v4u*)(V + (m0 + row) * D + lane * 16);
            const v4u a = vp[0], b = vp[1]; float xv[16] = {bf_lo(a.x), bf_hi(a.x), bf_lo(a.y), bf_hi(a.y), bf_lo(a.z), bf_hi(a.z), bf_lo(a.w), bf_hi(a.w), bf_lo(b.x), bf_hi(b.x), bf_lo(b.y), bf_hi(b.y), bf_lo(b.z), bf_hi(b.z), bf_lo(b.w), bf_hi(b.w)};
            float s = 0.f, q = 0.f;
#pragma unroll
            for (int e = 0; e < 16; ++e) s += xv[e];
            const float mean = wave_sum(s) * (1.0f / D);
#pragma unroll
            for (int e = 0; e < 16; ++e) { const float d = xv[e] - mean; q += d * d; }
            const float rstd = 1.0f / sqrtf(wave_sum(q) * (1.0f / D) + EPS);
            if (lane == 0) { st[row * 2] = mean; st[row * 2 + 1] = rstd; } }
        asm volatile("s_waitcnt lgkmcnt(0)\n\ts_barrier" ::: "memory");
        const int srow = tid >> 2, c4 = tid & 3;
        const float mean_s = st[srow * 2], rstd_s = st[srow * 2 + 1];
        const int tb = wid >> 1, db0 = (wid & 1) * 2;
        const int nks = 2 * tb + 2;
        const int vb0 = (int)(lds0 + LDS_VT) + ((lane >> 4) & 1) * 32 + (lane & 3) * 8 + (4 * hi + ((lane & 15) >> 2)) * 64;
#pragma unroll 1
        for (int g = 0; g < 8; ++g) {
            const bf16* wrow = WS16 + ((size_t)g * 128 + tb * 32 + r32) * 128 + 4 * hi;
            v2u af[8][2];
#pragma unroll
            for (int ks = 0; ks < 8; ++ks) if (ks < nks) { af[ks][0] = *(const v2u*)(wrow + ks * 16); af[ks][1] = *(const v2u*)(wrow + ks * 16 + 8); }
#pragma unroll
            for (int i = 0; i < 4; ++i) { const int c = g * 128 + i * 32 + c4 * 8;
                const v4u w = *(const v4u*)(V + (m0 + srow) * D + c);
                const f32x4 g0 = *(const f32x4*)(lng + c), g1 = *(const f32x4*)(lng + c + 4), b0 = *(const f32x4*)(lnb + c), b1 = *(const f32x4*)(lnb + c + 4);
                float x[8] = {bf_lo(w.x), bf_hi(w.x), bf_lo(w.y), bf_hi(w.y), bf_lo(w.z), bf_hi(w.z), bf_lo(w.w), bf_hi(w.w)};
                const float gg[8] = {g0.x, g0.y, g0.z, g0.w, g1.x, g1.y, g1.z, g1.w}, bb[8] = {b0.x, b0.y, b0.z, b0.w, b1.x, b1.y, b1.z, b1.w};
#pragma unroll
                for (int e = 0; e < 8; ++e) x[e] = (x[e] - mean_s) * rstd_s * gg[e] + bb[e];
                v4u o; o.x = pk2(x[0], x[1]); o.y = pk2(x[2], x[3]); o.z = pk2(x[4], x[5]); o.w = pk2(x[6], x[7]);
                *(__attribute__((address_space(3))) v4u*)(shm + LDS_VT + (i * 8 + (srow >> 4)) * 1024 + (srow & 15) * 64 + c4 * 16) = o; }
            asm volatile("s_waitcnt lgkmcnt(0)\n\ts_barrier" ::: "memory");
            f32x16 o[2]; o[0] = f32x16{}; o[1] = f32x16{};
#pragma unroll
            for (int ks = 0; ks < 8; ++ks) if (ks < nks) {
                const bf16x8 a = __builtin_bit_cast(bf16x8, (v4u){af[ks][0].x, af[ks][0].y, af[ks][1].x, af[ks][1].y});
#pragma unroll
                for (int dd = 0; dd < 2; ++dd) { s16x4 lo, hi4; const int vb = vb0 + ((db0 + dd) * 8 + ks) * 1024;
                    asm volatile("ds_read_b64_tr_b16 %0,%1" : "=&v"(lo) : "v"(vb) : "memory");
                    asm volatile("ds_read_b64_tr_b16 %0,%1 offset:512" : "=&v"(hi4) : "v"(vb) : "memory");
                    asm volatile("s_waitcnt lgkmcnt(0)" ::: "memory");
                    const bf16x8 bfr = (bf16x8){lo[0], lo[1], lo[2], lo[3], hi4[0], hi4[1], hi4[2], hi4[3]};
                    o[dd] = __builtin_amdgcn_mfma_f32_32x32x16_bf16(a, bfr, o[dd], 0, 0, 0); } }
            __attribute__((address_space(3))) bf16* stg = (__attribute__((address_space(3))) bf16*)(shm + LDS_OST) + wid * 2048;
#pragma unroll
            for (int r = 0; r < 16; ++r) { const int orow = nsa::crow(r, hi); const float bias = bs[g * 128 + tb * 32 + orow];
#pragma unroll
                for (int dd = 0; dd < 2; ++dd) stg[orow * 64 + dd * 32 + r32] = (bf16)f2bf(o[dd][r] + bias); }
            asm volatile("s_waitcnt lgkmcnt(0)" ::: "memory");
#pragma unroll
            for (int i = 0; i < 4; ++i) { const int row = i * 8 + (lane >> 3), chn = lane & 7;
                const v4u mv = *(const __attribute__((address_space(3))) v4u*)(stg + row * 64 + chn * 8);
                const size_t gi = (m0 + tb * 32 + row) * D + g * 128 + db0 * 32 + chn * 8;
                const v4u uv = *(const v4u*)(U + gi);
                v4u ov; ov.x = pk2(bf_lo(mv.x) * bf_lo(uv.x), bf_hi(mv.x) * bf_hi(uv.x)); ov.y = pk2(bf_lo(mv.y) * bf_lo(uv.y), bf_hi(mv.y) * bf_hi(uv.y));
                ov.z = pk2(bf_lo(mv.z) * bf_lo(uv.z), bf_hi(mv.z) * bf_hi(uv.z)); ov.w = pk2(bf_lo(mv.w) * bf_lo(uv.w), bf_hi(mv.w) * bf_hi(uv.w));
                *(v4u*)(GT + gi) = ov; }
            asm volatile("s_waitcnt lgkmcnt(0)\n\ts_barrier" ::: "memory");
        }
    }
}
}
__global__ void __launch_bounds__(NWAVES * 64, 2) fwd(Args args) {
    extern __shared__ __attribute__((aligned(16))) unsigned char lds[];
    Frame F;
    F.lds = (LAS unsigned char*)lds;
    volatile LAS unsigned* MISC = (volatile LAS unsigned*)(F.lds + MISC_OFF);
    F.tid = threadIdx.x; F.lane = F.tid & 63; F.wave = __builtin_amdgcn_readfirstlane(F.tid >> 6);
    F.G = gridDim.x; { const int bx = blockIdx.x; F.vcu = (F.G % 8 == 0) ? (bx % 8) * (F.G / 8) + bx / 8 : bx; }
    for (int u = F.tid; u < (LDS_BYTES - LDSCTL_OFF) / 4; u += NWAVES * 64) ((LAS unsigned*)(F.lds + LDSCTL_OFF))[u] = 0u;
    __syncthreads();
#if !MK_MULTI
    XcdBarrier bar = xcd_barrier_post((unsigned*)(args.ws + WS_CTL) + CW_BAR, MISC + 8);
#define GRID_BAR() xcd_barrier(bar)
#else
#define GRID_BAR() do {} while (0)
#endif
    const int lo = args.ph_lo, hi = args.ph_hi;
    int ph = 0;
#define PH_BEGIN if (ph >= lo && ph < hi) { Frame Fp = F; asm volatile("" : "+v"(Fp.tid), "+v"(Fp.lane)); \
        kargs_t KA = (kargs_t)__builtin_amdgcn_kernarg_segment_ptr(); asm volatile("" : "+s"(KA)); \
        unsigned char* const ws = KA->ws; LAS unsigned char* const ring = Fp.lds + RING_OFF; const int bx = (int)blockIdx.x; (void)ws; (void)ring; (void)bx;
#define PH_END   if (ph + 1 < hi) GRID_BAR(); } ++ph;
#define P_MOD   ((float*)(ws + WS_MOD))
#define P_KVMOD (P_MOD + (size_t)4 * 16 * 6144)
#define P_CB1   ((float*)(ws + WS_CB1))
#define P_GATE  ((float*)(ws + WS_GATE))
#define P_KCV   ((bf16*)(ws + WS_KCV))
#define P_CH    ((bf16*)(ws + WS_CH))
#define P_WB    ((bf16*)(ws + WS_W))
#define P_KV    ((bf16*)(ws + WS_KV))
#define P_HB    ((bf16*)(ws + WS_HB))
#define P_Y     ((bf16*)(ws + WS_Y))
#define P_BIG   ((bf16*)(ws + WS_BIG))
#define P_U     P_BIG
#define P_V     (P_BIG + (size_t)M * D)
#define P_Q     P_BIG
#define P_O     (P_BIG + (size_t)M * D)
#define P_HKV   P_O
#define P_HID   P_BIG
#define P_NG(L, i) (KA->in[4] + ((L) * 4 + (i)) * 1024)

    PH_BEGIN p0_prologue(Fp, KA); PH_END
    PH_BEGIN norm_phase<false, true, false>(Fp, KA->in[0], nullptr, nullptr, nullptr, nullptr, P_NG(0, 0), P_MOD + 0, P_MOD + 1024, 6144, P_HB, nullptr, nullptr, nullptr, 0, nullptr); PH_END

#pragma unroll 1
    for (int L = 0; L < DEPTH; ++L) {
        if (L < 2) {
            PH_BEGIN {
                pg8::Gemm g = pg8::make_gemm(P_HB, P_WB + WO_AIN + (size_t)L * 2048 * 1024, M, 2048, D); pg8::StaticOrder S; S.init(M, 2048, Fp.G, bx);
                pg8::EpiBf16<2> E{P_U, D, nullptr, 1024, (size_t)M * D, 1.f};
                pg8::gemm_phase<pg8::EpiBf16<2>, pg8::StaticOrder, true, true>(ring, g, S, E);
            } PH_END
            PH_BEGIN sgu::sgu_phase(Fp, P_U, P_V, KA->in[6] + L * 1024, KA->in[7] + L * 1024, P_WB + WO_WS + (size_t)L * 8 * 128 * 128, KA->in[9] + L * 8 * 128, P_HB); PH_END
            PH_BEGIN {
                pg8::Gemm g = pg8::make_gemm(P_HB, P_WB + WO_AOUT + (size_t)L * 1024 * 1024, M, D, D); pg8::StaticOrder S; S.init(M, D, Fp.G, bx);
                pg8::EpiBf16<0> E{P_Y, D, nullptr, 0, 0, 1.f};
                pg8::gemm_phase<pg8::EpiBf16<0>, pg8::StaticOrder, true, true>(ring, g, S, E);
            } PH_END
        } else {
            PH_BEGIN {
                if (L == 2) {
                    pg8::Gemm g = pg8::make_gemm(P_HKV, P_WB + WO_KV, M, NKV, D); pg8::StaticOrder S; S.init(M, NKV, Fp.G, bx);
                    pg8::EpiBf16<0> E{P_KV, NKV, nullptr, 0, 0, 1.f};
                    pg8::gemm_phase<pg8::EpiBf16<0>, pg8::StaticOrder, true, true>(ring, g, S, E);
                }
                {
                    pg8::Gemm g = pg8::make_gemm(P_HB, P_WB + WO_BIN + (size_t)(L - 2) * NQG * 1024, M, NQG, D); pg8::StaticOrder S; S.init(M, NQG, Fp.G, bx);
                    pg8::EpiQG E{P_Q, P_GATE, 0.125f * 1.4426950408889634f};
                    pg8::gemm_phase<pg8::EpiQG, pg8::StaticOrder, true, true>(ring, g, S, E);
                }
            } PH_END
            if (L == 2) {
                PH_BEGIN {
#pragma unroll 1
                    for (int j = 0; j < 2; ++j) {
                        pg8::Gemm g; g.A = P_KV + j * 256; g.Bt = P_WB + WO_C1 + (size_t)j * 256 * 2048; g.M = 8192; g.N = 256; g.K = 2048;
                        g.a_rs = 16u * NKV * 2u; g.a_hstep = 64 * 2; g.a_kstep = (size_t)NKV * 2; g.a_t1 = (size_t)T * NKV * 2; g.a_t0 = 128 * 2; g.a_sh = 1;
                        pg8::StaticOrder S; S.init(8192, 256, Fp.G, (bx + j * 128) % Fp.G);
                        pg8::EpiBf16<2> E{P_CH + (size_t)j * 8192 * 256, 256, P_CB1 + j * 256, 0, 0, 1.f};
                        pg8::gemm_phase<pg8::EpiBf16<2>, pg8::StaticOrder, true, true>(ring, g, S, E);
                    }
                } PH_END
                PH_BEGIN cmp2_phase(Fp, P_CH, KA->in[18], KA->in[19], P_KCV); PH_END
            }
            PH_BEGIN { const nsa::Tensors AT{P_Q, P_GATE, P_KCV, P_KV, P_O}; nsa::attn_phase(Fp, AT); } PH_END
            PH_BEGIN {
                pg8::Gemm g = pg8::make_gemm(P_O, P_WB + WO_BOUT + (size_t)(L - 2) * 1024 * 1024, M, D, D); pg8::StaticOrder S; S.init(M, D, Fp.G, bx);
                pg8::EpiBf16<0> E{P_Y, D, nullptr, 0, 0, 1.f};
                pg8::gemm_phase<pg8::EpiBf16<0>, pg8::StaticOrder, true, true>(ring, g, S, E);
            } PH_END
        }
        PH_BEGIN { const float* modL = P_MOD + (size_t)L * 16 * 6144; const float* xcur = (L == 0) ? KA->in[0] : (const float*)KA->out;
            norm_phase<true, true, false>(Fp, xcur, KA->out, P_Y, P_NG(L, 1), modL + 2 * 1024, P_NG(L, 2), modL + 3 * 1024, modL + 4 * 1024, 6144, P_HB, nullptr, nullptr, nullptr, 0, nullptr); } PH_END
#pragma unroll 1
        for (int hf = 0; hf < 2; ++hf) {
            PH_BEGIN {
                pg8::Gemm g = pg8::make_gemm(P_HB + (size_t)hf * MH * D, P_WB + WO_FIN + (size_t)L * 4096 * 1024, MH, FF, D); pg8::StaticOrder S; S.init(MH, FF, Fp.G, bx);
                pg8::EpiBf16<3> E{P_HID, FF, nullptr, 0, 0, 1.f};
                pg8::gemm_phase<pg8::EpiBf16<3>, pg8::StaticOrder, true, true>(ring, g, S, E);
            } PH_END
            PH_BEGIN {
                pg8::Gemm g = pg8::make_gemm(P_HID, P_WB + WO_FOUT + (size_t)L * 1024 * 4096, MH, D, FF); pg8::StaticOrder S; S.init(MH, D, Fp.G, bx);
                pg8::EpiBf16<0> E{P_Y + (size_t)hf * MH * D, D, nullptr, 0, 0, 1.f};
                pg8::gemm_phase<pg8::EpiBf16<0>, pg8::StaticOrder, true, true>(ring, g, S, E);
            } PH_END
        }
        PH_BEGIN {
            const float* modL = P_MOD + (size_t)L * 16 * 6144; float* xo = KA->out;
            const float* gy = P_NG(L, 3); const float* gate = modL + 5 * 1024;
            if (L == 3) norm_phase<true, false, false>(Fp, xo, xo, P_Y, gy, gate, nullptr, nullptr, nullptr, 6144, nullptr, nullptr, nullptr, nullptr, 0, nullptr);
            else { const float* modN = P_MOD + (size_t)(L + 1) * 16 * 6144; const float* gn = P_NG(L + 1, 0);
                if (L == 1) norm_phase<true, true, true>(Fp, xo, xo, P_Y, gy, gate, gn, modN + 0, modN + 1024, 6144, P_HB, KA->in[13], P_KVMOD + 0, P_KVMOD + 1024, 2048, P_HKV);
                else norm_phase<true, true, false>(Fp, xo, xo, P_Y, gy, gate, gn, modN + 0, modN + 1024, 6144, P_HB, nullptr, nullptr, nullptr, 0, nullptr); }
        } PH_END
    }
#undef PH_BEGIN
#undef PH_END
#undef GRID_BAR
}

extern "C" void kernel_launch(void* const* d_in, const int* in_sizes, int n_in, void* d_out, int out_size, void* d_ws, size_t ws_size, hipStream_t stream) {
    static int grid = 0;
    if (grid == 0) {
        if (n_in != 24 || out_size != M * D || ws_size < WS_END) { fprintf(stderr, "kernel_launch: unexpected shapes (n_in %d, out %d, ws %zu)\n", n_in, out_size, ws_size); grid = -1; return; }
        int dev = 0, cus = 0, per_cu = 0;
        if (hipGetDevice(&dev) != hipSuccess || hipDeviceGetAttribute(&cus, hipDeviceAttributeMultiprocessorCount, dev) != hipSuccess) { grid = -1; return; }
        if (hipFuncSetAttribute((const void*)fwd, hipFuncAttributeMaxDynamicSharedMemorySize, LDS_BYTES) != hipSuccess) { grid = -1; return; }
        if (hipOccupancyMaxActiveBlocksPerMultiprocessor(&per_cu, (const void*)fwd, NWAVES * 64, LDS_BYTES) != hipSuccess || per_cu < 1)
            fprintf(stderr, "kernel_launch: occupancy query reports %d workgroups per CU\n", per_cu);
        (void)hipGetLastError();
        grid = cus;
    }
    if (grid < 0) return;
    if (hipMemsetAsync((char*)d_ws + WS_CTL, 0, CTL_ZERO_BYTES, stream) != hipSuccess) return;
    Args a{};
    for (int i = 0; i < 24; ++i) a.in[i] = (const float*)d_in[i];
    a.out = (float*)d_out; a.ws = (unsigned char*)d_ws;
#if MK_MULTI
    for (int p = 0; p < 40; ++p) { a.ph_lo = p; a.ph_hi = p + 1; hipLaunchKernelGGL(fwd, dim3(grid), dim3(NWAVES * 64), LDS_BYTES, stream, a); }
#else
    a.ph_lo = 0; a.ph_hi = 1000; hipLaunchKernelGGL(fwd, dim3(grid), dim3(NWAVES * 64), LDS_BYTES, stream, a);
#endif
}
```

```cpp
#include <hip/hip_runtime.h>
#include <cstdio>
#include <cstdint>
#include <cmath>
#define MK_MULTI 0
#define PROBE_PHASES -1
#define PROBE_REPS 2
namespace pg8 {
#define PG8_LAS __attribute__((address_space(3)))
typedef unsigned short bf16_t;
typedef short bf16x8 __attribute__((ext_vector_type(8)));
typedef float f32x4 __attribute__((ext_vector_type(4)));
typedef unsigned u32x4 __attribute__((ext_vector_type(4)));
constexpr int BM = 256, BK = 64, HALF = 128, HTB = HALF * BK * 2  , STAGE_BYTES = 8 * HTB, NXCD = 8, WGM = 8;

__host__ __device__ __forceinline__ int lds_byte(int r, int c) { const int st = (r >> 4) * 2 + (c >> 5), rr = r & 15, cc = c & 31, ob = rr * 64 + cc * 2; return st * 1024 + (ob ^ (((ob >> 9) & 1) << 5)); }
__host__ __device__ __forceinline__ void stage_rc(int b, int& R, int& C) { const int st = b / 1024, sb = b % 1024, swz = sb ^ (((sb >> 9) & 1) << 5); R = (st >> 1) * 16 + swz / 64; C = (st & 1) * 32 + (swz % 64) / 2; }
__host__ __device__ __forceinline__ int perm32(int rho) { const int n = rho >> 4, i = rho & 15; return 8 * (i >> 2) + 4 * n + (i & 3); }

struct Unit { int pm, pn; };
struct Gemm { const bf16_t* A; const bf16_t* Bt; int M, N, K; unsigned a_rs; size_t a_hstep, a_kstep, a_t1, a_t0; int a_sh; int ldb; };
__device__ __forceinline__ Gemm make_gemm(const bf16_t* A, const bf16_t* Bt, int M, int N, int K) {
    Gemm g; g.A = A; g.Bt = Bt; g.M = M; g.N = N; g.K = K; g.a_rs = (unsigned)K * 2u; g.a_hstep = (size_t)HALF * K * 2; g.a_kstep = BK * 2; g.a_t1 = (size_t)BM * K * 2; g.a_t0 = 0; g.a_sh = 0; g.ldb = K; return g; }

struct StaticOrder {
    int nM, nN, nwg, G, c;
    __host__ __device__ void init(int M, int N, int G_, int c_) { nM = M / BM; nN = N / BM; nwg = nM * nN; G = G_; c = c_; }
    __host__ __device__ bool next(int i, Unit& u) const {
        const long L = (long)i * G + c; if (L >= nwg) return false;
        int wgid = (int)L; { const int q = nwg / NXCD, r = nwg % NXCD, xcd = wgid % NXCD, off = wgid / NXCD; wgid = (xcd < r ? xcd * (q + 1) : r * (q + 1) + (xcd - r) * q) + off; }
        const int nig = WGM * nN, gid = wgid / nig, fm = gid * WGM, gsz = (nM - fm) < WGM ? (nM - fm) : WGM;
        u.pm = fm + ((wgid % nig) % gsz); u.pn = (wgid % nig) / gsz; return true;
    }
    __device__ __forceinline__ void a_ready(const Unit&) const {}
    __device__ __forceinline__ void done(const Unit&) const {}
};

__device__ __forceinline__ unsigned cvt_pk_bf16(float lo, float hi) { unsigned r; asm volatile("v_cvt_pk_bf16_f32 %0, %1, %2" : "=v"(r) : "v"(lo), "v"(hi)); return r; }
__device__ __forceinline__ float gelu_tanh(float v) {
    const float u = v * (0.7978845608028654f + 0.035677408136300125f * v * v);
    const float e = __builtin_amdgcn_exp2f(u * -2.8853900817779268f);
    return v * __builtin_amdgcn_rcpf(1.0f + e);
}
template <int ACT> __device__ __forceinline__ float act_fn(float v) {
    if (ACT == 2) return gelu_tanh(v);
    if (ACT == 3) { const float r = v > 0.f ? v : 0.f; return r * r; }
    return v;
}

template <int ACT  > struct EpiBf16 {
    static constexpr bool PERM = true, AFTER_DRAIN = false;
    bf16_t* O; int ldc; const float* bias; int split_cols; size_t split_stride; float scale0;
    __device__ __forceinline__ void operator()(const f32x4 (&acc)[2][2][4][2], const Unit& u, int wr, int wc, int fr, int fq) const {
        const int row0 = u.pm * BM + wr * 64 + fr; int colt = u.pn * BM; bf16_t* base = O;
        float sc = 1.f; if (split_cols) { const int t = colt / split_cols; base += (size_t)t * split_stride; colt -= t * split_cols; if (t == 0) sc = scale0; }
        const int col0 = colt + wc * 32 + 8 * fq, bcol0 = u.pn * BM + wc * 32 + 8 * fq;
        f32x4 bv[2][2];
#pragma unroll
        for (int bj = 0; bj < 2; ++bj)
#pragma unroll
            for (int n = 0; n < 2; ++n) bv[bj][n] = bias ? *(const f32x4*)(bias + bcol0 + bj * HALF + 4 * n) : (f32x4){0.f, 0.f, 0.f, 0.f};
#pragma unroll
        for (int ai = 0; ai < 2; ++ai)
#pragma unroll
            for (int m = 0; m < 4; ++m) { bf16_t* rowp = base + (size_t)(row0 + ai * HALF + m * 16) * ldc + col0;
#pragma unroll
                for (int bj = 0; bj < 2; ++bj) { f32x4 v0 = acc[ai][bj][m][0] + bv[bj][0], v1 = acc[ai][bj][m][1] + bv[bj][1];
                    if (ACT != 0) {
#pragma unroll
                        for (int e = 0; e < 4; ++e) { v0[e] = act_fn<ACT>(v0[e]); v1[e] = act_fn<ACT>(v1[e]); } }
                    v0 = v0 * sc; v1 = v1 * sc; u32x4 w; w.x = cvt_pk_bf16(v0[0], v0[1]); w.y = cvt_pk_bf16(v0[2], v0[3]); w.z = cvt_pk_bf16(v1[0], v1[1]); w.w = cvt_pk_bf16(v1[2], v1[3]);
                    *(u32x4*)(rowp + bj * HALF) = w; } }
    }
};
struct EpiF32 {
    static constexpr bool PERM = false, AFTER_DRAIN = false;
    float* O; int ldc;
    __device__ __forceinline__ void operator()(const f32x4 (&acc)[2][2][4][2], const Unit& u, int wr, int wc, int fr, int fq) const {
        const int row0 = u.pm * BM + wr * 64 + fr, col0 = u.pn * BM + wc * 32 + 4 * fq;
#pragma unroll
        for (int ai = 0; ai < 2; ++ai)
#pragma unroll
            for (int m = 0; m < 4; ++m) { float* rowp = O + (size_t)(row0 + ai * HALF + m * 16) * ldc + col0;
#pragma unroll
                for (int bj = 0; bj < 2; ++bj)
#pragma unroll
                    for (int n = 0; n < 2; ++n) *(f32x4*)(rowp + bj * HALF + n * 16) = acc[ai][bj][m][n]; }
    }
};
struct EpiQG {
    static constexpr bool PERM = true, AFTER_DRAIN = false;
    bf16_t* Q; float* G; float qscale;
    __device__ __forceinline__ void operator()(const f32x4 (&acc)[2][2][4][2], const Unit& u, int wr, int wc, int fr, int fq) const {
        const int row0 = u.pm * BM + wr * 64 + fr;
        if (u.pn < 4) {
            const int col0 = u.pn * BM + wc * 32 + 8 * fq;
#pragma unroll
            for (int ai = 0; ai < 2; ++ai)
#pragma unroll
                for (int m = 0; m < 4; ++m) { bf16_t* rowp = Q + (size_t)(row0 + ai * HALF + m * 16) * 1024 + col0;
#pragma unroll
                    for (int bj = 0; bj < 2; ++bj) { const f32x4 v0 = acc[ai][bj][m][0] * qscale, v1 = acc[ai][bj][m][1] * qscale;
                        u32x4 w; w.x = cvt_pk_bf16(v0[0], v0[1]); w.y = cvt_pk_bf16(v0[2], v0[3]); w.z = cvt_pk_bf16(v1[0], v1[1]); w.w = cvt_pk_bf16(v1[2], v1[3]);
                        *(u32x4*)(rowp + bj * HALF) = w; } }
        } else if (wc < 2) {
#pragma unroll
            for (int ai = 0; ai < 2; ++ai)
#pragma unroll
                for (int m = 0; m < 4; ++m) { float* rowp = G + (size_t)(row0 + ai * HALF + m * 16) * 48;
#pragma unroll
                    for (int n = 0; n < 2; ++n) { const int col = wc * 32 + 8 * fq + 4 * n;
                        if (col < 48) { f32x4 v = acc[ai][0][m][n];
#pragma unroll
                            for (int e = 0; e < 4; ++e) v[e] = __builtin_amdgcn_rcpf(1.0f + __builtin_amdgcn_exp2f(v[e] * -1.4426950408889634f));
                            *(f32x4*)(rowp + col) = v; } } }
        }
    }
};

template <class Epi, class Sched, bool ALIGN_EPI = false, bool SP2 = false>
__device__ __forceinline__ void gemm_phase(PG8_LAS unsigned char* lds, const Gemm g, const Sched& S, const Epi& E) {
    int tid_ = threadIdx.x; asm volatile("" : "+v"(tid_));
    const int tid = tid_, wid = __builtin_amdgcn_readfirstlane(tid >> 6), lane = tid & 63, wr = wid >> 2, wc = wid & 3, fr = lane & 15, fq = lane >> 4;
    const int K = g.K, nt = K / BK;
    unsigned voffA[2], voffB[2];
#pragma unroll
    for (int i = 0; i < 2; ++i) { int R, C; stage_rc(tid * 16 + i * 8192, R, C); const int Rb = Epi::PERM ? ((R & ~31) + perm32(R & 31)) : R;
        voffA[i] = (unsigned)R * g.a_rs + (unsigned)C * 2u; voffB[i] = (unsigned)(Rb * g.ldb + C) * 2u; }
    const size_t kstepA = g.a_kstep, kstepB = (size_t)(BK * 2);
    const size_t hstepA = g.a_hstep, hstepB = (size_t)HALF * g.ldb * 2;
    const size_t tstepB = 2 * hstepB;
    const int a_msk = (1 << g.a_sh) - 1;
#define PG8_ATILE(pm) ((const char*)g.A + (size_t)((pm) >> g.a_sh) * g.a_t1 + (size_t)((pm) & a_msk) * g.a_t0)
    const unsigned ldsw = (unsigned)wid * 1024u;
    const int aoff = lds_byte(wr * 64 + fr, fq * 8), boff = lds_byte(wc * 32 + fr, fq * 8);
#define PG8_SA(b, h) (((b) * 2 + (h)) * HTB)
#define PG8_SB(b, h) ((4 + (b) * 2 + (h)) * HTB)
#define PG8_STAGE(bufoff, gbase, voff) do { _Pragma("unroll") for (int _i = 0; _i < 2; ++_i) \
        __builtin_amdgcn_global_load_lds((const unsigned*)((const char*)(gbase) + (voff)[_i]), (PG8_LAS unsigned*)(lds + (bufoff) + ldsw + _i * 8192), 16, 0, 0); } while (0)
#define PG8_LDA(dst, b, h) do { _Pragma("unroll") for (int m = 0; m < 4; ++m) _Pragma("unroll") for (int k = 0; k < 2; ++k) dst[m][k] = *(const PG8_LAS bf16x8*)(lds + PG8_SA(b, h) + aoff + m * 2048 + k * 1024); } while (0)
#define PG8_LDB(dst, b, h) do { _Pragma("unroll") for (int n = 0; n < 2; ++n) _Pragma("unroll") for (int k = 0; k < 2; ++k) dst[n][k] = *(const PG8_LAS bf16x8*)(lds + PG8_SB(b, h) + boff + n * 2048 + k * 1024); } while (0)
#define PG8_MMA(ai, bj, At, Bt) do { __builtin_amdgcn_s_setprio(1); _Pragma("unroll") for (int m = 0; m < 4; ++m) _Pragma("unroll") for (int n = 0; n < 2; ++n) _Pragma("unroll") for (int k = 0; k < 2; ++k) \
        acc[ai][bj][m][n] = __builtin_amdgcn_mfma_f32_16x16x32_bf16(Bt[n][k], At[m][k], acc[ai][bj][m][n], 0, 0, 0); __builtin_amdgcn_s_setprio(0); } while (0)
#define PG8_WAIT_V(n) asm volatile("s_waitcnt vmcnt(" #n ")" ::: "memory")
#define PG8_WAIT_L(n) asm volatile("s_waitcnt lgkmcnt(" #n ")" ::: "memory")
#define PG8_BAR __builtin_amdgcn_s_barrier()
#define PG8_SCHED __builtin_amdgcn_sched_barrier(0)
    Unit cur, nxt; int ui = 0;
    if (!S.next(0, cur)) return;
    f32x4 acc[2][2][4][2];
#pragma unroll
    for (int a = 0; a < 2; ++a)
#pragma unroll
        for (int b = 0; b < 2; ++b)
#pragma unroll
            for (int m = 0; m < 4; ++m)
#pragma unroll
                for (int n = 0; n < 2; ++n) acc[a][b][m][n] = (f32x4){0.f, 0.f, 0.f, 0.f};
    bf16x8 At[4][2], B0[2][2], B1[2][2];
    const char* cA = PG8_ATILE(cur.pm); const char* cB = (const char*)g.Bt + (size_t)cur.pn * tstepB;
    S.a_ready(cur);
    if constexpr (SP2) {
        PG8_STAGE(PG8_SB(0, 0), cB, voffB); PG8_STAGE(PG8_SB(0, 1), cB + hstepB, voffB); PG8_STAGE(PG8_SA(0, 0), cA, voffA); PG8_STAGE(PG8_SA(0, 1), cA + hstepA, voffA);
        if (wr == 1) PG8_BAR;
        PG8_WAIT_V(2); PG8_BAR;
        PG8_STAGE(PG8_SB(1, 0), cB + kstepB, voffB); PG8_STAGE(PG8_SA(1, 0), cA + kstepA, voffA); PG8_STAGE(PG8_SB(1, 1), cB + hstepB + kstepB, voffB);
        PG8_WAIT_V(6); PG8_BAR;
    } else {
        PG8_STAGE(PG8_SB(0, 0), cB, voffB); PG8_STAGE(PG8_SA(0, 0), cA, voffA); PG8_STAGE(PG8_SB(0, 1), cB + hstepB, voffB); PG8_STAGE(PG8_SA(0, 1), cA + hstepA, voffA);
        if (wr == 1) PG8_BAR;
        PG8_WAIT_V(4); PG8_BAR;
        PG8_STAGE(PG8_SB(1, 0), cB + kstepB, voffB); PG8_STAGE(PG8_SA(1, 0), cA + kstepA, voffA); PG8_STAGE(PG8_SB(1, 1), cB + hstepB + kstepB, voffB);
        PG8_WAIT_V(6); PG8_BAR;
    }
    for (;;) {
        const bool has_next = S.next(ui + 1, nxt);
        const char* nA = has_next ? PG8_ATILE(nxt.pm) : cA; const char* nB = has_next ? (const char*)g.Bt + (size_t)nxt.pn * tstepB : cB;
        for (int t = 0; t < nt; t += 2) {
            const bool last = (t == nt - 2);
            const char* a1 = cA + (size_t)(t + 1) * kstepA;
            const char* a2 = last ? nA : cA + (size_t)(t + 2) * kstepA; const char* b2 = last ? nB : cB + (size_t)(t + 2) * kstepB;
            const char* a3 = a2 + kstepA; const char* b3 = b2 + kstepB;
            if (last && has_next) S.a_ready(nxt);
            if constexpr (SP2) {
            PG8_LDB(B0, 0, 0); PG8_LDB(B1, 0, 1); PG8_SCHED; PG8_LDA(At, 0, 0); PG8_STAGE(PG8_SA(1, 1), a1 + hstepA, voffA);
            PG8_WAIT_V(8); PG8_WAIT_L(0); PG8_BAR; PG8_MMA(0, 0, At, B0); PG8_MMA(0, 1, At, B1); PG8_BAR; PG8_SCHED;
            PG8_LDA(At, 0, 1); PG8_STAGE(PG8_SB(0, 0), b2, voffB); PG8_STAGE(PG8_SB(0, 1), b2 + hstepB, voffB); PG8_STAGE(PG8_SA(0, 0), a2, voffA);
            PG8_WAIT_V(8); PG8_WAIT_L(0); PG8_BAR; PG8_MMA(1, 0, At, B0); PG8_MMA(1, 1, At, B1); PG8_BAR; PG8_SCHED;
            PG8_LDB(B0, 1, 0); PG8_LDB(B1, 1, 1); PG8_SCHED; PG8_LDA(At, 1, 0); PG8_STAGE(PG8_SA(0, 1), a2 + hstepA, voffA);
            PG8_WAIT_V(8); PG8_WAIT_L(0); PG8_BAR; PG8_MMA(0, 0, At, B0); PG8_MMA(0, 1, At, B1); PG8_BAR; PG8_SCHED;
            PG8_LDA(At, 1, 1); PG8_STAGE(PG8_SB(1, 0), b3, voffB); PG8_STAGE(PG8_SB(1, 1), b3 + hstepB, voffB); PG8_STAGE(PG8_SA(1, 0), a3, voffA);
            PG8_WAIT_V(8); PG8_WAIT_L(0); PG8_BAR; PG8_MMA(1, 0, At, B0); PG8_MMA(1, 1, At, B1); PG8_BAR; PG8_SCHED;
            } else {
            PG8_LDB(B0, 0, 0); PG8_SCHED; PG8_LDA(At, 0, 0); PG8_STAGE(PG8_SA(1, 1), a1 + hstepA, voffA);
            PG8_WAIT_L(8); PG8_BAR; PG8_WAIT_L(0); PG8_MMA(0, 0, At, B0); PG8_BAR; PG8_SCHED;
            PG8_LDB(B1, 0, 1); PG8_STAGE(PG8_SB(0, 0), b2, voffB);
            PG8_BAR; PG8_WAIT_L(0); PG8_MMA(0, 1, At, B1); PG8_BAR;
            PG8_LDA(At, 0, 1); PG8_STAGE(PG8_SA(0, 0), a2, voffA);
            PG8_BAR; PG8_WAIT_L(0); PG8_MMA(1, 0, At, B0); PG8_BAR; PG8_SCHED;
            PG8_STAGE(PG8_SB(0, 1), b2 + hstepB, voffB);
            PG8_WAIT_V(6); PG8_BAR; PG8_MMA(1, 1, At, B1); PG8_BAR;
            PG8_LDB(B0, 1, 0); PG8_SCHED; PG8_LDA(At, 1, 0); PG8_STAGE(PG8_SA(0, 1), a2 + hstepA, voffA);
            PG8_WAIT_L(8); PG8_BAR; PG8_WAIT_L(0); PG8_MMA(0, 0, At, B0); PG8_BAR; PG8_SCHED;
            PG8_LDB(B1, 1, 1); PG8_STAGE(PG8_SB(1, 0), b3, voffB);
            PG8_BAR; PG8_WAIT_L(0); PG8_MMA(0, 1, At, B1); PG8_BAR;
            PG8_LDA(At, 1, 1); PG8_STAGE(PG8_SA(1, 0), a3, voffA);
            PG8_BAR; PG8_WAIT_L(0); PG8_MMA(1, 0, At, B0); PG8_BAR; PG8_SCHED;
            PG8_STAGE(PG8_SB(1, 1), b3 + hstepB, voffB);
            PG8_WAIT_V(6); PG8_BAR; PG8_MMA(1, 1, At, B1); PG8_BAR;
            }
        }
        if constexpr (ALIGN_EPI) { if (wr == 0) PG8_BAR; }
        E(acc, cur, wr, wc, fr, fq); S.done(cur);
        if (!has_next) break;
#pragma unroll
        for (int a = 0; a < 2; ++a)
#pragma unroll
            for (int b = 0; b < 2; ++b)
#pragma unroll
                for (int m = 0; m < 4; ++m)
#pragma unroll
                    for (int n = 0; n < 2; ++n) acc[a][b][m][n] = (f32x4){0.f, 0.f, 0.f, 0.f};
        cur = nxt; cA = nA; cB = nB; ++ui;
        if constexpr (ALIGN_EPI) { if (wr == 1) PG8_BAR; }
    }
    PG8_WAIT_V(0);
    if constexpr (!ALIGN_EPI) { if (wr == 0) PG8_BAR; }
    PG8_BAR;
#undef PG8_ATILE
#undef PG8_SA
#undef PG8_SB
#undef PG8_STAGE
#undef PG8_LDA
#undef PG8_LDB
#undef PG8_MMA
#undef PG8_WAIT_V
#undef PG8_WAIT_L
#undef PG8_BAR
#undef PG8_SCHED
}
}
constexpr int NWAVES = 8;
#ifndef MK_MULTI
#define MK_MULTI 0
#endif

constexpr int BATCH = 16, T = 2048, D = 1024, FF = 4096, DEPTH = 4;
constexpr int M = BATCH * T;
constexpr int MH = M / 2;
constexpr int NKV = 1536;
constexpr int NQG = 1280;
constexpr int NCMP = 127;
constexpr float EPS = 1e-6f;

constexpr size_t MiB = 1u << 20;
constexpr size_t WS_CTL = 0, CTL_ZERO_BYTES = 64 * 1024;
constexpr size_t WS_MOD = 1 * MiB;
constexpr size_t WS_CB1 = 3 * MiB;
constexpr size_t WS_GATE = 4 * MiB;
constexpr size_t WS_KCV = 10 * MiB;
constexpr size_t WS_CH = 16 * MiB;
constexpr size_t WS_W = 32 * MiB;
constexpr size_t WS_KV = 128 * MiB;
constexpr size_t WS_HB = 224 * MiB;
constexpr size_t WS_Y = 288 * MiB;
constexpr size_t WS_BIG = 352 * MiB;
constexpr size_t WS_END = 480 * MiB;
constexpr size_t WO_AIN = 0;
constexpr size_t WO_AOUT = WO_AIN + 2ull * 2048 * 1024;
constexpr size_t WO_KV = WO_AOUT + 2ull * 1024 * 1024;
constexpr size_t WO_BIN = WO_KV + 1536ull * 1024;
constexpr size_t WO_BOUT = WO_BIN + 2ull * 1280 * 1024;
constexpr size_t WO_FIN = WO_BOUT + 2ull * 1024 * 1024;
constexpr size_t WO_FOUT = WO_FIN + 4ull * 4096 * 1024;
constexpr size_t WO_C1 = WO_FOUT + 4ull * 4096 * 1024;
constexpr size_t WO_WS = WO_C1 + 2ull * 256 * 2048;
constexpr size_t WO_END = WO_WS + 2ull * 8 * 128 * 128;
static_assert(WO_END * 2 <= 96 * MiB, "weights fit");
constexpr int CW_BAR = 1024;

constexpr int RING_OFF = 0, RING_BYTES = 131072;
constexpr int LDSCTL_OFF = RING_BYTES, MISC_OFF = LDSCTL_OFF + 320;
constexpr int LDS_BYTES = 147456;

#define GAS __attribute__((address_space(1)))
#define LAS __attribute__((address_space(3)))
typedef unsigned short bf16;
typedef unsigned v4u __attribute__((ext_vector_type(4)));
typedef unsigned v2u __attribute__((ext_vector_type(2)));
typedef float f32x4 __attribute__((ext_vector_type(4)));
typedef GAS unsigned gu32;
#define RLX_AGENT __ATOMIC_RELAXED, __HIP_MEMORY_SCOPE_AGENT
#define LDS_WAIT() asm volatile("s_waitcnt lgkmcnt(0)" ::: "memory")
#define VM_WAIT() asm volatile("s_waitcnt vmcnt(0)" ::: "memory")
__device__ __forceinline__ unsigned f2bf(float f) { unsigned u = __builtin_bit_cast(unsigned, f); return (u + 0x7fffu + ((u >> 16) & 1u)) >> 16; }
__device__ __forceinline__ unsigned pk2(float lo, float hi) { return f2bf(lo) | (f2bf(hi) << 16); }
__device__ __forceinline__ float bf_lo(unsigned w) { return __builtin_bit_cast(float, w << 16); }
__device__ __forceinline__ float bf_hi(unsigned w) { return __builtin_bit_cast(float, w & 0xffff0000u); }
__device__ __forceinline__ float bf1(bf16 h) { return __builtin_bit_cast(float, (unsigned)h << 16); }
__device__ __forceinline__ float wave_sum(float v) {
#pragma unroll
    for (int o = 1; o < 64; o <<= 1) v += __shfl_xor(v, o);
    return v;
}
__device__ __forceinline__ float wave_max(float v) {
#pragma unroll
    for (int o = 1; o < 64; o <<= 1) v = fmaxf(v, __shfl_xor(v, o));
    return v;
}

#define XB_TMO      128
#define XB_XCNT(j)  (256  + 64 * (j))
#define XB_XSUB(j)  (1280 + 64 * (j))
#define XB_XGEN(j)  (2304 + 64 * (j))
#define XB_TOP      3328
#define XB_TOPGEN   3392
#define XCD_BAR_WORDS 3456
#define XB_SPIN_CAP (1u << 18)

__device__ __forceinline__ unsigned xb_ld(unsigned* p)              { return __hip_atomic_load(p, __ATOMIC_RELAXED, __HIP_MEMORY_SCOPE_AGENT); }
__device__ __forceinline__ unsigned xb_add(unsigned* p, unsigned v) { return __hip_atomic_fetch_add(p, v, __ATOMIC_RELAXED, __HIP_MEMORY_SCOPE_AGENT); }
__device__ __forceinline__ unsigned xb_xcc_id() { return (unsigned)__builtin_amdgcn_s_getreg((3 << 11) | 20) & 0xFu; }
#define XB_SPIN(cond, bar) do { unsigned _sp = 0; while (cond) { __builtin_amdgcn_s_sleep(1); \
    if ((++_sp & 255u) == 0u) { if (xb_ld(&(bar)[XB_TMO])) break; if (_sp > XB_SPIN_CAP) { atomicAdd(&(bar)[XB_TMO], 1u); break; } } } } while (0)

struct XcdBarrier {
    unsigned* bar; unsigned x;
    volatile LAS unsigned* st;
};
__device__ __forceinline__ XcdBarrier xcd_barrier_post(unsigned* bar, volatile LAS unsigned* st) {
    XcdBarrier b; b.bar = bar; b.x = xb_xcc_id(); b.st = st;
    if (threadIdx.x == 0) (void)xb_add(&bar[XB_XCNT(b.x)], 1u);
    return b;
}
__device__ __forceinline__ void xcd_barrier_complete(unsigned* bar, unsigned x, unsigned& nloc, unsigned& nx) {
    const unsigned G = gridDim.x * gridDim.y * gridDim.z;
    unsigned sum, cnt, mine, sp = 0u;
    for (;;) {
        sum = 0u; cnt = 0u; mine = 0u;
#pragma unroll
        for (unsigned j = 0; j < 16; ++j) { const unsigned c = xb_ld(&bar[XB_XCNT(j)]); sum += c; cnt += (c > 0u) ? 1u : 0u; mine = (j == x) ? c : mine; }
        if (sum == G) break;
        __builtin_amdgcn_s_sleep(1);
        if ((++sp & 255u) == 0u) { if (xb_ld(&bar[XB_TMO])) break; if (sp > XB_SPIN_CAP) { atomicAdd(&bar[XB_TMO], 1u); break; } }
    }
    nloc = mine > 0u ? mine : 1u; nx = cnt > 0u ? cnt : 1u;
}
__device__ __forceinline__ void xcd_barrier(const XcdBarrier& b) {
    asm volatile("s_waitcnt vmcnt(0)" ::: "memory");
    __syncthreads();
    if (threadIdx.x == 0) {
        unsigned* bar = b.bar;
        __builtin_amdgcn_s_waitcnt(0);
        unsigned nloc = b.st[0], nx = b.st[1];
        if (nloc == 0u) { xcd_barrier_complete(bar, b.x, nloc, nx); b.st[0] = nloc; b.st[1] = nx; }
        const unsigned old = xb_add(&bar[XB_XSUB(b.x)], 1u);
        const unsigned gen = old / nloc;
        if (old + 1u == (gen + 1u) * nloc) {
            __builtin_amdgcn_fence(__ATOMIC_RELEASE, "agent");
            asm volatile("s_waitcnt vmcnt(0)" ::: "memory");
            const unsigned og = xb_add(&bar[XB_TOP], 1u);
            const unsigned tg = og / nx;
            if (og + 1u == (tg + 1u) * nx) xb_add(&bar[XB_TOPGEN], 1u);
            else XB_SPIN(xb_ld(&bar[XB_TOPGEN]) == tg, bar);
            __builtin_amdgcn_fence(__ATOMIC_ACQUIRE, "agent");
            xb_add(&bar[XB_XGEN(b.x)], 1u);
            asm volatile("s_waitcnt vmcnt(0)" ::: "memory");
        } else {
            XB_SPIN(xb_ld(&bar[XB_XGEN(b.x)]) == gen, bar);
            __builtin_amdgcn_fence(__ATOMIC_ACQUIRE, "agent");
            asm volatile("s_waitcnt vmcnt(0)" ::: "memory");
        }
    }
    __syncthreads();
}

struct Frame {
    LAS unsigned char* lds;
    int tid, lane, wave;
    int vcu, G;
};
__device__ __forceinline__ void tr_item(const float* W, int K, int ldw, int nvalid, bf16* WT, int nblk, LAS float* scr, int item, int lane) {
    const int kb = item / nblk, nb = item % nblk, k0 = 64 * kb, n0 = 32 * nb;
    const int nn = n0 + (lane & 31); const bool ok = nn < nvalid;
#pragma unroll 8
    for (int i = 0; i < 32; ++i) { const int kk = 2 * i + (lane >> 5); scr[kk * 33 + (lane & 31)] = ok ? W[(size_t)(k0 + kk) * ldw + nn] : 0.f; }
    LDS_WAIT(); asm volatile("" ::: "memory");
    const int c = lane & 7;
#pragma unroll
    for (int j = 0; j < 4; ++j) { const int n = (lane >> 3) + 8 * j; const LAS float* s = scr + (8 * c) * 33 + n;
        v4u o; o.x = pk2(s[0 * 33], s[1 * 33]); o.y = pk2(s[2 * 33], s[3 * 33]); o.z = pk2(s[4 * 33], s[5 * 33]); o.w = pk2(s[6 * 33], s[7 * 33]);
        *(GAS v4u*)(WT + (size_t)(n0 + n) * K + k0 + 8 * c) = o; }
    LDS_WAIT(); asm volatile("" ::: "memory");
}

struct Args { const float* in[24]; float* out; unsigned char* ws; int ph_lo, ph_hi; };
typedef const __attribute__((address_space(4))) Args* kargs_t;

__device__ __forceinline__ void p0_prologue(const Frame& F, kargs_t a) {
    LAS float* scr = (LAS float*)(F.lds + RING_OFF + F.wave * 16384);
    bf16* WB = (bf16*)(a->ws + WS_W);
    const int gw = F.vcu * NWAVES + F.wave, NGW = F.G * NWAVES;
    constexpr int I_AIN = 16 * 64, I_AOUT = 16 * 32, I_KV = 16 * 48, I_BIN = 16 * 40, I_BOUT = 16 * 32, I_FIN = 16 * 128, I_FOUT = 64 * 32, I_C1 = 32 * 8;
    constexpr int NITEMS = 2 * I_AIN + 2 * I_AOUT + I_KV + 2 * I_BIN + 2 * I_BOUT + 4 * I_FIN + 4 * I_FOUT + 2 * I_C1;
    for (int it = gw; it < NITEMS; it += NGW) {
        int r = it;
        if (r < 2 * I_AIN) { const int l = r / I_AIN; tr_item(a->in[5] + (size_t)l * 1024 * 2048, 1024, 2048, 2048, WB + WO_AIN + (size_t)l * 2048 * 1024, 64, scr, r % I_AIN, F.lane); continue; } r -= 2 * I_AIN;
        if (r < 2 * I_AOUT) { const int l = r / I_AOUT; tr_item(a->in[10] + (size_t)l * 1024 * 1024, 1024, 1024, 1024, WB + WO_AOUT + (size_t)l * 1024 * 1024, 32, scr, r % I_AOUT, F.lane); continue; } r -= 2 * I_AOUT;
        if (r < I_KV) { tr_item(a->in[14], 1024, 1536, 1536, WB + WO_KV, 48, scr, r, F.lane); continue; } r -= I_KV;
        if (r < 2 * I_BIN) { const int l = r / I_BIN; tr_item(a->in[20] + (size_t)l * 1024 * 1072, 1024, 1072, 1072, WB + WO_BIN + (size_t)l * 1280 * 1024, 40, scr, r % I_BIN, F.lane); continue; } r -= 2 * I_BIN;
        if (r < 2 * I_BOUT) { const int l = r / I_BOUT; tr_item(a->in[21] + (size_t)l * 1024 * 1024, 1024, 1024, 1024, WB + WO_BOUT + (size_t)l * 1024 * 1024, 32, scr, r % I_BOUT, F.lane); continue; } r -= 2 * I_BOUT;
        if (r < 4 * I_FIN) { const int l = r / I_FIN; tr_item(a->in[22] + (size_t)l * 1024 * 4096, 1024, 4096, 4096, WB + WO_FIN + (size_t)l * 4096 * 1024, 128, scr, r % I_FIN, F.lane); continue; } r -= 4 * I_FIN;
        if (r < 4 * I_FOUT) { const int l = r / I_FOUT; tr_item(a->in[23] + (size_t)l * 4096 * 1024, 4096, 1024, 1024, WB + WO_FOUT + (size_t)l * 1024 * 4096, 32, scr, r % I_FOUT, F.lane); continue; } r -= 4 * I_FOUT;
        { const int l = r / I_C1; tr_item(a->in[16] + (size_t)l * 2048 * 256, 2048, 256, 256, WB + WO_C1 + (size_t)l * 256 * 2048, 8, scr, r % I_C1, F.lane); }
    }
    for (int i = gw * 64 + F.lane; i < 2 * 8 * 128 * 128; i += NGW * 64) { const int s = i & 127, t = (i >> 7) & 127; WB[WO_WS + i] = (s <= t) ? (bf16)f2bf(a->in[8][i]) : (bf16)0; }
    __syncthreads();
    if (F.vcu < 208) {
        LAS float* cact = (LAS float*)(F.lds);
        LAS float* red = (LAS float*)(F.lds + 65536);
        for (int i = F.tid; i < 16 * 1024; i += NWAVES * 64) { const float c = a->in[1][i]; cact[i] = c / (1.0f + __expf(-c)); }
        __syncthreads();
        const int grp = F.vcu; const float* W; const float* bias; float* out; int ldw, n0, ostride;
        float* MOD = (float*)(a->ws + WS_MOD);
        if (grp < 192) { const int L = grp / 48; n0 = (grp % 48) * 128; W = a->in[2] + (size_t)L * 1024 * 6144; ldw = 6144; bias = a->in[3] + L * 6144; out = MOD + (size_t)L * 16 * 6144; ostride = 6144; }
        else { n0 = (grp - 192) * 128; W = a->in[11]; ldw = 2048; bias = a->in[12]; out = MOD + (size_t)4 * 16 * 6144; ostride = 2048; }
        float acc0[16], acc1[16];
#pragma unroll
        for (int b = 0; b < 16; ++b) { acc0[b] = 0.f; acc1[b] = 0.f; }
        const int kbeg = F.wave * 128;
        for (int k = kbeg; k < kbeg + 128; ++k) {
            const float2 w = *(const float2*)(W + (size_t)k * ldw + n0 + 2 * F.lane);
#pragma unroll
            for (int b = 0; b < 16; ++b) { const float cv = cact[b * 1024 + k]; acc0[b] += cv * w.x; acc1[b] += cv * w.y; }
        }
#pragma unroll
        for (int b = 0; b < 16; ++b) { red[(F.wave * 16 + b) * 128 + 2 * F.lane] = acc0[b]; red[(F.wave * 16 + b) * 128 + 2 * F.lane + 1] = acc1[b]; }
        __syncthreads();
        for (int o = F.tid; o < 2048; o += NWAVES * 64) { const int b = o >> 7, n = o & 127; float s = bias[n0 + n];
#pragma unroll
            for (int w = 0; w < 8; ++w) s += red[(w * 16 + b) * 128 + n];
            out[(size_t)b * ostride + n0 + n] = s; }
    } else if (F.vcu == 208) {
        const int j = F.tid >> 8, n = F.tid & 255; float s = a->in[17][j * 256 + n];
        const float* pos = a->in[15] + j * 2048; const float* w1 = a->in[16] + (size_t)j * 2048 * 256 + n;
        for (int kk = 0; kk < 2048; ++kk) s += pos[kk] * w1[(size_t)kk * 256];
        ((float*)(a->ws + WS_CB1))[j * 256 + n] = s;
    }
}

template <bool HAS_Y, bool HAS_H, bool HAS_KV>
__device__ __forceinline__ void norm_phase(const Frame& F, const float* xin, float* xout, const bf16* Y, const float* gy, const float* gate  ,
                                           const float* gn, const float* sh, const float* sc, int mstride, bf16* H,
                                           const float* gkv, const float* shkv, const float* sckv, int kvstride, bf16* HKV) {
    const int gw = F.vcu * NWAVES + F.wave, NGW = F.G * NWAVES;
    for (int blk = gw; blk < M / 16; blk += NGW) {
        const int b = blk / (T / 16);
        f32x4 A1[4], A2[4], A3[4], K2[4], K3[4];
#pragma unroll
        for (int j = 0; j < 4; ++j) { const int col = 256 * j + 4 * F.lane;
            if (HAS_Y) A1[j] = *(const f32x4*)(gate + (size_t)b * mstride + col) * *(const f32x4*)(gy + col);
            if (HAS_H) { A2[j] = *(const f32x4*)(gn + col) * (*(const f32x4*)(sc + (size_t)b * mstride + col) + 1.0f); A3[j] = *(const f32x4*)(sh + (size_t)b * mstride + col); }
            if (HAS_KV) { K2[j] = *(const f32x4*)(gkv + col) * (*(const f32x4*)(sckv + (size_t)b * kvstride + col) + 1.0f); K3[j] = *(const f32x4*)(shkv + (size_t)b * kvstride + col); }
        }
        for (int r = 0; r < 16; ++r) {
            const size_t m = (size_t)blk * 16 + r;
            f32x4 xv[4];
#pragma unroll
            for (int j = 0; j < 4; ++j) xv[j] = *(const f32x4*)(xin + m * D + 256 * j + 4 * F.lane);
            if (HAS_Y) {
                f32x4 yv[4]; float s = 0.f;
#pragma unroll
                for (int j = 0; j < 4; ++j) { const v2u w = *(const v2u*)(Y + m * D + 256 * j + 4 * F.lane); yv[j] = (f32x4){bf_lo(w.x), bf_hi(w.x), bf_lo(w.y), bf_hi(w.y)};
                    s += (yv[j].x * yv[j].x + yv[j].y * yv[j].y) + (yv[j].z * yv[j].z + yv[j].w * yv[j].w); }
                const float rstd = 1.0f / sqrtf(wave_sum(s) * (1.0f / D) + EPS);
#pragma unroll
                for (int j = 0; j < 4; ++j) { xv[j] = xv[j] + A1[j] * (yv[j] * rstd); *(f32x4*)(xout + m * D + 256 * j + 4 * F.lane) = xv[j]; }
            }
            if (HAS_H || HAS_KV) {
                float s = 0.f;
#pragma unroll
                for (int j = 0; j < 4; ++j) s += (xv[j].x * xv[j].x + xv[j].y * xv[j].y) + (xv[j].z * xv[j].z + xv[j].w * xv[j].w);
                const float rstd = 1.0f / sqrtf(wave_sum(s) * (1.0f / D) + EPS);
#pragma unroll
                for (int j = 0; j < 4; ++j) { const f32x4 xn = xv[j] * rstd;
                    if (HAS_H) { const f32x4 h = xn * A2[j] + A3[j]; v2u w; w.x = pk2(h.x, h.y); w.y = pk2(h.z, h.w); *(v2u*)(H + m * D + 256 * j + 4 * F.lane) = w; }
                    if (HAS_KV) { const f32x4 h = xn * K2[j] + K3[j]; v2u w; w.x = pk2(h.x, h.y); w.y = pk2(h.z, h.w); *(v2u*)(HKV + m * D + 256 * j + 4 * F.lane) = w; } }
            }
        }
    }
}

#if 0
__device__ __forceinline__ void sgu_phase_naive(const Frame& F, const bf16* U, const bf16* V, const float* lng, const float* lnb, const float* ws, const float* bs, bf16* GT) {
    LAS float* vt = (LAS float*)(F.lds);
    LAS float* wm = (LAS float*)(F.lds + 65536);
    LAS float* st = (LAS float*)(F.lds + 132096);
    for (int ch = F.vcu; ch < M / 128; ch += F.G) {
        const size_t m0 = (size_t)ch * 128;
        __syncthreads();
        for (int r = 0; r < 16; ++r) { const int row = F.wave * 16 + r; float s = 0.f, q = 0.f; float xv[16];
#pragma unroll
            for (int j = 0; j < 4; ++j) { const v2u w = *(const v2u*)(V + (m0 + row) * D + 256 * j + 4 * F.lane); xv[4 * j] = bf_lo(w.x); xv[4 * j + 1] = bf_hi(w.x); xv[4 * j + 2] = bf_lo(w.y); xv[4 * j + 3] = bf_hi(w.y); }
#pragma unroll
            for (int e = 0; e < 16; ++e) s += xv[e];
            const float mean = wave_sum(s) * (1.0f / D);
#pragma unroll
            for (int e = 0; e < 16; ++e) { const float d = xv[e] - mean; q += d * d; }
            const float rstd = 1.0f / sqrtf(wave_sum(q) * (1.0f / D) + EPS);
            if (F.lane == 0) { st[row * 2] = mean; st[row * 2 + 1] = rstd; } }
        __syncthreads();
        for (int g = 0; g < 8; ++g) {
            for (int i = F.tid; i < 128 * 128; i += NWAVES * 64) { const int s = i >> 7, d = i & 127; const int c = g * 128 + d;
                vt[i] = (bf1(V[(m0 + s) * D + c]) - st[s * 2]) * st[s * 2 + 1] * lng[c] + lnb[c];
                const int t = i >> 7, s2 = i & 127; wm[s2 * 128 + t] = (s2 <= t) ? ws[(size_t)g * 16384 + t * 128 + s2] : 0.f; }
            __syncthreads();
            const int d = F.tid & 127, tq = __builtin_amdgcn_readfirstlane(F.tid >> 7);
            float acc[32];
#pragma unroll
            for (int i = 0; i < 32; ++i) acc[i] = 0.f;
            for (int s = 0; s < 128; ++s) { const float vv = vt[s * 128 + d];
#pragma unroll
                for (int i4 = 0; i4 < 8; ++i4) { const f32x4 w4 = *(const LAS f32x4*)(wm + s * 128 + tq * 32 + i4 * 4);
                    acc[i4 * 4] += w4.x * vv; acc[i4 * 4 + 1] += w4.y * vv; acc[i4 * 4 + 2] += w4.z * vv; acc[i4 * 4 + 3] += w4.w * vv; } }
#pragma unroll
            for (int i = 0; i < 32; ++i) { const int t = tq * 32 + i; const size_t idx = (m0 + t) * D + g * 128 + d;
                GT[idx] = (bf16)f2bf(bf1(U[idx]) * (acc[i] + bs[g * 128 + t])); }
            __syncthreads();
        }
    }
}

#endif
__device__ __forceinline__ void cmp2_phase(const Frame& F, const float* PART, const float* cb1, const float* w2, const float* b2, bf16* KCV) {
    LAS float* w2l = (LAS float*)(F.lds + RING_OFF);
    LAS float* hl = (LAS float*)(F.lds + RING_OFF + 65536) + F.wave * 256;
    const int half = F.G / 2, j = F.vcu / half, vj = F.vcu % half;
    if (j < 2) {
        for (int i = F.tid; i < 256 * 64 / 4; i += NWAVES * 64) *(LAS f32x4*)(w2l + 4 * i) = *(const f32x4*)(w2 + (size_t)j * 256 * 64 + 4 * i);
    }
    __syncthreads();
    if (j < 2) {
        for (int r = vj * NWAVES + F.wave; r < 8192; r += half * NWAVES) {
            const float* p0 = PART + ((size_t)(j * 2 + 0) * 8192 + r) * 256; const float* p1 = PART + ((size_t)(j * 2 + 1) * 8192 + r) * 256;
            const f32x4 a = *(const f32x4*)(p0 + 4 * F.lane), b = *(const f32x4*)(p1 + 4 * F.lane), c = *(const f32x4*)(cb1 + j * 256 + 4 * F.lane);
            f32x4 h = a + b + c; h.x = pg8::gelu_tanh(h.x); h.y = pg8::gelu_tanh(h.y); h.z = pg8::gelu_tanh(h.z); h.w = pg8::gelu_tanh(h.w);
            *(LAS f32x4*)(hl + 4 * F.lane) = h;
            LDS_WAIT();
            float s0 = b2[j * 64 + F.lane], s1 = 0.f, s2 = 0.f, s3 = 0.f;
#pragma unroll 8
            for (int hh = 0; hh < 256; hh += 4) { const f32x4 h4 = *(const LAS f32x4*)(hl + hh);
                s0 += h4.x * w2l[hh * 64 + F.lane]; s1 += h4.y * w2l[(hh + 1) * 64 + F.lane]; s2 += h4.z * w2l[(hh + 2) * 64 + F.lane]; s3 += h4.w * w2l[(hh + 3) * 64 + F.lane]; }
            float s = (s0 + s1) + (s2 + s3);
            if ((r & 127) == 127) s = 0.f;
            KCV[((size_t)j * 8192 + r) * 64 + F.lane] = (bf16)f2bf(s);
            LDS_WAIT();
        }
    }
    __syncthreads();
}

#if 0
__device__ __forceinline__ void attn_phase_naive(const Frame& F, const bf16* Q, const float* GATE, const float* KCV, const bf16* KV, bf16* O) {
    LAS float* wl = (LAS float*)(F.lds + F.wave * 4096);
    LAS float* qs = wl;
    LAS float* ps = wl + 256;
    LAS float* pc = wl + 512;
    LAS float* im = wl + 640;
    const int gw = F.vcu * NWAVES + F.wave, NGW = F.G * NWAVES, lane = F.lane;
    constexpr float L2E = 1.4426950408889634f;
    for (int it = gw; it < BATCH * 4 * T; it += NGW) {
        const int t = it & (T - 1), g = (it >> 11) & 3, b = it >> 13;
        const size_t m = (size_t)b * T + t;
#pragma unroll
        for (int hh = 0; hh < 4; ++hh) qs[hh * 64 + lane] = bf1(Q[m * 1024 + (g * 4 + hh) * 64 + lane]);
        float mx[4], ls[4], oa[4], outv[4];
#define ATT_SCORE_BF16(kp, sv) do { asm volatile("" ::: "memory"); sv[0] = sv[1] = sv[2] = sv[3] = 0.f; \
        _Pragma("unroll") for (int d8 = 0; d8 < 8; ++d8) { const v4u kk = *(const v4u*)((kp) + d8 * 8); float kf[8] = {bf_lo(kk.x), bf_hi(kk.x), bf_lo(kk.y), bf_hi(kk.y), bf_lo(kk.z), bf_hi(kk.z), bf_lo(kk.w), bf_hi(kk.w)}; \
            _Pragma("unroll") for (int hh = 0; hh < 4; ++hh) { const f32x4 q0 = *(const LAS f32x4*)(qs + hh * 64 + d8 * 8), q1 = *(const LAS f32x4*)(qs + hh * 64 + d8 * 8 + 4); \
                sv[hh] += (q0.x * kf[0] + q0.y * kf[1]) + (q0.z * kf[2] + q0.w * kf[3]) + (q1.x * kf[4] + q1.y * kf[5]) + (q1.z * kf[6] + q1.w * kf[7]); } } } while (0)
#define ATT_SCORE_F32(kp, sv) do { asm volatile("" ::: "memory"); sv[0] = sv[1] = sv[2] = sv[3] = 0.f; \
        _Pragma("unroll") for (int d4 = 0; d4 < 16; ++d4) { const f32x4 kk = *(const f32x4*)((kp) + d4 * 4); \
            _Pragma("unroll") for (int hh = 0; hh < 4; ++hh) { const f32x4 q0 = *(const LAS f32x4*)(qs + hh * 64 + d4 * 4); \
                sv[hh] += (q0.x * kk.x + q0.y * kk.y) + (q0.z * kk.z + q0.w * kk.w); } } } while (0)
#define ATT_SOFTMAX_STEP(sv, valid) do { \
        _Pragma("unroll") for (int hh = 0; hh < 4; ++hh) { const float s_ = (valid) ? sv[hh] : -INFINITY; const float bm = wave_max(s_); const float mn = fmaxf(mx[hh], bm); \
            const float scl = __builtin_amdgcn_exp2f((mx[hh] - mn) * L2E); const float p = __builtin_amdgcn_exp2f((s_ - mn) * L2E); \
            ls[hh] = ls[hh] * scl + wave_sum(p); oa[hh] *= scl; mx[hh] = mn; ps[lane * 4 + hh] = p; } } while (0)
        LDS_WAIT();
        const int ncv = (t >= 31) ? ((t - 31) >> 4) + 1 : 0;
        const float* kc = KCV + ((size_t)(b * 4 + g) * 128) * 64; const float* vc = KCV + (size_t)8192 * 64 + ((size_t)(b * 4 + g) * 128) * 64;
        float ocmp[4] = {0.f, 0.f, 0.f, 0.f};
        pc[lane] = 0.f; pc[64 + lane] = 0.f;
        if (ncv > 0) {
            float s0[4], s1[4];
            ATT_SCORE_F32(kc + (size_t)lane * 64, s0); ATT_SCORE_F32(kc + (size_t)(64 + lane) * 64, s1);
            float psum0 = 0.f, psum1 = 0.f; float p0[4], p1[4];
#pragma unroll
            for (int hh = 0; hh < 4; ++hh) { const float a0 = (lane < ncv) ? s0[hh] : -INFINITY, a1 = (64 + lane < ncv) ? s1[hh] : -INFINITY;
                const float mm = wave_max(fmaxf(a0, a1)); const float e0 = __builtin_amdgcn_exp2f((a0 - mm) * L2E), e1 = __builtin_amdgcn_exp2f((a1 - mm) * L2E);
                const float den = wave_sum(e0 + e1); p0[hh] = e0 / den; p1[hh] = e1 / den; psum0 += p0[hh]; psum1 += p1[hh]; }
            pc[lane] = psum0; pc[64 + lane] = psum1;
#pragma unroll
            for (int hh = 0; hh < 4; ++hh) ps[lane * 4 + hh] = p0[hh];
            LDS_WAIT();
            const int n0 = ncv < 64 ? ncv : 64;
            for (int key = 0; key < n0; ++key) { const f32x4 p4 = *(const LAS f32x4*)(ps + key * 4); const float vv = vc[(size_t)key * 64 + lane];
                ocmp[0] += p4.x * vv; ocmp[1] += p4.y * vv; ocmp[2] += p4.z * vv; ocmp[3] += p4.w * vv; }
            LDS_WAIT();
            if (ncv > 64) {
#pragma unroll
                for (int hh = 0; hh < 4; ++hh) ps[lane * 4 + hh] = p1[hh];
                LDS_WAIT();
                for (int key = 0; key < ncv - 64; ++key) { const f32x4 p4 = *(const LAS f32x4*)(ps + key * 4); const float vv = vc[(size_t)(64 + key) * 64 + lane];
                    ocmp[0] += p4.x * vv; ocmp[1] += p4.y * vv; ocmp[2] += p4.z * vv; ocmp[3] += p4.w * vv; }
            }
        }
        LDS_WAIT();
        const int cur = t >> 6;
        unsigned selmask;
        {
            float imp = 0.f; const int j = lane & 31;
#pragma unroll
            for (int c = -1; c <= 3; ++c) { const int cc = 4 * j + c; if (cc >= 0 && cc < NCMP) imp += pc[cc]; }
            if (j > cur) imp = -1.0f;
            if (j == 0 || j == cur || j == cur - 1) imp = 1e4f;
            im[j] = imp;
            LDS_WAIT();
            int rank = 0;
            for (int i = 0; i < 32; ++i) { const float o = im[i]; rank += (o > imp || (o == imp && i < j)) ? 1 : 0; }
            const unsigned long long bal = __ballot(rank < 16 && j <= cur);
            selmask = (unsigned)bal;
        }
#pragma unroll
        for (int hh = 0; hh < 4; ++hh) { mx[hh] = -INFINITY; ls[hh] = 0.f; oa[hh] = 0.f; }
        {
            const bf16* kb = KV + (size_t)b * T * NKV + 2 * 256 + g * 64; const bf16* vb = KV + (size_t)b * T * NKV + 3 * 256 + g * 64;
            for (int j = 0; j <= cur; ++j) {
                if (!((selmask >> j) & 1u)) continue;
                const int kpos = j * 64 + lane; float sv[4];
                ATT_SCORE_BF16(kb + (size_t)kpos * NKV, sv);
                LDS_WAIT();
                ATT_SOFTMAX_STEP(sv, kpos <= t);
                LDS_WAIT();
                for (int key = 0; key < 64; ++key) { const f32x4 p4 = *(const LAS f32x4*)(ps + key * 4); const float vv = bf1(vb[(size_t)(j * 64 + key) * NKV + lane]);
                    oa[0] += p4.x * vv; oa[1] += p4.y * vv; oa[2] += p4.z * vv; oa[3] += p4.w * vv; }
            }
        }
        const float* gt = GATE + m * 48 + g * 12;
#pragma unroll
        for (int hh = 0; hh < 4; ++hh) outv[hh] = gt[hh * 3 + 0] * ocmp[hh] + gt[hh * 3 + 1] * (oa[hh] / ls[hh]);
#pragma unroll
        for (int hh = 0; hh < 4; ++hh) { mx[hh] = -INFINITY; ls[hh] = 0.f; oa[hh] = 0.f; }
        {
            const bf16* kb = KV + (size_t)b * T * NKV + 4 * 256 + g * 64; const bf16* vb = KV + (size_t)b * T * NKV + 5 * 256 + g * 64;
            const int start = t - 511 > 0 ? t - 511 : 0;
            for (int k0 = start; k0 <= t; k0 += 64) {
                const int kpos = k0 + lane; const int kr = kpos <= t ? kpos : t; float sv[4];
                ATT_SCORE_BF16(kb + (size_t)kr * NKV, sv);
                LDS_WAIT();
                ATT_SOFTMAX_STEP(sv, kpos <= t);
                LDS_WAIT();
                const int nk = (t - k0 + 1) < 64 ? (t - k0 + 1) : 64;
                for (int key = 0; key < nk; ++key) { const f32x4 p4 = *(const LAS f32x4*)(ps + key * 4); const float vv = bf1(vb[(size_t)(k0 + key) * NKV + lane]);
                    oa[0] += p4.x * vv; oa[1] += p4.y * vv; oa[2] += p4.z * vv; oa[3] += p4.w * vv; }
            }
        }
#pragma unroll
        for (int hh = 0; hh < 4; ++hh) { outv[hh] += gt[hh * 3 + 2] * (oa[hh] / ls[hh]); O[m * 1024 + (g * 4 + hh) * 64 + lane] = (bf16)f2bf(outv[hh]); }
        LDS_WAIT();
#undef ATT_SCORE_BF16
#undef ATT_SCORE_F32
#undef ATT_SOFTMAX_STEP
    }
}
#endif
namespace nsa {
using bf16x8 = __attribute__((ext_vector_type(8))) short;
using s16x4 = __attribute__((ext_vector_type(4))) short;
using f32x16 = __attribute__((ext_vector_type(16))) float;
using u32x4 = __attribute__((ext_vector_type(4))) unsigned;
typedef __attribute__((address_space(3))) const char* lds_cptr;
typedef __attribute__((address_space(3))) char* lds_ptr;
constexpr int NSLOT = 3, SLOTB = 8192;
constexpr int LDS_K = 0, LDS_V = NSLOT * SLOTB, LDS_WS = 2 * NSLOT * SLOTB  , LDS_OST = LDS_WS + 8 * 512  ,
              LDS_PI = LDS_OST + 8 * 4096  , LDS_IMP = LDS_PI + 32768  , LDS_SELM = LDS_IMP + 8192  , LDS_END = LDS_SELM + 256;
static_assert(LDS_END <= 131072, "attention LDS map");
constexpr int THR = 8;
__device__ __forceinline__ int crow(int r, int hi) { return (r & 3) + 8 * (r >> 2) + 4 * hi; }
#define NSA_SBAR() __builtin_amdgcn_sched_barrier(0)
__device__ __forceinline__ void glds16(const void* gsrc, unsigned lds_dst) { unsigned keep;
    asm volatile("s_mov_b32 %0, m0\n\ts_mov_b32 m0, %2\n\ts_nop 0\n\tglobal_load_lds_dwordx4 %1, off\n\ts_mov_b32 m0, %0" : "=&s"(keep) : "v"(gsrc), "s"(lds_dst) : "memory"); }
typedef float f32x2_t __attribute__((ext_vector_type(2))); typedef __bf16 bf16x2_t __attribute__((ext_vector_type(2)));
__device__ __forceinline__ unsigned cvtpk_s(float lo, float hi) { f32x2_t v = {lo, hi}; bf16x2_t b = __builtin_convertvector(v, bf16x2_t); return __builtin_bit_cast(unsigned, b); }
#define NSA_WAIT_BAR(N) asm volatile("s_waitcnt vmcnt(" #N ") lgkmcnt(0)\n\ts_barrier" ::: "memory")

__device__ __forceinline__ void qkt(f32x16& p0, f32x16& p1, lds_cptr Kslot, const bf16x8* qr, const f32x16& cinit, int r32, int hi) {
    lds_cptr kb = Kslot + hi * 1024 + r32 * 16;
#pragma unroll
    for (int d0 = 0; d0 < 4; ++d0) {
        const bf16x8 b0 = *(const __attribute__((address_space(3))) bf16x8*)(kb + d0 * 2048);
        const bf16x8 b1 = *(const __attribute__((address_space(3))) bf16x8*)(kb + d0 * 2048 + 512);
        if (d0 == 0) { p0 = __builtin_amdgcn_mfma_f32_32x32x16_bf16(b0, qr[0], cinit, 0, 0, 0); p1 = __builtin_amdgcn_mfma_f32_32x32x16_bf16(b1, qr[0], cinit, 0, 0, 0); }
        else { p0 = __builtin_amdgcn_mfma_f32_32x32x16_bf16(b0, qr[d0], p0, 0, 0, 0); p1 = __builtin_amdgcn_mfma_f32_32x32x16_bf16(b1, qr[d0], p1, 0, 0, 0); } }
}
__device__ __forceinline__ float rowmax(const f32x16& p0, const f32x16& p1) {
    float a = fmaxf(fmaxf(p0[0], p0[1]), p1[0]), b = fmaxf(fmaxf(p0[2], p0[3]), p1[1]); a = fmaxf(fmaxf(a, p1[2]), p1[3]);
#pragma unroll
    for (int r = 4; r < 16; r += 4) { a = fmaxf(fmaxf(a, p0[r]), p0[r + 1]); b = fmaxf(fmaxf(b, p0[r + 2]), p0[r + 3]); a = fmaxf(fmaxf(a, p1[r]), p1[r + 1]); b = fmaxf(fmaxf(b, p1[r + 2]), p1[r + 3]); }
    const float m = fmaxf(a, b);
    auto rr = __builtin_amdgcn_permlane32_swap(__float_as_uint(m), __float_as_uint(m), false, false);
    return fmaxf(__uint_as_float(rr[0]), __uint_as_float(rr[1]));
}
__device__ __forceinline__ float xhalf_sum(float v) { auto rr = __builtin_amdgcn_permlane32_swap(__float_as_uint(v), __float_as_uint(v), false, false); return __uint_as_float(rr[0]) + __uint_as_float(rr[1]); }
__device__ __forceinline__ float xhalf_other(float v, int hi) { auto rr = __builtin_amdgcn_permlane32_swap(__float_as_uint(v), __float_as_uint(v), false, false); return hi ? __uint_as_float(rr[0]) : __uint_as_float(rr[1]); }
__device__ __forceinline__ void pv(f32x16* o, int vb, bf16x8 pa0, bf16x8 pa1, bf16x8 pa2, bf16x8 pa3) {
#pragma unroll
    for (int d0 = 0; d0 < 2; ++d0) { s16x4 lo[4], hi[4];
#pragma unroll
        for (int ks = 0; ks < 4; ++ks) {
            asm volatile("ds_read_b64_tr_b16 %0,%1 offset:%c2" : "=&v"(lo[ks]) : "v"(vb), "i"(d0 * 4096 + ks * 1024) : "memory");
            asm volatile("ds_read_b64_tr_b16 %0,%1 offset:%c2" : "=&v"(hi[ks]) : "v"(vb), "i"(d0 * 4096 + ks * 1024 + 512) : "memory"); }
        asm volatile("s_waitcnt lgkmcnt(0)" ::: "memory"); NSA_SBAR();
#define NSA_PK(k) (bf16x8){lo[k][0], lo[k][1], lo[k][2], lo[k][3], hi[k][0], hi[k][1], hi[k][2], hi[k][3]}
        o[d0] = __builtin_amdgcn_mfma_f32_32x32x16_bf16(pa0, NSA_PK(0), o[d0], 0, 0, 0);
        o[d0] = __builtin_amdgcn_mfma_f32_32x32x16_bf16(pa1, NSA_PK(1), o[d0], 0, 0, 0);
        o[d0] = __builtin_amdgcn_mfma_f32_32x32x16_bf16(pa2, NSA_PK(2), o[d0], 0, 0, 0);
        o[d0] = __builtin_amdgcn_mfma_f32_32x32x16_bf16(pa3, NSA_PK(3), o[d0], 0, 0, 0);
#undef NSA_PK
    }
}
__device__ __forceinline__ void mask_range(f32x16& p, int kb, int lo, int hi_) {
#pragma unroll
    for (int r = 0; r < 16; ++r) { const int kk = kb + (r & 3) + 8 * (r >> 2); if (kk < lo || kk > hi_) p[r] = -INFINITY; }
}
#define NSA_PACK(P0, P1) do { pw0 = (u32x4){cvtpk_s(P0[0], P0[1]), cvtpk_s(P0[2], P0[3]), cvtpk_s(P0[4], P0[5]), cvtpk_s(P0[6], P0[7])}; \
    pw1 = (u32x4){cvtpk_s(P0[8], P0[9]), cvtpk_s(P0[10], P0[11]), cvtpk_s(P0[12], P0[13]), cvtpk_s(P0[14], P0[15])}; \
    pw2 = (u32x4){cvtpk_s(P1[0], P1[1]), cvtpk_s(P1[2], P1[3]), cvtpk_s(P1[4], P1[5]), cvtpk_s(P1[6], P1[7])}; \
    pw3 = (u32x4){cvtpk_s(P1[8], P1[9]), cvtpk_s(P1[10], P1[11]), cvtpk_s(P1[12], P1[13]), cvtpk_s(P1[14], P1[15])}; } while (0)
#define NSA_PAF(k) __builtin_bit_cast(bf16x8, pw##k)

struct Tensors { const bf16* Q; const float* GATE; const bf16* KCV; const bf16* KV; bf16* O; };

template <int MODE>
__device__ __forceinline__ void flash_pass(lds_ptr shm, unsigned lds0, const bf16* Kh, const bf16* Vh, int qt, const bf16x8* qr, unsigned selmask, int tq, float gate,
                                           f32x16* otot, int wid, int lane, int r32, int hi) {
    constexpr int PITCH = NKV;
    const bf16* ksrc = Kh + (size_t)lane * PITCH + wid * 8;
    const bf16* vsrc = Vh + (size_t)(16 * (wid & 3) + (lane >> 2)) * PITCH + (wid >> 2) * 32 + (lane & 3) * 8;
    const unsigned kdst = lds0 + LDS_K + wid * 1024, vdst = lds0 + LDS_V + wid * 1024;
    __attribute__((address_space(3))) float* wsf = (__attribute__((address_space(3))) float*)(shm + LDS_WS) + wid * 128;
    const int vb0 = (int)(lds0 + LDS_V) + ((lane >> 4) & 1) * 32 + (lane & 3) * 8 + (4 * hi + ((lane & 15) >> 2)) * 64;
    const int NT = (MODE == 1) ? qt + 1 : (qt < 8 ? qt + 1 : 9);
#define NSA_TIX(i) ((MODE == 1) ? (i) : (qt - (i)))
#define NSA_DMA(i, slot) do { const int t_ = NSA_TIX(i); glds16(ksrc + (size_t)t_ * 64 * PITCH, (unsigned)__builtin_amdgcn_readfirstlane(kdst + (slot))); glds16(vsrc + (size_t)t_ * 64 * PITCH, (unsigned)__builtin_amdgcn_readfirstlane(vdst + (slot))); } while (0)
    NSA_DMA(0, 0);
    if (NT > 1) NSA_DMA(1, SLOTB);
    float mhat = 0.f, l_reg = 0.f; f32x16 o[2]; o[0] = f32x16{}; o[1] = f32x16{};
    int sl_cur = 0;
    for (int i = 0; i < NT; ++i) {
        if (i + 1 < NT) NSA_WAIT_BAR(2); else NSA_WAIT_BAR(0);
        { const int sl2 = (sl_cur >= SLOTB) ? sl_cur - SLOTB : sl_cur + 2 * SLOTB; if (i + 2 < NT) NSA_DMA(i + 2, sl2); }
        const int t = NSA_TIX(i);
        float cval = -mhat;
        if (MODE == 1) { if (!((selmask >> t) & 1u)) cval = -INFINITY; }
        f32x16 cin;
#pragma unroll
        for (int r = 0; r < 16; ++r) cin[r] = cval;
        f32x16 p0, p1;
        qkt(p0, p1, (lds_cptr)(shm + LDS_K + sl_cur), qr, cin, r32, hi);
        if (t == qt) { mask_range(p0, 4 * hi, 0, tq); mask_range(p1, 32 + 4 * hi, 0, tq); }
        if (MODE == 2) { if (t == qt - 8) { mask_range(p0, 4 * hi, tq + 1, 63); mask_range(p1, 32 + 4 * hi, tq + 1, 63); } }
        const float rm = rowmax(p0, p1);
        bool resc = false;
        if (i == 0 || __any(rm > (float)THR)) {
            const float dl = (i == 0) ? fmaxf(rm, -1e30f) : fmaxf(rm, 0.f); mhat += dl;
#pragma unroll
            for (int r = 0; r < 16; ++r) { p0[r] -= dl; p1[r] -= dl; }
            const float f = __builtin_amdgcn_exp2f(-dl); l_reg *= f; if (hi == 0) wsf[r32] = f; resc = (i != 0);
        }
        float sacc = 0.f;
#pragma unroll
        for (int r = 0; r < 16; ++r) { p0[r] = __builtin_amdgcn_exp2f(p0[r]); p1[r] = __builtin_amdgcn_exp2f(p1[r]); sacc += p0[r] + p1[r]; }
        l_reg += sacc;
        u32x4 pw0, pw1, pw2, pw3; NSA_PACK(p0, p1);
        if (resc) { asm volatile("s_waitcnt lgkmcnt(0)" ::: "memory");
#pragma unroll
            for (int d = 0; d < 2; ++d)
#pragma unroll
                for (int r = 0; r < 16; ++r) o[d][r] *= wsf[crow(r, hi)]; }
        pv(o, vb0 + sl_cur, NSA_PAF(0), NSA_PAF(1), NSA_PAF(2), NSA_PAF(3));
        sl_cur = (sl_cur == (NSLOT - 1) * SLOTB) ? 0 : sl_cur + SLOTB;
    }
    const float l = xhalf_sum(l_reg);
    asm volatile("s_waitcnt lgkmcnt(0)" ::: "memory");
    if (hi == 0) wsf[r32] = gate / l;
    asm volatile("s_waitcnt lgkmcnt(0)" ::: "memory");
#pragma unroll
    for (int r = 0; r < 16; ++r) { const float w = wsf[crow(r, hi)]; otot[0][r] += o[0][r] * w; otot[1][r] += o[1][r] * w; }
    asm volatile("s_waitcnt lgkmcnt(0)\n\ts_barrier" ::: "memory");
#undef NSA_TIX
#undef NSA_DMA
}

__device__ __forceinline__ void attn_unit(int b, int g, int qt, const Tensors& T_, lds_ptr shm, int tid_) {
    int tid = tid_; asm volatile("" : "+v"(tid));
    const int lane = tid & 63, r32 = lane & 31, hi = lane >> 5; const int wid = __builtin_amdgcn_readfirstlane(tid >> 6);
    const int hh = wid & 3, ts = wid >> 2, tq = ts * 32 + r32;
    const size_t m0 = (size_t)b * T + (size_t)qt * 64;
    const unsigned lds0 = (unsigned)(uintptr_t)shm;
    __attribute__((address_space(3))) float* wsf = (__attribute__((address_space(3))) float*)(shm + LDS_WS) + wid * 128;
    {
        const bf16* Kc = T_.KCV + (size_t)(b * 4 + g) * 128 * 64; const bf16* Vc = Kc + (size_t)8192 * 64;
        const bf16* ksrc = Kc + (size_t)lane * 64 + wid * 8;
        const bf16* vsrc = Vc + (size_t)(16 * (wid & 3) + (lane >> 2)) * 64 + (wid >> 2) * 32 + (lane & 3) * 8;
        const unsigned kdst = lds0 + LDS_K + wid * 1024, vdst = lds0 + LDS_V + wid * 1024;
        glds16(ksrc, (unsigned)__builtin_amdgcn_readfirstlane(kdst)); glds16(vsrc, (unsigned)__builtin_amdgcn_readfirstlane(vdst));
        glds16(ksrc + 64 * 64, (unsigned)__builtin_amdgcn_readfirstlane(kdst + SLOTB)); glds16(vsrc + 64 * 64, (unsigned)__builtin_amdgcn_readfirstlane(vdst + SLOTB));
    }
    bf16x8 qr[4];
    {
        const bf16* Qw = T_.Q + (m0 + ts * 32) * 1024 + (g * 4 + hh) * 64;
#pragma unroll
        for (int d0 = 0; d0 < 4; ++d0) qr[d0] = *reinterpret_cast<const bf16x8*>(&Qw[(size_t)r32 * 1024 + d0 * 16 + hi * 8]);
    }
    const float* gp = T_.GATE + (m0 + tq) * 48 + (g * 4 + hh) * 3;
    const float g_cmp = gp[0], g_sel = gp[1], g_win = gp[2];
    f32x16 otot[2];
    NSA_WAIT_BAR(0);
    {
        const int t = qt * 64 + tq;
        const int ncv = (t >= 31) ? ((t - 31) >> 4) + 1 : 0;
        f32x16 zero = f32x16{}; f32x16 pA0, pA1, pB0, pB1;
        qkt(pA0, pA1, (lds_cptr)(shm + LDS_K), qr, zero, r32, hi);
        qkt(pB0, pB1, (lds_cptr)(shm + LDS_K + SLOTB), qr, zero, r32, hi);
        mask_range(pA0, 4 * hi, 0, ncv - 1); mask_range(pA1, 32 + 4 * hi, 0, ncv - 1); mask_range(pB0, 64 + 4 * hi, 0, ncv - 1); mask_range(pB1, 96 + 4 * hi, 0, ncv - 1);
        const float m = fmaxf(fmaxf(rowmax(pA0, pA1), rowmax(pB0, pB1)), -1e30f);
        float sacc = 0.f;
#pragma unroll
        for (int r = 0; r < 16; ++r) { pA0[r] = __builtin_amdgcn_exp2f(pA0[r] - m); pA1[r] = __builtin_amdgcn_exp2f(pA1[r] - m); pB0[r] = __builtin_amdgcn_exp2f(pB0[r] - m); pB1[r] = __builtin_amdgcn_exp2f(pB1[r] - m);
            sacc += (pA0[r] + pA1[r]) + (pB0[r] + pB1[r]); }
        const float l = xhalf_sum(sacc); const float inv = l > 0.f ? 1.0f / l : 0.f;
#pragma unroll
        for (int r = 0; r < 16; ++r) { pA0[r] *= inv; pA1[r] *= inv; pB0[r] *= inv; pB1[r] *= inv; }
        {
            __attribute__((address_space(3))) float* PI = (__attribute__((address_space(3))) float*)(shm + LDS_PI) + (hh * 64 + tq) * 32;
            float prev_oth = 0.f;
#define NSA_GRP(P, blk) _Pragma("unroll") for (int q4 = 0; q4 < 4; ++q4) { const int k = (blk) * 4 + q4; const float Gs = (P[4 * q4] + P[4 * q4 + 1]) + (P[4 * q4 + 2] + P[4 * q4 + 3]); \
                const float oth = xhalf_other(P[4 * q4 + 3], hi); PI[2 * k + hi] = Gs + (hi ? oth : prev_oth); prev_oth = oth; }
            NSA_GRP(pA0, 0) NSA_GRP(pA1, 1) NSA_GRP(pB0, 2) NSA_GRP(pB1, 3)
#undef NSA_GRP
        }
        otot[0] = f32x16{}; otot[1] = f32x16{};
        const int vb0 = (int)(lds0 + LDS_V) + ((lane >> 4) & 1) * 32 + (lane & 3) * 8 + (4 * hi + ((lane & 15) >> 2)) * 64;
        u32x4 pw0, pw1, pw2, pw3;
        NSA_PACK(pA0, pA1); pv(otot, vb0, NSA_PAF(0), NSA_PAF(1), NSA_PAF(2), NSA_PAF(3));
        NSA_PACK(pB0, pB1); pv(otot, vb0 + SLOTB, NSA_PAF(0), NSA_PAF(1), NSA_PAF(2), NSA_PAF(3));
        if (hi == 0) wsf[r32] = g_cmp;
        asm volatile("s_waitcnt lgkmcnt(0)" ::: "memory");
#pragma unroll
        for (int r = 0; r < 16; ++r) { const float w = wsf[crow(r, hi)]; otot[0][r] *= w; otot[1][r] *= w; }
    }
    asm volatile("s_waitcnt lgkmcnt(0)\n\ts_barrier" ::: "memory");
    {
        const __attribute__((address_space(3))) float* PI = (const __attribute__((address_space(3))) float*)(shm + LDS_PI);
        __attribute__((address_space(3))) float* IMP = (__attribute__((address_space(3))) float*)(shm + LDS_IMP);
        __attribute__((address_space(3))) unsigned* SELM = (__attribute__((address_space(3))) unsigned*)(shm + LDS_SELM);
#pragma unroll
        for (int it = 0; it < 4; ++it) { const int idx = tid + it * 512, tok = idx >> 5, j = idx & 31;
            float imp = ((PI[(0 * 64 + tok) * 32 + j] + PI[(1 * 64 + tok) * 32 + j]) + PI[(2 * 64 + tok) * 32 + j]) + PI[(3 * 64 + tok) * 32 + j];
            if (j > qt) imp = -1.0f;
            if (j == 0 || j == qt || j == qt - 1) imp = 1e4f;
            IMP[idx] = imp; }
        asm volatile("s_waitcnt lgkmcnt(0)\n\ts_barrier" ::: "memory");
#pragma unroll
        for (int it = 0; it < 4; ++it) { const int idx = tid + it * 512, tok = idx >> 5, j = idx & 31;
            const float mine = IMP[idx]; int rank = 0;
#pragma unroll
            for (int i4 = 0; i4 < 8; ++i4) { const f32x4 o4 = *(const __attribute__((address_space(3))) f32x4*)(IMP + tok * 32 + i4 * 4);
                rank += (o4.x > mine || (o4.x == mine && i4 * 4 + 0 < j)) ? 1 : 0; rank += (o4.y > mine || (o4.y == mine && i4 * 4 + 1 < j)) ? 1 : 0;
                rank += (o4.z > mine || (o4.z == mine && i4 * 4 + 2 < j)) ? 1 : 0; rank += (o4.w > mine || (o4.w == mine && i4 * 4 + 3 < j)) ? 1 : 0; }
            const unsigned long long bal = __ballot(rank < 16 && j <= qt);
            if (lane == 0) SELM[tok] = (unsigned)bal;
            if (lane == 32) SELM[tok] = (unsigned)(bal >> 32); }
        asm volatile("s_waitcnt lgkmcnt(0)\n\ts_barrier" ::: "memory");
    }
    const unsigned selmask = ((const __attribute__((address_space(3))) unsigned*)(shm + LDS_SELM))[tq];
    const bf16* KVb = T_.KV + (size_t)b * T * NKV + g * 64;
    flash_pass<1>(shm, lds0, KVb + 2 * 256, KVb + 3 * 256, qt, qr, selmask, tq, g_sel, otot, wid, lane, r32, hi);
    flash_pass<2>(shm, lds0, KVb + 4 * 256, KVb + 5 * 256, qt, qr, 0u, tq, g_win, otot, wid, lane, r32, hi);
    {
        bf16* Ow = T_.O + (m0 + ts * 32) * 1024 + (g * 4 + hh) * 64;
        __attribute__((address_space(3))) bf16* stg = (__attribute__((address_space(3))) bf16*)(shm + LDS_OST) + wid * 2048;
#pragma unroll
        for (int r = 0; r < 16; ++r) { const int orow = crow(r, hi);
#pragma unroll
            for (int d0 = 0; d0 < 2; ++d0) stg[orow * 64 + d0 * 32 + r32] = (bf16)f2bf(otot[d0][r]); }
        asm volatile("s_waitcnt lgkmcnt(0)" ::: "memory");
#pragma unroll
        for (int i = 0; i < 4; ++i) { const int row = i * 8 + (lane >> 3), ch = lane & 7; const u32x4 v = *(const __attribute__((address_space(3))) u32x4*)(stg + row * 64 + ch * 8); *(u32x4*)(Ow + (size_t)row * 1024 + ch * 8) = v; }
    }
    asm volatile("s_waitcnt lgkmcnt(0)\n\ts_barrier" ::: "memory");
}

__device__ __forceinline__ void attn_phase(const Frame& F, const Tensors& T_) {
    lds_ptr shm = (lds_ptr)(F.lds + RING_OFF);
    for (int v = F.vcu; v < BATCH * 4 * 4; v += F.G) {
        const int bg = v >> 2, s = v & 3;
#pragma unroll 1
        for (int i = 0; i < 8; ++i) { const int qt = (i & 1) ? (8 * (i >> 1) + 7 - s) : (8 * (i >> 1) + s);
            attn_unit(bg >> 2, bg & 3, qt, T_, shm, F.tid); }
    }
}
#undef NSA_SBAR
#undef NSA_WAIT_BAR
#undef NSA_PACK
#undef NSA_PAF
}
namespace sgu {
using nsa::bf16x8; using nsa::s16x4; using nsa::f32x16; using nsa::u32x4;
constexpr int LDS_VT = 0  , LDS_ST = 32768  , LDS_OST = 34816  , LDS_END = LDS_OST + 8 * 4096;
__device__ __forceinline__ void sgu_phase(const Frame& F, const bf16* U, const bf16* V, const float* lng, const float* lnb, const bf16* WS16, const float* bs, bf16* GT) {
    typedef __attribute__((address_space(3))) char* lptr;
    lptr shm = (lptr)(F.lds + RING_OFF);
    __attribute__((address_space(3))) float* st = (__attribute__((address_space(3))) float*)(shm + LDS_ST);
    const unsigned lds0 = (unsigned)(uintptr_t)shm;
    for (int ch = F.vcu; ch < M / 128; ch += F.G) {
        int tid = F.tid; asm volatile("" : "+v"(tid));
        const int lane = tid & 63, r32 = lane & 31, hi = lane >> 5; const int wid = __builtin_amdgcn_readfirstlane(tid >> 6);
        const size_t m0 = (size_t)ch * 128;
        for (int r = 0; r < 16; ++r) { const int row = wid * 16 + r; const v4u* vp = (const v4u*)(V + (m0 + row) * D + lane * 16);
            const v4u a = vp[0], b = vp[1]; float xv[16] = {bf_lo(a.x), bf_hi(a.x), bf_lo(a.y), bf_hi(a.y), bf_lo(a.z), bf_hi(a.z), bf_lo(a.w), bf_hi(a.w), bf_lo(b.x), bf_hi(b.x), bf_lo(b.y), bf_hi(b.y), bf_lo(b.z), bf_hi(b.z), bf_lo(b.w), bf_hi(b.w)};
            float s = 0.f, q = 0.f;
#pragma unroll
            for (int e = 0; e < 16; ++e) s += xv[e];
            const float mean = wave_sum(s) * (1.0f / D);
#pragma unroll
            for (int e = 0; e < 16; ++e) { const float d = xv[e] - mean; q += d * d; }
            const float rstd = 1.0f / sqrtf(wave_sum(q) * (1.0f / D) + EPS);
            if (lane == 0) { st[row * 2] = mean; st[row * 2 + 1] = rstd; } }
        asm volatile("s_waitcnt lgkmcnt(0)\n\ts_barrier" ::: "memory");
        const int srow = tid >> 2, c4 = tid & 3;
        const float mean_s = st[srow * 2], rstd_s = st[srow * 2 + 1];
        const int tb = wid >> 1, db0 = (wid & 1) * 2;
        const int nks = 2 * tb + 2;
        const int vb0 = (int)(lds0 + LDS_VT) + ((lane >> 4) & 1) * 32 + (lane & 3) * 8 + (4 * hi + ((lane & 15) >> 2)) * 64;
#pragma unroll 1
        for (int g = 0; g < 8; ++g) {
            const bf16* wrow = WS16 + ((size_t)g * 128 + tb * 32 + r32) * 128 + 4 * hi;
            v2u af[8][2];
#pragma unroll
            for (int ks = 0; ks < 8; ++ks) if (ks < nks) { af[ks][0] = *(const v2u*)(wrow + ks * 16); af[ks][1] = *(const v2u*)(wrow + ks * 16 + 8); }
#pragma unroll
            for (int i = 0; i < 4; ++i) { const int c = g * 128 + i * 32 + c4 * 8;
                const v4u w = *(const v4u*)(V + (m0 + srow) * D + c);
                const f32x4 g0 = *(const f32x4*)(lng + c), g1 = *(const f32x4*)(lng + c + 4), b0 = *(const f32x4*)(lnb + c), b1 = *(const f32x4*)(lnb + c + 4);
                float x[8] = {bf_lo(w.x), bf_hi(w.x), bf_lo(w.y), bf_hi(w.y), bf_lo(w.z), bf_hi(w.z), bf_lo(w.w), bf_hi(w.w)};
                const float gg[8] = {g0.x, g0.y, g0.z, g0.w, g1.x, g1.y, g1.z, g1.w}, bb[8] = {b0.x, b0.y, b0.z, b0.w, b1.x, b1.y, b1.z, b1.w};
#pragma unroll
                for (int e = 0; e < 8; ++e) x[e] = (x[e] - mean_s) * rstd_s * gg[e] + bb[e];
                v4u o; o.x = pk2(x[0], x[1]); o.y = pk2(x[2], x[3]); o.z = pk2(x[4], x[5]); o.w = pk2(x[6], x[7]);
                *(__attribute__((address_space(3))) v4u*)(shm + LDS_VT + (i * 8 + (srow >> 4)) * 1024 + (srow & 15) * 64 + c4 * 16) = o; }
            asm volatile("s_waitcnt lgkmcnt(0)\n\ts_barrier" ::: "memory");
            f32x16 o[2]; o[0] = f32x16{}; o[1] = f32x16{};
#pragma unroll
            for (int ks = 0; ks < 8; ++ks) if (ks < nks) {
                const bf16x8 a = __builtin_bit_cast(bf16x8, (v4u){af[ks][0].x, af[ks][0].y, af[ks][1].x, af[ks][1].y});
#pragma unroll
                for (int dd = 0; dd < 2; ++dd) { s16x4 lo, hi4; const int vb = vb0 + ((db0 + dd) * 8 + ks) * 1024;
                    asm volatile("ds_read_b64_tr_b16 %0,%1" : "=&v"(lo) : "v"(vb) : "memory");
                    asm volatile("ds_read_b64_tr_b16 %0,%1 offset:512" : "=&v"(hi4) : "v"(vb) : "memory");
                    asm volatile("s_waitcnt lgkmcnt(0)" ::: "memory");
                    const bf16x8 bfr = (bf16x8){lo[0], lo[1], lo[2], lo[3], hi4[0], hi4[1], hi4[2], hi4[3]};
                    o[dd] = __builtin_amdgcn_mfma_f32_32x32x16_bf16(a, bfr, o[dd], 0, 0, 0); } }
            __attribute__((address_space(3))) bf16* stg = (__attribute__((address_space(3))) bf16*)(shm + LDS_OST) + wid * 2048;
#pragma unroll
            for (int r = 0; r < 16; ++r) { const int orow = nsa::crow(r, hi); const float bias = bs[g * 128 + tb * 32 + orow];
#pragma unroll
                for (int dd = 0; dd < 2; ++dd) stg[orow * 64 + dd * 32 + r32] = (bf16)f2bf(o[dd][r] + bias); }
            asm volatile("s_waitcnt lgkmcnt(0)" ::: "memory");
#pragma unroll
            for (int i = 0; i < 4; ++i) { const int row = i * 8 + (lane >> 3), chn = lane & 7;
                const v4u mv = *(const __attribute__((address_space(3))) v4u*)(stg + row * 64 + chn * 8);
                const size_t gi = (m0 + tb * 32 + row) * D + g * 128 + db0 * 32 + chn * 8;
                const v4u uv = *(const v4u*)(U + gi);
                v4u ov; ov.x = pk2(bf_lo(mv.x) * bf_lo(uv.x), bf_hi(mv.x) * bf_hi(uv.x)); ov.y = pk2(bf_lo(mv.y) * bf_lo(uv.y), bf_hi(mv.y) * bf_hi(uv.y));
                ov.z = pk2(bf_lo(mv.z) * bf_lo(uv.z), bf_hi(mv.z) * bf_hi(uv.z)); ov.w = pk2(bf_lo(mv.w) * bf_lo(uv.w), bf_hi(mv.w) * bf_hi(uv.w));
                *(v4u*)(GT + gi) = ov; }
            asm volatile("s_waitcnt lgkmcnt(0)\n\ts_barrier" ::: "memory");
        }
    }
}
}
__global__ void __launch_bounds__(NWAVES * 64, 2) fwd(Args args) {
    extern __shared__ __attribute__((aligned(16))) unsigned char lds[];
    Frame F;
    F.lds = (LAS unsigned char*)lds;
    volatile LAS unsigned* MISC = (volatile LAS unsigned*)(F.lds + MISC_OFF);
    F.tid = threadIdx.x; F.lane = F.tid & 63; F.wave = __builtin_amdgcn_readfirstlane(F.tid >> 6);
    F.G = gridDim.x; { const int bx = blockIdx.x; F.vcu = (F.G % 8 == 0) ? (bx % 8) * (F.G / 8) + bx / 8 : bx; }
    for (int u = F.tid; u < (LDS_BYTES - LDSCTL_OFF) / 4; u += NWAVES * 64) ((LAS unsigned*)(F.lds + LDSCTL_OFF))[u] = 0u;
    __syncthreads();
#if !MK_MULTI
    XcdBarrier bar = xcd_barrier_post((unsigned*)(args.ws + WS_CTL) + CW_BAR, MISC + 8);
#define GRID_BAR() xcd_barrier(bar)
#else
#define GRID_BAR() do {} while (0)
#endif
    const int lo = args.ph_lo, hi = args.ph_hi;
    int ph = 0;
#define PH_BEGIN if (ph >= lo && ph < hi) { Frame Fp = F; asm volatile("" : "+v"(Fp.tid), "+v"(Fp.lane)); \
        kargs_t KA = (kargs_t)__builtin_amdgcn_kernarg_segment_ptr(); asm volatile("" : "+s"(KA)); \
        unsigned char* const ws = KA->ws; LAS unsigned char* const ring = Fp.lds + RING_OFF; const int bx = (int)blockIdx.x; (void)ws; (void)ring; (void)bx;
#define PH_END   if (ph + 1 < hi) GRID_BAR(); } ++ph;
#define P_MOD   ((float*)(ws + WS_MOD))
#define P_KVMOD (P_MOD + (size_t)4 * 16 * 6144)
#define P_CB1   ((float*)(ws + WS_CB1))
#define P_GATE  ((float*)(ws + WS_GATE))
#define P_KCV   ((bf16*)(ws + WS_KCV))
#define P_CH    ((bf16*)(ws + WS_CH))
#define P_WB    ((bf16*)(ws + WS_W))
#define P_KV    ((bf16*)(ws + WS_KV))
#define P_HB    ((bf16*)(ws + WS_HB))
#define P_Y     ((bf16*)(ws + WS_Y))
#define P_BIG   ((bf16*)(ws + WS_BIG))
#define P_U     P_BIG
#define P_V     (P_BIG + (size_t)M * D)
#define P_Q     P_BIG
#define P_O     (P_BIG + (size_t)M * D)
#define P_HKV   P_O
#define P_HID   P_BIG
#define P_NG(L, i) (KA->in[4] + ((L) * 4 + (i)) * 1024)

    PH_BEGIN p0_prologue(Fp, KA); PH_END
    PH_BEGIN norm_phase<false, true, false>(Fp, KA->in[0], nullptr, nullptr, nullptr, nullptr, P_NG(0, 0), P_MOD + 0, P_MOD + 1024, 6144, P_HB, nullptr, nullptr, nullptr, 0, nullptr); PH_END

#pragma unroll 1
    for (int L = 0; L < DEPTH; ++L) {
        if (L < 2) {
            PH_BEGIN {
                pg8::Gemm g = pg8::make_gemm(P_HB, P_WB + WO_AIN + (size_t)L * 2048 * 1024, M, 2048, D); pg8::StaticOrder S; S.init(M, 2048, Fp.G, bx);
                pg8::EpiBf16<2> E{P_U, D, nullptr, 1024, (size_t)M * D, 1.f};
                pg8::gemm_phase<pg8::EpiBf16<2>, pg8::StaticOrder, true, true>(ring, g, S, E);
            } PH_END
            PH_BEGIN sgu::sgu_phase(Fp, P_U, P_V, KA->in[6] + L * 1024, KA->in[7] + L * 1024, P_WB + WO_WS + (size_t)L * 8 * 128 * 128, KA->in[9] + L * 8 * 128, P_HB); PH_END
            PH_BEGIN {
                pg8::Gemm g = pg8::make_gemm(P_HB, P_WB + WO_AOUT + (size_t)L * 1024 * 1024, M, D, D); pg8::StaticOrder S; S.init(M, D, Fp.G, bx);
                pg8::EpiBf16<0> E{P_Y, D, nullptr, 0, 0, 1.f};
                pg8::gemm_phase<pg8::EpiBf16<0>, pg8::StaticOrder, true, true>(ring, g, S, E);
            } PH_END
        } else {
            if (L == 2) {
                PH_BEGIN {
                    pg8::Gemm g = pg8::make_gemm(P_HKV, P_WB + WO_KV, M, NKV, D); pg8::StaticOrder S; S.init(M, NKV, Fp.G, bx);
                    pg8::EpiBf16<0> E{P_KV, NKV, nullptr, 0, 0, 1.f};
                    pg8::gemm_phase<pg8::EpiBf16<0>, pg8::StaticOrder, true, true>(ring, g, S, E);
                } PH_END
            }
            PH_BEGIN {
                {
                    pg8::Gemm g = pg8::make_gemm(P_HB, P_WB + WO_BIN + (size_t)(L - 2) * NQG * 1024, M, NQG, D); pg8::StaticOrder S; S.init(M, NQG, Fp.G, bx);
                    pg8::EpiQG E{P_Q, P_GATE, 0.125f * 1.4426950408889634f};
                    pg8::gemm_phase<pg8::EpiQG, pg8::StaticOrder, true, true>(ring, g, S, E);
                }
                if (L == 2) {
#pragma unroll 1
                    for (int q = 0; q < 4; ++q) { const int j = q >> 1, kh = q & 1;
                        pg8::Gemm g; g.A = P_KV + j * 256 + (size_t)kh * 16 * NKV; g.Bt = P_WB + WO_C1 + (size_t)j * 256 * 2048 + kh * 1024; g.M = 8192; g.N = 256; g.K = 1024; g.ldb = 2048;
                        g.a_rs = 16u * NKV * 2u; g.a_hstep = 64 * 2; g.a_kstep = (size_t)NKV * 2; g.a_t1 = (size_t)T * NKV * 2; g.a_t0 = 128 * 2; g.a_sh = 1;
                        pg8::StaticOrder S; S.init(8192, 256, Fp.G, (bx + 128 - 32 * q) % Fp.G);
                        pg8::EpiF32 E{(float*)P_Y + (size_t)q * 8192 * 256, 256};
                        pg8::gemm_phase<pg8::EpiF32, pg8::StaticOrder, true, true>(ring, g, S, E);
                    }
                }
            } PH_END
            if (L == 2) {
                PH_BEGIN cmp2_phase(Fp, (const float*)P_Y, P_CB1, KA->in[18], KA->in[19], P_KCV); PH_END
            }
            PH_BEGIN { const nsa::Tensors AT{P_Q, P_GATE, P_KCV, P_KV, P_O}; nsa::attn_phase(Fp, AT); } PH_END
            PH_BEGIN {
                pg8::Gemm g = pg8::make_gemm(P_O, P_WB + WO_BOUT + (size_t)(L - 2) * 1024 * 1024, M, D, D); pg8::StaticOrder S; S.init(M, D, Fp.G, bx);
                pg8::EpiBf16<0> E{P_Y, D, nullptr, 0, 0, 1.f};
                pg8::gemm_phase<pg8::EpiBf16<0>, pg8::StaticOrder, true, true>(ring, g, S, E);
            } PH_END
        }
        PH_BEGIN { const float* modL = P_MOD + (size_t)L * 16 * 6144; const float* xcur = (L == 0) ? KA->in[0] : (const float*)KA->out;
            norm_phase<true, true, false>(Fp, xcur, KA->out, P_Y, P_NG(L, 1), modL + 2 * 1024, P_NG(L, 2), modL + 3 * 1024, modL + 4 * 1024, 6144, P_HB, nullptr, nullptr, nullptr, 0, nullptr); } PH_END
#pragma unroll 1
        for (int hf = 0; hf < 2; ++hf) {
            PH_BEGIN {
                pg8::Gemm g = pg8::make_gemm(P_HB + (size_t)hf * MH * D, P_WB + WO_FIN + (size_t)L * 4096 * 1024, MH, FF, D); pg8::StaticOrder S; S.init(MH, FF, Fp.G, bx);
                pg8::EpiBf16<3> E{P_HID, FF, nullptr, 0, 0, 1.f};
                pg8::gemm_phase<pg8::EpiBf16<3>, pg8::StaticOrder, true, true>(ring, g, S, E);
            } PH_END
            PH_BEGIN {
                pg8::Gemm g = pg8::make_gemm(P_HID, P_WB + WO_FOUT + (size_t)L * 1024 * 4096, MH, D, FF); pg8::StaticOrder S; S.init(MH, D, Fp.G, bx);
                pg8::EpiBf16<0> E{P_Y + (size_t)hf * MH * D, D, nullptr, 0, 0, 1.f};
                pg8::gemm_phase<pg8::EpiBf16<0>, pg8::StaticOrder, true, true>(ring, g, S, E);
            } PH_END
        }
        PH_BEGIN {
            const float* modL = P_MOD + (size_t)L * 16 * 6144; float* xo = KA->out;
            const float* gy = P_NG(L, 3); const float* gate = modL + 5 * 1024;
            if (L == 3) norm_phase<true, false, false>(Fp, xo, xo, P_Y, gy, gate, nullptr, nullptr, nullptr, 6144, nullptr, nullptr, nullptr, nullptr, 0, nullptr);
            else { const float* modN = P_MOD + (size_t)(L + 1) * 16 * 6144; const float* gn = P_NG(L + 1, 0);
                if (L == 1) norm_phase<true, true, true>(Fp, xo, xo, P_Y, gy, gate, gn, modN + 0, modN + 1024, 6144, P_HB, KA->in[13], P_KVMOD + 0, P_KVMOD + 1024, 2048, P_HKV);
                else norm_phase<true, true, false>(Fp, xo, xo, P_Y, gy, gate, gn, modN + 0, modN + 1024, 6144, P_HB, nullptr, nullptr, nullptr, 0, nullptr); }
        } PH_END
    }
#undef PH_BEGIN
#undef PH_END
#undef GRID_BAR
}

extern "C" void kernel_launch(void* const* d_in, const int* in_sizes, int n_in, void* d_out, int out_size, void* d_ws, size_t ws_size, hipStream_t stream) {
    static int grid = 0;
    if (grid == 0) {
        if (n_in != 24 || out_size != M * D || ws_size < WS_END) { fprintf(stderr, "kernel_launch: unexpected shapes (n_in %d, out %d, ws %zu)\n", n_in, out_size, ws_size); grid = -1; return; }
        int dev = 0, cus = 0, per_cu = 0;
        if (hipGetDevice(&dev) != hipSuccess || hipDeviceGetAttribute(&cus, hipDeviceAttributeMultiprocessorCount, dev) != hipSuccess) { grid = -1; return; }
        if (hipFuncSetAttribute((const void*)fwd, hipFuncAttributeMaxDynamicSharedMemorySize, LDS_BYTES) != hipSuccess) { grid = -1; return; }
        if (hipOccupancyMaxActiveBlocksPerMultiprocessor(&per_cu, (const void*)fwd, NWAVES * 64, LDS_BYTES) != hipSuccess || per_cu < 1)
            fprintf(stderr, "kernel_launch: occupancy query reports %d workgroups per CU\n", per_cu);
        (void)hipGetLastError();
        grid = cus;
    }
    if (grid < 0) return;
    if (hipMemsetAsync((char*)d_ws + WS_CTL, 0, CTL_ZERO_BYTES, stream) != hipSuccess) return;
    Args a{};
    for (int i = 0; i < 24; ++i) a.in[i] = (const float*)d_in[i];
    a.out = (float*)d_out; a.ws = (unsigned char*)d_ws;
#if MK_MULTI
    static const int probe[] = {PROBE_PHASES, -1};
    for (int p = 0; p < 40; ++p) { a.ph_lo = p; a.ph_hi = p + 1; int n = 1; for (int k = 0; probe[k] >= 0; ++k) if (probe[k] == p) n += PROBE_REPS;
        for (int r = 0; r < n; ++r) hipLaunchKernelGGL(fwd, dim3(grid), dim3(NWAVES * 64), LDS_BYTES, stream, a); }
#else
    a.ph_lo = 0; a.ph_hi = 1000; hipLaunchKernelGGL(fwd, dim3(grid), dim3(NWAVES * 64), LDS_BYTES, stream, a);
#endif
}
```

```cpp
#include <hip/hip_runtime.h>
#include <cstdio>
#include <cstdint>
#include <cmath>
#define MK_MULTI 0
#define PROBE_PHASES -1
#define PROBE_REPS 2
#define PROBE_ATT 0
#define STAGGER_FIN 0
namespace pg8 {
#define PG8_LAS __attribute__((address_space(3)))
typedef unsigned short bf16_t;
typedef short bf16x8 __attribute__((ext_vector_type(8)));
typedef float f32x4 __attribute__((ext_vector_type(4)));
typedef unsigned u32x4 __attribute__((ext_vector_type(4)));
constexpr int BM = 256, BK = 64, HALF = 128, HTB = HALF * BK * 2  , STAGE_BYTES = 8 * HTB, NXCD = 8, WGM = 8;

__host__ __device__ __forceinline__ int lds_byte(int r, int c) { const int st = (r >> 4) * 2 + (c >> 5), rr = r & 15, cc = c & 31, ob = rr * 64 + cc * 2; return st * 1024 + (ob ^ (((ob >> 9) & 1) << 5)); }
__host__ __device__ __forceinline__ void stage_rc(int b, int& R, int& C) { const int st = b / 1024, sb = b % 1024, swz = sb ^ (((sb >> 9) & 1) << 5); R = (st >> 1) * 16 + swz / 64; C = (st & 1) * 32 + (swz % 64) / 2; }
__host__ __device__ __forceinline__ int perm32(int rho) { const int n = rho >> 4, i = rho & 15; return 8 * (i >> 2) + 4 * n + (i & 3); }

struct Unit { int pm, pn; };
struct Gemm { const bf16_t* A; const bf16_t* Bt; int M, N, K; unsigned a_rs; size_t a_hstep, a_kstep, a_t1, a_t0; int a_sh; int ldb; int stagger_ticks; };
__device__ __forceinline__ Gemm make_gemm(const bf16_t* A, const bf16_t* Bt, int M, int N, int K) {
    Gemm g; g.A = A; g.Bt = Bt; g.M = M; g.N = N; g.K = K; g.a_rs = (unsigned)K * 2u; g.a_hstep = (size_t)HALF * K * 2; g.a_kstep = BK * 2; g.a_t1 = (size_t)BM * K * 2; g.a_t0 = 0; g.a_sh = 0; g.ldb = K; g.stagger_ticks = 0; return g; }

struct StaticOrder {
    int nM, nN, nwg, G, c;
    __host__ __device__ void init(int M, int N, int G_, int c_) { nM = M / BM; nN = N / BM; nwg = nM * nN; G = G_; c = c_; }
    __host__ __device__ bool next(int i, Unit& u) const {
        const long L = (long)i * G + c; if (L >= nwg) return false;
        int wgid = (int)L; { const int q = nwg / NXCD, r = nwg % NXCD, xcd = wgid % NXCD, off = wgid / NXCD; wgid = (xcd < r ? xcd * (q + 1) : r * (q + 1) + (xcd - r) * q) + off; }
        const int nig = WGM * nN, gid = wgid / nig, fm = gid * WGM, gsz = (nM - fm) < WGM ? (nM - fm) : WGM;
        u.pm = fm + ((wgid % nig) % gsz); u.pn = (wgid % nig) / gsz; return true;
    }
    __device__ __forceinline__ void a_ready(const Unit&) const {}
    __device__ __forceinline__ void done(const Unit&) const {}
};
struct GroupOrder {
    int nM, nN, nwg, G, c;
    __host__ __device__ void init(int M, int N, int G_, int c_) { nM = M / BM; nN = N / BM; nwg = nM * nN; G = G_; c = c_; }
    __host__ __device__ bool next(int i, Unit& u) const {
        const int wgid = i * G + c; if (wgid >= nwg) return false;
        const int nig = WGM * nN, gid = wgid / nig, fm = gid * WGM, gsz = (nM - fm) < WGM ? (nM - fm) : WGM;
        u.pm = fm + ((wgid % nig) % gsz); u.pn = (wgid % nig) / gsz; return true;
    }
    __device__ __forceinline__ void a_ready(const Unit&) const {}
    __device__ __forceinline__ void done(const Unit&) const {}
};

__device__ __forceinline__ unsigned cvt_pk_bf16(float lo, float hi) { unsigned r; asm volatile("v_cvt_pk_bf16_f32 %0, %1, %2" : "=v"(r) : "v"(lo), "v"(hi)); return r; }
__device__ __forceinline__ float gelu_tanh(float v) {
    const float u = v * (0.7978845608028654f + 0.035677408136300125f * v * v);
    const float e = __builtin_amdgcn_exp2f(u * -2.8853900817779268f);
    return v * __builtin_amdgcn_rcpf(1.0f + e);
}
template <int ACT> __device__ __forceinline__ float act_fn(float v) {
    if (ACT == 2) return gelu_tanh(v);
    if (ACT == 3) { const float r = v > 0.f ? v : 0.f; return r * r; }
    return v;
}

template <int ACT  > struct EpiBf16 {
    static constexpr bool PERM = true, AFTER_DRAIN = false;
    bf16_t* O; int ldc; const float* bias; int split_cols; size_t split_stride; float scale0;
    __device__ __forceinline__ void operator()(const f32x4 (&acc)[2][2][4][2], const Unit& u, int wr, int wc, int fr, int fq) const {
        const int row0 = u.pm * BM + wr * 64 + fr; int colt = u.pn * BM; bf16_t* base = O;
        float sc = 1.f; if (split_cols) { const int t = colt / split_cols; base += (size_t)t * split_stride; colt -= t * split_cols; if (t == 0) sc = scale0; }
        const int col0 = colt + wc * 32 + 8 * fq, bcol0 = u.pn * BM + wc * 32 + 8 * fq;
        f32x4 bv[2][2];
#pragma unroll
        for (int bj = 0; bj < 2; ++bj)
#pragma unroll
            for (int n = 0; n < 2; ++n) bv[bj][n] = bias ? *(const f32x4*)(bias + bcol0 + bj * HALF + 4 * n) : (f32x4){0.f, 0.f, 0.f, 0.f};
#pragma unroll
        for (int ai = 0; ai < 2; ++ai)
#pragma unroll
            for (int m = 0; m < 4; ++m) { bf16_t* rowp = base + (size_t)(row0 + ai * HALF + m * 16) * ldc + col0;
#pragma unroll
                for (int bj = 0; bj < 2; ++bj) { f32x4 v0 = acc[ai][bj][m][0] + bv[bj][0], v1 = acc[ai][bj][m][1] + bv[bj][1];
                    if (ACT != 0) {
#pragma unroll
                        for (int e = 0; e < 4; ++e) { v0[e] = act_fn<ACT>(v0[e]); v1[e] = act_fn<ACT>(v1[e]); } }
                    v0 = v0 * sc; v1 = v1 * sc; u32x4 w; w.x = cvt_pk_bf16(v0[0], v0[1]); w.y = cvt_pk_bf16(v0[2], v0[3]); w.z = cvt_pk_bf16(v1[0], v1[1]); w.w = cvt_pk_bf16(v1[2], v1[3]);
                    *(u32x4*)(rowp + bj * HALF) = w; } }
    }
};
struct EpiF32 {
    static constexpr bool PERM = false, AFTER_DRAIN = false;
    float* O; int ldc;
    __device__ __forceinline__ void operator()(const f32x4 (&acc)[2][2][4][2], const Unit& u, int wr, int wc, int fr, int fq) const {
        const int row0 = u.pm * BM + wr * 64 + fr, col0 = u.pn * BM + wc * 32 + 4 * fq;
#pragma unroll
        for (int ai = 0; ai < 2; ++ai)
#pragma unroll
            for (int m = 0; m < 4; ++m) { float* rowp = O + (size_t)(row0 + ai * HALF + m * 16) * ldc + col0;
#pragma unroll
                for (int bj = 0; bj < 2; ++bj)
#pragma unroll
                    for (int n = 0; n < 2; ++n) *(f32x4*)(rowp + bj * HALF + n * 16) = acc[ai][bj][m][n]; }
    }
};
struct EpiQG {
    static constexpr bool PERM = true, AFTER_DRAIN = false;
    bf16_t* Q; float* G; float qscale;
    __device__ __forceinline__ void operator()(const f32x4 (&acc)[2][2][4][2], const Unit& u, int wr, int wc, int fr, int fq) const {
        const int row0 = u.pm * BM + wr * 64 + fr;
        if (u.pn < 4) {
            const int col0 = u.pn * BM + wc * 32 + 8 * fq;
#pragma unroll
            for (int ai = 0; ai < 2; ++ai)
#pragma unroll
                for (int m = 0; m < 4; ++m) { bf16_t* rowp = Q + (size_t)(row0 + ai * HALF + m * 16) * 1024 + col0;
#pragma unroll
                    for (int bj = 0; bj < 2; ++bj) { const f32x4 v0 = acc[ai][bj][m][0] * qscale, v1 = acc[ai][bj][m][1] * qscale;
                        u32x4 w; w.x = cvt_pk_bf16(v0[0], v0[1]); w.y = cvt_pk_bf16(v0[2], v0[3]); w.z = cvt_pk_bf16(v1[0], v1[1]); w.w = cvt_pk_bf16(v1[2], v1[3]);
                        *(u32x4*)(rowp + bj * HALF) = w; } }
        } else if (wc < 2) {
#pragma unroll
            for (int ai = 0; ai < 2; ++ai)
#pragma unroll
                for (int m = 0; m < 4; ++m) { float* rowp = G + (size_t)(row0 + ai * HALF + m * 16) * 48;
#pragma unroll
                    for (int n = 0; n < 2; ++n) { const int col = wc * 32 + 8 * fq + 4 * n;
                        if (col < 48) { f32x4 v = acc[ai][0][m][n];
#pragma unroll
                            for (int e = 0; e < 4; ++e) v[e] = __builtin_amdgcn_rcpf(1.0f + __builtin_amdgcn_exp2f(v[e] * -1.4426950408889634f));
                            *(f32x4*)(rowp + col) = v; } } }
        }
    }
};

template <class Epi, class Sched, bool ALIGN_EPI = false, bool SP2 = false>
__device__ __forceinline__ void gemm_phase(PG8_LAS unsigned char* lds, const Gemm g, const Sched& S, const Epi& E) {
    int tid_ = threadIdx.x; asm volatile("" : "+v"(tid_));
    const int tid = tid_, wid = __builtin_amdgcn_readfirstlane(tid >> 6), lane = tid & 63, wr = wid >> 2, wc = wid & 3, fr = lane & 15, fq = lane >> 4;
    const int K = g.K, nt = K / BK;
    unsigned voffA[2], voffB[2];
#pragma unroll
    for (int i = 0; i < 2; ++i) { int R, C; stage_rc(tid * 16 + i * 8192, R, C); const int Rb = Epi::PERM ? ((R & ~31) + perm32(R & 31)) : R;
        voffA[i] = (unsigned)R * g.a_rs + (unsigned)C * 2u; voffB[i] = (unsigned)(Rb * g.ldb + C) * 2u; }
    const size_t kstepA = g.a_kstep, kstepB = (size_t)(BK * 2);
    const size_t hstepA = g.a_hstep, hstepB = (size_t)HALF * g.ldb * 2;
    const size_t tstepB = 2 * hstepB;
    const int a_msk = (1 << g.a_sh) - 1;
#define PG8_ATILE(pm) ((const char*)g.A + (size_t)((pm) >> g.a_sh) * g.a_t1 + (size_t)((pm) & a_msk) * g.a_t0)
    const unsigned ldsw = (unsigned)wid * 1024u;
    const int aoff = lds_byte(wr * 64 + fr, fq * 8), boff = lds_byte(wc * 32 + fr, fq * 8);
#define PG8_SA(b, h) (((b) * 2 + (h)) * HTB)
#define PG8_SB(b, h) ((4 + (b) * 2 + (h)) * HTB)
#define PG8_STAGE(bufoff, gbase, voff) do { _Pragma("unroll") for (int _i = 0; _i < 2; ++_i) \
        __builtin_amdgcn_global_load_lds((const unsigned*)((const char*)(gbase) + (voff)[_i]), (PG8_LAS unsigned*)(lds + (bufoff) + ldsw + _i * 8192), 16, 0, 0); } while (0)
#define PG8_LDA(dst, b, h) do { _Pragma("unroll") for (int m = 0; m < 4; ++m) _Pragma("unroll") for (int k = 0; k < 2; ++k) dst[m][k] = *(const PG8_LAS bf16x8*)(lds + PG8_SA(b, h) + aoff + m * 2048 + k * 1024); } while (0)
#define PG8_LDB(dst, b, h) do { _Pragma("unroll") for (int n = 0; n < 2; ++n) _Pragma("unroll") for (int k = 0; k < 2; ++k) dst[n][k] = *(const PG8_LAS bf16x8*)(lds + PG8_SB(b, h) + boff + n * 2048 + k * 1024); } while (0)
#define PG8_MMA(ai, bj, At, Bt) do { __builtin_amdgcn_s_setprio(1); _Pragma("unroll") for (int m = 0; m < 4; ++m) _Pragma("unroll") for (int n = 0; n < 2; ++n) _Pragma("unroll") for (int k = 0; k < 2; ++k) \
        acc[ai][bj][m][n] = __builtin_amdgcn_mfma_f32_16x16x32_bf16(Bt[n][k], At[m][k], acc[ai][bj][m][n], 0, 0, 0); __builtin_amdgcn_s_setprio(0); } while (0)
#define PG8_WAIT_V(n) asm volatile("s_waitcnt vmcnt(" #n ")" ::: "memory")
#define PG8_WAIT_L(n) asm volatile("s_waitcnt lgkmcnt(" #n ")" ::: "memory")
#define PG8_BAR __builtin_amdgcn_s_barrier()
#define PG8_SCHED __builtin_amdgcn_sched_barrier(0)
    Unit cur, nxt; int ui = 0;
    if (!S.next(0, cur)) return;
    if (g.stagger_ticks > 0) {
        const unsigned long long t0 = __builtin_amdgcn_s_memrealtime(); const unsigned long long dt = (unsigned long long)(((unsigned)blockIdx.x >> 3) & 3u) * (unsigned)g.stagger_ticks;
        while (__builtin_amdgcn_s_memrealtime() - t0 < dt) __builtin_amdgcn_s_sleep(4);
    }
    f32x4 acc[2][2][4][2];
#pragma unroll
    for (int a = 0; a < 2; ++a)
#pragma unroll
        for (int b = 0; b < 2; ++b)
#pragma unroll
            for (int m = 0; m < 4; ++m)
#pragma unroll
                for (int n = 0; n < 2; ++n) acc[a][b][m][n] = (f32x4){0.f, 0.f, 0.f, 0.f};
    bf16x8 At[4][2], B0[2][2], B1[2][2];
    const char* cA = PG8_ATILE(cur.pm); const char* cB = (const char*)g.Bt + (size_t)cur.pn * tstepB;
    S.a_ready(cur);
    if constexpr (SP2) {
        PG8_STAGE(PG8_SB(0, 0), cB, voffB); PG8_STAGE(PG8_SB(0, 1), cB + hstepB, voffB); PG8_STAGE(PG8_SA(0, 0), cA, voffA); PG8_STAGE(PG8_SA(0, 1), cA + hstepA, voffA);
        if (wr == 1) PG8_BAR;
        PG8_WAIT_V(2); PG8_BAR;
        PG8_STAGE(PG8_SB(1, 0), cB + kstepB, voffB); PG8_STAGE(PG8_SA(1, 0), cA + kstepA, voffA); PG8_STAGE(PG8_SB(1, 1), cB + hstepB + kstepB, voffB);
        PG8_WAIT_V(6); PG8_BAR;
    } else {
        PG8_STAGE(PG8_SB(0, 0), cB, voffB); PG8_STAGE(PG8_SA(0, 0), cA, voffA); PG8_STAGE(PG8_SB(0, 1), cB + hstepB, voffB); PG8_STAGE(PG8_SA(0, 1), cA + hstepA, voffA);
        if (wr == 1) PG8_BAR;
        PG8_WAIT_V(4); PG8_BAR;
        PG8_STAGE(PG8_SB(1, 0), cB + kstepB, voffB); PG8_STAGE(PG8_SA(1, 0), cA + kstepA, voffA); PG8_STAGE(PG8_SB(1, 1), cB + hstepB + kstepB, voffB);
        PG8_WAIT_V(6); PG8_BAR;
    }
    for (;;) {
        const bool has_next = S.next(ui + 1, nxt);
        const char* nA = has_next ? PG8_ATILE(nxt.pm) : cA; const char* nB = has_next ? (const char*)g.Bt + (size_t)nxt.pn * tstepB : cB;
        for (int t = 0; t < nt; t += 2) {
            const bool last = (t == nt - 2);
            const char* a1 = cA + (size_t)(t + 1) * kstepA;
            const char* a2 = last ? nA : cA + (size_t)(t + 2) * kstepA; const char* b2 = last ? nB : cB + (size_t)(t + 2) * kstepB;
            const char* a3 = a2 + kstepA; const char* b3 = b2 + kstepB;
            if (last && has_next) S.a_ready(nxt);
            if constexpr (SP2) {
            PG8_LDB(B0, 0, 0); PG8_LDB(B1, 0, 1); PG8_SCHED; PG8_LDA(At, 0, 0); PG8_STAGE(PG8_SA(1, 1), a1 + hstepA, voffA);
            PG8_WAIT_V(8); PG8_WAIT_L(0); PG8_BAR; PG8_MMA(0, 0, At, B0); PG8_MMA(0, 1, At, B1); PG8_BAR; PG8_SCHED;
            PG8_LDA(At, 0, 1); PG8_STAGE(PG8_SB(0, 0), b2, voffB); PG8_STAGE(PG8_SB(0, 1), b2 + hstepB, voffB); PG8_STAGE(PG8_SA(0, 0), a2, voffA);
            PG8_WAIT_V(8); PG8_WAIT_L(0); PG8_BAR; PG8_MMA(1, 0, At, B0); PG8_MMA(1, 1, At, B1); PG8_BAR; PG8_SCHED;
            PG8_LDB(B0, 1, 0); PG8_LDB(B1, 1, 1); PG8_SCHED; PG8_LDA(At, 1, 0); PG8_STAGE(PG8_SA(0, 1), a2 + hstepA, voffA);
            PG8_WAIT_V(8); PG8_WAIT_L(0); PG8_BAR; PG8_MMA(0, 0, At, B0); PG8_MMA(0, 1, At, B1); PG8_BAR; PG8_SCHED;
            PG8_LDA(At, 1, 1); PG8_STAGE(PG8_SB(1, 0), b3, voffB); PG8_STAGE(PG8_SB(1, 1), b3 + hstepB, voffB); PG8_STAGE(PG8_SA(1, 0), a3, voffA);
            PG8_WAIT_V(8); PG8_WAIT_L(0); PG8_BAR; PG8_MMA(1, 0, At, B0); PG8_MMA(1, 1, At, B1); PG8_BAR; PG8_SCHED;
            } else {
            PG8_LDB(B0, 0, 0); PG8_SCHED; PG8_LDA(At, 0, 0); PG8_STAGE(PG8_SA(1, 1), a1 + hstepA, voffA);
            PG8_WAIT_L(8); PG8_BAR; PG8_WAIT_L(0); PG8_MMA(0, 0, At, B0); PG8_BAR; PG8_SCHED;
            PG8_LDB(B1, 0, 1); PG8_STAGE(PG8_SB(0, 0), b2, voffB);
            PG8_BAR; PG8_WAIT_L(0); PG8_MMA(0, 1, At, B1); PG8_BAR;
            PG8_LDA(At, 0, 1); PG8_STAGE(PG8_SA(0, 0), a2, voffA);
            PG8_BAR; PG8_WAIT_L(0); PG8_MMA(1, 0, At, B0); PG8_BAR; PG8_SCHED;
            PG8_STAGE(PG8_SB(0, 1), b2 + hstepB, voffB);
            PG8_WAIT_V(6); PG8_BAR; PG8_MMA(1, 1, At, B1); PG8_BAR;
            PG8_LDB(B0, 1, 0); PG8_SCHED; PG8_LDA(At, 1, 0); PG8_STAGE(PG8_SA(0, 1), a2 + hstepA, voffA);
            PG8_WAIT_L(8); PG8_BAR; PG8_WAIT_L(0); PG8_MMA(0, 0, At, B0); PG8_BAR; PG8_SCHED;
            PG8_LDB(B1, 1, 1); PG8_STAGE(PG8_SB(1, 0), b3, voffB);
            PG8_BAR; PG8_WAIT_L(0); PG8_MMA(0, 1, At, B1); PG8_BAR;
            PG8_LDA(At, 1, 1); PG8_STAGE(PG8_SA(1, 0), a3, voffA);
            PG8_BAR; PG8_WAIT_L(0); PG8_MMA(1, 0, At, B0); PG8_BAR; PG8_SCHED;
            PG8_STAGE(PG8_SB(1, 1), b3 + hstepB, voffB);
            PG8_WAIT_V(6); PG8_BAR; PG8_MMA(1, 1, At, B1); PG8_BAR;
            }
        }
        if constexpr (ALIGN_EPI) { if (wr == 0) PG8_BAR; }
        E(acc, cur, wr, wc, fr, fq); S.done(cur);
        if (!has_next) break;
#pragma unroll
        for (int a = 0; a < 2; ++a)
#pragma unroll
            for (int b = 0; b < 2; ++b)
#pragma unroll
                for (int m = 0; m < 4; ++m)
#pragma unroll
                    for (int n = 0; n < 2; ++n) acc[a][b][m][n] = (f32x4){0.f, 0.f, 0.f, 0.f};
        cur = nxt; cA = nA; cB = nB; ++ui;
        if constexpr (ALIGN_EPI) { if (wr == 1) PG8_BAR; }
    }
    PG8_WAIT_V(0);
    if constexpr (!ALIGN_EPI) { if (wr == 0) PG8_BAR; }
    PG8_BAR;
#undef PG8_ATILE
#undef PG8_SA
#undef PG8_SB
#undef PG8_STAGE
#undef PG8_LDA
#undef PG8_LDB
#undef PG8_MMA
#undef PG8_WAIT_V
#undef PG8_WAIT_L
#undef PG8_BAR
#undef PG8_SCHED
}
}
constexpr int NWAVES = 8;
#ifndef MK_MULTI
#define MK_MULTI 0
#endif

constexpr int BATCH = 16, T = 2048, D = 1024, FF = 4096, DEPTH = 4;
constexpr int M = BATCH * T;
constexpr int MH = M / 2;
constexpr int NKV = 1536;
constexpr int NQG = 1280;
constexpr int NCMP = 127;
constexpr float EPS = 1e-6f;

constexpr size_t MiB = 1u << 20;
constexpr size_t WS_CTL = 0, CTL_ZERO_BYTES = 64 * 1024;
constexpr size_t WS_MOD = 1 * MiB;
constexpr size_t WS_CB1 = 3 * MiB;
constexpr size_t WS_GATE = 4 * MiB;
constexpr size_t WS_KCV = 10 * MiB;
constexpr size_t WS_CH = 16 * MiB;
constexpr size_t WS_W = 32 * MiB;
constexpr size_t WS_KV = 128 * MiB;
constexpr size_t WS_HB = 224 * MiB;
constexpr size_t WS_Y = 288 * MiB;
constexpr size_t WS_BIG = 352 * MiB;
constexpr size_t WS_END = 480 * MiB;
constexpr size_t WO_AIN = 0;
constexpr size_t WO_AOUT = WO_AIN + 2ull * 2048 * 1024;
constexpr size_t WO_KV = WO_AOUT + 2ull * 1024 * 1024;
constexpr size_t WO_BIN = WO_KV + 1536ull * 1024;
constexpr size_t WO_BOUT = WO_BIN + 2ull * 1280 * 1024;
constexpr size_t WO_FIN = WO_BOUT + 2ull * 1024 * 1024;
constexpr size_t WO_FOUT = WO_FIN + 4ull * 4096 * 1024;
constexpr size_t WO_C1 = WO_FOUT + 4ull * 4096 * 1024;
constexpr size_t WO_WS = WO_C1 + 2ull * 256 * 2048;
constexpr size_t WO_END = WO_WS + 2ull * 8 * 128 * 128;
static_assert(WO_END * 2 <= 96 * MiB, "weights fit");
constexpr int CW_BAR = 1024;

constexpr int RING_OFF = 0, RING_BYTES = 131072;
constexpr int LDSCTL_OFF = RING_BYTES, MISC_OFF = LDSCTL_OFF + 320;
constexpr int LDS_BYTES = 147456;

#define GAS __attribute__((address_space(1)))
#define LAS __attribute__((address_space(3)))
typedef unsigned short bf16;
typedef unsigned v4u __attribute__((ext_vector_type(4)));
typedef unsigned v2u __attribute__((ext_vector_type(2)));
typedef float f32x4 __attribute__((ext_vector_type(4)));
typedef GAS unsigned gu32;
#define RLX_AGENT __ATOMIC_RELAXED, __HIP_MEMORY_SCOPE_AGENT
#define LDS_WAIT() asm volatile("s_waitcnt lgkmcnt(0)" ::: "memory")
#define VM_WAIT() asm volatile("s_waitcnt vmcnt(0)" ::: "memory")
__device__ __forceinline__ unsigned f2bf(float f) { unsigned u = __builtin_bit_cast(unsigned, f); return (u + 0x7fffu + ((u >> 16) & 1u)) >> 16; }
__device__ __forceinline__ unsigned pk2(float lo, float hi) { return f2bf(lo) | (f2bf(hi) << 16); }
__device__ __forceinline__ float bf_lo(unsigned w) { return __builtin_bit_cast(float, w << 16); }
__device__ __forceinline__ float bf_hi(unsigned w) { return __builtin_bit_cast(float, w & 0xffff0000u); }
__device__ __forceinline__ float bf1(bf16 h) { return __builtin_bit_cast(float, (unsigned)h << 16); }
__device__ __forceinline__ float wave_sum(float v) {
#pragma unroll
    for (int o = 1; o < 64; o <<= 1) v += __shfl_xor(v, o);
    return v;
}
__device__ __forceinline__ float wave_max(float v) {
#pragma unroll
    for (int o = 1; o < 64; o <<= 1) v = fmaxf(v, __shfl_xor(v, o));
    return v;
}

#define XB_TMO      128
#define XB_XCNT(j)  (256  + 64 * (j))
#define XB_XSUB(j)  (1280 + 64 * (j))
#define XB_XGEN(j)  (2304 + 64 * (j))
#define XB_TOP      3328
#define XB_TOPGEN   3392
#define XCD_BAR_WORDS 3456
#define XB_SPIN_CAP (1u << 18)

__device__ __forceinline__ unsigned xb_ld(unsigned* p)              { return __hip_atomic_load(p, __ATOMIC_RELAXED, __HIP_MEMORY_SCOPE_AGENT); }
__device__ __forceinline__ unsigned xb_add(unsigned* p, unsigned v) { return __hip_atomic_fetch_add(p, v, __ATOMIC_RELAXED, __HIP_MEMORY_SCOPE_AGENT); }
__device__ __forceinline__ unsigned xb_xcc_id() { return (unsigned)__builtin_amdgcn_s_getreg((3 << 11) | 20) & 0xFu; }
#define XB_SPIN(cond, bar) do { unsigned _sp = 0; while (cond) { __builtin_amdgcn_s_sleep(1); \
    if ((++_sp & 255u) == 0u) { if (xb_ld(&(bar)[XB_TMO])) break; if (_sp > XB_SPIN_CAP) { atomicAdd(&(bar)[XB_TMO], 1u); break; } } } } while (0)

struct XcdBarrier {
    unsigned* bar; unsigned x;
    volatile LAS unsigned* st;
};
__device__ __forceinline__ XcdBarrier xcd_barrier_post(unsigned* bar, volatile LAS unsigned* st) {
    XcdBarrier b; b.bar = bar; b.x = xb_xcc_id(); b.st = st;
    if (threadIdx.x == 0) (void)xb_add(&bar[XB_XCNT(b.x)], 1u);
    return b;
}
__device__ __forceinline__ void xcd_barrier_complete(unsigned* bar, unsigned x, unsigned& nloc, unsigned& nx) {
    const unsigned G = gridDim.x * gridDim.y * gridDim.z;
    unsigned sum, cnt, mine, sp = 0u;
    for (;;) {
        sum = 0u; cnt = 0u; mine = 0u;
#pragma unroll
        for (unsigned j = 0; j < 16; ++j) { const unsigned c = xb_ld(&bar[XB_XCNT(j)]); sum += c; cnt += (c > 0u) ? 1u : 0u; mine = (j == x) ? c : mine; }
        if (sum == G) break;
        __builtin_amdgcn_s_sleep(1);
        if ((++sp & 255u) == 0u) { if (xb_ld(&bar[XB_TMO])) break; if (sp > XB_SPIN_CAP) { atomicAdd(&bar[XB_TMO], 1u); break; } }
    }
    nloc = mine > 0u ? mine : 1u; nx = cnt > 0u ? cnt : 1u;
}
__device__ __forceinline__ void xcd_barrier(const XcdBarrier& b) {
    asm volatile("s_waitcnt vmcnt(0)" ::: "memory");
    __syncthreads();
    if (threadIdx.x == 0) {
        unsigned* bar = b.bar;
        __builtin_amdgcn_s_waitcnt(0);
        unsigned nloc = b.st[0], nx = b.st[1];
        if (nloc == 0u) { xcd_barrier_complete(bar, b.x, nloc, nx); b.st[0] = nloc; b.st[1] = nx; }
        const unsigned old = xb_add(&bar[XB_XSUB(b.x)], 1u);
        const unsigned gen = old / nloc;
        if (old + 1u == (gen + 1u) * nloc) {
            __builtin_amdgcn_fence(__ATOMIC_RELEASE, "agent");
            asm volatile("s_waitcnt vmcnt(0)" ::: "memory");
            const unsigned og = xb_add(&bar[XB_TOP], 1u);
            const unsigned tg = og / nx;
            if (og + 1u == (tg + 1u) * nx) xb_add(&bar[XB_TOPGEN], 1u);
            else XB_SPIN(xb_ld(&bar[XB_TOPGEN]) == tg, bar);
            __builtin_amdgcn_fence(__ATOMIC_ACQUIRE, "agent");
            xb_add(&bar[XB_XGEN(b.x)], 1u);
            asm volatile("s_waitcnt vmcnt(0)" ::: "memory");
        } else {
            XB_SPIN(xb_ld(&bar[XB_XGEN(b.x)]) == gen, bar);
            __builtin_amdgcn_fence(__ATOMIC_ACQUIRE, "agent");
            asm volatile("s_waitcnt vmcnt(0)" ::: "memory");
        }
    }
    __syncthreads();
}

constexpr int GRP_WGS = 32, NGRP = 8, CW_GRP = 8192, GROWS = M / NGRP;
__device__ __forceinline__ void grp_barrier(unsigned* cnt, unsigned* bar) {
    asm volatile("s_waitcnt vmcnt(0)" ::: "memory");
    __syncthreads();
    if (threadIdx.x == 0) {
        __builtin_amdgcn_fence(__ATOMIC_RELEASE, "agent");
        asm volatile("s_waitcnt vmcnt(0)" ::: "memory");
        const unsigned old = xb_add(cnt, 1u);
        const unsigned target = (old / (unsigned)GRP_WGS + 1u) * (unsigned)GRP_WGS;
        XB_SPIN(xb_ld(cnt) < target, bar);
        __builtin_amdgcn_fence(__ATOMIC_ACQUIRE, "agent");
        asm volatile("s_waitcnt vmcnt(0)" ::: "memory");
    }
    __syncthreads();
}

struct Frame {
    LAS unsigned char* lds;
    int tid, lane, wave;
    int vcu, G;
};
__device__ __forceinline__ void tr_item(const float* W, int K, int ldw, int nvalid, bf16* WT, int nblk, LAS float* scr, int item, int lane) {
    const int kb = item / nblk, nb = item % nblk, k0 = 64 * kb, n0 = 32 * nb;
    const int kr = lane >> 3, n4 = (lane & 7) * 4; const bool ok = (n0 + n4) < nvalid;
    f32x4 v[8];
#pragma unroll
    for (int i = 0; i < 8; ++i) v[i] = ok ? *(const f32x4*)(W + (size_t)(k0 + 8 * i + kr) * ldw + n0 + n4) : (f32x4){0.f, 0.f, 0.f, 0.f};
#pragma unroll
    for (int i = 0; i < 8; ++i) { LAS float* d = scr + (8 * i + kr) * 33 + n4; d[0] = v[i].x; d[1] = v[i].y; d[2] = v[i].z; d[3] = v[i].w; }
    LDS_WAIT(); asm volatile("" ::: "memory");
    const int c = lane & 7;
#pragma unroll
    for (int j = 0; j < 4; ++j) { const int n = (lane >> 3) + 8 * j; const LAS float* s = scr + (8 * c) * 33 + n;
        v4u o; o.x = pk2(s[0 * 33], s[1 * 33]); o.y = pk2(s[2 * 33], s[3 * 33]); o.z = pk2(s[4 * 33], s[5 * 33]); o.w = pk2(s[6 * 33], s[7 * 33]);
        *(GAS v4u*)(WT + (size_t)(n0 + n) * K + k0 + 8 * c) = o; }
    LDS_WAIT(); asm volatile("" ::: "memory");
}

struct Args { const float* in[24]; float* out; unsigned char* ws; int ph_lo, ph_hi; };
typedef const __attribute__((address_space(4))) Args* kargs_t;

__device__ __forceinline__ void p0_prologue(const Frame& F, kargs_t a) {
    LAS float* scr = (LAS float*)(F.lds + RING_OFF + F.wave * 16384);
    bf16* WB = (bf16*)(a->ws + WS_W);
    const int gw = F.vcu * NWAVES + F.wave, NGW = F.G * NWAVES;
    constexpr int I_AIN = 16 * 64, I_AOUT = 16 * 32, I_KV = 16 * 48, I_BIN = 16 * 40, I_BOUT = 16 * 32, I_FIN = 16 * 128, I_FOUT = 64 * 32, I_C1 = 32 * 8;
    constexpr int NITEMS = 2 * I_AIN + 2 * I_AOUT + I_KV + 2 * I_BIN + 2 * I_BOUT + 4 * I_FIN + 4 * I_FOUT + 2 * I_C1;
    for (int it = gw; it < NITEMS; it += NGW) {
        int r = it;
        if (r < 2 * I_AIN) { const int l = r / I_AIN; tr_item(a->in[5] + (size_t)l * 1024 * 2048, 1024, 2048, 2048, WB + WO_AIN + (size_t)l * 2048 * 1024, 64, scr, r % I_AIN, F.lane); continue; } r -= 2 * I_AIN;
        if (r < 2 * I_AOUT) { const int l = r / I_AOUT; tr_item(a->in[10] + (size_t)l * 1024 * 1024, 1024, 1024, 1024, WB + WO_AOUT + (size_t)l * 1024 * 1024, 32, scr, r % I_AOUT, F.lane); continue; } r -= 2 * I_AOUT;
        if (r < I_KV) { tr_item(a->in[14], 1024, 1536, 1536, WB + WO_KV, 48, scr, r, F.lane); continue; } r -= I_KV;
        if (r < 2 * I_BIN) { const int l = r / I_BIN; tr_item(a->in[20] + (size_t)l * 1024 * 1072, 1024, 1072, 1072, WB + WO_BIN + (size_t)l * 1280 * 1024, 40, scr, r % I_BIN, F.lane); continue; } r -= 2 * I_BIN;
        if (r < 2 * I_BOUT) { const int l = r / I_BOUT; tr_item(a->in[21] + (size_t)l * 1024 * 1024, 1024, 1024, 1024, WB + WO_BOUT + (size_t)l * 1024 * 1024, 32, scr, r % I_BOUT, F.lane); continue; } r -= 2 * I_BOUT;
        if (r < 4 * I_FIN) { const int l = r / I_FIN; tr_item(a->in[22] + (size_t)l * 1024 * 4096, 1024, 4096, 4096, WB + WO_FIN + (size_t)l * 4096 * 1024, 128, scr, r % I_FIN, F.lane); continue; } r -= 4 * I_FIN;
        if (r < 4 * I_FOUT) { const int l = r / I_FOUT; tr_item(a->in[23] + (size_t)l * 4096 * 1024, 4096, 1024, 1024, WB + WO_FOUT + (size_t)l * 1024 * 4096, 32, scr, r % I_FOUT, F.lane); continue; } r -= 4 * I_FOUT;
        { const int l = r / I_C1; tr_item(a->in[16] + (size_t)l * 2048 * 256, 2048, 256, 256, WB + WO_C1 + (size_t)l * 256 * 2048, 8, scr, r % I_C1, F.lane); }
    }
    for (int i = gw * 64 + F.lane; i < 2 * 8 * 128 * 128; i += NGW * 64) { const int s = i & 127, t = (i >> 7) & 127; WB[WO_WS + i] = (s <= t) ? (bf16)f2bf(a->in[8][i]) : (bf16)0; }
    __syncthreads();
    if (F.vcu < 208) {
        LAS float* cact = (LAS float*)(F.lds);
        LAS float* red = (LAS float*)(F.lds + 65536);
        for (int i = F.tid; i < 16 * 1024; i += NWAVES * 64) { const float c = a->in[1][i]; cact[i] = c / (1.0f + __expf(-c)); }
        __syncthreads();
        const int grp = F.vcu; const float* W; const float* bias; float* out; int ldw, n0, ostride;
        float* MOD = (float*)(a->ws + WS_MOD);
        if (grp < 192) { const int L = grp / 48; n0 = (grp % 48) * 128; W = a->in[2] + (size_t)L * 1024 * 6144; ldw = 6144; bias = a->in[3] + L * 6144; out = MOD + (size_t)L * 16 * 6144; ostride = 6144; }
        else { n0 = (grp - 192) * 128; W = a->in[11]; ldw = 2048; bias = a->in[12]; out = MOD + (size_t)4 * 16 * 6144; ostride = 2048; }
        float acc0[16], acc1[16];
#pragma unroll
        for (int b = 0; b < 16; ++b) { acc0[b] = 0.f; acc1[b] = 0.f; }
        const int kbeg = F.wave * 128;
        for (int k = kbeg; k < kbeg + 128; k += 8) {
            float2 w[8];
#pragma unroll
            for (int u = 0; u < 8; ++u) w[u] = *(const float2*)(W + (size_t)(k + u) * ldw + n0 + 2 * F.lane);
#pragma unroll
            for (int u = 0; u < 8; ++u)
#pragma unroll
                for (int b = 0; b < 16; ++b) { const float cv = cact[b * 1024 + k + u]; acc0[b] += cv * w[u].x; acc1[b] += cv * w[u].y; }
        }
#pragma unroll
        for (int b = 0; b < 16; ++b) { red[(F.wave * 16 + b) * 128 + 2 * F.lane] = acc0[b]; red[(F.wave * 16 + b) * 128 + 2 * F.lane + 1] = acc1[b]; }
        __syncthreads();
        for (int o = F.tid; o < 2048; o += NWAVES * 64) { const int b = o >> 7, n = o & 127; float s = bias[n0 + n];
#pragma unroll
            for (int w = 0; w < 8; ++w) s += red[(w * 16 + b) * 128 + n];
            out[(size_t)b * ostride + n0 + n] = s; }
    } else if (F.vcu == 208) {
        const int j = F.tid >> 8, n = F.tid & 255; float s = a->in[17][j * 256 + n];
        const float* pos = a->in[15] + j * 2048; const float* w1 = a->in[16] + (size_t)j * 2048 * 256 + n;
        for (int kk = 0; kk < 2048; ++kk) s += pos[kk] * w1[(size_t)kk * 256];
        ((float*)(a->ws + WS_CB1))[j * 256 + n] = s;
    }
}

template <bool HAS_Y, bool HAS_H, bool HAS_KV, bool XIN_BF, bool XOUT_BF>
__device__ __forceinline__ void norm_phase(const Frame& F, const void* xin_, void* xout_, const bf16* Y, const float* gy, const float* gate  ,
                                           const float* gn, const float* sh, const float* sc, int mstride, bf16* H,
                                           const float* gkv, const float* shkv, const float* sckv, int kvstride, bf16* HKV) {
    const int gw = F.vcu * NWAVES + F.wave, NGW = F.G * NWAVES;
    for (int blk = gw; blk < M / 16; blk += NGW) {
        const int b = blk / (T / 16);
        f32x4 A1[4], A2[4], A3[4], K2[4], K3[4];
#pragma unroll
        for (int j = 0; j < 4; ++j) { const int col = 256 * j + 4 * F.lane;
            if (HAS_Y) A1[j] = *(const f32x4*)(gate + (size_t)b * mstride + col) * *(const f32x4*)(gy + col);
            if (HAS_H) { A2[j] = *(const f32x4*)(gn + col) * (*(const f32x4*)(sc + (size_t)b * mstride + col) + 1.0f); A3[j] = *(const f32x4*)(sh + (size_t)b * mstride + col); }
            if (HAS_KV) { K2[j] = *(const f32x4*)(gkv + col) * (*(const f32x4*)(sckv + (size_t)b * kvstride + col) + 1.0f); K3[j] = *(const f32x4*)(shkv + (size_t)b * kvstride + col); }
        }
        for (int r = 0; r < 16; r += 2) {
            const size_t m = (size_t)blk * 16 + r;
            f32x4 xa[4], xb[4]; v2u ya[4], yb[4];
#pragma unroll
            for (int j = 0; j < 4; ++j) {
                if (XIN_BF) { const v2u w0 = __builtin_nontemporal_load((const v2u*)((const bf16*)xin_ + m * D + 256 * j + 4 * F.lane)), w1 = __builtin_nontemporal_load((const v2u*)((const bf16*)xin_ + (m + 1) * D + 256 * j + 4 * F.lane));
                    xa[j] = (f32x4){bf_lo(w0.x), bf_hi(w0.x), bf_lo(w0.y), bf_hi(w0.y)}; xb[j] = (f32x4){bf_lo(w1.x), bf_hi(w1.x), bf_lo(w1.y), bf_hi(w1.y)}; }
                else { xa[j] = __builtin_nontemporal_load((const f32x4*)((const float*)xin_ + m * D + 256 * j + 4 * F.lane)); xb[j] = __builtin_nontemporal_load((const f32x4*)((const float*)xin_ + (m + 1) * D + 256 * j + 4 * F.lane)); }
                if (HAS_Y) { ya[j] = __builtin_nontemporal_load((const v2u*)(Y + m * D + 256 * j + 4 * F.lane)); yb[j] = __builtin_nontemporal_load((const v2u*)(Y + (m + 1) * D + 256 * j + 4 * F.lane)); } }
#define NORM_ROW(xv, yw, mm) do { \
            if (HAS_Y) { f32x4 yv[4]; float s = 0.f; \
                _Pragma("unroll") for (int j = 0; j < 4; ++j) { const v2u w = yw[j]; yv[j] = (f32x4){bf_lo(w.x), bf_hi(w.x), bf_lo(w.y), bf_hi(w.y)}; \
                    s += (yv[j].x * yv[j].x + yv[j].y * yv[j].y) + (yv[j].z * yv[j].z + yv[j].w * yv[j].w); } \
                const float rstd = 1.0f / sqrtf(wave_sum(s) * (1.0f / D) + EPS); \
                _Pragma("unroll") for (int j = 0; j < 4; ++j) { xv[j] = xv[j] + A1[j] * (yv[j] * rstd); \
                    if (XOUT_BF) { v2u w; w.x = pk2(xv[j].x, xv[j].y); w.y = pk2(xv[j].z, xv[j].w); __builtin_nontemporal_store(w, (v2u*)((bf16*)xout_ + (mm) * D + 256 * j + 4 * F.lane)); } \
                    else __builtin_nontemporal_store(xv[j], (f32x4*)((float*)xout_ + (mm) * D + 256 * j + 4 * F.lane)); } } \
            if (HAS_H || HAS_KV) { float s = 0.f; \
                _Pragma("unroll") for (int j = 0; j < 4; ++j) s += (xv[j].x * xv[j].x + xv[j].y * xv[j].y) + (xv[j].z * xv[j].z + xv[j].w * xv[j].w); \
                const float rstd = 1.0f / sqrtf(wave_sum(s) * (1.0f / D) + EPS); \
                _Pragma("unroll") for (int j = 0; j < 4; ++j) { const f32x4 xn = xv[j] * rstd; \
                    if (HAS_H) { const f32x4 h = xn * A2[j] + A3[j]; v2u w; w.x = pk2(h.x, h.y); w.y = pk2(h.z, h.w); *(v2u*)(H + (mm) * D + 256 * j + 4 * F.lane) = w; } \
                    if (HAS_KV) { const f32x4 h = xn * K2[j] + K3[j]; v2u w; w.x = pk2(h.x, h.y); w.y = pk2(h.z, h.w); *(v2u*)(HKV + (mm) * D + 256 * j + 4 * F.lane) = w; } } } } while (0)
            NORM_ROW(xa, ya, m);
            NORM_ROW(xb, yb, m + 1);
#undef NORM_ROW
        }
    }
}

__device__ __forceinline__ void cmp2_phase(const Frame& F, const float* PART, const float* cb1, const float* w2, const float* b2, bf16* KCV) {
    LAS float* w2l = (LAS float*)(F.lds + RING_OFF);
    LAS float* hl = (LAS float*)(F.lds + RING_OFF + 65536) + F.wave * 256;
    const int grp = F.vcu / GRP_WGS, lc = F.vcu % GRP_WGS, half = GRP_WGS / 2, j = lc / half, vj = lc % half;
    PART += (size_t)grp * (8u << 20) / 4;
    if (j < 2) {
        for (int i = F.tid; i < 256 * 64 / 4; i += NWAVES * 64) *(LAS f32x4*)(w2l + 4 * i) = *(const f32x4*)(w2 + (size_t)j * 256 * 64 + 4 * i);
    }
    __syncthreads();
    if (j < 2) {
        for (int rl = vj * NWAVES + F.wave; rl < 1024; rl += half * NWAVES) { const int r = grp * 1024 + rl;
            const float* p0 = PART + ((size_t)(j * 2 + 0) * 1024 + rl) * 256; const float* p1 = PART + ((size_t)(j * 2 + 1) * 1024 + rl) * 256;
            const f32x4 a = *(const f32x4*)(p0 + 4 * F.lane), b = *(const f32x4*)(p1 + 4 * F.lane), c = *(const f32x4*)(cb1 + j * 256 + 4 * F.lane);
            f32x4 h = a + b + c; h.x = pg8::gelu_tanh(h.x); h.y = pg8::gelu_tanh(h.y); h.z = pg8::gelu_tanh(h.z); h.w = pg8::gelu_tanh(h.w);
            *(LAS f32x4*)(hl + 4 * F.lane) = h;
            LDS_WAIT();
            float s0 = b2[j * 64 + F.lane], s1 = 0.f, s2 = 0.f, s3 = 0.f;
#pragma unroll 8
            for (int hh = 0; hh < 256; hh += 4) { const f32x4 h4 = *(const LAS f32x4*)(hl + hh);
                s0 += h4.x * w2l[hh * 64 + F.lane]; s1 += h4.y * w2l[(hh + 1) * 64 + F.lane]; s2 += h4.z * w2l[(hh + 2) * 64 + F.lane]; s3 += h4.w * w2l[(hh + 3) * 64 + F.lane]; }
            float s = (s0 + s1) + (s2 + s3);
            if ((r & 127) == 127) s = 0.f;
            KCV[((size_t)j * 8192 + r) * 64 + F.lane] = (bf16)f2bf(s);
            LDS_WAIT();
        }
    }
    __syncthreads();
}

namespace nsa {
using bf16x8 = __attribute__((ext_vector_type(8))) short;
using s16x4 = __attribute__((ext_vector_type(4))) short;
using f32x16 = __attribute__((ext_vector_type(16))) float;
using u32x4 = __attribute__((ext_vector_type(4))) unsigned;
typedef __attribute__((address_space(3))) const char* lds_cptr;
typedef __attribute__((address_space(3))) char* lds_ptr;
constexpr int NSLOT = 3, SLOTB = 8192;
constexpr int LDS_K = 0, LDS_V = NSLOT * SLOTB, LDS_WS = 2 * NSLOT * SLOTB  , LDS_OST = LDS_WS + 8 * 512  ,
              LDS_PI = LDS_OST + 8 * 4096  , LDS_IMP = LDS_PI + 32768  , LDS_SELM = LDS_IMP + 8192  , LDS_END = LDS_SELM + 256;
static_assert(LDS_END <= 131072, "attention LDS map");
constexpr int THR = 8;
__device__ __forceinline__ int crow(int r, int hi) { return (r & 3) + 8 * (r >> 2) + 4 * hi; }
#define NSA_SBAR() __builtin_amdgcn_sched_barrier(0)
__device__ __forceinline__ void glds16(const void* gsrc, unsigned lds_dst) { unsigned keep;
    asm volatile("s_mov_b32 %0, m0\n\ts_mov_b32 m0, %2\n\ts_nop 0\n\tglobal_load_lds_dwordx4 %1, off\n\ts_mov_b32 m0, %0" : "=&s"(keep) : "v"(gsrc), "s"(lds_dst) : "memory"); }
typedef float f32x2_t __attribute__((ext_vector_type(2))); typedef __bf16 bf16x2_t __attribute__((ext_vector_type(2)));
__device__ __forceinline__ unsigned cvtpk_s(float lo, float hi) { f32x2_t v = {lo, hi}; bf16x2_t b = __builtin_convertvector(v, bf16x2_t); return __builtin_bit_cast(unsigned, b); }
#define NSA_WAIT_BAR(N) asm volatile("s_waitcnt vmcnt(" #N ") lgkmcnt(0)\n\ts_barrier" ::: "memory")

__device__ __forceinline__ void qkt(f32x16& p0, f32x16& p1, lds_cptr Kslot, const bf16x8* qr, const f32x16& cinit, int r32, int hi) {
    lds_cptr kb = Kslot + hi * 1024 + r32 * 16;
#pragma unroll
    for (int d0 = 0; d0 < 4; ++d0) {
        const bf16x8 b0 = *(const __attribute__((address_space(3))) bf16x8*)(kb + d0 * 2048);
        const bf16x8 b1 = *(const __attribute__((address_space(3))) bf16x8*)(kb + d0 * 2048 + 512);
        if (d0 == 0) { p0 = __builtin_amdgcn_mfma_f32_32x32x16_bf16(b0, qr[0], cinit, 0, 0, 0); p1 = __builtin_amdgcn_mfma_f32_32x32x16_bf16(b1, qr[0], cinit, 0, 0, 0); }
        else { p0 = __builtin_amdgcn_mfma_f32_32x32x16_bf16(b0, qr[d0], p0, 0, 0, 0); p1 = __builtin_amdgcn_mfma_f32_32x32x16_bf16(b1, qr[d0], p1, 0, 0, 0); } }
}
__device__ __forceinline__ float rowmax(const f32x16& p0, const f32x16& p1) {
    float a = fmaxf(fmaxf(p0[0], p0[1]), p1[0]), b = fmaxf(fmaxf(p0[2], p0[3]), p1[1]); a = fmaxf(fmaxf(a, p1[2]), p1[3]);
#pragma unroll
    for (int r = 4; r < 16; r += 4) { a = fmaxf(fmaxf(a, p0[r]), p0[r + 1]); b = fmaxf(fmaxf(b, p0[r + 2]), p0[r + 3]); a = fmaxf(fmaxf(a, p1[r]), p1[r + 1]); b = fmaxf(fmaxf(b, p1[r + 2]), p1[r + 3]); }
    const float m = fmaxf(a, b);
    auto rr = __builtin_amdgcn_permlane32_swap(__float_as_uint(m), __float_as_uint(m), false, false);
    return fmaxf(__uint_as_float(rr[0]), __uint_as_float(rr[1]));
}
__device__ __forceinline__ float xhalf_sum(float v) { auto rr = __builtin_amdgcn_permlane32_swap(__float_as_uint(v), __float_as_uint(v), false, false); return __uint_as_float(rr[0]) + __uint_as_float(rr[1]); }
__device__ __forceinline__ float xhalf_other(float v, int hi) { auto rr = __builtin_amdgcn_permlane32_swap(__float_as_uint(v), __float_as_uint(v), false, false); return hi ? __uint_as_float(rr[0]) : __uint_as_float(rr[1]); }
__device__ __forceinline__ void pv(f32x16* o, int vb, bf16x8 pa0, bf16x8 pa1, bf16x8 pa2, bf16x8 pa3) {
#pragma unroll
    for (int d0 = 0; d0 < 2; ++d0) { s16x4 lo[4], hi[4];
#pragma unroll
        for (int ks = 0; ks < 4; ++ks) {
            asm volatile("ds_read_b64_tr_b16 %0,%1 offset:%c2" : "=&v"(lo[ks]) : "v"(vb), "i"(d0 * 4096 + ks * 1024) : "memory");
            asm volatile("ds_read_b64_tr_b16 %0,%1 offset:%c2" : "=&v"(hi[ks]) : "v"(vb), "i"(d0 * 4096 + ks * 1024 + 512) : "memory"); }
        asm volatile("s_waitcnt lgkmcnt(0)" ::: "memory"); NSA_SBAR();
#define NSA_PK(k) (bf16x8){lo[k][0], lo[k][1], lo[k][2], lo[k][3], hi[k][0], hi[k][1], hi[k][2], hi[k][3]}
        o[d0] = __builtin_amdgcn_mfma_f32_32x32x16_bf16(pa0, NSA_PK(0), o[d0], 0, 0, 0);
        o[d0] = __builtin_amdgcn_mfma_f32_32x32x16_bf16(pa1, NSA_PK(1), o[d0], 0, 0, 0);
        o[d0] = __builtin_amdgcn_mfma_f32_32x32x16_bf16(pa2, NSA_PK(2), o[d0], 0, 0, 0);
        o[d0] = __builtin_amdgcn_mfma_f32_32x32x16_bf16(pa3, NSA_PK(3), o[d0], 0, 0, 0);
#undef NSA_PK
    }
}
__device__ __forceinline__ void mask_range(f32x16& p, int kb, int lo, int hi_) {
#pragma unroll
    for (int r = 0; r < 16; ++r) { const int kk = kb + (r & 3) + 8 * (r >> 2); if (kk < lo || kk > hi_) p[r] = -INFINITY; }
}
#define NSA_PACK(P0, P1) do { pw0 = (u32x4){cvtpk_s(P0[0], P0[1]), cvtpk_s(P0[2], P0[3]), cvtpk_s(P0[4], P0[5]), cvtpk_s(P0[6], P0[7])}; \
    pw1 = (u32x4){cvtpk_s(P0[8], P0[9]), cvtpk_s(P0[10], P0[11]), cvtpk_s(P0[12], P0[13]), cvtpk_s(P0[14], P0[15])}; \
    pw2 = (u32x4){cvtpk_s(P1[0], P1[1]), cvtpk_s(P1[2], P1[3]), cvtpk_s(P1[4], P1[5]), cvtpk_s(P1[6], P1[7])}; \
    pw3 = (u32x4){cvtpk_s(P1[8], P1[9]), cvtpk_s(P1[10], P1[11]), cvtpk_s(P1[12], P1[13]), cvtpk_s(P1[14], P1[15])}; } while (0)
#define NSA_PAF(k) __builtin_bit_cast(bf16x8, pw##k)

struct Tensors { const bf16* Q; const float* GATE; const bf16* KCV; const bf16* KV; bf16* O; };

__device__ __forceinline__ void stream_dma(const bf16* ksrc, const bf16* vsrc, unsigned kdst, unsigned vdst, int n, int NT1, int qt, int slot) {
    const int t_ = (n < NT1) ? n : qt - (n - NT1); const size_t off = (size_t)t_ * 64 * NKV + ((n < NT1) ? 0 : 512);
    glds16(ksrc + off, (unsigned)__builtin_amdgcn_readfirstlane(kdst + slot)); glds16(vsrc + off, (unsigned)__builtin_amdgcn_readfirstlane(vdst + slot));
}
__device__ __forceinline__ void stream_prologue(unsigned lds0, const bf16* Ksel, const bf16* Vsel, int qt, int wid, int lane) {
    const bf16* ksrc = Ksel + (size_t)lane * NKV + wid * 8;
    const bf16* vsrc = Vsel + (size_t)(16 * (wid & 3) + (lane >> 2)) * NKV + (wid >> 2) * 32 + (lane & 3) * 8;
    const unsigned kdst = lds0 + LDS_K + wid * 1024, vdst = lds0 + LDS_V + wid * 1024;
    stream_dma(ksrc, vsrc, kdst, vdst, 0, qt + 1, qt, 0); stream_dma(ksrc, vsrc, kdst, vdst, 1, qt + 1, qt, SLOTB);
}
__device__ __forceinline__ void flash_stream(lds_ptr shm, unsigned lds0, const bf16* Ksel, const bf16* Vsel, int qt, const bf16x8* qr, unsigned selmask, int tq, float g_sel, float g_win,
                                             f32x16* otot, int wid, int lane, int r32, int hi) {
    const bf16* ksrc = Ksel + (size_t)lane * NKV + wid * 8;
    const bf16* vsrc = Vsel + (size_t)(16 * (wid & 3) + (lane >> 2)) * NKV + (wid >> 2) * 32 + (lane & 3) * 8;
    const unsigned kdst = lds0 + LDS_K + wid * 1024, vdst = lds0 + LDS_V + wid * 1024;
    __attribute__((address_space(3))) float* wsf = (__attribute__((address_space(3))) float*)(shm + LDS_WS) + wid * 128;
    const int vb0 = (int)(lds0 + LDS_V) + ((lane >> 4) & 1) * 32 + (lane & 3) * 8 + (4 * hi + ((lane & 15) >> 2)) * 64;
    const int NT1 = qt + 1, NT2 = (qt < 8 ? qt + 1 : 9), NTS = NT1 + NT2;
    float mhat = 0.f, l_reg = 0.f; f32x16 o[2]; o[0] = f32x16{}; o[1] = f32x16{};
#define NSA_FINALIZE(gate_) do { const float l_ = xhalf_sum(l_reg); asm volatile("s_waitcnt lgkmcnt(0)" ::: "memory"); if (hi == 0) wsf[r32] = (gate_) / l_; asm volatile("s_waitcnt lgkmcnt(0)" ::: "memory"); \
        _Pragma("unroll") for (int r = 0; r < 16; ++r) { const float w = wsf[crow(r, hi)]; otot[0][r] += o[0][r] * w; otot[1][r] += o[1][r] * w; } } while (0)
    int sl_cur = 0;
    for (int n = 0; n < NTS; ++n) {
        if (n + 1 < NTS) NSA_WAIT_BAR(2); else NSA_WAIT_BAR(0);
        { const int sl2 = (sl_cur >= SLOTB) ? sl_cur - SLOTB : sl_cur + 2 * SLOTB; if (n + 2 < NTS) stream_dma(ksrc, vsrc, kdst, vdst, n + 2, NT1, qt, sl2); }
        if (n == NT1) { NSA_FINALIZE(g_sel); mhat = 0.f; l_reg = 0.f; o[0] = f32x16{}; o[1] = f32x16{}; }
        const bool win = n >= NT1, first = (n == 0) || (n == NT1);
        const int t = win ? qt - (n - NT1) : n;
        float cval = -mhat;
        if (!win && !((selmask >> t) & 1u)) cval = -INFINITY;
        f32x16 cin;
#pragma unroll
        for (int r = 0; r < 16; ++r) cin[r] = cval;
        f32x16 p0, p1;
        qkt(p0, p1, (lds_cptr)(shm + LDS_K + sl_cur), qr, cin, r32, hi);
        if (t == qt) { mask_range(p0, 4 * hi, 0, tq); mask_range(p1, 32 + 4 * hi, 0, tq); }
        if (win && t == qt - 8) { mask_range(p0, 4 * hi, tq + 1, 63); mask_range(p1, 32 + 4 * hi, tq + 1, 63); }
        const float rm = rowmax(p0, p1);
        bool resc = false;
        if (first || __any(rm > (float)THR)) {
            const float dl = first ? fmaxf(rm, -1e30f) : fmaxf(rm, 0.f); mhat += dl;
#pragma unroll
            for (int r = 0; r < 16; ++r) { p0[r] -= dl; p1[r] -= dl; }
            const float f = __builtin_amdgcn_exp2f(-dl); l_reg *= f; if (hi == 0) wsf[r32] = f; resc = !first;
        }
        float sacc = 0.f;
#pragma unroll
        for (int r = 0; r < 16; ++r) { p0[r] = __builtin_amdgcn_exp2f(p0[r]); p1[r] = __builtin_amdgcn_exp2f(p1[r]); sacc += p0[r] + p1[r]; }
        l_reg += sacc;
        u32x4 pw0, pw1, pw2, pw3; NSA_PACK(p0, p1);
        if (resc) { asm volatile("s_waitcnt lgkmcnt(0)" ::: "memory");
#pragma unroll
            for (int d = 0; d < 2; ++d)
#pragma unroll
                for (int r = 0; r < 16; ++r) o[d][r] *= wsf[crow(r, hi)]; }
        pv(o, vb0 + sl_cur, NSA_PAF(0), NSA_PAF(1), NSA_PAF(2), NSA_PAF(3));
        sl_cur = (sl_cur == (NSLOT - 1) * SLOTB) ? 0 : sl_cur + SLOTB;
    }
    NSA_FINALIZE(g_win);
#undef NSA_FINALIZE
    asm volatile("s_waitcnt lgkmcnt(0)\n\ts_barrier" ::: "memory");
}

__device__ __forceinline__ void attn_unit(int b, int g, int qt, const Tensors& T_, lds_ptr shm, int tid_) {
    int tid = tid_; asm volatile("" : "+v"(tid));
    const int lane = tid & 63, r32 = lane & 31, hi = lane >> 5; const int wid = __builtin_amdgcn_readfirstlane(tid >> 6);
    const int hh = wid & 3, ts = wid >> 2, tq = ts * 32 + r32;
    const size_t m0 = (size_t)b * T + (size_t)qt * 64;
    const unsigned lds0 = (unsigned)(uintptr_t)shm;
    __attribute__((address_space(3))) float* wsf = (__attribute__((address_space(3))) float*)(shm + LDS_WS) + wid * 128;
    {
        const bf16* Kc = T_.KCV + (size_t)(b * 4 + g) * 128 * 64; const bf16* Vc = Kc + (size_t)8192 * 64;
        const bf16* ksrc = Kc + (size_t)lane * 64 + wid * 8;
        const bf16* vsrc = Vc + (size_t)(16 * (wid & 3) + (lane >> 2)) * 64 + (wid >> 2) * 32 + (lane & 3) * 8;
        const unsigned kdst = lds0 + LDS_K + wid * 1024, vdst = lds0 + LDS_V + wid * 1024;
        glds16(ksrc, (unsigned)__builtin_amdgcn_readfirstlane(kdst)); glds16(vsrc, (unsigned)__builtin_amdgcn_readfirstlane(vdst));
        glds16(ksrc + 64 * 64, (unsigned)__builtin_amdgcn_readfirstlane(kdst + SLOTB)); glds16(vsrc + 64 * 64, (unsigned)__builtin_amdgcn_readfirstlane(vdst + SLOTB));
    }
    bf16x8 qr[4];
    {
        const bf16* Qw = T_.Q + (m0 + ts * 32) * 1024 + (g * 4 + hh) * 64;
#pragma unroll
        for (int d0 = 0; d0 < 4; ++d0) qr[d0] = *reinterpret_cast<const bf16x8*>(&Qw[(size_t)r32 * 1024 + d0 * 16 + hi * 8]);
    }
    const float* gp = T_.GATE + (m0 + tq) * 48 + (g * 4 + hh) * 3;
    const float g_cmp = gp[0], g_sel = gp[1], g_win = gp[2];
    f32x16 otot[2];
    NSA_WAIT_BAR(0);
    {
        const int t = qt * 64 + tq;
        const int ncv = (t >= 31) ? ((t - 31) >> 4) + 1 : 0;
        f32x16 zero = f32x16{}; f32x16 pA0, pA1, pB0, pB1;
        qkt(pA0, pA1, (lds_cptr)(shm + LDS_K), qr, zero, r32, hi);
        qkt(pB0, pB1, (lds_cptr)(shm + LDS_K + SLOTB), qr, zero, r32, hi);
        mask_range(pA0, 4 * hi, 0, ncv - 1); mask_range(pA1, 32 + 4 * hi, 0, ncv - 1); mask_range(pB0, 64 + 4 * hi, 0, ncv - 1); mask_range(pB1, 96 + 4 * hi, 0, ncv - 1);
        const float m = fmaxf(fmaxf(rowmax(pA0, pA1), rowmax(pB0, pB1)), -1e30f);
        float sacc = 0.f;
#pragma unroll
        for (int r = 0; r < 16; ++r) { pA0[r] = __builtin_amdgcn_exp2f(pA0[r] - m); pA1[r] = __builtin_amdgcn_exp2f(pA1[r] - m); pB0[r] = __builtin_amdgcn_exp2f(pB0[r] - m); pB1[r] = __builtin_amdgcn_exp2f(pB1[r] - m);
            sacc += (pA0[r] + pA1[r]) + (pB0[r] + pB1[r]); }
        const float l = xhalf_sum(sacc); const float inv = l > 0.f ? 1.0f / l : 0.f;
#pragma unroll
        for (int r = 0; r < 16; ++r) { pA0[r] *= inv; pA1[r] *= inv; pB0[r] *= inv; pB1[r] *= inv; }
        {
            __attribute__((address_space(3))) float* PI = (__attribute__((address_space(3))) float*)(shm + LDS_PI) + (hh * 64 + tq) * 32;
            float prev_oth = 0.f;
#define NSA_GRP(P, blk) _Pragma("unroll") for (int q4 = 0; q4 < 4; ++q4) { const int k = (blk) * 4 + q4; const float Gs = (P[4 * q4] + P[4 * q4 + 1]) + (P[4 * q4 + 2] + P[4 * q4 + 3]); \
                const float oth = xhalf_other(P[4 * q4 + 3], hi); PI[2 * k + hi] = Gs + (hi ? oth : prev_oth); prev_oth = oth; }
            NSA_GRP(pA0, 0) NSA_GRP(pA1, 1) NSA_GRP(pB0, 2) NSA_GRP(pB1, 3)
#undef NSA_GRP
        }
        otot[0] = f32x16{}; otot[1] = f32x16{};
        const int vb0 = (int)(lds0 + LDS_V) + ((lane >> 4) & 1) * 32 + (lane & 3) * 8 + (4 * hi + ((lane & 15) >> 2)) * 64;
        u32x4 pw0, pw1, pw2, pw3;
        NSA_PACK(pA0, pA1); pv(otot, vb0, NSA_PAF(0), NSA_PAF(1), NSA_PAF(2), NSA_PAF(3));
        NSA_PACK(pB0, pB1); pv(otot, vb0 + SLOTB, NSA_PAF(0), NSA_PAF(1), NSA_PAF(2), NSA_PAF(3));
        if (hi == 0) wsf[r32] = g_cmp;
        asm volatile("s_waitcnt lgkmcnt(0)" ::: "memory");
#pragma unroll
        for (int r = 0; r < 16; ++r) { const float w = wsf[crow(r, hi)]; otot[0][r] *= w; otot[1][r] *= w; }
    }
    asm volatile("s_waitcnt lgkmcnt(0)\n\ts_barrier" ::: "memory");
    const bf16* KVb = T_.KV + (size_t)b * T * NKV + g * 64;
    stream_prologue(lds0, KVb + 2 * 256, KVb + 3 * 256, qt, wid, lane);
    {
        const __attribute__((address_space(3))) float* PI = (const __attribute__((address_space(3))) float*)(shm + LDS_PI);
        __attribute__((address_space(3))) unsigned* IMP = (__attribute__((address_space(3))) unsigned*)(shm + LDS_IMP);
        __attribute__((address_space(3))) unsigned* SELM = (__attribute__((address_space(3))) unsigned*)(shm + LDS_SELM);
#pragma unroll
        for (int it = 0; it < 4; ++it) { const int idx = tid + it * 512, tok = idx >> 5, j = idx & 31;
            float imp = ((PI[(0 * 64 + tok) * 32 + j] + PI[(1 * 64 + tok) * 32 + j]) + PI[(2 * 64 + tok) * 32 + j]) + PI[(3 * 64 + tok) * 32 + j];
            unsigned key = (__float_as_uint(imp) & ~31u) | (unsigned)(31 - j);
            if (j > qt) key = (unsigned)(31 - j);
            if (j == 0 || j == qt || j == qt - 1) key = (__float_as_uint(1e4f) & ~31u) | (unsigned)(31 - j);
            IMP[idx] = key; }
        asm volatile("s_waitcnt lgkmcnt(0)\n\ts_barrier" ::: "memory");
#pragma unroll
        for (int it = 0; it < 4; ++it) { const int idx = tid + it * 512, tok = idx >> 5, j = idx & 31;
            const unsigned mine = IMP[idx]; int rank = 0;
#pragma unroll
            for (int i4 = 0; i4 < 8; ++i4) { const u32x4 o4 = *(const __attribute__((address_space(3))) u32x4*)(IMP + tok * 32 + i4 * 4);
                rank += (o4.x > mine) ? 1 : 0; rank += (o4.y > mine) ? 1 : 0; rank += (o4.z > mine) ? 1 : 0; rank += (o4.w > mine) ? 1 : 0; }
            const unsigned long long bal = __ballot(rank < 16 && j <= qt);
            if (lane == 0) SELM[tok] = (unsigned)bal;
            if (lane == 32) SELM[tok] = (unsigned)(bal >> 32); }
        asm volatile("s_waitcnt lgkmcnt(0)\n\ts_barrier" ::: "memory");
    }
    const unsigned selmask = ((const __attribute__((address_space(3))) unsigned*)(shm + LDS_SELM))[tq];
    flash_stream(shm, lds0, KVb + 2 * 256, KVb + 3 * 256, qt, qr, selmask, tq, g_sel, g_win, otot, wid, lane, r32, hi);
    {
        bf16* Ow = T_.O + (m0 + ts * 32) * 1024 + (g * 4 + hh) * 64;
        __attribute__((address_space(3))) bf16* stg = (__attribute__((address_space(3))) bf16*)(shm + LDS_OST) + wid * 2048;
#pragma unroll
        for (int r = 0; r < 16; ++r) { const int orow = crow(r, hi);
#pragma unroll
            for (int d0 = 0; d0 < 2; ++d0) stg[orow * 64 + d0 * 32 + r32] = (bf16)f2bf(otot[d0][r]); }
        asm volatile("s_waitcnt lgkmcnt(0)" ::: "memory");
#pragma unroll
        for (int i = 0; i < 4; ++i) { const int row = i * 8 + (lane >> 3), ch = lane & 7; const u32x4 v = *(const __attribute__((address_space(3))) u32x4*)(stg + row * 64 + ch * 8); *(u32x4*)(Ow + (size_t)row * 1024 + ch * 8) = v; }
    }
    asm volatile("s_waitcnt lgkmcnt(0)\n\ts_barrier" ::: "memory");
}

__device__ __forceinline__ void attn_phase(const Frame& F, const Tensors& T_) {
    lds_ptr shm = (lds_ptr)(F.lds + RING_OFF);
    for (int v = F.vcu; v < BATCH * 4 * 4; v += F.G) {
        const int bg = v >> 2, s = v & 3;
#pragma unroll 1
        for (int i = 0; i < 8; ++i) { const int qt = (i & 1) ? (8 * (i >> 1) + 7 - s) : (8 * (i >> 1) + s);
            attn_unit(bg >> 2, bg & 3, qt, T_, shm, F.tid); }
    }
}
#undef NSA_SBAR
#undef NSA_WAIT_BAR
#undef NSA_PACK
#undef NSA_PAF
}
namespace sgu {
using nsa::bf16x8; using nsa::s16x4; using nsa::f32x16; using nsa::u32x4;
constexpr int LDS_VT = 0  , LDS_ST = 32768  , LDS_OST = 34816  , LDS_END = LDS_OST + 8 * 4096;
__device__ __forceinline__ void sgu_phase(const Frame& F, const bf16* U, const bf16* V, const float* lng, const float* lnb, const bf16* WS16, const float* bs, bf16* GT) {
    typedef __attribute__((address_space(3))) char* lptr;
    lptr shm = (lptr)(F.lds + RING_OFF);
    __attribute__((address_space(3))) float* st = (__attribute__((address_space(3))) float*)(shm + LDS_ST);
    const unsigned lds0 = (unsigned)(uintptr_t)shm;
    for (int ch = F.vcu; ch < M / 128; ch += F.G) {
        int tid = F.tid; asm volatile("" : "+v"(tid));
        const int lane = tid & 63, r32 = lane & 31, hi = lane >> 5; const int wid = __builtin_amdgcn_readfirstlane(tid >> 6);
        const size_t m0 = (size_t)ch * 128;
#pragma unroll 1
        for (int rb = 0; rb < 16; rb += 4) {
            v4u ra[4], rc[4];
#pragma unroll
            for (int r = 0; r < 4; ++r) { const v4u* vp = (const v4u*)(V + (m0 + wid * 16 + rb + r) * D + lane * 16); ra[r] = vp[0]; rc[r] = vp[1]; }
#pragma unroll
            for (int r = 0; r < 4; ++r) { const int row = wid * 16 + rb + r; const v4u a = ra[r], b = rc[r];
                float xv[16] = {bf_lo(a.x), bf_hi(a.x), bf_lo(a.y), bf_hi(a.y), bf_lo(a.z), bf_hi(a.z), bf_lo(a.w), bf_hi(a.w), bf_lo(b.x), bf_hi(b.x), bf_lo(b.y), bf_hi(b.y), bf_lo(b.z), bf_hi(b.z), bf_lo(b.w), bf_hi(b.w)};
                float s = 0.f, q = 0.f;
#pragma unroll
                for (int e = 0; e < 16; ++e) s += xv[e];
                const float mean = wave_sum(s) * (1.0f / D);
#pragma unroll
                for (int e = 0; e < 16; ++e) { const float d = xv[e] - mean; q += d * d; }
                const float rstd = 1.0f / sqrtf(wave_sum(q) * (1.0f / D) + EPS);
                if (lane == 0) { st[row * 2] = mean; st[row * 2 + 1] = rstd; } }
        }
        asm volatile("s_waitcnt lgkmcnt(0)\n\ts_barrier" ::: "memory");
        const int srow = tid >> 2, c4 = tid & 3;
        const float mean_s = st[srow * 2], rstd_s = st[srow * 2 + 1];
        const int tb = wid >> 1, db0 = (wid & 1) * 2;
        const int nks = 2 * tb + 2;
        const int vb0 = (int)(lds0 + LDS_VT) + ((lane >> 4) & 1) * 32 + (lane & 3) * 8 + (4 * hi + ((lane & 15) >> 2)) * 64;
        v4u vnext[4];
#pragma unroll
        for (int i = 0; i < 4; ++i) vnext[i] = *(const v4u*)(V + (m0 + srow) * D + i * 32 + c4 * 8);
#pragma unroll 1
        for (int g = 0; g < 8; ++g) {
            v4u vcur[4];
#pragma unroll
            for (int i = 0; i < 4; ++i) vcur[i] = vnext[i];
            if (g + 1 < 8) {
#pragma unroll
                for (int i = 0; i < 4; ++i) vnext[i] = *(const v4u*)(V + (m0 + srow) * D + (g + 1) * 128 + i * 32 + c4 * 8); }
            v4u uvv[4];
#pragma unroll
            for (int i = 0; i < 4; ++i) uvv[i] = *(const v4u*)(U + (m0 + tb * 32 + i * 8 + (lane >> 3)) * D + g * 128 + db0 * 32 + (lane & 7) * 8);
            const bf16* wrow = WS16 + ((size_t)g * 128 + tb * 32 + r32) * 128 + 4 * hi;
            v2u af[8][2];
#pragma unroll
            for (int ks = 0; ks < 8; ++ks) if (ks < nks) { af[ks][0] = *(const v2u*)(wrow + ks * 16); af[ks][1] = *(const v2u*)(wrow + ks * 16 + 8); }
#pragma unroll
            for (int i = 0; i < 4; ++i) { const int c = g * 128 + i * 32 + c4 * 8;
                const v4u w = vcur[i];
                const f32x4 g0 = *(const f32x4*)(lng + c), g1 = *(const f32x4*)(lng + c + 4), b0 = *(const f32x4*)(lnb + c), b1 = *(const f32x4*)(lnb + c + 4);
                float x[8] = {bf_lo(w.x), bf_hi(w.x), bf_lo(w.y), bf_hi(w.y), bf_lo(w.z), bf_hi(w.z), bf_lo(w.w), bf_hi(w.w)};
                const float gg[8] = {g0.x, g0.y, g0.z, g0.w, g1.x, g1.y, g1.z, g1.w}, bb[8] = {b0.x, b0.y, b0.z, b0.w, b1.x, b1.y, b1.z, b1.w};
#pragma unroll
                for (int e = 0; e < 8; ++e) x[e] = (x[e] - mean_s) * rstd_s * gg[e] + bb[e];
                v4u o; o.x = pk2(x[0], x[1]); o.y = pk2(x[2], x[3]); o.z = pk2(x[4], x[5]); o.w = pk2(x[6], x[7]);
                *(__attribute__((address_space(3))) v4u*)(shm + LDS_VT + (i * 8 + (srow >> 4)) * 1024 + (srow & 15) * 64 + c4 * 16) = o; }
            asm volatile("s_waitcnt lgkmcnt(0)\n\ts_barrier" ::: "memory");
            f32x16 o[2]; o[0] = f32x16{}; o[1] = f32x16{};
#pragma unroll
            for (int ks = 0; ks < 8; ++ks) if (ks < nks) {
                const bf16x8 a = __builtin_bit_cast(bf16x8, (v4u){af[ks][0].x, af[ks][0].y, af[ks][1].x, af[ks][1].y});
#pragma unroll
                for (int dd = 0; dd < 2; ++dd) { s16x4 lo, hi4; const int vb = vb0 + ((db0 + dd) * 8 + ks) * 1024;
                    asm volatile("ds_read_b64_tr_b16 %0,%1" : "=&v"(lo) : "v"(vb) : "memory");
                    asm volatile("ds_read_b64_tr_b16 %0,%1 offset:512" : "=&v"(hi4) : "v"(vb) : "memory");
                    asm volatile("s_waitcnt lgkmcnt(0)" ::: "memory");
                    const bf16x8 bfr = (bf16x8){lo[0], lo[1], lo[2], lo[3], hi4[0], hi4[1], hi4[2], hi4[3]};
                    o[dd] = __builtin_amdgcn_mfma_f32_32x32x16_bf16(a, bfr, o[dd], 0, 0, 0); } }
            __attribute__((address_space(3))) bf16* stg = (__attribute__((address_space(3))) bf16*)(shm + LDS_OST) + wid * 2048;
#pragma unroll
            for (int r = 0; r < 16; ++r) { const int orow = nsa::crow(r, hi); const float bias = bs[g * 128 + tb * 32 + orow];
#pragma unroll
                for (int dd = 0; dd < 2; ++dd) stg[orow * 64 + dd * 32 + r32] = (bf16)f2bf(o[dd][r] + bias); }
            asm volatile("s_waitcnt lgkmcnt(0)" ::: "memory");
#pragma unroll
            for (int i = 0; i < 4; ++i) { const int row = i * 8 + (lane >> 3), chn = lane & 7;
                const v4u mv = *(const __attribute__((address_space(3))) v4u*)(stg + row * 64 + chn * 8);
                const size_t gi = (m0 + tb * 32 + row) * D + g * 128 + db0 * 32 + chn * 8;
                const v4u uv = uvv[i];
                v4u ov; ov.x = pk2(bf_lo(mv.x) * bf_lo(uv.x), bf_hi(mv.x) * bf_hi(uv.x)); ov.y = pk2(bf_lo(mv.y) * bf_lo(uv.y), bf_hi(mv.y) * bf_hi(uv.y));
                ov.z = pk2(bf_lo(mv.z) * bf_lo(uv.z), bf_hi(mv.z) * bf_hi(uv.z)); ov.w = pk2(bf_lo(mv.w) * bf_lo(uv.w), bf_hi(mv.w) * bf_hi(uv.w));
                *(v4u*)(GT + gi) = ov; }
            asm volatile("s_waitcnt lgkmcnt(0)\n\ts_barrier" ::: "memory");
        }
    }
}
}
__global__ void __launch_bounds__(NWAVES * 64, 2) fwd(Args args) {
    extern __shared__ __attribute__((aligned(16))) unsigned char lds[];
    Frame F;
    F.lds = (LAS unsigned char*)lds;
    volatile LAS unsigned* MISC = (volatile LAS unsigned*)(F.lds + MISC_OFF);
    F.tid = threadIdx.x; F.lane = F.tid & 63; F.wave = __builtin_amdgcn_readfirstlane(F.tid >> 6);
    F.G = gridDim.x; { const int bx = blockIdx.x; F.vcu = (F.G % 8 == 0) ? (bx % 8) * (F.G / 8) + bx / 8 : bx; }
    for (int u = F.tid; u < (LDS_BYTES - LDSCTL_OFF) / 4; u += NWAVES * 64) ((LAS unsigned*)(F.lds + LDSCTL_OFF))[u] = 0u;
    __syncthreads();
#if !MK_MULTI
    XcdBarrier bar = xcd_barrier_post((unsigned*)(args.ws + WS_CTL) + CW_BAR, MISC + 8);
#define GRID_BAR() xcd_barrier(bar)
#define GRP_BAR() grp_barrier((unsigned*)(ws + WS_CTL) + CW_GRP + 64 * grp, (unsigned*)(ws + WS_CTL) + CW_BAR)
#else
#define GRID_BAR() do {} while (0)
#define GRP_BAR() do {} while (0)
#endif
    const int lo = args.ph_lo, hi = args.ph_hi;
    int ph = 0;
#define PH_BEGIN if (ph >= lo && ph < hi) { Frame Fp = F; asm volatile("" : "+v"(Fp.tid), "+v"(Fp.lane)); \
        kargs_t KA = (kargs_t)__builtin_amdgcn_kernarg_segment_ptr(); asm volatile("" : "+s"(KA)); \
        unsigned char* const ws = KA->ws; LAS unsigned char* const ring = Fp.lds + RING_OFF; const int grp = Fp.vcu / GRP_WGS, lc = Fp.vcu % GRP_WGS; const size_t R0 = (size_t)grp * GROWS; (void)ws; (void)ring; (void)lc; (void)R0;
#define PH_END   if (ph + 1 < hi) GRP_BAR(); } ++ph;
#define PH_END_GRID   if (ph + 1 < hi) GRID_BAR(); } ++ph;
#define P_MOD   ((float*)(ws + WS_MOD))
#define P_KVMOD (P_MOD + (size_t)4 * 16 * 6144)
#define P_CB1   ((float*)(ws + WS_CB1))
#define P_GATE  ((float*)(ws + WS_GATE))
#define P_KCV   ((bf16*)(ws + WS_KCV))
#define P_WB    ((bf16*)(ws + WS_W))
#define P_KV    ((bf16*)(ws + WS_KV))
#define P_XB    ((bf16*)(ws + WS_HB))
#define P_Y     ((bf16*)(ws + WS_Y))
#define P_HB    ((bf16*)KA->out + (size_t)grp * (4u << 20))
#define P_BIGW  ((bf16*)(ws + WS_BIG) + (size_t)grp * (8u << 20))
#define P_U     ((bf16*)(ws + WS_BIG) + (size_t)grp * (4u << 20))
#define P_V     (P_U + (4u << 20))
#define P_Q     P_U
#define P_O     P_V
#define P_HKV   P_O
#define P_NG(L, i) (KA->in[4] + ((L) * 4 + (i)) * 1024)

    PH_BEGIN p0_prologue(Fp, KA); PH_END_GRID
    PH_BEGIN norm_phase<false, true, false, false, false>(Fp, KA->in[0], nullptr, nullptr, nullptr, nullptr, P_NG(0, 0), P_MOD + 0, P_MOD + 1024, 6144, P_HB, nullptr, nullptr, nullptr, 0, nullptr); PH_END

#pragma unroll 1
    for (int L = 0; L < DEPTH; ++L) {
        if (L < 2) {
            PH_BEGIN {
                pg8::Gemm g = pg8::make_gemm(P_HB + R0 * D, P_WB + WO_AIN + (size_t)L * 2048 * 1024, GROWS, 2048, D); pg8::GroupOrder S; S.init(GROWS, 2048, GRP_WGS, lc);
                pg8::EpiBf16<2> E{P_U + R0 * D, D, nullptr, 1024, (size_t)(4u << 20), 1.f};
                pg8::gemm_phase<pg8::EpiBf16<2>, pg8::GroupOrder, true, true>(ring, g, S, E);
            } PH_END
            PH_BEGIN sgu::sgu_phase(Fp, P_U, P_V, KA->in[6] + L * 1024, KA->in[7] + L * 1024, P_WB + WO_WS + (size_t)L * 8 * 128 * 128, KA->in[9] + L * 8 * 128, P_HB); PH_END
            PH_BEGIN {
                pg8::Gemm g = pg8::make_gemm(P_HB + R0 * D, P_WB + WO_AOUT + (size_t)L * 1024 * 1024, GROWS, D, D); pg8::GroupOrder S; S.init(GROWS, D, GRP_WGS, lc);
                pg8::EpiBf16<0> E{P_Y + R0 * D, D, nullptr, 0, 0, 1.f};
                pg8::gemm_phase<pg8::EpiBf16<0>, pg8::GroupOrder, true, true>(ring, g, S, E);
            } PH_END
        } else {
            if (L == 2) {
                PH_BEGIN {
                    pg8::Gemm g = pg8::make_gemm(P_HKV + R0 * D, P_WB + WO_KV, GROWS, NKV, D); pg8::GroupOrder S; S.init(GROWS, NKV, GRP_WGS, lc);
                    pg8::EpiBf16<0> E{P_KV + R0 * NKV, NKV, nullptr, 0, 0, 1.f};
                    pg8::gemm_phase<pg8::EpiBf16<0>, pg8::GroupOrder, true, true>(ring, g, S, E);
                } PH_END
            }
            PH_BEGIN {
                {
                    pg8::Gemm g = pg8::make_gemm(P_HB + R0 * D, P_WB + WO_BIN + (size_t)(L - 2) * NQG * 1024, GROWS, NQG, D); pg8::GroupOrder S; S.init(GROWS, NQG, GRP_WGS, lc);
                    pg8::EpiQG E{P_Q + R0 * D, P_GATE + R0 * 48, 0.125f * 1.4426950408889634f};
                    pg8::gemm_phase<pg8::EpiQG, pg8::GroupOrder, true, true>(ring, g, S, E);
                }
                if (L == 2) {
#pragma unroll 1
                    for (int q = 0; q < 4; ++q) { const int j = q >> 1, kh = q & 1;
                        pg8::Gemm g; g.A = P_KV + (size_t)(2 * grp) * T * NKV + j * 256 + (size_t)kh * 16 * NKV; g.Bt = P_WB + WO_C1 + (size_t)j * 256 * 2048 + kh * 1024; g.M = 1024; g.N = 256; g.K = 1024; g.ldb = 2048;
                        g.a_rs = 16u * NKV * 2u; g.a_hstep = 64 * 2; g.a_kstep = (size_t)NKV * 2; g.a_t1 = (size_t)T * NKV * 2; g.a_t0 = 128 * 2; g.a_sh = 1; g.stagger_ticks = 0;
                        pg8::GroupOrder S; S.init(1024, 256, GRP_WGS, (lc + GRP_WGS - 16 - 4 * q) % GRP_WGS);
                        pg8::EpiF32 E{(float*)(ws + WS_Y + (size_t)grp * (8u << 20)) + (size_t)q * 1024 * 256, 256};
                        pg8::gemm_phase<pg8::EpiF32, pg8::GroupOrder, true, true>(ring, g, S, E);
                    }
                }
            } PH_END
            if (L == 2) {
                PH_BEGIN cmp2_phase(Fp, (const float*)P_Y, P_CB1, KA->in[18], KA->in[19], P_KCV); PH_END
            }
            PH_BEGIN { const nsa::Tensors AT{P_Q, P_GATE, P_KCV, P_KV, P_O}; nsa::attn_phase(Fp, AT); } PH_END
            PH_BEGIN {
                pg8::Gemm g = pg8::make_gemm(P_O + R0 * D, P_WB + WO_BOUT + (size_t)(L - 2) * 1024 * 1024, GROWS, D, D); pg8::GroupOrder S; S.init(GROWS, D, GRP_WGS, lc);
                pg8::EpiBf16<0> E{P_Y + R0 * D, D, nullptr, 0, 0, 1.f};
                pg8::gemm_phase<pg8::EpiBf16<0>, pg8::GroupOrder, true, true>(ring, g, S, E);
            } PH_END
        }
        PH_BEGIN { const float* modL = P_MOD + (size_t)L * 16 * 6144;
            if (L == 0) norm_phase<true, true, false, false, true>(Fp, KA->in[0], P_XB, P_Y, P_NG(L, 1), modL + 2 * 1024, P_NG(L, 2), modL + 3 * 1024, modL + 4 * 1024, 6144, P_HB, nullptr, nullptr, nullptr, 0, nullptr);
            else norm_phase<true, true, false, true, true>(Fp, P_XB, P_XB, P_Y, P_NG(L, 1), modL + 2 * 1024, P_NG(L, 2), modL + 3 * 1024, modL + 4 * 1024, 6144, P_HB, nullptr, nullptr, nullptr, 0, nullptr); } PH_END
#pragma unroll 1
        for (int hf = 0; hf < 2; ++hf) {
            PH_BEGIN {
                pg8::Gemm g = pg8::make_gemm(P_HB + (R0 + (size_t)hf * T) * D, P_WB + WO_FIN + (size_t)L * 4096 * 1024, T, FF, D); pg8::GroupOrder S; S.init(T, FF, GRP_WGS, lc);
                pg8::EpiBf16<3> E{P_BIGW, FF, nullptr, 0, 0, 1.f};
                pg8::gemm_phase<pg8::EpiBf16<3>, pg8::GroupOrder, true, true>(ring, g, S, E);
            } PH_END
            PH_BEGIN {
                pg8::Gemm g = pg8::make_gemm(P_BIGW, P_WB + WO_FOUT + (size_t)L * 1024 * 4096, T, D, FF); pg8::GroupOrder S; S.init(T, D, GRP_WGS, lc);
                pg8::EpiBf16<0> E{P_Y + (R0 + (size_t)hf * T) * D, D, nullptr, 0, 0, 1.f};
                pg8::gemm_phase<pg8::EpiBf16<0>, pg8::GroupOrder, true, true>(ring, g, S, E);
            } PH_END
        }
        PH_BEGIN {
            const float* modL = P_MOD + (size_t)L * 16 * 6144;
            const float* gy = P_NG(L, 3); const float* gate = modL + 5 * 1024;
            if (L == 3) norm_phase<true, false, false, true, false>(Fp, P_XB, KA->out, P_Y, gy, gate, nullptr, nullptr, nullptr, 6144, nullptr, nullptr, nullptr, nullptr, 0, nullptr);
            else { const float* modN = P_MOD + (size_t)(L + 1) * 16 * 6144; const float* gn = P_NG(L + 1, 0);
                if (L == 1) norm_phase<true, true, true, true, true>(Fp, P_XB, P_XB, P_Y, gy, gate, gn, modN + 0, modN + 1024, 6144, P_HB, KA->in[13], P_KVMOD + 0, P_KVMOD + 1024, 2048, P_HKV);
                else norm_phase<true, true, false, true, true>(Fp, P_XB, P_XB, P_Y, gy, gate, gn, modN + 0, modN + 1024, 6144, P_HB, nullptr, nullptr, nullptr, 0, nullptr); }
        } PH_END
    }
#undef PH_BEGIN
#undef PH_END
#undef PH_END_GRID
#undef GRID_BAR
#undef GRP_BAR
}

extern "C" void kernel_launch(void* const* d_in, const int* in_sizes, int n_in, void* d_out, int out_size, void* d_ws, size_t ws_size, hipStream_t stream) {
    static int grid = 0;
    if (grid == 0) {
        if (n_in != 24 || out_size != M * D || ws_size < WS_END) { fprintf(stderr, "kernel_launch: unexpected shapes (n_in %d, out %d, ws %zu)\n", n_in, out_size, ws_size); grid = -1; return; }
        int dev = 0, cus = 0, per_cu = 0;
        if (hipGetDevice(&dev) != hipSuccess || hipDeviceGetAttribute(&cus, hipDeviceAttributeMultiprocessorCount, dev) != hipSuccess) { grid = -1; return; }
        if (hipFuncSetAttribute((const void*)fwd, hipFuncAttributeMaxDynamicSharedMemorySize, LDS_BYTES) != hipSuccess) { grid = -1; return; }
        if (hipOccupancyMaxActiveBlocksPerMultiprocessor(&per_cu, (const void*)fwd, NWAVES * 64, LDS_BYTES) != hipSuccess || per_cu < 1)
            fprintf(stderr, "kernel_launch: occupancy query reports %d workgroups per CU\n", per_cu);
        (void)hipGetLastError();
        grid = cus;
        if (grid != NGRP * GRP_WGS) { fprintf(stderr, "kernel_launch: %d CUs, this build deals the work to %d workgroups\n", cus, NGRP * GRP_WGS); grid = -1; return; }
    }
    if (grid < 0) return;
    if (hipMemsetAsync((char*)d_ws + WS_CTL, 0, CTL_ZERO_BYTES, stream) != hipSuccess) return;
    Args a{};
    for (int i = 0; i < 24; ++i) a.in[i] = (const float*)d_in[i];
    a.out = (float*)d_out; a.ws = (unsigned char*)d_ws;
#if MK_MULTI
    static const int probe[] = {PROBE_PHASES, -1};
    for (int p = 0; p < 40; ++p) { a.ph_lo = p; a.ph_hi = p + 1; int n = 1; for (int k = 0; probe[k] >= 0; ++k) if (probe[k] == p) n += PROBE_REPS;
        for (int r = 0; r < n; ++r) hipLaunchKernelGGL(fwd, dim3(grid), dim3(NWAVES * 64), LDS_BYTES, stream, a); }
#else
    a.ph_lo = 0; a.ph_hi = 1000; hipLaunchKernelGGL(fwd, dim3(grid), dim3(NWAVES * 64), LDS_BYTES, stream, a);
#endif
}
```

```cpp
#include <hip/hip_runtime.h>
#include <cstdio>
#include <cstdint>
#include <cmath>
#define MK_MULTI 0
#define PROBE_PHASES -1
#define PROBE_REPS 2
#define PROBE_ATT 0
#define STAGGER_FIN 0
namespace pg8 {
#define PG8_LAS __attribute__((address_space(3)))
typedef unsigned short bf16_t;
typedef short bf16x8 __attribute__((ext_vector_type(8)));
typedef float f32x4 __attribute__((ext_vector_type(4)));
typedef unsigned u32x4 __attribute__((ext_vector_type(4)));
constexpr int BM = 256, BK = 64, HALF = 128, HTB = HALF * BK * 2  , STAGE_BYTES = 8 * HTB, NXCD = 8, WGM = 8;

__host__ __device__ __forceinline__ int lds_byte(int r, int c) { const int st = (r >> 4) * 2 + (c >> 5), rr = r & 15, cc = c & 31, ob = rr * 64 + cc * 2; return st * 1024 + (ob ^ (((ob >> 9) & 1) << 5)); }
__host__ __device__ __forceinline__ void stage_rc(int b, int& R, int& C) { const int st = b / 1024, sb = b % 1024, swz = sb ^ (((sb >> 9) & 1) << 5); R = (st >> 1) * 16 + swz / 64; C = (st & 1) * 32 + (swz % 64) / 2; }
__host__ __device__ __forceinline__ int perm32(int rho) { const int n = rho >> 4, i = rho & 15; return 8 * (i >> 2) + 4 * n + (i & 3); }

struct Unit { int pm, pn; };
struct Gemm { const bf16_t* A; const bf16_t* Bt; int M, N, K; unsigned a_rs; size_t a_hstep, a_kstep, a_t1, a_t0; int a_sh; int ldb; int stagger_ticks; };
__device__ __forceinline__ Gemm make_gemm(const bf16_t* A, const bf16_t* Bt, int M, int N, int K) {
    Gemm g; g.A = A; g.Bt = Bt; g.M = M; g.N = N; g.K = K; g.a_rs = (unsigned)K * 2u; g.a_hstep = (size_t)HALF * K * 2; g.a_kstep = BK * 2; g.a_t1 = (size_t)BM * K * 2; g.a_t0 = 0; g.a_sh = 0; g.ldb = K; g.stagger_ticks = 0; return g; }

struct StaticOrder {
    int nM, nN, nwg, G, c;
    __host__ __device__ void init(int M, int N, int G_, int c_) { nM = M / BM; nN = N / BM; nwg = nM * nN; G = G_; c = c_; }
    __host__ __device__ bool next(int i, Unit& u) const {
        const long L = (long)i * G + c; if (L >= nwg) return false;
        int wgid = (int)L; { const int q = nwg / NXCD, r = nwg % NXCD, xcd = wgid % NXCD, off = wgid / NXCD; wgid = (xcd < r ? xcd * (q + 1) : r * (q + 1) + (xcd - r) * q) + off; }
        const int nig = WGM * nN, gid = wgid / nig, fm = gid * WGM, gsz = (nM - fm) < WGM ? (nM - fm) : WGM;
        u.pm = fm + ((wgid % nig) % gsz); u.pn = (wgid % nig) / gsz; return true;
    }
    __device__ __forceinline__ void a_ready(const Unit&) const {}
    __device__ __forceinline__ void done(const Unit&) const {}
};
struct GroupOrder {
    int nM, nN, nwg, G, c;
    __host__ __device__ void init(int M, int N, int G_, int c_) { nM = M / BM; nN = N / BM; nwg = nM * nN; G = G_; c = c_; }
    __host__ __device__ bool next(int i, Unit& u) const {
        const int wgid = i * G + c; if (wgid >= nwg) return false;
        const int nig = WGM * nN, gid = wgid / nig, fm = gid * WGM, gsz = (nM - fm) < WGM ? (nM - fm) : WGM;
        u.pm = fm + ((wgid % nig) % gsz); u.pn = (wgid % nig) / gsz; return true;
    }
    __device__ __forceinline__ void a_ready(const Unit&) const {}
    __device__ __forceinline__ void done(const Unit&) const {}
};

__device__ __forceinline__ unsigned cvt_pk_bf16(float lo, float hi) { unsigned r; asm volatile("v_cvt_pk_bf16_f32 %0, %1, %2" : "=v"(r) : "v"(lo), "v"(hi)); return r; }
__device__ __forceinline__ float gelu_tanh(float v) {
    const float u = v * (0.7978845608028654f + 0.035677408136300125f * v * v);
    const float e = __builtin_amdgcn_exp2f(u * -2.8853900817779268f);
    return v * __builtin_amdgcn_rcpf(1.0f + e);
}
template <int ACT> __device__ __forceinline__ float act_fn(float v) {
    if (ACT == 2) return gelu_tanh(v);
    if (ACT == 3) { const float r = v > 0.f ? v : 0.f; return r * r; }
    return v;
}

template <int ACT  > struct EpiBf16 {
    static constexpr bool PERM = true, AFTER_DRAIN = false;
    bf16_t* O; int ldc; const float* bias; int split_cols; size_t split_stride; float scale0;
    __device__ __forceinline__ void operator()(const f32x4 (&acc)[2][2][4][2], const Unit& u, int wr, int wc, int fr, int fq) const {
        const int row0 = u.pm * BM + wr * 64 + fr; int colt = u.pn * BM; bf16_t* base = O;
        float sc = 1.f; if (split_cols) { const int t = colt / split_cols; base += (size_t)t * split_stride; colt -= t * split_cols; if (t == 0) sc = scale0; }
        const int col0 = colt + wc * 32 + 8 * fq, bcol0 = u.pn * BM + wc * 32 + 8 * fq;
        f32x4 bv[2][2];
#pragma unroll
        for (int bj = 0; bj < 2; ++bj)
#pragma unroll
            for (int n = 0; n < 2; ++n) bv[bj][n] = bias ? *(const f32x4*)(bias + bcol0 + bj * HALF + 4 * n) : (f32x4){0.f, 0.f, 0.f, 0.f};
#pragma unroll
        for (int ai = 0; ai < 2; ++ai)
#pragma unroll
            for (int m = 0; m < 4; ++m) { bf16_t* rowp = base + (size_t)(row0 + ai * HALF + m * 16) * ldc + col0;
#pragma unroll
                for (int bj = 0; bj < 2; ++bj) { f32x4 v0 = acc[ai][bj][m][0] + bv[bj][0], v1 = acc[ai][bj][m][1] + bv[bj][1];
                    if (ACT != 0) {
#pragma unroll
                        for (int e = 0; e < 4; ++e) { v0[e] = act_fn<ACT>(v0[e]); v1[e] = act_fn<ACT>(v1[e]); } }
                    v0 = v0 * sc; v1 = v1 * sc; u32x4 w; w.x = cvt_pk_bf16(v0[0], v0[1]); w.y = cvt_pk_bf16(v0[2], v0[3]); w.z = cvt_pk_bf16(v1[0], v1[1]); w.w = cvt_pk_bf16(v1[2], v1[3]);
                    *(u32x4*)(rowp + bj * HALF) = w; } }
    }
};
struct EpiF32 {
    static constexpr bool PERM = false, AFTER_DRAIN = false;
    float* O; int ldc;
    __device__ __forceinline__ void operator()(const f32x4 (&acc)[2][2][4][2], const Unit& u, int wr, int wc, int fr, int fq) const {
        const int row0 = u.pm * BM + wr * 64 + fr, col0 = u.pn * BM + wc * 32 + 4 * fq;
#pragma unroll
        for (int ai = 0; ai < 2; ++ai)
#pragma unroll
            for (int m = 0; m < 4; ++m) { float* rowp = O + (size_t)(row0 + ai * HALF + m * 16) * ldc + col0;
#pragma unroll
                for (int bj = 0; bj < 2; ++bj)
#pragma unroll
                    for (int n = 0; n < 2; ++n) *(f32x4*)(rowp + bj * HALF + n * 16) = acc[ai][bj][m][n]; }
    }
};
struct EpiQG {
    static constexpr bool PERM = true, AFTER_DRAIN = false;
    bf16_t* Q; float* G; float qscale;
    __device__ __forceinline__ void operator()(const f32x4 (&acc)[2][2][4][2], const Unit& u, int wr, int wc, int fr, int fq) const {
        const int row0 = u.pm * BM + wr * 64 + fr;
        if (u.pn < 4) {
            const int col0 = u.pn * BM + wc * 32 + 8 * fq;
#pragma unroll
            for (int ai = 0; ai < 2; ++ai)
#pragma unroll
                for (int m = 0; m < 4; ++m) { bf16_t* rowp = Q + (size_t)(row0 + ai * HALF + m * 16) * 1024 + col0;
#pragma unroll
                    for (int bj = 0; bj < 2; ++bj) { const f32x4 v0 = acc[ai][bj][m][0] * qscale, v1 = acc[ai][bj][m][1] * qscale;
                        u32x4 w; w.x = cvt_pk_bf16(v0[0], v0[1]); w.y = cvt_pk_bf16(v0[2], v0[3]); w.z = cvt_pk_bf16(v1[0], v1[1]); w.w = cvt_pk_bf16(v1[2], v1[3]);
                        *(u32x4*)(rowp + bj * HALF) = w; } }
        } else if (wc < 2) {
#pragma unroll
            for (int ai = 0; ai < 2; ++ai)
#pragma unroll
                for (int m = 0; m < 4; ++m) { float* rowp = G + (size_t)(row0 + ai * HALF + m * 16) * 48;
#pragma unroll
                    for (int n = 0; n < 2; ++n) { const int col = wc * 32 + 8 * fq + 4 * n;
                        if (col < 48) { f32x4 v = acc[ai][0][m][n];
#pragma unroll
                            for (int e = 0; e < 4; ++e) v[e] = __builtin_amdgcn_rcpf(1.0f + __builtin_amdgcn_exp2f(v[e] * -1.4426950408889634f));
                            *(f32x4*)(rowp + col) = v; } } }
        }
    }
};

template <class Epi, class Sched, bool ALIGN_EPI = false, bool SP2 = false>
__device__ __forceinline__ void gemm_phase(PG8_LAS unsigned char* lds, const Gemm g, const Sched& S, const Epi& E) {
    int tid_ = threadIdx.x; asm volatile("" : "+v"(tid_));
    const int tid = tid_, wid = __builtin_amdgcn_readfirstlane(tid >> 6), lane = tid & 63, wr = wid >> 2, wc = wid & 3, fr = lane & 15, fq = lane >> 4;
    const int K = g.K, nt = K / BK;
    unsigned voffA[2], voffB[2];
#pragma unroll
    for (int i = 0; i < 2; ++i) { int R, C; stage_rc(tid * 16 + i * 8192, R, C); const int Rb = Epi::PERM ? ((R & ~31) + perm32(R & 31)) : R;
        voffA[i] = (unsigned)R * g.a_rs + (unsigned)C * 2u; voffB[i] = (unsigned)(Rb * g.ldb + C) * 2u; }
    const size_t kstepA = g.a_kstep, kstepB = (size_t)(BK * 2);
    const size_t hstepA = g.a_hstep, hstepB = (size_t)HALF * g.ldb * 2;
    const size_t tstepB = 2 * hstepB;
    const int a_msk = (1 << g.a_sh) - 1;
#define PG8_ATILE(pm) ((const char*)g.A + (size_t)((pm) >> g.a_sh) * g.a_t1 + (size_t)((pm) & a_msk) * g.a_t0)
    const unsigned ldsw = (unsigned)wid * 1024u;
    const int aoff = lds_byte(wr * 64 + fr, fq * 8), boff = lds_byte(wc * 32 + fr, fq * 8);
#define PG8_SA(b, h) (((b) * 2 + (h)) * HTB)
#define PG8_SB(b, h) ((4 + (b) * 2 + (h)) * HTB)
#define PG8_STAGE(bufoff, gbase, voff) do { _Pragma("unroll") for (int _i = 0; _i < 2; ++_i) \
        __builtin_amdgcn_global_load_lds((const unsigned*)((const char*)(gbase) + (voff)[_i]), (PG8_LAS unsigned*)(lds + (bufoff) + ldsw + _i * 8192), 16, 0, 0); } while (0)
#define PG8_LDA(dst, b, h) do { _Pragma("unroll") for (int m = 0; m < 4; ++m) _Pragma("unroll") for (int k = 0; k < 2; ++k) dst[m][k] = *(const PG8_LAS bf16x8*)(lds + PG8_SA(b, h) + aoff + m * 2048 + k * 1024); } while (0)
#define PG8_LDB(dst, b, h) do { _Pragma("unroll") for (int n = 0; n < 2; ++n) _Pragma("unroll") for (int k = 0; k < 2; ++k) dst[n][k] = *(const PG8_LAS bf16x8*)(lds + PG8_SB(b, h) + boff + n * 2048 + k * 1024); } while (0)
#define PG8_MMA(ai, bj, At, Bt) do { __builtin_amdgcn_s_setprio(1); _Pragma("unroll") for (int m = 0; m < 4; ++m) _Pragma("unroll") for (int n = 0; n < 2; ++n) _Pragma("unroll") for (int k = 0; k < 2; ++k) \
        acc[ai][bj][m][n] = __builtin_amdgcn_mfma_f32_16x16x32_bf16(Bt[n][k], At[m][k], acc[ai][bj][m][n], 0, 0, 0); __builtin_amdgcn_s_setprio(0); } while (0)
#define PG8_WAIT_V(n) asm volatile("s_waitcnt vmcnt(" #n ")" ::: "memory")
#define PG8_WAIT_L(n) asm volatile("s_waitcnt lgkmcnt(" #n ")" ::: "memory")
#define PG8_BAR __builtin_amdgcn_s_barrier()
#define PG8_SCHED __builtin_amdgcn_sched_barrier(0)
    Unit cur, nxt; int ui = 0;
    if (!S.next(0, cur)) return;
    if (g.stagger_ticks > 0) {
        const unsigned long long t0 = __builtin_amdgcn_s_memrealtime(); const unsigned long long dt = (unsigned long long)(((unsigned)blockIdx.x >> 3) & 3u) * (unsigned)g.stagger_ticks;
        while (__builtin_amdgcn_s_memrealtime() - t0 < dt) __builtin_amdgcn_s_sleep(4);
    }
    f32x4 acc[2][2][4][2];
#pragma unroll
    for (int a = 0; a < 2; ++a)
#pragma unroll
        for (int b = 0; b < 2; ++b)
#pragma unroll
            for (int m = 0; m < 4; ++m)
#pragma unroll
                for (int n = 0; n < 2; ++n) acc[a][b][m][n] = (f32x4){0.f, 0.f, 0.f, 0.f};
    bf16x8 At[4][2], B0[2][2], B1[2][2];
    const char* cA = PG8_ATILE(cur.pm); const char* cB = (const char*)g.Bt + (size_t)cur.pn * tstepB;
    S.a_ready(cur);
    if constexpr (SP2) {
        PG8_STAGE(PG8_SB(0, 0), cB, voffB); PG8_STAGE(PG8_SB(0, 1), cB + hstepB, voffB); PG8_STAGE(PG8_SA(0, 0), cA, voffA); PG8_STAGE(PG8_SA(0, 1), cA + hstepA, voffA);
        if (wr == 1) PG8_BAR;
        PG8_WAIT_V(2); PG8_BAR;
        PG8_STAGE(PG8_SB(1, 0), cB + kstepB, voffB); PG8_STAGE(PG8_SA(1, 0), cA + kstepA, voffA); PG8_STAGE(PG8_SB(1, 1), cB + hstepB + kstepB, voffB);
        PG8_WAIT_V(6); PG8_BAR;
    } else {
        PG8_STAGE(PG8_SB(0, 0), cB, voffB); PG8_STAGE(PG8_SA(0, 0), cA, voffA); PG8_STAGE(PG8_SB(0, 1), cB + hstepB, voffB); PG8_STAGE(PG8_SA(0, 1), cA + hstepA, voffA);
        if (wr == 1) PG8_BAR;
        PG8_WAIT_V(4); PG8_BAR;
        PG8_STAGE(PG8_SB(1, 0), cB + kstepB, voffB); PG8_STAGE(PG8_SA(1, 0), cA + kstepA, voffA); PG8_STAGE(PG8_SB(1, 1), cB + hstepB + kstepB, voffB);
        PG8_WAIT_V(6); PG8_BAR;
    }
    for (;;) {
        const bool has_next = S.next(ui + 1, nxt);
        const char* nA = has_next ? PG8_ATILE(nxt.pm) : cA; const char* nB = has_next ? (const char*)g.Bt + (size_t)nxt.pn * tstepB : cB;
        for (int t = 0; t < nt; t += 2) {
            const bool last = (t == nt - 2);
            const char* a1 = cA + (size_t)(t + 1) * kstepA;
            const char* a2 = last ? nA : cA + (size_t)(t + 2) * kstepA; const char* b2 = last ? nB : cB + (size_t)(t + 2) * kstepB;
            const char* a3 = a2 + kstepA; const char* b3 = b2 + kstepB;
            if (last && has_next) S.a_ready(nxt);
            if constexpr (SP2) {
            PG8_LDB(B0, 0, 0); PG8_LDB(B1, 0, 1); PG8_SCHED; PG8_LDA(At, 0, 0); PG8_STAGE(PG8_SA(1, 1), a1 + hstepA, voffA);
            PG8_WAIT_V(8); PG8_WAIT_L(0); PG8_BAR; PG8_MMA(0, 0, At, B0); PG8_MMA(0, 1, At, B1); PG8_BAR; PG8_SCHED;
            PG8_LDA(At, 0, 1); PG8_STAGE(PG8_SB(0, 0), b2, voffB); PG8_STAGE(PG8_SB(0, 1), b2 + hstepB, voffB); PG8_STAGE(PG8_SA(0, 0), a2, voffA);
            PG8_WAIT_V(8); PG8_WAIT_L(0); PG8_BAR; PG8_MMA(1, 0, At, B0); PG8_MMA(1, 1, At, B1); PG8_BAR; PG8_SCHED;
            PG8_LDB(B0, 1, 0); PG8_LDB(B1, 1, 1); PG8_SCHED; PG8_LDA(At, 1, 0); PG8_STAGE(PG8_SA(0, 1), a2 + hstepA, voffA);
            PG8_WAIT_V(8); PG8_WAIT_L(0); PG8_BAR; PG8_MMA(0, 0, At, B0); PG8_MMA(0, 1, At, B1); PG8_BAR; PG8_SCHED;
            PG8_LDA(At, 1, 1); PG8_STAGE(PG8_SB(1, 0), b3, voffB); PG8_STAGE(PG8_SB(1, 1), b3 + hstepB, voffB); PG8_STAGE(PG8_SA(1, 0), a3, voffA);
            PG8_WAIT_V(8); PG8_WAIT_L(0); PG8_BAR; PG8_MMA(1, 0, At, B0); PG8_MMA(1, 1, At, B1); PG8_BAR; PG8_SCHED;
            } else {
            PG8_LDB(B0, 0, 0); PG8_SCHED; PG8_LDA(At, 0, 0); PG8_STAGE(PG8_SA(1, 1), a1 + hstepA, voffA);
            PG8_WAIT_L(8); PG8_BAR; PG8_WAIT_L(0); PG8_MMA(0, 0, At, B0); PG8_BAR; PG8_SCHED;
            PG8_LDB(B1, 0, 1); PG8_STAGE(PG8_SB(0, 0), b2, voffB);
            PG8_BAR; PG8_WAIT_L(0); PG8_MMA(0, 1, At, B1); PG8_BAR;
            PG8_LDA(At, 0, 1); PG8_STAGE(PG8_SA(0, 0), a2, voffA);
            PG8_BAR; PG8_WAIT_L(0); PG8_MMA(1, 0, At, B0); PG8_BAR; PG8_SCHED;
            PG8_STAGE(PG8_SB(0, 1), b2 + hstepB, voffB);
            PG8_WAIT_V(6); PG8_BAR; PG8_MMA(1, 1, At, B1); PG8_BAR;
            PG8_LDB(B0, 1, 0); PG8_SCHED; PG8_LDA(At, 1, 0); PG8_STAGE(PG8_SA(0, 1), a2 + hstepA, voffA);
            PG8_WAIT_L(8); PG8_BAR; PG8_WAIT_L(0); PG8_MMA(0, 0, At, B0); PG8_BAR; PG8_SCHED;
            PG8_LDB(B1, 1, 1); PG8_STAGE(PG8_SB(1, 0), b3, voffB);
            PG8_BAR; PG8_WAIT_L(0); PG8_MMA(0, 1, At, B1); PG8_BAR;
            PG8_LDA(At, 1, 1); PG8_STAGE(PG8_SA(1, 0), a3, voffA);
            PG8_BAR; PG8_WAIT_L(0); PG8_MMA(1, 0, At, B0); PG8_BAR; PG8_SCHED;
            PG8_STAGE(PG8_SB(1, 1), b3 + hstepB, voffB);
            PG8_WAIT_V(6); PG8_BAR; PG8_MMA(1, 1, At, B1); PG8_BAR;
            }
        }
        if constexpr (ALIGN_EPI) { if (wr == 0) PG8_BAR; }
        E(acc, cur, wr, wc, fr, fq); S.done(cur);
        if (!has_next) break;
#pragma unroll
        for (int a = 0; a < 2; ++a)
#pragma unroll
            for (int b = 0; b < 2; ++b)
#pragma unroll
                for (int m = 0; m < 4; ++m)
#pragma unroll
                    for (int n = 0; n < 2; ++n) acc[a][b][m][n] = (f32x4){0.f, 0.f, 0.f, 0.f};
        cur = nxt; cA = nA; cB = nB; ++ui;
        if constexpr (ALIGN_EPI) { if (wr == 1) PG8_BAR; }
    }
    PG8_WAIT_V(0);
    if constexpr (!ALIGN_EPI) { if (wr == 0) PG8_BAR; }
    PG8_BAR;
#undef PG8_ATILE
#undef PG8_SA
#undef PG8_SB
#undef PG8_STAGE
#undef PG8_LDA
#undef PG8_LDB
#undef PG8_MMA
#undef PG8_WAIT_V
#undef PG8_WAIT_L
#undef PG8_BAR
#undef PG8_SCHED
}
}
constexpr int NWAVES = 8;
#ifndef MK_MULTI
#define MK_MULTI 0
#endif

constexpr int BATCH = 16, T = 2048, D = 1024, FF = 4096, DEPTH = 4;
constexpr int M = BATCH * T;
constexpr int MH = M / 2;
constexpr int NKV = 1536;
constexpr int NQG = 1280;
constexpr int NCMP = 127;
constexpr float EPS = 1e-6f;

constexpr size_t MiB = 1u << 20;
constexpr size_t WS_CTL = 0, CTL_ZERO_BYTES = 64 * 1024;
constexpr size_t WS_MOD = 1 * MiB;
constexpr size_t WS_CB1 = 3 * MiB;
constexpr size_t WS_GATE = 4 * MiB;
constexpr size_t WS_KCV = 10 * MiB;
constexpr size_t WS_CH = 16 * MiB;
constexpr size_t WS_W = 32 * MiB;
constexpr size_t WS_KV = 128 * MiB;
constexpr size_t WS_HB = 224 * MiB;
constexpr size_t WS_Y = 288 * MiB;
constexpr size_t WS_BIG = 352 * MiB;
constexpr size_t WS_END = 480 * MiB;
constexpr size_t WO_AIN = 0;
constexpr size_t WO_AOUT = WO_AIN + 2ull * 2048 * 1024;
constexpr size_t WO_KV = WO_AOUT + 2ull * 1024 * 1024;
constexpr size_t WO_BIN = WO_KV + 1536ull * 1024;
constexpr size_t WO_BOUT = WO_BIN + 2ull * 1280 * 1024;
constexpr size_t WO_FIN = WO_BOUT + 2ull * 1024 * 1024;
constexpr size_t WO_FOUT = WO_FIN + 4ull * 4096 * 1024;
constexpr size_t WO_C1 = WO_FOUT + 4ull * 4096 * 1024;
constexpr size_t WO_WS = WO_C1 + 2ull * 256 * 2048;
constexpr size_t WO_END = WO_WS + 2ull * 8 * 128 * 128;
static_assert(WO_END * 2 <= 96 * MiB, "weights fit");
constexpr int CW_BAR = 1024;

constexpr int RING_OFF = 0, RING_BYTES = 131072;
constexpr int LDSCTL_OFF = RING_BYTES, MISC_OFF = LDSCTL_OFF + 320;
constexpr int LDS_BYTES = 147456;

#define GAS __attribute__((address_space(1)))
#define LAS __attribute__((address_space(3)))
typedef unsigned short bf16;
typedef unsigned v4u __attribute__((ext_vector_type(4)));
typedef unsigned v2u __attribute__((ext_vector_type(2)));
typedef float f32x4 __attribute__((ext_vector_type(4)));
typedef GAS unsigned gu32;
#define RLX_AGENT __ATOMIC_RELAXED, __HIP_MEMORY_SCOPE_AGENT
#define LDS_WAIT() asm volatile("s_waitcnt lgkmcnt(0)" ::: "memory")
#define VM_WAIT() asm volatile("s_waitcnt vmcnt(0)" ::: "memory")
__device__ __forceinline__ unsigned f2bf(float f) { unsigned u = __builtin_bit_cast(unsigned, f); return (u + 0x7fffu + ((u >> 16) & 1u)) >> 16; }
__device__ __forceinline__ unsigned pk2(float lo, float hi) { return f2bf(lo) | (f2bf(hi) << 16); }
__device__ __forceinline__ float bf_lo(unsigned w) { return __builtin_bit_cast(float, w << 16); }
__device__ __forceinline__ float bf_hi(unsigned w) { return __builtin_bit_cast(float, w & 0xffff0000u); }
__device__ __forceinline__ float bf1(bf16 h) { return __builtin_bit_cast(float, (unsigned)h << 16); }
__device__ __forceinline__ float wave_sum(float v) {
#pragma unroll
    for (int o = 1; o < 64; o <<= 1) v += __shfl_xor(v, o);
    return v;
}
__device__ __forceinline__ float wave_max(float v) {
#pragma unroll
    for (int o = 1; o < 64; o <<= 1) v = fmaxf(v, __shfl_xor(v, o));
    return v;
}

#define XB_TMO      128
#define XB_XCNT(j)  (256  + 64 * (j))
#define XB_XSUB(j)  (1280 + 64 * (j))
#define XB_XGEN(j)  (2304 + 64 * (j))
#define XB_TOP      3328
#define XB_TOPGEN   3392
#define XCD_BAR_WORDS 3456
#define XB_SPIN_CAP (1u << 18)

__device__ __forceinline__ unsigned xb_ld(unsigned* p)              { return __hip_atomic_load(p, __ATOMIC_RELAXED, __HIP_MEMORY_SCOPE_AGENT); }
__device__ __forceinline__ unsigned xb_add(unsigned* p, unsigned v) { return __hip_atomic_fetch_add(p, v, __ATOMIC_RELAXED, __HIP_MEMORY_SCOPE_AGENT); }
__device__ __forceinline__ unsigned xb_xcc_id() { return (unsigned)__builtin_amdgcn_s_getreg((3 << 11) | 20) & 0xFu; }
#define XB_SPIN(cond, bar) do { unsigned _sp = 0; while (cond) { __builtin_amdgcn_s_sleep(1); \
    if ((++_sp & 255u) == 0u) { if (xb_ld(&(bar)[XB_TMO])) break; if (_sp > XB_SPIN_CAP) { atomicAdd(&(bar)[XB_TMO], 1u); break; } } } } while (0)

struct XcdBarrier {
    unsigned* bar; unsigned x;
    volatile LAS unsigned* st;
};
__device__ __forceinline__ XcdBarrier xcd_barrier_post(unsigned* bar, volatile LAS unsigned* st) {
    XcdBarrier b; b.bar = bar; b.x = xb_xcc_id(); b.st = st;
    if (threadIdx.x == 0) (void)xb_add(&bar[XB_XCNT(b.x)], 1u);
    return b;
}
__device__ __forceinline__ void xcd_barrier_complete(unsigned* bar, unsigned x, unsigned& nloc, unsigned& nx) {
    const unsigned G = gridDim.x * gridDim.y * gridDim.z;
    unsigned sum, cnt, mine, sp = 0u;
    for (;;) {
        sum = 0u; cnt = 0u; mine = 0u;
#pragma unroll
        for (unsigned j = 0; j < 16; ++j) { const unsigned c = xb_ld(&bar[XB_XCNT(j)]); sum += c; cnt += (c > 0u) ? 1u : 0u; mine = (j == x) ? c : mine; }
        if (sum == G) break;
        __builtin_amdgcn_s_sleep(1);
        if ((++sp & 255u) == 0u) { if (xb_ld(&bar[XB_TMO])) break; if (sp > XB_SPIN_CAP) { atomicAdd(&bar[XB_TMO], 1u); break; } }
    }
    nloc = mine > 0u ? mine : 1u; nx = cnt > 0u ? cnt : 1u;
}
__device__ __forceinline__ void xcd_barrier(const XcdBarrier& b) {
    asm volatile("s_waitcnt vmcnt(0)" ::: "memory");
    __syncthreads();
    if (threadIdx.x == 0) {
        unsigned* bar = b.bar;
        __builtin_amdgcn_s_waitcnt(0);
        unsigned nloc = b.st[0], nx = b.st[1];
        if (nloc == 0u) { xcd_barrier_complete(bar, b.x, nloc, nx); b.st[0] = nloc; b.st[1] = nx; }
        const unsigned old = xb_add(&bar[XB_XSUB(b.x)], 1u);
        const unsigned gen = old / nloc;
        if (old + 1u == (gen + 1u) * nloc) {
            __builtin_amdgcn_fence(__ATOMIC_RELEASE, "agent");
            asm volatile("s_waitcnt vmcnt(0)" ::: "memory");
            const unsigned og = xb_add(&bar[XB_TOP], 1u);
            const unsigned tg = og / nx;
            if (og + 1u == (tg + 1u) * nx) xb_add(&bar[XB_TOPGEN], 1u);
            else XB_SPIN(xb_ld(&bar[XB_TOPGEN]) == tg, bar);
            __builtin_amdgcn_fence(__ATOMIC_ACQUIRE, "agent");
            xb_add(&bar[XB_XGEN(b.x)], 1u);
            asm volatile("s_waitcnt vmcnt(0)" ::: "memory");
        } else {
            XB_SPIN(xb_ld(&bar[XB_XGEN(b.x)]) == gen, bar);
            __builtin_amdgcn_fence(__ATOMIC_ACQUIRE, "agent");
            asm volatile("s_waitcnt vmcnt(0)" ::: "memory");
        }
    }
    __syncthreads();
}

constexpr int GRP_WGS = 32, NGRP = 8, CW_GRP = 8192, GROWS = M / NGRP;
__device__ __forceinline__ void grp_barrier(unsigned* w, unsigned* bar) {
    asm volatile("s_waitcnt vmcnt(0)" ::: "memory");
    __syncthreads();
    if (threadIdx.x == 0) {
        const unsigned mask = xb_ld(w + 32); const bool one_xcd = (mask & (mask - 1u)) == 0u;
        if (!one_xcd) { __builtin_amdgcn_fence(__ATOMIC_RELEASE, "agent"); asm volatile("s_waitcnt vmcnt(0)" ::: "memory"); }
        const unsigned old = xb_add(w, 1u);
        const unsigned gen = old / (unsigned)GRP_WGS;
        if (old + 1u == (gen + 1u) * (unsigned)GRP_WGS) {
            if (one_xcd) { __builtin_amdgcn_fence(__ATOMIC_RELEASE, "agent"); asm volatile("s_waitcnt vmcnt(0)" ::: "memory"); }
            xb_add(w + 16, 1u);
        } else XB_SPIN(xb_ld(w + 16) == gen, bar);
        __builtin_amdgcn_fence(__ATOMIC_ACQUIRE, "agent");
        asm volatile("s_waitcnt vmcnt(0)" ::: "memory");
    }
    __syncthreads();
}

struct Frame {
    LAS unsigned char* lds;
    int tid, lane, wave;
    int vcu, G;
};
__device__ __forceinline__ void tr_item(const float* W, int K, int ldw, int nvalid, bf16* WT, int nblk, LAS float* scr, int item, int lane) {
    const int kb = item / nblk, nb = item % nblk, k0 = 64 * kb, n0 = 32 * nb;
    const int kr = lane >> 3, n4 = (lane & 7) * 4; const bool ok = (n0 + n4) < nvalid;
    f32x4 v[8];
#pragma unroll
    for (int i = 0; i < 8; ++i) v[i] = ok ? *(const f32x4*)(W + (size_t)(k0 + 8 * i + kr) * ldw + n0 + n4) : (f32x4){0.f, 0.f, 0.f, 0.f};
#pragma unroll
    for (int i = 0; i < 8; ++i) { LAS float* d = scr + (8 * i + kr) * 33 + n4; d[0] = v[i].x; d[1] = v[i].y; d[2] = v[i].z; d[3] = v[i].w; }
    LDS_WAIT(); asm volatile("" ::: "memory");
    const int c = lane & 7;
#pragma unroll
    for (int j = 0; j < 4; ++j) { const int n = (lane >> 3) + 8 * j; const LAS float* s = scr + (8 * c) * 33 + n;
        v4u o; o.x = pk2(s[0 * 33], s[1 * 33]); o.y = pk2(s[2 * 33], s[3 * 33]); o.z = pk2(s[4 * 33], s[5 * 33]); o.w = pk2(s[6 * 33], s[7 * 33]);
        *(GAS v4u*)(WT + (size_t)(n0 + n) * K + k0 + 8 * c) = o; }
    LDS_WAIT(); asm volatile("" ::: "memory");
}

struct Args { const float* in[24]; float* out; unsigned char* ws; int ph_lo, ph_hi; };
typedef const __attribute__((address_space(4))) Args* kargs_t;

__device__ __forceinline__ void p0_prologue(const Frame& F, kargs_t a) {
    LAS float* scr = (LAS float*)(F.lds + RING_OFF + F.wave * 16384);
    bf16* WB = (bf16*)(a->ws + WS_W);
    const int gw = F.vcu * NWAVES + F.wave, NGW = F.G * NWAVES;
    constexpr int I_AIN = 16 * 64, I_AOUT = 16 * 32, I_KV = 16 * 48, I_BIN = 16 * 40, I_BOUT = 16 * 32, I_FIN = 16 * 128, I_FOUT = 64 * 32, I_C1 = 32 * 8;
    constexpr int NITEMS = 2 * I_AIN + 2 * I_AOUT + I_KV + 2 * I_BIN + 2 * I_BOUT + 4 * I_FIN + 4 * I_FOUT + 2 * I_C1;
    for (int it = gw; it < NITEMS; it += NGW) {
        int r = it;
        if (r < 2 * I_AIN) { const int l = r / I_AIN; tr_item(a->in[5] + (size_t)l * 1024 * 2048, 1024, 2048, 2048, WB + WO_AIN + (size_t)l * 2048 * 1024, 64, scr, r % I_AIN, F.lane); continue; } r -= 2 * I_AIN;
        if (r < 2 * I_AOUT) { const int l = r / I_AOUT; tr_item(a->in[10] + (size_t)l * 1024 * 1024, 1024, 1024, 1024, WB + WO_AOUT + (size_t)l * 1024 * 1024, 32, scr, r % I_AOUT, F.lane); continue; } r -= 2 * I_AOUT;
        if (r < I_KV) { tr_item(a->in[14], 1024, 1536, 1536, WB + WO_KV, 48, scr, r, F.lane); continue; } r -= I_KV;
        if (r < 2 * I_BIN) { const int l = r / I_BIN; tr_item(a->in[20] + (size_t)l * 1024 * 1072, 1024, 1072, 1072, WB + WO_BIN + (size_t)l * 1280 * 1024, 40, scr, r % I_BIN, F.lane); continue; } r -= 2 * I_BIN;
        if (r < 2 * I_BOUT) { const int l = r / I_BOUT; tr_item(a->in[21] + (size_t)l * 1024 * 1024, 1024, 1024, 1024, WB + WO_BOUT + (size_t)l * 1024 * 1024, 32, scr, r % I_BOUT, F.lane); continue; } r -= 2 * I_BOUT;
        if (r < 4 * I_FIN) { const int l = r / I_FIN; tr_item(a->in[22] + (size_t)l * 1024 * 4096, 1024, 4096, 4096, WB + WO_FIN + (size_t)l * 4096 * 1024, 128, scr, r % I_FIN, F.lane); continue; } r -= 4 * I_FIN;
        if (r < 4 * I_FOUT) { const int l = r / I_FOUT; tr_item(a->in[23] + (size_t)l * 4096 * 1024, 4096, 1024, 1024, WB + WO_FOUT + (size_t)l * 1024 * 4096, 32, scr, r % I_FOUT, F.lane); continue; } r -= 4 * I_FOUT;
        { const int l = r / I_C1; tr_item(a->in[16] + (size_t)l * 2048 * 256, 2048, 256, 256, WB + WO_C1 + (size_t)l * 256 * 2048, 8, scr, r % I_C1, F.lane); }
    }
    for (int i = gw * 64 + F.lane; i < 2 * 8 * 128 * 128; i += NGW * 64) { const int s = i & 127, t = (i >> 7) & 127; WB[WO_WS + i] = (s <= t) ? (bf16)f2bf(a->in[8][i]) : (bf16)0; }
    __syncthreads();
    if (F.vcu < 208) {
        LAS float* cact = (LAS float*)(F.lds);
        LAS float* red = (LAS float*)(F.lds + 65536);
        for (int i = F.tid; i < 16 * 1024; i += NWAVES * 64) { const float c = a->in[1][i]; cact[i] = c / (1.0f + __expf(-c)); }
        __syncthreads();
        const int grp = F.vcu; const float* W; const float* bias; float* out; int ldw, n0, ostride;
        float* MOD = (float*)(a->ws + WS_MOD);
        if (grp < 192) { const int L = grp / 48; n0 = (grp % 48) * 128; W = a->in[2] + (size_t)L * 1024 * 6144; ldw = 6144; bias = a->in[3] + L * 6144; out = MOD + (size_t)L * 16 * 6144; ostride = 6144; }
        else { n0 = (grp - 192) * 128; W = a->in[11]; ldw = 2048; bias = a->in[12]; out = MOD + (size_t)4 * 16 * 6144; ostride = 2048; }
        float acc0[16], acc1[16];
#pragma unroll
        for (int b = 0; b < 16; ++b) { acc0[b] = 0.f; acc1[b] = 0.f; }
        const int kbeg = F.wave * 128;
        for (int k = kbeg; k < kbeg + 128; k += 8) {
            float2 w[8];
#pragma unroll
            for (int u = 0; u < 8; ++u) w[u] = *(const float2*)(W + (size_t)(k + u) * ldw + n0 + 2 * F.lane);
#pragma unroll
            for (int u = 0; u < 8; ++u)
#pragma unroll
                for (int b = 0; b < 16; ++b) { const float cv = cact[b * 1024 + k + u]; acc0[b] += cv * w[u].x; acc1[b] += cv * w[u].y; }
        }
#pragma unroll
        for (int b = 0; b < 16; ++b) { red[(F.wave * 16 + b) * 128 + 2 * F.lane] = acc0[b]; red[(F.wave * 16 + b) * 128 + 2 * F.lane + 1] = acc1[b]; }
        __syncthreads();
        for (int o = F.tid; o < 2048; o += NWAVES * 64) { const int b = o >> 7, n = o & 127; float s = bias[n0 + n];
#pragma unroll
            for (int w = 0; w < 8; ++w) s += red[(w * 16 + b) * 128 + n];
            out[(size_t)b * ostride + n0 + n] = s; }
    } else if (F.vcu == 208) {
        const int j = F.tid >> 8, n = F.tid & 255; float s = a->in[17][j * 256 + n];
        const float* pos = a->in[15] + j * 2048; const float* w1 = a->in[16] + (size_t)j * 2048 * 256 + n;
        for (int kk = 0; kk < 2048; ++kk) s += pos[kk] * w1[(size_t)kk * 256];
        ((float*)(a->ws + WS_CB1))[j * 256 + n] = s;
    }
}

template <bool HAS_Y, bool HAS_H, bool HAS_KV, bool XIN_BF, bool XOUT_BF>
__device__ __forceinline__ void norm_phase(const Frame& F, const void* xin_, void* xout_, const bf16* Y, const float* gy, const float* gate  ,
                                           const float* gn, const float* sh, const float* sc, int mstride, bf16* H,
                                           const float* gkv, const float* shkv, const float* sckv, int kvstride, bf16* HKV) {
    const int gw = F.vcu * NWAVES + F.wave, NGW = F.G * NWAVES;
    for (int blk = gw; blk < M / 16; blk += NGW) {
        const int b = blk / (T / 16);
        f32x4 A1[4], A2[4], A3[4], K2[4], K3[4];
#pragma unroll
        for (int j = 0; j < 4; ++j) { const int col = 256 * j + 4 * F.lane;
            if (HAS_Y) A1[j] = *(const f32x4*)(gate + (size_t)b * mstride + col) * *(const f32x4*)(gy + col);
            if (HAS_H) { A2[j] = *(const f32x4*)(gn + col) * (*(const f32x4*)(sc + (size_t)b * mstride + col) + 1.0f); A3[j] = *(const f32x4*)(sh + (size_t)b * mstride + col); }
            if (HAS_KV) { K2[j] = *(const f32x4*)(gkv + col) * (*(const f32x4*)(sckv + (size_t)b * kvstride + col) + 1.0f); K3[j] = *(const f32x4*)(shkv + (size_t)b * kvstride + col); }
        }
        for (int r = 0; r < 16; r += 2) {
            const size_t m = (size_t)blk * 16 + r;
            f32x4 xa[4], xb[4]; v2u ya[4], yb[4];
#pragma unroll
            for (int j = 0; j < 4; ++j) {
                if (XIN_BF) { const v2u w0 = __builtin_nontemporal_load((const v2u*)((const bf16*)xin_ + m * D + 256 * j + 4 * F.lane)), w1 = __builtin_nontemporal_load((const v2u*)((const bf16*)xin_ + (m + 1) * D + 256 * j + 4 * F.lane));
                    xa[j] = (f32x4){bf_lo(w0.x), bf_hi(w0.x), bf_lo(w0.y), bf_hi(w0.y)}; xb[j] = (f32x4){bf_lo(w1.x), bf_hi(w1.x), bf_lo(w1.y), bf_hi(w1.y)}; }
                else { xa[j] = __builtin_nontemporal_load((const f32x4*)((const float*)xin_ + m * D + 256 * j + 4 * F.lane)); xb[j] = __builtin_nontemporal_load((const f32x4*)((const float*)xin_ + (m + 1) * D + 256 * j + 4 * F.lane)); }
                if (HAS_Y) { ya[j] = __builtin_nontemporal_load((const v2u*)(Y + m * D + 256 * j + 4 * F.lane)); yb[j] = __builtin_nontemporal_load((const v2u*)(Y + (m + 1) * D + 256 * j + 4 * F.lane)); } }
#define NORM_ROW(xv, yw, mm) do { \
            if (HAS_Y) { f32x4 yv[4]; float s = 0.f; \
                _Pragma("unroll") for (int j = 0; j < 4; ++j) { const v2u w = yw[j]; yv[j] = (f32x4){bf_lo(w.x), bf_hi(w.x), bf_lo(w.y), bf_hi(w.y)}; \
                    s += (yv[j].x * yv[j].x + yv[j].y * yv[j].y) + (yv[j].z * yv[j].z + yv[j].w * yv[j].w); } \
                const float rstd = 1.0f / sqrtf(wave_sum(s) * (1.0f / D) + EPS); \
                _Pragma("unroll") for (int j = 0; j < 4; ++j) { xv[j] = xv[j] + A1[j] * (yv[j] * rstd); \
                    if (XOUT_BF) { v2u w; w.x = pk2(xv[j].x, xv[j].y); w.y = pk2(xv[j].z, xv[j].w); __builtin_nontemporal_store(w, (v2u*)((bf16*)xout_ + (mm) * D + 256 * j + 4 * F.lane)); } \
                    else __builtin_nontemporal_store(xv[j], (f32x4*)((float*)xout_ + (mm) * D + 256 * j + 4 * F.lane)); } } \
            if (HAS_H || HAS_KV) { float s = 0.f; \
                _Pragma("unroll") for (int j = 0; j < 4; ++j) s += (xv[j].x * xv[j].x + xv[j].y * xv[j].y) + (xv[j].z * xv[j].z + xv[j].w * xv[j].w); \
                const float rstd = 1.0f / sqrtf(wave_sum(s) * (1.0f / D) + EPS); \
                _Pragma("unroll") for (int j = 0; j < 4; ++j) { const f32x4 xn = xv[j] * rstd; \
                    if (HAS_H) { const f32x4 h = xn * A2[j] + A3[j]; v2u w; w.x = pk2(h.x, h.y); w.y = pk2(h.z, h.w); *(v2u*)(H + (mm) * D + 256 * j + 4 * F.lane) = w; } \
                    if (HAS_KV) { const f32x4 h = xn * K2[j] + K3[j]; v2u w; w.x = pk2(h.x, h.y); w.y = pk2(h.z, h.w); *(v2u*)(HKV + (mm) * D + 256 * j + 4 * F.lane) = w; } } } } while (0)
            NORM_ROW(xa, ya, m);
            NORM_ROW(xb, yb, m + 1);
#undef NORM_ROW
        }
    }
}

__device__ __forceinline__ void cmp2_phase(const Frame& F, const float* PART, const float* cb1, const float* w2, const float* b2, bf16* KCV) {
    LAS float* w2l = (LAS float*)(F.lds + RING_OFF);
    LAS float* hl = (LAS float*)(F.lds + RING_OFF + 65536) + F.wave * 256;
    const int grp = F.vcu / GRP_WGS, lc = F.vcu % GRP_WGS, half = GRP_WGS / 2, j = lc / half, vj = lc % half;
    PART += (size_t)grp * (8u << 20) / 4;
    if (j < 2) {
        for (int i = F.tid; i < 256 * 64 / 4; i += NWAVES * 64) *(LAS f32x4*)(w2l + 4 * i) = *(const f32x4*)(w2 + (size_t)j * 256 * 64 + 4 * i);
    }
    __syncthreads();
    if (j < 2) {
        for (int rl = vj * NWAVES + F.wave; rl < 1024; rl += half * NWAVES) { const int r = grp * 1024 + rl;
            const float* p0 = PART + ((size_t)(j * 2 + 0) * 1024 + rl) * 256; const float* p1 = PART + ((size_t)(j * 2 + 1) * 1024 + rl) * 256;
            const f32x4 a = *(const f32x4*)(p0 + 4 * F.lane), b = *(const f32x4*)(p1 + 4 * F.lane), c = *(const f32x4*)(cb1 + j * 256 + 4 * F.lane);
            f32x4 h = a + b + c; h.x = pg8::gelu_tanh(h.x); h.y = pg8::gelu_tanh(h.y); h.z = pg8::gelu_tanh(h.z); h.w = pg8::gelu_tanh(h.w);
            *(LAS f32x4*)(hl + 4 * F.lane) = h;
            LDS_WAIT();
            float s0 = b2[j * 64 + F.lane], s1 = 0.f, s2 = 0.f, s3 = 0.f;
#pragma unroll 8
            for (int hh = 0; hh < 256; hh += 4) { const f32x4 h4 = *(const LAS f32x4*)(hl + hh);
                s0 += h4.x * w2l[hh * 64 + F.lane]; s1 += h4.y * w2l[(hh + 1) * 64 + F.lane]; s2 += h4.z * w2l[(hh + 2) * 64 + F.lane]; s3 += h4.w * w2l[(hh + 3) * 64 + F.lane]; }
            float s = (s0 + s1) + (s2 + s3);
            if ((r & 127) == 127) s = 0.f;
            KCV[((size_t)j * 8192 + r) * 64 + F.lane] = (bf16)f2bf(s);
            LDS_WAIT();
        }
    }
    __syncthreads();
}

namespace nsa {
using bf16x8 = __attribute__((ext_vector_type(8))) short;
using s16x4 = __attribute__((ext_vector_type(4))) short;
using f32x16 = __attribute__((ext_vector_type(16))) float;
using u32x4 = __attribute__((ext_vector_type(4))) unsigned;
typedef __attribute__((address_space(3))) const char* lds_cptr;
typedef __attribute__((address_space(3))) char* lds_ptr;
constexpr int NSLOT = 3, SLOTB = 8192;
constexpr int LDS_K = 0, LDS_V = NSLOT * SLOTB, LDS_WS = 2 * NSLOT * SLOTB  , LDS_OST = LDS_WS + 8 * 512  ,
              LDS_PI = LDS_OST + 8 * 4096  , LDS_IMP = LDS_PI + 32768  , LDS_SELM = LDS_IMP + 8192  , LDS_END = LDS_SELM + 256;
static_assert(LDS_END <= 131072, "attention LDS map");
constexpr int THR = 8;
__device__ __forceinline__ int crow(int r, int hi) { return (r & 3) + 8 * (r >> 2) + 4 * hi; }
#define NSA_SBAR() __builtin_amdgcn_sched_barrier(0)
__device__ __forceinline__ void glds16(const void* gsrc, unsigned lds_dst) { unsigned keep;
    asm volatile("s_mov_b32 %0, m0\n\ts_mov_b32 m0, %2\n\ts_nop 0\n\tglobal_load_lds_dwordx4 %1, off\n\ts_mov_b32 m0, %0" : "=&s"(keep) : "v"(gsrc), "s"(lds_dst) : "memory"); }
typedef float f32x2_t __attribute__((ext_vector_type(2))); typedef __bf16 bf16x2_t __attribute__((ext_vector_type(2)));
__device__ __forceinline__ unsigned cvtpk_s(float lo, float hi) { f32x2_t v = {lo, hi}; bf16x2_t b = __builtin_convertvector(v, bf16x2_t); return __builtin_bit_cast(unsigned, b); }
#define NSA_WAIT_BAR(N) asm volatile("s_waitcnt vmcnt(" #N ") lgkmcnt(0)\n\ts_barrier" ::: "memory")

__device__ __forceinline__ void qkt(f32x16& p0, f32x16& p1, lds_cptr Kslot, const bf16x8* qr, const f32x16& cinit, int r32, int hi) {
    lds_cptr kb = Kslot + hi * 1024 + r32 * 16;
#pragma unroll
    for (int d0 = 0; d0 < 4; ++d0) {
        const bf16x8 b0 = *(const __attribute__((address_space(3))) bf16x8*)(kb + d0 * 2048);
        const bf16x8 b1 = *(const __attribute__((address_space(3))) bf16x8*)(kb + d0 * 2048 + 512);
        if (d0 == 0) { p0 = __builtin_amdgcn_mfma_f32_32x32x16_bf16(b0, qr[0], cinit, 0, 0, 0); p1 = __builtin_amdgcn_mfma_f32_32x32x16_bf16(b1, qr[0], cinit, 0, 0, 0); }
        else { p0 = __builtin_amdgcn_mfma_f32_32x32x16_bf16(b0, qr[d0], p0, 0, 0, 0); p1 = __builtin_amdgcn_mfma_f32_32x32x16_bf16(b1, qr[d0], p1, 0, 0, 0); } }
}
__device__ __forceinline__ float rowmax(const f32x16& p0, const f32x16& p1) {
    float a = fmaxf(fmaxf(p0[0], p0[1]), p1[0]), b = fmaxf(fmaxf(p0[2], p0[3]), p1[1]); a = fmaxf(fmaxf(a, p1[2]), p1[3]);
#pragma unroll
    for (int r = 4; r < 16; r += 4) { a = fmaxf(fmaxf(a, p0[r]), p0[r + 1]); b = fmaxf(fmaxf(b, p0[r + 2]), p0[r + 3]); a = fmaxf(fmaxf(a, p1[r]), p1[r + 1]); b = fmaxf(fmaxf(b, p1[r + 2]), p1[r + 3]); }
    const float m = fmaxf(a, b);
    auto rr = __builtin_amdgcn_permlane32_swap(__float_as_uint(m), __float_as_uint(m), false, false);
    return fmaxf(__uint_as_float(rr[0]), __uint_as_float(rr[1]));
}
__device__ __forceinline__ float xhalf_sum(float v) { auto rr = __builtin_amdgcn_permlane32_swap(__float_as_uint(v), __float_as_uint(v), false, false); return __uint_as_float(rr[0]) + __uint_as_float(rr[1]); }
__device__ __forceinline__ float xhalf_other(float v, int hi) { auto rr = __builtin_amdgcn_permlane32_swap(__float_as_uint(v), __float_as_uint(v), false, false); return hi ? __uint_as_float(rr[0]) : __uint_as_float(rr[1]); }
__device__ __forceinline__ void pv(f32x16* o, int vb, bf16x8 pa0, bf16x8 pa1, bf16x8 pa2, bf16x8 pa3) {
#pragma unroll
    for (int d0 = 0; d0 < 2; ++d0) { s16x4 lo[4], hi[4];
#pragma unroll
        for (int ks = 0; ks < 4; ++ks) {
            asm volatile("ds_read_b64_tr_b16 %0,%1 offset:%c2" : "=&v"(lo[ks]) : "v"(vb), "i"(d0 * 4096 + ks * 1024) : "memory");
            asm volatile("ds_read_b64_tr_b16 %0,%1 offset:%c2" : "=&v"(hi[ks]) : "v"(vb), "i"(d0 * 4096 + ks * 1024 + 512) : "memory"); }
        asm volatile("s_waitcnt lgkmcnt(0)" ::: "memory"); NSA_SBAR();
#define NSA_PK(k) (bf16x8){lo[k][0], lo[k][1], lo[k][2], lo[k][3], hi[k][0], hi[k][1], hi[k][2], hi[k][3]}
        o[d0] = __builtin_amdgcn_mfma_f32_32x32x16_bf16(pa0, NSA_PK(0), o[d0], 0, 0, 0);
        o[d0] = __builtin_amdgcn_mfma_f32_32x32x16_bf16(pa1, NSA_PK(1), o[d0], 0, 0, 0);
        o[d0] = __builtin_amdgcn_mfma_f32_32x32x16_bf16(pa2, NSA_PK(2), o[d0], 0, 0, 0);
        o[d0] = __builtin_amdgcn_mfma_f32_32x32x16_bf16(pa3, NSA_PK(3), o[d0], 0, 0, 0);
#undef NSA_PK
    }
}
__device__ __forceinline__ void mask_range(f32x16& p, int kb, int lo, int hi_) {
#pragma unroll
    for (int r = 0; r < 16; ++r) { const int kk = kb + (r & 3) + 8 * (r >> 2); if (kk < lo || kk > hi_) p[r] = -INFINITY; }
}
#define NSA_PACK(P0, P1) do { pw0 = (u32x4){cvtpk_s(P0[0], P0[1]), cvtpk_s(P0[2], P0[3]), cvtpk_s(P0[4], P0[5]), cvtpk_s(P0[6], P0[7])}; \
    pw1 = (u32x4){cvtpk_s(P0[8], P0[9]), cvtpk_s(P0[10], P0[11]), cvtpk_s(P0[12], P0[13]), cvtpk_s(P0[14], P0[15])}; \
    pw2 = (u32x4){cvtpk_s(P1[0], P1[1]), cvtpk_s(P1[2], P1[3]), cvtpk_s(P1[4], P1[5]), cvtpk_s(P1[6], P1[7])}; \
    pw3 = (u32x4){cvtpk_s(P1[8], P1[9]), cvtpk_s(P1[10], P1[11]), cvtpk_s(P1[12], P1[13]), cvtpk_s(P1[14], P1[15])}; } while (0)
#define NSA_PAF(k) __builtin_bit_cast(bf16x8, pw##k)

struct Tensors { const bf16* Q; const float* GATE; const bf16* KCV; const bf16* KV; bf16* O; };

__device__ __forceinline__ void stream_dma(const bf16* ksrc, const bf16* vsrc, unsigned kdst, unsigned vdst, int n, int NT1, int qt, int slot) {
    const int t_ = (n < NT1) ? n : qt - (n - NT1); const size_t off = (size_t)t_ * 64 * NKV + ((n < NT1) ? 0 : 512);
    glds16(ksrc + off, (unsigned)__builtin_amdgcn_readfirstlane(kdst + slot)); glds16(vsrc + off, (unsigned)__builtin_amdgcn_readfirstlane(vdst + slot));
}
__device__ __forceinline__ void stream_prologue(unsigned lds0, const bf16* Ksel, const bf16* Vsel, int qt, int wid, int lane) {
    const bf16* ksrc = Ksel + (size_t)lane * NKV + wid * 8;
    const bf16* vsrc = Vsel + (size_t)(16 * (wid & 3) + (lane >> 2)) * NKV + (wid >> 2) * 32 + (lane & 3) * 8;
    const unsigned kdst = lds0 + LDS_K + wid * 1024, vdst = lds0 + LDS_V + wid * 1024;
    stream_dma(ksrc, vsrc, kdst, vdst, 0, qt + 1, qt, 0); stream_dma(ksrc, vsrc, kdst, vdst, 1, qt + 1, qt, SLOTB);
}
__device__ __forceinline__ void flash_stream(lds_ptr shm, unsigned lds0, const bf16* Ksel, const bf16* Vsel, int qt, const bf16x8* qr, unsigned selmask, int tq, float g_sel, float g_win,
                                             f32x16* otot, int wid, int lane, int r32, int hi) {
    const bf16* ksrc = Ksel + (size_t)lane * NKV + wid * 8;
    const bf16* vsrc = Vsel + (size_t)(16 * (wid & 3) + (lane >> 2)) * NKV + (wid >> 2) * 32 + (lane & 3) * 8;
    const unsigned kdst = lds0 + LDS_K + wid * 1024, vdst = lds0 + LDS_V + wid * 1024;
    __attribute__((address_space(3))) float* wsf = (__attribute__((address_space(3))) float*)(shm + LDS_WS) + wid * 128;
    const int vb0 = (int)(lds0 + LDS_V) + ((lane >> 4) & 1) * 32 + (lane & 3) * 8 + (4 * hi + ((lane & 15) >> 2)) * 64;
    const int NT1 = qt + 1, NT2 = (qt < 8 ? qt + 1 : 9), NTS = NT1 + NT2;
    float mhat = 0.f, l_reg = 0.f; f32x16 o[2]; o[0] = f32x16{}; o[1] = f32x16{};
#define NSA_FINALIZE(gate_) do { const float l_ = xhalf_sum(l_reg); asm volatile("s_waitcnt lgkmcnt(0)" ::: "memory"); if (hi == 0) wsf[r32] = (gate_) / l_; asm volatile("s_waitcnt lgkmcnt(0)" ::: "memory"); \
        _Pragma("unroll") for (int r = 0; r < 16; ++r) { const float w = wsf[crow(r, hi)]; otot[0][r] += o[0][r] * w; otot[1][r] += o[1][r] * w; } } while (0)
    int sl_cur = 0;
    for (int n = 0; n < NTS; ++n) {
        if (n + 1 < NTS) NSA_WAIT_BAR(2); else NSA_WAIT_BAR(0);
        { const int sl2 = (sl_cur >= SLOTB) ? sl_cur - SLOTB : sl_cur + 2 * SLOTB; if (n + 2 < NTS) stream_dma(ksrc, vsrc, kdst, vdst, n + 2, NT1, qt, sl2); }
        if (n == NT1) { NSA_FINALIZE(g_sel); mhat = 0.f; l_reg = 0.f; o[0] = f32x16{}; o[1] = f32x16{}; }
        const bool win = n >= NT1, first = (n == 0) || (n == NT1);
        const int t = win ? qt - (n - NT1) : n;
        float cval = -mhat;
        if (!win && !((selmask >> t) & 1u)) cval = -INFINITY;
        f32x16 cin;
#pragma unroll
        for (int r = 0; r < 16; ++r) cin[r] = cval;
        f32x16 p0, p1;
        qkt(p0, p1, (lds_cptr)(shm + LDS_K + sl_cur), qr, cin, r32, hi);
        if (t == qt) { mask_range(p0, 4 * hi, 0, tq); mask_range(p1, 32 + 4 * hi, 0, tq); }
        if (win && t == qt - 8) { mask_range(p0, 4 * hi, tq + 1, 63); mask_range(p1, 32 + 4 * hi, tq + 1, 63); }
        const float rm = rowmax(p0, p1);
        bool resc = false;
        if (first || __any(rm > (float)THR)) {
            const float dl = first ? fmaxf(rm, -1e30f) : fmaxf(rm, 0.f); mhat += dl;
#pragma unroll
            for (int r = 0; r < 16; ++r) { p0[r] -= dl; p1[r] -= dl; }
            const float f = __builtin_amdgcn_exp2f(-dl); l_reg *= f; if (hi == 0) wsf[r32] = f; resc = !first;
        }
        float sacc = 0.f;
#pragma unroll
        for (int r = 0; r < 16; ++r) { p0[r] = __builtin_amdgcn_exp2f(p0[r]); p1[r] = __builtin_amdgcn_exp2f(p1[r]); sacc += p0[r] + p1[r]; }
        l_reg += sacc;
        u32x4 pw0, pw1, pw2, pw3; NSA_PACK(p0, p1);
        if (resc) { asm volatile("s_waitcnt lgkmcnt(0)" ::: "memory");
#pragma unroll
            for (int d = 0; d < 2; ++d)
#pragma unroll
                for (int r = 0; r < 16; ++r) o[d][r] *= wsf[crow(r, hi)]; }
        pv(o, vb0 + sl_cur, NSA_PAF(0), NSA_PAF(1), NSA_PAF(2), NSA_PAF(3));
        sl_cur = (sl_cur == (NSLOT - 1) * SLOTB) ? 0 : sl_cur + SLOTB;
    }
    NSA_FINALIZE(g_win);
#undef NSA_FINALIZE
    asm volatile("s_waitcnt lgkmcnt(0)\n\ts_barrier" ::: "memory");
}

__device__ __forceinline__ void attn_unit(int b, int g, int qt, const Tensors& T_, lds_ptr shm, int tid_) {
    int tid = tid_; asm volatile("" : "+v"(tid));
    const int lane = tid & 63, r32 = lane & 31, hi = lane >> 5; const int wid = __builtin_amdgcn_readfirstlane(tid >> 6);
    const int hh = wid & 3, ts = wid >> 2, tq = ts * 32 + r32;
    const size_t m0 = (size_t)b * T + (size_t)qt * 64;
    const unsigned lds0 = (unsigned)(uintptr_t)shm;
    __attribute__((address_space(3))) float* wsf = (__attribute__((address_space(3))) float*)(shm + LDS_WS) + wid * 128;
    {
        const bf16* Kc = T_.KCV + (size_t)(b * 4 + g) * 128 * 64; const bf16* Vc = Kc + (size_t)8192 * 64;
        const bf16* ksrc = Kc + (size_t)lane * 64 + wid * 8;
        const bf16* vsrc = Vc + (size_t)(16 * (wid & 3) + (lane >> 2)) * 64 + (wid >> 2) * 32 + (lane & 3) * 8;
        const unsigned kdst = lds0 + LDS_K + wid * 1024, vdst = lds0 + LDS_V + wid * 1024;
        glds16(ksrc, (unsigned)__builtin_amdgcn_readfirstlane(kdst)); glds16(vsrc, (unsigned)__builtin_amdgcn_readfirstlane(vdst));
        glds16(ksrc + 64 * 64, (unsigned)__builtin_amdgcn_readfirstlane(kdst + SLOTB)); glds16(vsrc + 64 * 64, (unsigned)__builtin_amdgcn_readfirstlane(vdst + SLOTB));
    }
    bf16x8 qr[4];
    {
        const bf16* Qw = T_.Q + (m0 + ts * 32) * 1024 + (g * 4 + hh) * 64;
#pragma unroll
        for (int d0 = 0; d0 < 4; ++d0) qr[d0] = *reinterpret_cast<const bf16x8*>(&Qw[(size_t)r32 * 1024 + d0 * 16 + hi * 8]);
    }
    const float* gp = T_.GATE + (m0 + tq) * 48 + (g * 4 + hh) * 3;
    const float g_cmp = gp[0], g_sel = gp[1], g_win = gp[2];
    f32x16 otot[2];
    NSA_WAIT_BAR(0);
    {
        const int t = qt * 64 + tq;
        const int ncv = (t >= 31) ? ((t - 31) >> 4) + 1 : 0;
        f32x16 zero = f32x16{}; f32x16 pA0, pA1, pB0, pB1;
        qkt(pA0, pA1, (lds_cptr)(shm + LDS_K), qr, zero, r32, hi);
        qkt(pB0, pB1, (lds_cptr)(shm + LDS_K + SLOTB), qr, zero, r32, hi);
        mask_range(pA0, 4 * hi, 0, ncv - 1); mask_range(pA1, 32 + 4 * hi, 0, ncv - 1); mask_range(pB0, 64 + 4 * hi, 0, ncv - 1); mask_range(pB1, 96 + 4 * hi, 0, ncv - 1);
        const float m = fmaxf(fmaxf(rowmax(pA0, pA1), rowmax(pB0, pB1)), -1e30f);
        float sacc = 0.f;
#pragma unroll
        for (int r = 0; r < 16; ++r) { pA0[r] = __builtin_amdgcn_exp2f(pA0[r] - m); pA1[r] = __builtin_amdgcn_exp2f(pA1[r] - m); pB0[r] = __builtin_amdgcn_exp2f(pB0[r] - m); pB1[r] = __builtin_amdgcn_exp2f(pB1[r] - m);
            sacc += (pA0[r] + pA1[r]) + (pB0[r] + pB1[r]); }
        const float l = xhalf_sum(sacc); const float inv = l > 0.f ? 1.0f / l : 0.f;
#pragma unroll
        for (int r = 0; r < 16; ++r) { pA0[r] *= inv; pA1[r] *= inv; pB0[r] *= inv; pB1[r] *= inv; }
        {
            __attribute__((address_space(3))) float* PI = (__attribute__((address_space(3))) float*)(shm + LDS_PI) + (hh * 64 + tq) * 32;
            float prev_oth = 0.f;
#define NSA_GRP(P, blk) _Pragma("unroll") for (int q4 = 0; q4 < 4; ++q4) { const int k = (blk) * 4 + q4; const float Gs = (P[4 * q4] + P[4 * q4 + 1]) + (P[4 * q4 + 2] + P[4 * q4 + 3]); \
                const float oth = xhalf_other(P[4 * q4 + 3], hi); PI[2 * k + hi] = Gs + (hi ? oth : prev_oth); prev_oth = oth; }
            NSA_GRP(pA0, 0) NSA_GRP(pA1, 1) NSA_GRP(pB0, 2) NSA_GRP(pB1, 3)
#undef NSA_GRP
        }
        otot[0] = f32x16{}; otot[1] = f32x16{};
        const int vb0 = (int)(lds0 + LDS_V) + ((lane >> 4) & 1) * 32 + (lane & 3) * 8 + (4 * hi + ((lane & 15) >> 2)) * 64;
        u32x4 pw0, pw1, pw2, pw3;
        NSA_PACK(pA0, pA1); pv(otot, vb0, NSA_PAF(0), NSA_PAF(1), NSA_PAF(2), NSA_PAF(3));
        NSA_PACK(pB0, pB1); pv(otot, vb0 + SLOTB, NSA_PAF(0), NSA_PAF(1), NSA_PAF(2), NSA_PAF(3));
        if (hi == 0) wsf[r32] = g_cmp;
        asm volatile("s_waitcnt lgkmcnt(0)" ::: "memory");
#pragma unroll
        for (int r = 0; r < 16; ++r) { const float w = wsf[crow(r, hi)]; otot[0][r] *= w; otot[1][r] *= w; }
    }
    asm volatile("s_waitcnt lgkmcnt(0)\n\ts_barrier" ::: "memory");
    const bf16* KVb = T_.KV + (size_t)b * T * NKV + g * 64;
    stream_prologue(lds0, KVb + 2 * 256, KVb + 3 * 256, qt, wid, lane);
    {
        const __attribute__((address_space(3))) float* PI = (const __attribute__((address_space(3))) float*)(shm + LDS_PI);
        __attribute__((address_space(3))) unsigned* IMP = (__attribute__((address_space(3))) unsigned*)(shm + LDS_IMP);
        __attribute__((address_space(3))) unsigned* SELM = (__attribute__((address_space(3))) unsigned*)(shm + LDS_SELM);
#pragma unroll
        for (int it = 0; it < 4; ++it) { const int idx = tid + it * 512, tok = idx >> 5, j = idx & 31;
            float imp = ((PI[(0 * 64 + tok) * 32 + j] + PI[(1 * 64 + tok) * 32 + j]) + PI[(2 * 64 + tok) * 32 + j]) + PI[(3 * 64 + tok) * 32 + j];
            unsigned key = (__float_as_uint(imp) & ~31u) | (unsigned)(31 - j);
            if (j > qt) key = (unsigned)(31 - j);
            if (j == 0 || j == qt || j == qt - 1) key = (__float_as_uint(1e4f) & ~31u) | (unsigned)(31 - j);
            IMP[idx] = key; }
        asm volatile("s_waitcnt lgkmcnt(0)\n\ts_barrier" ::: "memory");
#pragma unroll
        for (int it = 0; it < 4; ++it) { const int idx = tid + it * 512, tok = idx >> 5, j = idx & 31;
            const unsigned mine = IMP[idx]; int rank = 0;
#pragma unroll
            for (int i4 = 0; i4 < 8; ++i4) { const u32x4 o4 = *(const __attribute__((address_space(3))) u32x4*)(IMP + tok * 32 + i4 * 4);
                rank += (o4.x > mine) ? 1 : 0; rank += (o4.y > mine) ? 1 : 0; rank += (o4.z > mine) ? 1 : 0; rank += (o4.w > mine) ? 1 : 0; }
            const unsigned long long bal = __ballot(rank < 16 && j <= qt);
            if (lane == 0) SELM[tok] = (unsigned)bal;
            if (lane == 32) SELM[tok] = (unsigned)(bal >> 32); }
        asm volatile("s_waitcnt lgkmcnt(0)\n\ts_barrier" ::: "memory");
    }
    const unsigned selmask = ((const __attribute__((address_space(3))) unsigned*)(shm + LDS_SELM))[tq];
    flash_stream(shm, lds0, KVb + 2 * 256, KVb + 3 * 256, qt, qr, selmask, tq, g_sel, g_win, otot, wid, lane, r32, hi);
    {
        bf16* Ow = T_.O + (m0 + ts * 32) * 1024 + (g * 4 + hh) * 64;
        __attribute__((address_space(3))) bf16* stg = (__attribute__((address_space(3))) bf16*)(shm + LDS_OST) + wid * 2048;
#pragma unroll
        for (int r = 0; r < 16; ++r) { const int orow = crow(r, hi);
#pragma unroll
            for (int d0 = 0; d0 < 2; ++d0) stg[orow * 64 + d0 * 32 + r32] = (bf16)f2bf(otot[d0][r]); }
        asm volatile("s_waitcnt lgkmcnt(0)" ::: "memory");
#pragma unroll
        for (int i = 0; i < 4; ++i) { const int row = i * 8 + (lane >> 3), ch = lane & 7; const u32x4 v = *(const __attribute__((address_space(3))) u32x4*)(stg + row * 64 + ch * 8); *(u32x4*)(Ow + (size_t)row * 1024 + ch * 8) = v; }
    }
    asm volatile("s_waitcnt lgkmcnt(0)\n\ts_barrier" ::: "memory");
}

__device__ __forceinline__ void attn_phase(const Frame& F, const Tensors& T_) {
    lds_ptr shm = (lds_ptr)(F.lds + RING_OFF);
    for (int v = F.vcu; v < BATCH * 4 * 4; v += F.G) {
        const int bg = v >> 2, s = v & 3;
#pragma unroll 1
        for (int i = 0; i < 8; ++i) { const int qt = (i & 1) ? (8 * (i >> 1) + 7 - s) : (8 * (i >> 1) + s);
            attn_unit(bg >> 2, bg & 3, qt, T_, shm, F.tid); }
    }
}
#undef NSA_SBAR
#undef NSA_WAIT_BAR
#undef NSA_PACK
#undef NSA_PAF
}
namespace sgu {
using nsa::bf16x8; using nsa::s16x4; using nsa::f32x16; using nsa::u32x4;
constexpr int LDS_VT = 0  , LDS_ST = 32768  , LDS_OST = 34816  , LDS_END = LDS_OST + 8 * 4096;
__device__ __forceinline__ void sgu_phase(const Frame& F, const bf16* U, const bf16* V, const float* lng, const float* lnb, const bf16* WS16, const float* bs, bf16* GT) {
    typedef __attribute__((address_space(3))) char* lptr;
    lptr shm = (lptr)(F.lds + RING_OFF);
    __attribute__((address_space(3))) float* st = (__attribute__((address_space(3))) float*)(shm + LDS_ST);
    const unsigned lds0 = (unsigned)(uintptr_t)shm;
    for (int ch = F.vcu; ch < M / 128; ch += F.G) {
        int tid = F.tid; asm volatile("" : "+v"(tid));
        const int lane = tid & 63, r32 = lane & 31, hi = lane >> 5; const int wid = __builtin_amdgcn_readfirstlane(tid >> 6);
        const size_t m0 = (size_t)ch * 128;
#pragma unroll 1
        for (int rb = 0; rb < 16; rb += 4) {
            v4u ra[4], rc[4];
#pragma unroll
            for (int r = 0; r < 4; ++r) { const v4u* vp = (const v4u*)(V + (m0 + wid * 16 + rb + r) * D + lane * 16); ra[r] = vp[0]; rc[r] = vp[1]; }
#pragma unroll
            for (int r = 0; r < 4; ++r) { const int row = wid * 16 + rb + r; const v4u a = ra[r], b = rc[r];
                float xv[16] = {bf_lo(a.x), bf_hi(a.x), bf_lo(a.y), bf_hi(a.y), bf_lo(a.z), bf_hi(a.z), bf_lo(a.w), bf_hi(a.w), bf_lo(b.x), bf_hi(b.x), bf_lo(b.y), bf_hi(b.y), bf_lo(b.z), bf_hi(b.z), bf_lo(b.w), bf_hi(b.w)};
                float s = 0.f, q = 0.f;
#pragma unroll
                for (int e = 0; e < 16; ++e) s += xv[e];
                const float mean = wave_sum(s) * (1.0f / D);
#pragma unroll
                for (int e = 0; e < 16; ++e) { const float d = xv[e] - mean; q += d * d; }
                const float rstd = 1.0f / sqrtf(wave_sum(q) * (1.0f / D) + EPS);
                if (lane == 0) { st[row * 2] = mean; st[row * 2 + 1] = rstd; } }
        }
        asm volatile("s_waitcnt lgkmcnt(0)\n\ts_barrier" ::: "memory");
        const int srow = tid >> 2, c4 = tid & 3;
        const float mean_s = st[srow * 2], rstd_s = st[srow * 2 + 1];
        const int tb = wid >> 1, db0 = (wid & 1) * 2;
        const int nks = 2 * tb + 2;
        const int vb0 = (int)(lds0 + LDS_VT) + ((lane >> 4) & 1) * 32 + (lane & 3) * 8 + (4 * hi + ((lane & 15) >> 2)) * 64;
        v4u vnext[4];
#pragma unroll
        for (int i = 0; i < 4; ++i) vnext[i] = *(const v4u*)(V + (m0 + srow) * D + i * 32 + c4 * 8);
#pragma unroll 1
        for (int g = 0; g < 8; ++g) {
            v4u vcur[4];
#pragma unroll
            for (int i = 0; i < 4; ++i) vcur[i] = vnext[i];
            if (g + 1 < 8) {
#pragma unroll
                for (int i = 0; i < 4; ++i) vnext[i] = *(const v4u*)(V + (m0 + srow) * D + (g + 1) * 128 + i * 32 + c4 * 8); }
            v4u uvv[4];
#pragma unroll
            for (int i = 0; i < 4; ++i) uvv[i] = *(const v4u*)(U + (m0 + tb * 32 + i * 8 + (lane >> 3)) * D + g * 128 + db0 * 32 + (lane & 7) * 8);
            const bf16* wrow = WS16 + ((size_t)g * 128 + tb * 32 + r32) * 128 + 4 * hi;
            v2u af[8][2];
#pragma unroll
            for (int ks = 0; ks < 8; ++ks) if (ks < nks) { af[ks][0] = *(const v2u*)(wrow + ks * 16); af[ks][1] = *(const v2u*)(wrow + ks * 16 + 8); }
#pragma unroll
            for (int i = 0; i < 4; ++i) { const int c = g * 128 + i * 32 + c4 * 8;
                const v4u w = vcur[i];
                const f32x4 g0 = *(const f32x4*)(lng + c), g1 = *(const f32x4*)(lng + c + 4), b0 = *(const f32x4*)(lnb + c), b1 = *(const f32x4*)(lnb + c + 4);
                float x[8] = {bf_lo(w.x), bf_hi(w.x), bf_lo(w.y), bf_hi(w.y), bf_lo(w.z), bf_hi(w.z), bf_lo(w.w), bf_hi(w.w)};
                const float gg[8] = {g0.x, g0.y, g0.z, g0.w, g1.x, g1.y, g1.z, g1.w}, bb[8] = {b0.x, b0.y, b0.z, b0.w, b1.x, b1.y, b1.z, b1.w};
#pragma unroll
                for (int e = 0; e < 8; ++e) x[e] = (x[e] - mean_s) * rstd_s * gg[e] + bb[e];
                v4u o; o.x = pk2(x[0], x[1]); o.y = pk2(x[2], x[3]); o.z = pk2(x[4], x[5]); o.w = pk2(x[6], x[7]);
                *(__attribute__((address_space(3))) v4u*)(shm + LDS_VT + (i * 8 + (srow >> 4)) * 1024 + (srow & 15) * 64 + c4 * 16) = o; }
            asm volatile("s_waitcnt lgkmcnt(0)\n\ts_barrier" ::: "memory");
            f32x16 o[2]; o[0] = f32x16{}; o[1] = f32x16{};
#pragma unroll
            for (int ks = 0; ks < 8; ++ks) if (ks < nks) {
                const bf16x8 a = __builtin_bit_cast(bf16x8, (v4u){af[ks][0].x, af[ks][0].y, af[ks][1].x, af[ks][1].y});
#pragma unroll
                for (int dd = 0; dd < 2; ++dd) { s16x4 lo, hi4; const int vb = vb0 + ((db0 + dd) * 8 + ks) * 1024;
                    asm volatile("ds_read_b64_tr_b16 %0,%1" : "=&v"(lo) : "v"(vb) : "memory");
                    asm volatile("ds_read_b64_tr_b16 %0,%1 offset:512" : "=&v"(hi4) : "v"(vb) : "memory");
                    asm volatile("s_waitcnt lgkmcnt(0)" ::: "memory");
                    const bf16x8 bfr = (bf16x8){lo[0], lo[1], lo[2], lo[3], hi4[0], hi4[1], hi4[2], hi4[3]};
                    o[dd] = __builtin_amdgcn_mfma_f32_32x32x16_bf16(a, bfr, o[dd], 0, 0, 0); } }
            __attribute__((address_space(3))) bf16* stg = (__attribute__((address_space(3))) bf16*)(shm + LDS_OST) + wid * 2048;
#pragma unroll
            for (int r = 0; r < 16; ++r) { const int orow = nsa::crow(r, hi); const float bias = bs[g * 128 + tb * 32 + orow];
#pragma unroll
                for (int dd = 0; dd < 2; ++dd) stg[orow * 64 + dd * 32 + r32] = (bf16)f2bf(o[dd][r] + bias); }
            asm volatile("s_waitcnt lgkmcnt(0)" ::: "memory");
#pragma unroll
            for (int i = 0; i < 4; ++i) { const int row = i * 8 + (lane >> 3), chn = lane & 7;
                const v4u mv = *(const __attribute__((address_space(3))) v4u*)(stg + row * 64 + chn * 8);
                const size_t gi = (m0 + tb * 32 + row) * D + g * 128 + db0 * 32 + chn * 8;
                const v4u uv = uvv[i];
                v4u ov; ov.x = pk2(bf_lo(mv.x) * bf_lo(uv.x), bf_hi(mv.x) * bf_hi(uv.x)); ov.y = pk2(bf_lo(mv.y) * bf_lo(uv.y), bf_hi(mv.y) * bf_hi(uv.y));
                ov.z = pk2(bf_lo(mv.z) * bf_lo(uv.z), bf_hi(mv.z) * bf_hi(uv.z)); ov.w = pk2(bf_lo(mv.w) * bf_lo(uv.w), bf_hi(mv.w) * bf_hi(uv.w));
                *(v4u*)(GT + gi) = ov; }
            asm volatile("s_waitcnt lgkmcnt(0)\n\ts_barrier" ::: "memory");
        }
    }
}
}
__global__ void __launch_bounds__(NWAVES * 64, 2) fwd(Args args) {
    extern __shared__ __attribute__((aligned(16))) unsigned char lds[];
    Frame F;
    F.lds = (LAS unsigned char*)lds;
    volatile LAS unsigned* MISC = (volatile LAS unsigned*)(F.lds + MISC_OFF);
    F.tid = threadIdx.x; F.lane = F.tid & 63; F.wave = __builtin_amdgcn_readfirstlane(F.tid >> 6);
    F.G = gridDim.x; { const int bx = blockIdx.x; F.vcu = (F.G % 8 == 0) ? (bx % 8) * (F.G / 8) + bx / 8 : bx; }
    for (int u = F.tid; u < (LDS_BYTES - LDSCTL_OFF) / 4; u += NWAVES * 64) ((LAS unsigned*)(F.lds + LDSCTL_OFF))[u] = 0u;
    __syncthreads();
#if !MK_MULTI
    XcdBarrier bar = xcd_barrier_post((unsigned*)(args.ws + WS_CTL) + CW_BAR, MISC + 8);
    if (threadIdx.x == 0) (void)__hip_atomic_fetch_or((unsigned*)(args.ws + WS_CTL) + CW_GRP + 64 * (F.vcu / GRP_WGS) + 32, 1u << bar.x, RLX_AGENT);
#define GRID_BAR() xcd_barrier(bar)
#define GRP_BAR() grp_barrier((unsigned*)(ws + WS_CTL) + CW_GRP + 64 * grp, (unsigned*)(ws + WS_CTL) + CW_BAR)
#else
#define GRID_BAR() do {} while (0)
#define GRP_BAR() do {} while (0)
#endif
    const int lo = args.ph_lo, hi = args.ph_hi;
    int ph = 0;
#define PH_BEGIN if (ph >= lo && ph < hi) { Frame Fp = F; asm volatile("" : "+v"(Fp.tid), "+v"(Fp.lane)); \
        kargs_t KA = (kargs_t)__builtin_amdgcn_kernarg_segment_ptr(); asm volatile("" : "+s"(KA)); \
        unsigned char* const ws = KA->ws; LAS unsigned char* const ring = Fp.lds + RING_OFF; const int grp = Fp.vcu / GRP_WGS, lc = Fp.vcu % GRP_WGS; const size_t R0 = (size_t)grp * GROWS; (void)ws; (void)ring; (void)lc; (void)R0;
#define PH_END   if (ph + 1 < hi) GRP_BAR(); } ++ph;
#define PH_END_GRID   if (ph + 1 < hi) GRID_BAR(); } ++ph;
#define P_MOD   ((float*)(ws + WS_MOD))
#define P_KVMOD (P_MOD + (size_t)4 * 16 * 6144)
#define P_CB1   ((float*)(ws + WS_CB1))
#define P_GATE  ((float*)(ws + WS_GATE))
#define P_KCV   ((bf16*)(ws + WS_KCV))
#define P_WB    ((bf16*)(ws + WS_W))
#define P_KV    ((bf16*)(ws + WS_KV))
#define P_XB    ((bf16*)(ws + WS_HB))
#define P_Y     ((bf16*)(ws + WS_Y))
#define P_HB    ((bf16*)KA->out + (size_t)grp * (4u << 20))
#define P_BIGW  ((bf16*)(ws + WS_BIG) + (size_t)grp * (8u << 20))
#define P_U     ((bf16*)(ws + WS_BIG) + (size_t)grp * (4u << 20))
#define P_V     (P_U + (4u << 20))
#define P_Q     P_U
#define P_O     P_V
#define P_HKV   P_O
#define P_NG(L, i) (KA->in[4] + ((L) * 4 + (i)) * 1024)

    PH_BEGIN p0_prologue(Fp, KA); PH_END_GRID
    PH_BEGIN norm_phase<false, true, false, false, false>(Fp, KA->in[0], nullptr, nullptr, nullptr, nullptr, P_NG(0, 0), P_MOD + 0, P_MOD + 1024, 6144, P_HB, nullptr, nullptr, nullptr, 0, nullptr); PH_END

#pragma unroll 1
    for (int L = 0; L < DEPTH; ++L) {
        if (L < 2) {
            PH_BEGIN {
                pg8::Gemm g = pg8::make_gemm(P_HB + R0 * D, P_WB + WO_AIN + (size_t)L * 2048 * 1024, GROWS, 2048, D); pg8::GroupOrder S; S.init(GROWS, 2048, GRP_WGS, lc);
                pg8::EpiBf16<2> E{P_U + R0 * D, D, nullptr, 1024, (size_t)(4u << 20), 1.f};
                pg8::gemm_phase<pg8::EpiBf16<2>, pg8::GroupOrder, true, true>(ring, g, S, E);
            } PH_END
            PH_BEGIN sgu::sgu_phase(Fp, P_U, P_V, KA->in[6] + L * 1024, KA->in[7] + L * 1024, P_WB + WO_WS + (size_t)L * 8 * 128 * 128, KA->in[9] + L * 8 * 128, P_HB); PH_END
            PH_BEGIN {
                pg8::Gemm g = pg8::make_gemm(P_HB + R0 * D, P_WB + WO_AOUT + (size_t)L * 1024 * 1024, GROWS, D, D); pg8::GroupOrder S; S.init(GROWS, D, GRP_WGS, lc);
                pg8::EpiBf16<0> E{P_Y + R0 * D, D, nullptr, 0, 0, 1.f};
                pg8::gemm_phase<pg8::EpiBf16<0>, pg8::GroupOrder, true, true>(ring, g, S, E);
            } PH_END
        } else {
            if (L == 2) {
                PH_BEGIN {
                    pg8::Gemm g = pg8::make_gemm(P_HKV + R0 * D, P_WB + WO_KV, GROWS, NKV, D); pg8::GroupOrder S; S.init(GROWS, NKV, GRP_WGS, lc);
                    pg8::EpiBf16<0> E{P_KV + R0 * NKV, NKV, nullptr, 0, 0, 1.f};
                    pg8::gemm_phase<pg8::EpiBf16<0>, pg8::GroupOrder, true, true>(ring, g, S, E);
                } PH_END
            }
            PH_BEGIN {
                {
                    pg8::Gemm g = pg8::make_gemm(P_HB + R0 * D, P_WB + WO_BIN + (size_t)(L - 2) * NQG * 1024, GROWS, NQG, D); pg8::GroupOrder S; S.init(GROWS, NQG, GRP_WGS, lc);
                    pg8::EpiQG E{P_Q + R0 * D, P_GATE + R0 * 48, 0.125f * 1.4426950408889634f};
                    pg8::gemm_phase<pg8::EpiQG, pg8::GroupOrder, true, true>(ring, g, S, E);
                }
                if (L == 2) {
#pragma unroll 1
                    for (int q = 0; q < 4; ++q) { const int j = q >> 1, kh = q & 1;
                        pg8::Gemm g; g.A = P_KV + (size_t)(2 * grp) * T * NKV + j * 256 + (size_t)kh * 16 * NKV; g.Bt = P_WB + WO_C1 + (size_t)j * 256 * 2048 + kh * 1024; g.M = 1024; g.N = 256; g.K = 1024; g.ldb = 2048;
                        g.a_rs = 16u * NKV * 2u; g.a_hstep = 64 * 2; g.a_kstep = (size_t)NKV * 2; g.a_t1 = (size_t)T * NKV * 2; g.a_t0 = 128 * 2; g.a_sh = 1; g.stagger_ticks = 0;
                        pg8::GroupOrder S; S.init(1024, 256, GRP_WGS, (lc + GRP_WGS - 16 - 4 * q) % GRP_WGS);
                        pg8::EpiF32 E{(float*)(ws + WS_Y + (size_t)grp * (8u << 20)) + (size_t)q * 1024 * 256, 256};
                        pg8::gemm_phase<pg8::EpiF32, pg8::GroupOrder, true, true>(ring, g, S, E);
                    }
                }
            } PH_END
            if (L == 2) {
                PH_BEGIN cmp2_phase(Fp, (const float*)P_Y, P_CB1, KA->in[18], KA->in[19], P_KCV); PH_END
            }
            PH_BEGIN { const nsa::Tensors AT{P_Q, P_GATE, P_KCV, P_KV, P_O}; nsa::attn_phase(Fp, AT); } PH_END
            PH_BEGIN {
                pg8::Gemm g = pg8::make_gemm(P_O + R0 * D, P_WB + WO_BOUT + (size_t)(L - 2) * 1024 * 1024, GROWS, D, D); pg8::GroupOrder S; S.init(GROWS, D, GRP_WGS, lc);
                pg8::EpiBf16<0> E{P_Y + R0 * D, D, nullptr, 0, 0, 1.f};
                pg8::gemm_phase<pg8::EpiBf16<0>, pg8::GroupOrder, true, true>(ring, g, S, E);
            } PH_END
        }
        PH_BEGIN { const float* modL = P_MOD + (size_t)L * 16 * 6144;
            if (L == 0) norm_phase<true, true, false, false, true>(Fp, KA->in[0], P_XB, P_Y, P_NG(L, 1), modL + 2 * 1024, P_NG(L, 2), modL + 3 * 1024, modL + 4 * 1024, 6144, P_HB, nullptr, nullptr, nullptr, 0, nullptr);
            else norm_phase<true, true, false, true, true>(Fp, P_XB, P_XB, P_Y, P_NG(L, 1), modL + 2 * 1024, P_NG(L, 2), modL + 3 * 1024, modL + 4 * 1024, 6144, P_HB, nullptr, nullptr, nullptr, 0, nullptr); } PH_END
#pragma unroll 1
        for (int hf = 0; hf < 2; ++hf) {
            PH_BEGIN {
                pg8::Gemm g = pg8::make_gemm(P_HB + (R0 + (size_t)hf * T) * D, P_WB + WO_FIN + (size_t)L * 4096 * 1024, T, FF, D); pg8::GroupOrder S; S.init(T, FF, GRP_WGS, lc);
                pg8::EpiBf16<3> E{P_BIGW, FF, nullptr, 0, 0, 1.f};
                pg8::gemm_phase<pg8::EpiBf16<3>, pg8::GroupOrder, true, true>(ring, g, S, E);
            } PH_END
            PH_BEGIN {
                pg8::Gemm g = pg8::make_gemm(P_BIGW, P_WB + WO_FOUT + (size_t)L * 1024 * 4096, T, D, FF); pg8::GroupOrder S; S.init(T, D, GRP_WGS, lc);
                pg8::EpiBf16<0> E{P_Y + (R0 + (size_t)hf * T) * D, D, nullptr, 0, 0, 1.f};
                pg8::gemm_phase<pg8::EpiBf16<0>, pg8::GroupOrder, true, true>(ring, g, S, E);
            } PH_END
        }
        PH_BEGIN {
            const float* modL = P_MOD + (size_t)L * 16 * 6144;
            const float* gy = P_NG(L, 3); const float* gate = modL + 5 * 1024;
            if (L == 3) norm_phase<true, false, false, true, false>(Fp, P_XB, KA->out, P_Y, gy, gate, nullptr, nullptr, nullptr, 6144, nullptr, nullptr, nullptr, nullptr, 0, nullptr);
            else { const float* modN = P_MOD + (size_t)(L + 1) * 16 * 6144; const float* gn = P_NG(L + 1, 0);
                if (L == 1) norm_phase<true, true, true, true, true>(Fp, P_XB, P_XB, P_Y, gy, gate, gn, modN + 0, modN + 1024, 6144, P_HB, KA->in[13], P_KVMOD + 0, P_KVMOD + 1024, 2048, P_HKV);
                else norm_phase<true, true, false, true, true>(Fp, P_XB, P_XB, P_Y, gy, gate, gn, modN + 0, modN + 1024, 6144, P_HB, nullptr, nullptr, nullptr, 0, nullptr); }
        } PH_END
    }
#undef PH_BEGIN
#undef PH_END
#undef PH_END_GRID
#undef GRID_BAR
#undef GRP_BAR
}

extern "C" void kernel_launch(void* const* d_in, const int* in_sizes, int n_in, void* d_out, int out_size, void* d_ws, size_t ws_size, hipStream_t stream) {
    static int grid = 0;
    if (grid == 0) {
        if (n_in != 24 || out_size != M * D || ws_size < WS_END) { fprintf(stderr, "kernel_launch: unexpected shapes (n_in %d, out %d, ws %zu)\n", n_in, out_size, ws_size); grid = -1; return; }
        int dev = 0, cus = 0, per_cu = 0;
        if (hipGetDevice(&dev) != hipSuccess || hipDeviceGetAttribute(&cus, hipDeviceAttributeMultiprocessorCount, dev) != hipSuccess) { grid = -1; return; }
        if (hipFuncSetAttribute((const void*)fwd, hipFuncAttributeMaxDynamicSharedMemorySize, LDS_BYTES) != hipSuccess) { grid = -1; return; }
        if (hipOccupancyMaxActiveBlocksPerMultiprocessor(&per_cu, (const void*)fwd, NWAVES * 64, LDS_BYTES) != hipSuccess || per_cu < 1)
            fprintf(stderr, "kernel_launch: occupancy query reports %d workgroups per CU\n", per_cu);
        (void)hipGetLastError();
        grid = cus;
        if (grid != NGRP * GRP_WGS) { fprintf(stderr, "kernel_launch: %d CUs, this build deals the work to %d workgroups\n", cus, NGRP * GRP_WGS); grid = -1; return; }
    }
    if (grid < 0) return;
    if (hipMemsetAsync((char*)d_ws + WS_CTL, 0, CTL_ZERO_BYTES, stream) != hipSuccess) return;
    Args a{};
    for (int i = 0; i < 24; ++i) a.in[i] = (const float*)d_in[i];
    a.out = (float*)d_out; a.ws = (unsigned char*)d_ws;
#if MK_MULTI
    static const int probe[] = {PROBE_PHASES, -1};
    for (int p = 0; p < 40; ++p) { a.ph_lo = p; a.ph_hi = p + 1; int n = 1; for (int k = 0; probe[k] >= 0; ++k) if (probe[k] == p) n += PROBE_REPS;
        for (int r = 0; r < n; ++r) hipLaunchKernelGGL(fwd, dim3(grid), dim3(NWAVES * 64), LDS_BYTES, stream, a); }
#else
    a.ph_lo = 0; a.ph_hi = 1000; hipLaunchKernelGGL(fwd, dim3(grid), dim3(NWAVES * 64), LDS_BYTES, stream, a);
#endif
}
```

```cpp
#include <hip/hip_runtime.h>
#include <cstdio>
#include <cstdint>
#include <cmath>
#define MK_MULTI 0
#define PROBE_PHASES -1
#define PROBE_REPS 2
#define PROBE_ATT 0
#define STAGGER_FIN 0
namespace pg8 {
#define PG8_LAS __attribute__((address_space(3)))
typedef unsigned short bf16_t;
typedef short bf16x8 __attribute__((ext_vector_type(8)));
typedef float f32x4 __attribute__((ext_vector_type(4)));
typedef unsigned u32x4 __attribute__((ext_vector_type(4)));
constexpr int BM = 256, BK = 64, HALF = 128, HTB = HALF * BK * 2  , STAGE_BYTES = 8 * HTB, NXCD = 8, WGM = 8;

__host__ __device__ __forceinline__ int lds_byte(int r, int c) { const int st = (r >> 4) * 2 + (c >> 5), rr = r & 15, cc = c & 31, ob = rr * 64 + cc * 2; return st * 1024 + (ob ^ (((ob >> 9) & 1) << 5)); }
__host__ __device__ __forceinline__ void stage_rc(int b, int& R, int& C) { const int st = b / 1024, sb = b % 1024, swz = sb ^ (((sb >> 9) & 1) << 5); R = (st >> 1) * 16 + swz / 64; C = (st & 1) * 32 + (swz % 64) / 2; }
__host__ __device__ __forceinline__ int perm32(int rho) { const int n = rho >> 4, i = rho & 15; return 8 * (i >> 2) + 4 * n + (i & 3); }

struct Unit { int pm, pn; };
struct Gemm { const bf16_t* A; const bf16_t* Bt; int M, N, K; unsigned a_rs; size_t a_hstep, a_kstep, a_t1, a_t0; int a_sh; int ldb; int stagger_ticks; };
__device__ __forceinline__ Gemm make_gemm(const bf16_t* A, const bf16_t* Bt, int M, int N, int K) {
    Gemm g; g.A = A; g.Bt = Bt; g.M = M; g.N = N; g.K = K; g.a_rs = (unsigned)K * 2u; g.a_hstep = (size_t)HALF * K * 2; g.a_kstep = BK * 2; g.a_t1 = (size_t)BM * K * 2; g.a_t0 = 0; g.a_sh = 0; g.ldb = K; g.stagger_ticks = 0; return g; }

struct StaticOrder {
    int nM, nN, nwg, G, c;
    __host__ __device__ void init(int M, int N, int G_, int c_) { nM = M / BM; nN = N / BM; nwg = nM * nN; G = G_; c = c_; }
    __host__ __device__ bool next(int i, Unit& u) const {
        const long L = (long)i * G + c; if (L >= nwg) return false;
        int wgid = (int)L; { const int q = nwg / NXCD, r = nwg % NXCD, xcd = wgid % NXCD, off = wgid / NXCD; wgid = (xcd < r ? xcd * (q + 1) : r * (q + 1) + (xcd - r) * q) + off; }
        const int nig = WGM * nN, gid = wgid / nig, fm = gid * WGM, gsz = (nM - fm) < WGM ? (nM - fm) : WGM;
        u.pm = fm + ((wgid % nig) % gsz); u.pn = (wgid % nig) / gsz; return true;
    }
    __device__ __forceinline__ void a_ready(const Unit&) const {}
    __device__ __forceinline__ void done(const Unit&) const {}
};
struct GroupOrder {
    int nM, nN, nwg, G, c;
    __host__ __device__ void init(int M, int N, int G_, int c_) { nM = M / BM; nN = N / BM; nwg = nM * nN; G = G_; c = c_; }
    __host__ __device__ bool next(int i, Unit& u) const {
        const int wgid = i * G + c; if (wgid >= nwg) return false;
        const int nig = WGM * nN, gid = wgid / nig, fm = gid * WGM, gsz = (nM - fm) < WGM ? (nM - fm) : WGM;
        u.pm = fm + ((wgid % nig) % gsz); u.pn = (wgid % nig) / gsz; return true;
    }
    __device__ __forceinline__ void a_ready(const Unit&) const {}
    __device__ __forceinline__ void done(const Unit&) const {}
};

__device__ __forceinline__ unsigned cvt_pk_bf16(float lo, float hi) { unsigned r; asm volatile("v_cvt_pk_bf16_f32 %0, %1, %2" : "=v"(r) : "v"(lo), "v"(hi)); return r; }
__device__ __forceinline__ float gelu_tanh(float v) {
    const float u = v * (0.7978845608028654f + 0.035677408136300125f * v * v);
    const float e = __builtin_amdgcn_exp2f(u * -2.8853900817779268f);
    return v * __builtin_amdgcn_rcpf(1.0f + e);
}
template <int ACT> __device__ __forceinline__ float act_fn(float v) {
    if (ACT == 2) return gelu_tanh(v);
    if (ACT == 3) { const float r = v > 0.f ? v : 0.f; return r * r; }
    return v;
}

template <int ACT  > struct EpiBf16 {
    static constexpr bool PERM = true, AFTER_DRAIN = false;
    bf16_t* O; int ldc; const float* bias; int split_cols; size_t split_stride; float scale0;
    __device__ __forceinline__ void operator()(const f32x4 (&acc)[2][2][4][2], const Unit& u, int wr, int wc, int fr, int fq) const {
        const int row0 = u.pm * BM + wr * 64 + fr; int colt = u.pn * BM; bf16_t* base = O;
        float sc = 1.f; if (split_cols) { const int t = colt / split_cols; base += (size_t)t * split_stride; colt -= t * split_cols; if (t == 0) sc = scale0; }
        const int col0 = colt + wc * 32 + 8 * fq, bcol0 = u.pn * BM + wc * 32 + 8 * fq;
        f32x4 bv[2][2];
#pragma unroll
        for (int bj = 0; bj < 2; ++bj)
#pragma unroll
            for (int n = 0; n < 2; ++n) bv[bj][n] = bias ? *(const f32x4*)(bias + bcol0 + bj * HALF + 4 * n) : (f32x4){0.f, 0.f, 0.f, 0.f};
#pragma unroll
        for (int ai = 0; ai < 2; ++ai)
#pragma unroll
            for (int m = 0; m < 4; ++m) { bf16_t* rowp = base + (size_t)(row0 + ai * HALF + m * 16) * ldc + col0;
#pragma unroll
                for (int bj = 0; bj < 2; ++bj) { f32x4 v0 = acc[ai][bj][m][0] + bv[bj][0], v1 = acc[ai][bj][m][1] + bv[bj][1];
                    if (ACT != 0) {
#pragma unroll
                        for (int e = 0; e < 4; ++e) { v0[e] = act_fn<ACT>(v0[e]); v1[e] = act_fn<ACT>(v1[e]); } }
                    v0 = v0 * sc; v1 = v1 * sc; u32x4 w; w.x = cvt_pk_bf16(v0[0], v0[1]); w.y = cvt_pk_bf16(v0[2], v0[3]); w.z = cvt_pk_bf16(v1[0], v1[1]); w.w = cvt_pk_bf16(v1[2], v1[3]);
                    *(u32x4*)(rowp + bj * HALF) = w; } }
    }
};
struct EpiF32 {
    static constexpr bool PERM = false, AFTER_DRAIN = false;
    float* O; int ldc;
    __device__ __forceinline__ void operator()(const f32x4 (&acc)[2][2][4][2], const Unit& u, int wr, int wc, int fr, int fq) const {
        const int row0 = u.pm * BM + wr * 64 + fr, col0 = u.pn * BM + wc * 32 + 4 * fq;
#pragma unroll
        for (int ai = 0; ai < 2; ++ai)
#pragma unroll
            for (int m = 0; m < 4; ++m) { float* rowp = O + (size_t)(row0 + ai * HALF + m * 16) * ldc + col0;
#pragma unroll
                for (int bj = 0; bj < 2; ++bj)
#pragma unroll
                    for (int n = 0; n < 2; ++n) *(f32x4*)(rowp + bj * HALF + n * 16) = acc[ai][bj][m][n]; }
    }
};
struct EpiQG {
    static constexpr bool PERM = true, AFTER_DRAIN = false;
    bf16_t* Q; float* G; float qscale;
    __device__ __forceinline__ void operator()(const f32x4 (&acc)[2][2][4][2], const Unit& u, int wr, int wc, int fr, int fq) const {
        const int row0 = u.pm * BM + wr * 64 + fr;
        if (u.pn < 4) {
            const int col0 = u.pn * BM + wc * 32 + 8 * fq;
#pragma unroll
            for (int ai = 0; ai < 2; ++ai)
#pragma unroll
                for (int m = 0; m < 4; ++m) { bf16_t* rowp = Q + (size_t)(row0 + ai * HALF + m * 16) * 1024 + col0;
#pragma unroll
                    for (int bj = 0; bj < 2; ++bj) { const f32x4 v0 = acc[ai][bj][m][0] * qscale, v1 = acc[ai][bj][m][1] * qscale;
                        u32x4 w; w.x = cvt_pk_bf16(v0[0], v0[1]); w.y = cvt_pk_bf16(v0[2], v0[3]); w.z = cvt_pk_bf16(v1[0], v1[1]); w.w = cvt_pk_bf16(v1[2], v1[3]);
                        *(u32x4*)(rowp + bj * HALF) = w; } }
        } else if (wc < 2) {
#pragma unroll
            for (int ai = 0; ai < 2; ++ai)
#pragma unroll
                for (int m = 0; m < 4; ++m) { float* rowp = G + (size_t)(row0 + ai * HALF + m * 16) * 48;
#pragma unroll
                    for (int n = 0; n < 2; ++n) { const int col = wc * 32 + 8 * fq + 4 * n;
                        if (col < 48) { f32x4 v = acc[ai][0][m][n];
#pragma unroll
                            for (int e = 0; e < 4; ++e) v[e] = __builtin_amdgcn_rcpf(1.0f + __builtin_amdgcn_exp2f(v[e] * -1.4426950408889634f));
                            *(f32x4*)(rowp + col) = v; } } }
        }
    }
};

template <class Epi, class Sched, bool ALIGN_EPI = false, bool SP2 = false>
__device__ __forceinline__ void gemm_phase(PG8_LAS unsigned char* lds, const Gemm g, const Sched& S, const Epi& E) {
    int tid_ = threadIdx.x; asm volatile("" : "+v"(tid_));
    const int tid = tid_, wid = __builtin_amdgcn_readfirstlane(tid >> 6), lane = tid & 63, wr = wid >> 2, wc = wid & 3, fr = lane & 15, fq = lane >> 4;
    const int K = g.K, nt = K / BK;
    unsigned voffA[2], voffB[2];
#pragma unroll
    for (int i = 0; i < 2; ++i) { int R, C; stage_rc(tid * 16 + i * 8192, R, C); const int Rb = Epi::PERM ? ((R & ~31) + perm32(R & 31)) : R;
        voffA[i] = (unsigned)R * g.a_rs + (unsigned)C * 2u; voffB[i] = (unsigned)(Rb * g.ldb + C) * 2u; }
    const size_t kstepA = g.a_kstep, kstepB = (size_t)(BK * 2);
    const size_t hstepA = g.a_hstep, hstepB = (size_t)HALF * g.ldb * 2;
    const size_t tstepB = 2 * hstepB;
    const int a_msk = (1 << g.a_sh) - 1;
#define PG8_ATILE(pm) ((const char*)g.A + (size_t)((pm) >> g.a_sh) * g.a_t1 + (size_t)((pm) & a_msk) * g.a_t0)
    const unsigned ldsw = (unsigned)wid * 1024u;
    const int aoff = lds_byte(wr * 64 + fr, fq * 8), boff = lds_byte(wc * 32 + fr, fq * 8);
#define PG8_SA(b, h) (((b) * 2 + (h)) * HTB)
#define PG8_SB(b, h) ((4 + (b) * 2 + (h)) * HTB)
#define PG8_STAGE(bufoff, gbase, voff) do { _Pragma("unroll") for (int _i = 0; _i < 2; ++_i) \
        __builtin_amdgcn_global_load_lds((const unsigned*)((const char*)(gbase) + (voff)[_i]), (PG8_LAS unsigned*)(lds + (bufoff) + ldsw + _i * 8192), 16, 0, 0); } while (0)
#define PG8_LDA(dst, b, h) do { _Pragma("unroll") for (int m = 0; m < 4; ++m) _Pragma("unroll") for (int k = 0; k < 2; ++k) dst[m][k] = *(const PG8_LAS bf16x8*)(lds + PG8_SA(b, h) + aoff + m * 2048 + k * 1024); } while (0)
#define PG8_LDB(dst, b, h) do { _Pragma("unroll") for (int n = 0; n < 2; ++n) _Pragma("unroll") for (int k = 0; k < 2; ++k) dst[n][k] = *(const PG8_LAS bf16x8*)(lds + PG8_SB(b, h) + boff + n * 2048 + k * 1024); } while (0)
#define PG8_MMA(ai, bj, At, Bt) do { __builtin_amdgcn_s_setprio(1); _Pragma("unroll") for (int m = 0; m < 4; ++m) _Pragma("unroll") for (int n = 0; n < 2; ++n) _Pragma("unroll") for (int k = 0; k < 2; ++k) \
        acc[ai][bj][m][n] = __builtin_amdgcn_mfma_f32_16x16x32_bf16(Bt[n][k], At[m][k], acc[ai][bj][m][n], 0, 0, 0); __builtin_amdgcn_s_setprio(0); } while (0)
#define PG8_WAIT_V(n) asm volatile("s_waitcnt vmcnt(" #n ")" ::: "memory")
#define PG8_WAIT_L(n) asm volatile("s_waitcnt lgkmcnt(" #n ")" ::: "memory")
#define PG8_BAR __builtin_amdgcn_s_barrier()
#define PG8_SCHED __builtin_amdgcn_sched_barrier(0)
    Unit cur, nxt; int ui = 0;
    if (!S.next(0, cur)) return;
    if (g.stagger_ticks > 0) {
        const unsigned long long t0 = __builtin_amdgcn_s_memrealtime(); const unsigned long long dt = (unsigned long long)(((unsigned)blockIdx.x >> 3) & 3u) * (unsigned)g.stagger_ticks;
        while (__builtin_amdgcn_s_memrealtime() - t0 < dt) __builtin_amdgcn_s_sleep(4);
    }
    f32x4 acc[2][2][4][2];
#pragma unroll
    for (int a = 0; a < 2; ++a)
#pragma unroll
        for (int b = 0; b < 2; ++b)
#pragma unroll
            for (int m = 0; m < 4; ++m)
#pragma unroll
                for (int n = 0; n < 2; ++n) acc[a][b][m][n] = (f32x4){0.f, 0.f, 0.f, 0.f};
    bf16x8 At[4][2], B0[2][2], B1[2][2];
    const char* cA = PG8_ATILE(cur.pm); const char* cB = (const char*)g.Bt + (size_t)cur.pn * tstepB;
    S.a_ready(cur);
    if constexpr (SP2) {
        PG8_STAGE(PG8_SB(0, 0), cB, voffB); PG8_STAGE(PG8_SB(0, 1), cB + hstepB, voffB); PG8_STAGE(PG8_SA(0, 0), cA, voffA); PG8_STAGE(PG8_SA(0, 1), cA + hstepA, voffA);
        if (wr == 1) PG8_BAR;
        PG8_WAIT_V(2); PG8_BAR;
        PG8_STAGE(PG8_SB(1, 0), cB + kstepB, voffB); PG8_STAGE(PG8_SA(1, 0), cA + kstepA, voffA); PG8_STAGE(PG8_SB(1, 1), cB + hstepB + kstepB, voffB);
        PG8_WAIT_V(6); PG8_BAR;
    } else {
        PG8_STAGE(PG8_SB(0, 0), cB, voffB); PG8_STAGE(PG8_SA(0, 0), cA, voffA); PG8_STAGE(PG8_SB(0, 1), cB + hstepB, voffB); PG8_STAGE(PG8_SA(0, 1), cA + hstepA, voffA);
        if (wr == 1) PG8_BAR;
        PG8_WAIT_V(4); PG8_BAR;
        PG8_STAGE(PG8_SB(1, 0), cB + kstepB, voffB); PG8_STAGE(PG8_SA(1, 0), cA + kstepA, voffA); PG8_STAGE(PG8_SB(1, 1), cB + hstepB + kstepB, voffB);
        PG8_WAIT_V(6); PG8_BAR;
    }
    for (;;) {
        const bool has_next = S.next(ui + 1, nxt);
        const char* nA = has_next ? PG8_ATILE(nxt.pm) : cA; const char* nB = has_next ? (const char*)g.Bt + (size_t)nxt.pn * tstepB : cB;
        for (int t = 0; t < nt; t += 2) {
            const bool last = (t == nt - 2);
            const char* a1 = cA + (size_t)(t + 1) * kstepA;
            const char* a2 = last ? nA : cA + (size_t)(t + 2) * kstepA; const char* b2 = last ? nB : cB + (size_t)(t + 2) * kstepB;
            const char* a3 = a2 + kstepA; const char* b3 = b2 + kstepB;
            if (last && has_next) S.a_ready(nxt);
            if constexpr (SP2) {
            PG8_LDB(B0, 0, 0); PG8_LDB(B1, 0, 1); PG8_SCHED; PG8_LDA(At, 0, 0); PG8_STAGE(PG8_SA(1, 1), a1 + hstepA, voffA);
            PG8_WAIT_V(8); PG8_WAIT_L(0); PG8_BAR; PG8_MMA(0, 0, At, B0); PG8_MMA(0, 1, At, B1); PG8_BAR; PG8_SCHED;
            PG8_LDA(At, 0, 1); PG8_STAGE(PG8_SB(0, 0), b2, voffB); PG8_STAGE(PG8_SB(0, 1), b2 + hstepB, voffB); PG8_STAGE(PG8_SA(0, 0), a2, voffA);
            PG8_WAIT_V(8); PG8_WAIT_L(0); PG8_BAR; PG8_MMA(1, 0, At, B0); PG8_MMA(1, 1, At, B1); PG8_BAR; PG8_SCHED;
            PG8_LDB(B0, 1, 0); PG8_LDB(B1, 1, 1); PG8_SCHED; PG8_LDA(At, 1, 0); PG8_STAGE(PG8_SA(0, 1), a2 + hstepA, voffA);
            PG8_WAIT_V(8); PG8_WAIT_L(0); PG8_BAR; PG8_MMA(0, 0, At, B0); PG8_MMA(0, 1, At, B1); PG8_BAR; PG8_SCHED;
            PG8_LDA(At, 1, 1); PG8_STAGE(PG8_SB(1, 0), b3, voffB); PG8_STAGE(PG8_SB(1, 1), b3 + hstepB, voffB); PG8_STAGE(PG8_SA(1, 0), a3, voffA);
            PG8_WAIT_V(8); PG8_WAIT_L(0); PG8_BAR; PG8_MMA(1, 0, At, B0); PG8_MMA(1, 1, At, B1); PG8_BAR; PG8_SCHED;
            } else {
            PG8_LDB(B0, 0, 0); PG8_SCHED; PG8_LDA(At, 0, 0); PG8_STAGE(PG8_SA(1, 1), a1 + hstepA, voffA);
            PG8_WAIT_L(8); PG8_BAR; PG8_WAIT_L(0); PG8_MMA(0, 0, At, B0); PG8_BAR; PG8_SCHED;
            PG8_LDB(B1, 0, 1); PG8_STAGE(PG8_SB(0, 0), b2, voffB);
            PG8_BAR; PG8_WAIT_L(0); PG8_MMA(0, 1, At, B1); PG8_BAR;
            PG8_LDA(At, 0, 1); PG8_STAGE(PG8_SA(0, 0), a2, voffA);
            PG8_BAR; PG8_WAIT_L(0); PG8_MMA(1, 0, At, B0); PG8_BAR; PG8_SCHED;
            PG8_STAGE(PG8_SB(0, 1), b2 + hstepB, voffB);
            PG8_WAIT_V(6); PG8_BAR; PG8_MMA(1, 1, At, B1); PG8_BAR;
            PG8_LDB(B0, 1, 0); PG8_SCHED; PG8_LDA(At, 1, 0); PG8_STAGE(PG8_SA(0, 1), a2 + hstepA, voffA);
            PG8_WAIT_L(8); PG8_BAR; PG8_WAIT_L(0); PG8_MMA(0, 0, At, B0); PG8_BAR; PG8_SCHED;
            PG8_LDB(B1, 1, 1); PG8_STAGE(PG8_SB(1, 0), b3, voffB);
            PG8_BAR; PG8_WAIT_L(0); PG8_MMA(0, 1, At, B1); PG8_BAR;
            PG8_LDA(At, 1, 1); PG8_STAGE(PG8_SA(1, 0), a3, voffA);
            PG8_BAR; PG8_WAIT_L(0); PG8_MMA(1, 0, At, B0); PG8_BAR; PG8_SCHED;
            PG8_STAGE(PG8_SB(1, 1), b3 + hstepB, voffB);
            PG8_WAIT_V(6); PG8_BAR; PG8_MMA(1, 1, At, B1); PG8_BAR;
            }
        }
        if constexpr (ALIGN_EPI) { if (wr == 0) PG8_BAR; }
        E(acc, cur, wr, wc, fr, fq); S.done(cur);
        if (!has_next) break;
#pragma unroll
        for (int a = 0; a < 2; ++a)
#pragma unroll
            for (int b = 0; b < 2; ++b)
#pragma unroll
                for (int m = 0; m < 4; ++m)
#pragma unroll
                    for (int n = 0; n < 2; ++n) acc[a][b][m][n] = (f32x4){0.f, 0.f, 0.f, 0.f};
        cur = nxt; cA = nA; cB = nB; ++ui;
        if constexpr (ALIGN_EPI) { if (wr == 1) PG8_BAR; }
    }
    PG8_WAIT_V(0);
    if constexpr (!ALIGN_EPI) { if (wr == 0) PG8_BAR; }
    PG8_BAR;
#undef PG8_ATILE
#undef PG8_SA
#undef PG8_SB
#undef PG8_STAGE
#undef PG8_LDA
#undef PG8_LDB
#undef PG8_MMA
#undef PG8_WAIT_V
#undef PG8_WAIT_L
#undef PG8_BAR
#undef PG8_SCHED
}
}
constexpr int NWAVES = 8;
#ifndef MK_MULTI
#define MK_MULTI 0
#endif

constexpr int BATCH = 16, T = 2048, D = 1024, FF = 4096, DEPTH = 4;
constexpr int M = BATCH * T;
constexpr int MH = M / 2;
constexpr int NKV = 1536;
constexpr int NQG = 1280;
constexpr int NCMP = 127;
constexpr float EPS = 1e-6f;

constexpr size_t MiB = 1u << 20;
constexpr size_t WS_CTL = 0, CTL_ZERO_BYTES = 64 * 1024;
constexpr size_t WS_MOD = 1 * MiB;
constexpr size_t WS_CB1 = 3 * MiB;
constexpr size_t WS_GATE = 4 * MiB;
constexpr size_t WS_KCV = 10 * MiB;
constexpr size_t WS_CH = 16 * MiB;
constexpr size_t WS_W = 32 * MiB;
constexpr size_t WS_KV = 128 * MiB;
constexpr size_t WS_HB = 224 * MiB;
constexpr size_t WS_Y = 288 * MiB;
constexpr size_t WS_BIG = 352 * MiB;
constexpr size_t WS_END = 480 * MiB;
constexpr size_t WO_AIN = 0;
constexpr size_t WO_AOUT = WO_AIN + 2ull * 2048 * 1024;
constexpr size_t WO_KV = WO_AOUT + 2ull * 1024 * 1024;
constexpr size_t WO_BIN = WO_KV + 1536ull * 1024;
constexpr size_t WO_BOUT = WO_BIN + 2ull * 1280 * 1024;
constexpr size_t WO_FIN = WO_BOUT + 2ull * 1024 * 1024;
constexpr size_t WO_FOUT = WO_FIN + 4ull * 4096 * 1024;
constexpr size_t WO_C1 = WO_FOUT + 4ull * 4096 * 1024;
constexpr size_t WO_WS = WO_C1 + 2ull * 256 * 2048;
constexpr size_t WO_END = WO_WS + 2ull * 8 * 128 * 128;
static_assert(WO_END * 2 <= 96 * MiB, "weights fit");
constexpr int CW_BAR = 1024;

constexpr int RING_OFF = 0, RING_BYTES = 131072;
constexpr int LDSCTL_OFF = RING_BYTES, MISC_OFF = LDSCTL_OFF + 320;
constexpr int LDS_BYTES = 147456;

#define GAS __attribute__((address_space(1)))
#define LAS __attribute__((address_space(3)))
typedef unsigned short bf16;
typedef unsigned v4u __attribute__((ext_vector_type(4)));
typedef unsigned v2u __attribute__((ext_vector_type(2)));
typedef float f32x4 __attribute__((ext_vector_type(4)));
typedef GAS unsigned gu32;
#define RLX_AGENT __ATOMIC_RELAXED, __HIP_MEMORY_SCOPE_AGENT
#define LDS_WAIT() asm volatile("s_waitcnt lgkmcnt(0)" ::: "memory")
#define VM_WAIT() asm volatile("s_waitcnt vmcnt(0)" ::: "memory")
__device__ __forceinline__ unsigned f2bf(float f) { unsigned u = __builtin_bit_cast(unsigned, f); return (u + 0x7fffu + ((u >> 16) & 1u)) >> 16; }
__device__ __forceinline__ unsigned pk2(float lo, float hi) { return f2bf(lo) | (f2bf(hi) << 16); }
__device__ __forceinline__ float bf_lo(unsigned w) { return __builtin_bit_cast(float, w << 16); }
__device__ __forceinline__ float bf_hi(unsigned w) { return __builtin_bit_cast(float, w & 0xffff0000u); }
__device__ __forceinline__ float bf1(bf16 h) { return __builtin_bit_cast(float, (unsigned)h << 16); }
__device__ __forceinline__ float wave_sum(float v) {
#pragma unroll
    for (int o = 1; o < 64; o <<= 1) v += __shfl_xor(v, o);
    return v;
}
__device__ __forceinline__ float wave_max(float v) {
#pragma unroll
    for (int o = 1; o < 64; o <<= 1) v = fmaxf(v, __shfl_xor(v, o));
    return v;
}

#define XB_TMO      128
#define XB_XCNT(j)  (256  + 64 * (j))
#define XB_XSUB(j)  (1280 + 64 * (j))
#define XB_XGEN(j)  (2304 + 64 * (j))
#define XB_TOP      3328
#define XB_TOPGEN   3392
#define XCD_BAR_WORDS 3456
#define XB_SPIN_CAP (1u << 18)

__device__ __forceinline__ unsigned xb_ld(unsigned* p)              { return __hip_atomic_load(p, __ATOMIC_RELAXED, __HIP_MEMORY_SCOPE_AGENT); }
__device__ __forceinline__ unsigned xb_add(unsigned* p, unsigned v) { return __hip_atomic_fetch_add(p, v, __ATOMIC_RELAXED, __HIP_MEMORY_SCOPE_AGENT); }
__device__ __forceinline__ unsigned xb_xcc_id() { return (unsigned)__builtin_amdgcn_s_getreg((3 << 11) | 20) & 0xFu; }
#define XB_SPIN(cond, bar) do { unsigned _sp = 0; while (cond) { __builtin_amdgcn_s_sleep(1); \
    if ((++_sp & 255u) == 0u) { if (xb_ld(&(bar)[XB_TMO])) break; if (_sp > XB_SPIN_CAP) { atomicAdd(&(bar)[XB_TMO], 1u); break; } } } } while (0)

struct XcdBarrier {
    unsigned* bar; unsigned x;
    volatile LAS unsigned* st;
};
__device__ __forceinline__ XcdBarrier xcd_barrier_post(unsigned* bar, volatile LAS unsigned* st) {
    XcdBarrier b; b.bar = bar; b.x = xb_xcc_id(); b.st = st;
    if (threadIdx.x == 0) (void)xb_add(&bar[XB_XCNT(b.x)], 1u);
    return b;
}
__device__ __forceinline__ void xcd_barrier_complete(unsigned* bar, unsigned x, unsigned& nloc, unsigned& nx) {
    const unsigned G = gridDim.x * gridDim.y * gridDim.z;
    unsigned sum, cnt, mine, sp = 0u;
    for (;;) {
        sum = 0u; cnt = 0u; mine = 0u;
#pragma unroll
        for (unsigned j = 0; j < 16; ++j) { const unsigned c = xb_ld(&bar[XB_XCNT(j)]); sum += c; cnt += (c > 0u) ? 1u : 0u; mine = (j == x) ? c : mine; }
        if (sum == G) break;
        __builtin_amdgcn_s_sleep(1);
        if ((++sp & 255u) == 0u) { if (xb_ld(&bar[XB_TMO])) break; if (sp > XB_SPIN_CAP) { atomicAdd(&bar[XB_TMO], 1u); break; } }
    }
    nloc = mine > 0u ? mine : 1u; nx = cnt > 0u ? cnt : 1u;
}
__device__ __forceinline__ void xcd_barrier(const XcdBarrier& b) {
    asm volatile("s_waitcnt vmcnt(0)" ::: "memory");
    __syncthreads();
    if (threadIdx.x == 0) {
        unsigned* bar = b.bar;
        __builtin_amdgcn_s_waitcnt(0);
        unsigned nloc = b.st[0], nx = b.st[1];
        if (nloc == 0u) { xcd_barrier_complete(bar, b.x, nloc, nx); b.st[0] = nloc; b.st[1] = nx; }
        const unsigned old = xb_add(&bar[XB_XSUB(b.x)], 1u);
        const unsigned gen = old / nloc;
        if (old + 1u == (gen + 1u) * nloc) {
            __builtin_amdgcn_fence(__ATOMIC_RELEASE, "agent");
            asm volatile("s_waitcnt vmcnt(0)" ::: "memory");
            const unsigned og = xb_add(&bar[XB_TOP], 1u);
            const unsigned tg = og / nx;
            if (og + 1u == (tg + 1u) * nx) xb_add(&bar[XB_TOPGEN], 1u);
            else XB_SPIN(xb_ld(&bar[XB_TOPGEN]) == tg, bar);
            __builtin_amdgcn_fence(__ATOMIC_ACQUIRE, "agent");
            xb_add(&bar[XB_XGEN(b.x)], 1u);
            asm volatile("s_waitcnt vmcnt(0)" ::: "memory");
        } else {
            XB_SPIN(xb_ld(&bar[XB_XGEN(b.x)]) == gen, bar);
            __builtin_amdgcn_fence(__ATOMIC_ACQUIRE, "agent");
            asm volatile("s_waitcnt vmcnt(0)" ::: "memory");
        }
    }
    __syncthreads();
}

constexpr int GRP_WGS = 32, NGRP = 8, CW_GRP = 8192, GROWS = M / NGRP;
__device__ __forceinline__ void grp_barrier(unsigned* w, unsigned* bar) {
    asm volatile("s_waitcnt vmcnt(0)" ::: "memory");
    __syncthreads();
    if (threadIdx.x == 0) {
        const unsigned mask = xb_ld(w + 32); const bool one_xcd = (mask & (mask - 1u)) == 0u;
        if (!one_xcd) { __builtin_amdgcn_fence(__ATOMIC_RELEASE, "agent"); asm volatile("s_waitcnt vmcnt(0)" ::: "memory"); }
        const unsigned old = xb_add(w, 1u);
        const unsigned gen = old / (unsigned)GRP_WGS;
        if (old + 1u == (gen + 1u) * (unsigned)GRP_WGS) xb_add(w + 16, 1u);
        else XB_SPIN(xb_ld(w + 16) == gen, bar);
        __builtin_amdgcn_fence(__ATOMIC_ACQUIRE, "agent");
        asm volatile("s_waitcnt vmcnt(0)" ::: "memory");
    }
    __syncthreads();
}

struct Frame {
    LAS unsigned char* lds;
    int tid, lane, wave;
    int vcu, G;
};
__device__ __forceinline__ void tr_item(const float* W, int K, int ldw, int nvalid, bf16* WT, int nblk, LAS float* scr, int item, int lane) {
    const int kb = item / nblk, nb = item % nblk, k0 = 64 * kb, n0 = 32 * nb;
    const int kr = lane >> 3, n4 = (lane & 7) * 4; const bool ok = (n0 + n4) < nvalid;
    f32x4 v[8];
#pragma unroll
    for (int i = 0; i < 8; ++i) v[i] = ok ? *(const f32x4*)(W + (size_t)(k0 + 8 * i + kr) * ldw + n0 + n4) : (f32x4){0.f, 0.f, 0.f, 0.f};
#pragma unroll
    for (int i = 0; i < 8; ++i) { LAS float* d = scr + (8 * i + kr) * 33 + n4; d[0] = v[i].x; d[1] = v[i].y; d[2] = v[i].z; d[3] = v[i].w; }
    LDS_WAIT(); asm volatile("" ::: "memory");
    const int c = lane & 7;
#pragma unroll
    for (int j = 0; j < 4; ++j) { const int n = (lane >> 3) + 8 * j; const LAS float* s = scr + (8 * c) * 33 + n;
        v4u o; o.x = pk2(s[0 * 33], s[1 * 33]); o.y = pk2(s[2 * 33], s[3 * 33]); o.z = pk2(s[4 * 33], s[5 * 33]); o.w = pk2(s[6 * 33], s[7 * 33]);
        *(GAS v4u*)(WT + (size_t)(n0 + n) * K + k0 + 8 * c) = o; }
    LDS_WAIT(); asm volatile("" ::: "memory");
}

struct Args { const float* in[24]; float* out; unsigned char* ws; int ph_lo, ph_hi; };
typedef const __attribute__((address_space(4))) Args* kargs_t;

__device__ __forceinline__ void p0_prologue(const Frame& F, kargs_t a) {
    LAS float* scr = (LAS float*)(F.lds + RING_OFF + F.wave * 16384);
    bf16* WB = (bf16*)(a->ws + WS_W);
    const int gw = F.vcu * NWAVES + F.wave, NGW = F.G * NWAVES;
    constexpr int I_AIN = 16 * 64, I_AOUT = 16 * 32, I_KV = 16 * 48, I_BIN = 16 * 40, I_BOUT = 16 * 32, I_FIN = 16 * 128, I_FOUT = 64 * 32, I_C1 = 32 * 8;
    constexpr int NITEMS = 2 * I_AIN + 2 * I_AOUT + I_KV + 2 * I_BIN + 2 * I_BOUT + 4 * I_FIN + 4 * I_FOUT + 2 * I_C1;
    for (int it = gw; it < NITEMS; it += NGW) {
        int r = it;
        if (r < 2 * I_AIN) { const int l = r / I_AIN; tr_item(a->in[5] + (size_t)l * 1024 * 2048, 1024, 2048, 2048, WB + WO_AIN + (size_t)l * 2048 * 1024, 64, scr, r % I_AIN, F.lane); continue; } r -= 2 * I_AIN;
        if (r < 2 * I_AOUT) { const int l = r / I_AOUT; tr_item(a->in[10] + (size_t)l * 1024 * 1024, 1024, 1024, 1024, WB + WO_AOUT + (size_t)l * 1024 * 1024, 32, scr, r % I_AOUT, F.lane); continue; } r -= 2 * I_AOUT;
        if (r < I_KV) { tr_item(a->in[14], 1024, 1536, 1536, WB + WO_KV, 48, scr, r, F.lane); continue; } r -= I_KV;
        if (r < 2 * I_BIN) { const int l = r / I_BIN; tr_item(a->in[20] + (size_t)l * 1024 * 1072, 1024, 1072, 1072, WB + WO_BIN + (size_t)l * 1280 * 1024, 40, scr, r % I_BIN, F.lane); continue; } r -= 2 * I_BIN;
        if (r < 2 * I_BOUT) { const int l = r / I_BOUT; tr_item(a->in[21] + (size_t)l * 1024 * 1024, 1024, 1024, 1024, WB + WO_BOUT + (size_t)l * 1024 * 1024, 32, scr, r % I_BOUT, F.lane); continue; } r -= 2 * I_BOUT;
        if (r < 4 * I_FIN) { const int l = r / I_FIN; tr_item(a->in[22] + (size_t)l * 1024 * 4096, 1024, 4096, 4096, WB + WO_FIN + (size_t)l * 4096 * 1024, 128, scr, r % I_FIN, F.lane); continue; } r -= 4 * I_FIN;
        if (r < 4 * I_FOUT) { const int l = r / I_FOUT; tr_item(a->in[23] + (size_t)l * 4096 * 1024, 4096, 1024, 1024, WB + WO_FOUT + (size_t)l * 1024 * 4096, 32, scr, r % I_FOUT, F.lane); continue; } r -= 4 * I_FOUT;
        { const int l = r / I_C1; tr_item(a->in[16] + (size_t)l * 2048 * 256, 2048, 256, 256, WB + WO_C1 + (size_t)l * 256 * 2048, 8, scr, r % I_C1, F.lane); }
    }
    for (int i = gw * 64 + F.lane; i < 2 * 8 * 128 * 128; i += NGW * 64) { const int s = i & 127, t = (i >> 7) & 127; WB[WO_WS + i] = (s <= t) ? (bf16)f2bf(a->in[8][i]) : (bf16)0; }
    __syncthreads();
    if (F.vcu < 208) {
        LAS float* cact = (LAS float*)(F.lds);
        LAS float* red = (LAS float*)(F.lds + 65536);
        for (int i = F.tid; i < 16 * 1024; i += NWAVES * 64) { const float c = a->in[1][i]; cact[i] = c / (1.0f + __expf(-c)); }
        __syncthreads();
        const int grp = F.vcu; const float* W; const float* bias; float* out; int ldw, n0, ostride;
        float* MOD = (float*)(a->ws + WS_MOD);
        if (grp < 192) { const int L = grp / 48; n0 = (grp % 48) * 128; W = a->in[2] + (size_t)L * 1024 * 6144; ldw = 6144; bias = a->in[3] + L * 6144; out = MOD + (size_t)L * 16 * 6144; ostride = 6144; }
        else { n0 = (grp - 192) * 128; W = a->in[11]; ldw = 2048; bias = a->in[12]; out = MOD + (size_t)4 * 16 * 6144; ostride = 2048; }
        float acc0[16], acc1[16];
#pragma unroll
        for (int b = 0; b < 16; ++b) { acc0[b] = 0.f; acc1[b] = 0.f; }
        const int kbeg = F.wave * 128;
        for (int k = kbeg; k < kbeg + 128; k += 8) {
            float2 w[8];
#pragma unroll
            for (int u = 0; u < 8; ++u) w[u] = *(const float2*)(W + (size_t)(k + u) * ldw + n0 + 2 * F.lane);
#pragma unroll
            for (int u = 0; u < 8; ++u)
#pragma unroll
                for (int b = 0; b < 16; ++b) { const float cv = cact[b * 1024 + k + u]; acc0[b] += cv * w[u].x; acc1[b] += cv * w[u].y; }
        }
#pragma unroll
        for (int b = 0; b < 16; ++b) { red[(F.wave * 16 + b) * 128 + 2 * F.lane] = acc0[b]; red[(F.wave * 16 + b) * 128 + 2 * F.lane + 1] = acc1[b]; }
        __syncthreads();
        for (int o = F.tid; o < 2048; o += NWAVES * 64) { const int b = o >> 7, n = o & 127; float s = bias[n0 + n];
#pragma unroll
            for (int w = 0; w < 8; ++w) s += red[(w * 16 + b) * 128 + n];
            out[(size_t)b * ostride + n0 + n] = s; }
    } else if (F.vcu == 208) {
        const int j = F.tid >> 8, n = F.tid & 255; float s = a->in[17][j * 256 + n];
        const float* pos = a->in[15] + j * 2048; const float* w1 = a->in[16] + (size_t)j * 2048 * 256 + n;
        for (int kk = 0; kk < 2048; ++kk) s += pos[kk] * w1[(size_t)kk * 256];
        ((float*)(a->ws + WS_CB1))[j * 256 + n] = s;
    }
}

template <bool HAS_Y, bool HAS_H, bool HAS_KV, bool XIN_BF, bool XOUT_BF>
__device__ __forceinline__ void norm_phase(const Frame& F, const void* xin_, void* xout_, const bf16* Y, const float* gy, const float* gate  ,
                                           const float* gn, const float* sh, const float* sc, int mstride, bf16* H,
                                           const float* gkv, const float* shkv, const float* sckv, int kvstride, bf16* HKV) {
    const int gw = F.vcu * NWAVES + F.wave, NGW = F.G * NWAVES;
    for (int blk = gw; blk < M / 16; blk += NGW) {
        const int b = blk / (T / 16);
        f32x4 A1[4], A2[4], A3[4], K2[4], K3[4];
#pragma unroll
        for (int j = 0; j < 4; ++j) { const int col = 256 * j + 4 * F.lane;
            if (HAS_Y) A1[j] = *(const f32x4*)(gate + (size_t)b * mstride + col) * *(const f32x4*)(gy + col);
            if (HAS_H) { A2[j] = *(const f32x4*)(gn + col) * (*(const f32x4*)(sc + (size_t)b * mstride + col) + 1.0f); A3[j] = *(const f32x4*)(sh + (size_t)b * mstride + col); }
            if (HAS_KV) { K2[j] = *(const f32x4*)(gkv + col) * (*(const f32x4*)(sckv + (size_t)b * kvstride + col) + 1.0f); K3[j] = *(const f32x4*)(shkv + (size_t)b * kvstride + col); }
        }
        for (int r = 0; r < 16; r += 2) {
            const size_t m = (size_t)blk * 16 + r;
            f32x4 xa[4], xb[4]; v2u ya[4], yb[4];
#pragma unroll
            for (int j = 0; j < 4; ++j) {
                if (XIN_BF) { const v2u w0 = __builtin_nontemporal_load((const v2u*)((const bf16*)xin_ + m * D + 256 * j + 4 * F.lane)), w1 = __builtin_nontemporal_load((const v2u*)((const bf16*)xin_ + (m + 1) * D + 256 * j + 4 * F.lane));
                    xa[j] = (f32x4){bf_lo(w0.x), bf_hi(w0.x), bf_lo(w0.y), bf_hi(w0.y)}; xb[j] = (f32x4){bf_lo(w1.x), bf_hi(w1.x), bf_lo(w1.y), bf_hi(w1.y)}; }
                else { xa[j] = __builtin_nontemporal_load((const f32x4*)((const float*)xin_ + m * D + 256 * j + 4 * F.lane)); xb[j] = __builtin_nontemporal_load((const f32x4*)((const float*)xin_ + (m + 1) * D + 256 * j + 4 * F.lane)); }
                if (HAS_Y) { ya[j] = __builtin_nontemporal_load((const v2u*)(Y + m * D + 256 * j + 4 * F.lane)); yb[j] = __builtin_nontemporal_load((const v2u*)(Y + (m + 1) * D + 256 * j + 4 * F.lane)); } }
#define NORM_ROW(xv, yw, mm) do { \
            if (HAS_Y) { f32x4 yv[4]; float s = 0.f; \
                _Pragma("unroll") for (int j = 0; j < 4; ++j) { const v2u w = yw[j]; yv[j] = (f32x4){bf_lo(w.x), bf_hi(w.x), bf_lo(w.y), bf_hi(w.y)}; \
                    s += (yv[j].x * yv[j].x + yv[j].y * yv[j].y) + (yv[j].z * yv[j].z + yv[j].w * yv[j].w); } \
                const float rstd = 1.0f / sqrtf(wave_sum(s) * (1.0f / D) + EPS); \
                _Pragma("unroll") for (int j = 0; j < 4; ++j) { xv[j] = xv[j] + A1[j] * (yv[j] * rstd); \
                    if (XOUT_BF) { v2u w; w.x = pk2(xv[j].x, xv[j].y); w.y = pk2(xv[j].z, xv[j].w); __builtin_nontemporal_store(w, (v2u*)((bf16*)xout_ + (mm) * D + 256 * j + 4 * F.lane)); } \
                    else __builtin_nontemporal_store(xv[j], (f32x4*)((float*)xout_ + (mm) * D + 256 * j + 4 * F.lane)); } } \
            if (HAS_H || HAS_KV) { float s = 0.f; \
                _Pragma("unroll") for (int j = 0; j < 4; ++j) s += (xv[j].x * xv[j].x + xv[j].y * xv[j].y) + (xv[j].z * xv[j].z + xv[j].w * xv[j].w); \
                const float rstd = 1.0f / sqrtf(wave_sum(s) * (1.0f / D) + EPS); \
                _Pragma("unroll") for (int j = 0; j < 4; ++j) { const f32x4 xn = xv[j] * rstd; \
                    if (HAS_H) { const f32x4 h = xn * A2[j] + A3[j]; v2u w; w.x = pk2(h.x, h.y); w.y = pk2(h.z, h.w); *(v2u*)(H + (mm) * D + 256 * j + 4 * F.lane) = w; } \
                    if (HAS_KV) { const f32x4 h = xn * K2[j] + K3[j]; v2u w; w.x = pk2(h.x, h.y); w.y = pk2(h.z, h.w); *(v2u*)(HKV + (mm) * D + 256 * j + 4 * F.lane) = w; } } } } while (0)
            NORM_ROW(xa, ya, m);
            NORM_ROW(xb, yb, m + 1);
#undef NORM_ROW
        }
    }
}

__device__ __forceinline__ void cmp2_phase(const Frame& F, const float* PART, const float* cb1, const float* w2, const float* b2, bf16* KCV) {
    LAS float* w2l = (LAS float*)(F.lds + RING_OFF);
    LAS float* hl = (LAS float*)(F.lds + RING_OFF + 65536) + F.wave * 256;
    const int grp = F.vcu / GRP_WGS, lc = F.vcu % GRP_WGS, half = GRP_WGS / 2, j = lc / half, vj = lc % half;
    PART += (size_t)grp * (8u << 20) / 4;
    if (j < 2) {
        for (int i = F.tid; i < 256 * 64 / 4; i += NWAVES * 64) *(LAS f32x4*)(w2l + 4 * i) = *(const f32x4*)(w2 + (size_t)j * 256 * 64 + 4 * i);
    }
    __syncthreads();
    if (j < 2) {
        for (int rl = vj * NWAVES + F.wave; rl < 1024; rl += half * NWAVES) { const int r = grp * 1024 + rl;
            const float* p0 = PART + ((size_t)(j * 2 + 0) * 1024 + rl) * 256; const float* p1 = PART + ((size_t)(j * 2 + 1) * 1024 + rl) * 256;
            const f32x4 a = *(const f32x4*)(p0 + 4 * F.lane), b = *(const f32x4*)(p1 + 4 * F.lane), c = *(const f32x4*)(cb1 + j * 256 + 4 * F.lane);
            f32x4 h = a + b + c; h.x = pg8::gelu_tanh(h.x); h.y = pg8::gelu_tanh(h.y); h.z = pg8::gelu_tanh(h.z); h.w = pg8::gelu_tanh(h.w);
            *(LAS f32x4*)(hl + 4 * F.lane) = h;
            LDS_WAIT();
            float s0 = b2[j * 64 + F.lane], s1 = 0.f, s2 = 0.f, s3 = 0.f;
#pragma unroll 8
            for (int hh = 0; hh < 256; hh += 4) { const f32x4 h4 = *(const LAS f32x4*)(hl + hh);
                s0 += h4.x * w2l[hh * 64 + F.lane]; s1 += h4.y * w2l[(hh + 1) * 64 + F.lane]; s2 += h4.z * w2l[(hh + 2) * 64 + F.lane]; s3 += h4.w * w2l[(hh + 3) * 64 + F.lane]; }
            float s = (s0 + s1) + (s2 + s3);
            if ((r & 127) == 127) s = 0.f;
            KCV[((size_t)j * 8192 + r) * 64 + F.lane] = (bf16)f2bf(s);
            LDS_WAIT();
        }
    }
    __syncthreads();
}

namespace nsa {
using bf16x8 = __attribute__((ext_vector_type(8))) short;
using s16x4 = __attribute__((ext_vector_type(4))) short;
using f32x16 = __attribute__((ext_vector_type(16))) float;
using u32x4 = __attribute__((ext_vector_type(4))) unsigned;
typedef __attribute__((address_space(3))) const char* lds_cptr;
typedef __attribute__((address_space(3))) char* lds_ptr;
constexpr int NSLOT = 3, SLOTB = 8192;
constexpr int LDS_K = 0, LDS_V = NSLOT * SLOTB, LDS_WS = 2 * NSLOT * SLOTB  , LDS_OST = LDS_WS + 8 * 512  ,
              LDS_PI = LDS_OST + 8 * 4096  , LDS_IMP = LDS_PI + 32768  , LDS_SELM = LDS_IMP + 8192  , LDS_END = LDS_SELM + 256;
static_assert(LDS_END <= 131072, "attention LDS map");
constexpr int THR = 8;
__device__ __forceinline__ int crow(int r, int hi) { return (r & 3) + 8 * (r >> 2) + 4 * hi; }
#define NSA_SBAR() __builtin_amdgcn_sched_barrier(0)
__device__ __forceinline__ void glds16(const void* gsrc, unsigned lds_dst) { unsigned keep;
    asm volatile("s_mov_b32 %0, m0\n\ts_mov_b32 m0, %2\n\ts_nop 0\n\tglobal_load_lds_dwordx4 %1, off\n\ts_mov_b32 m0, %0" : "=&s"(keep) : "v"(gsrc), "s"(lds_dst) : "memory"); }
typedef float f32x2_t __attribute__((ext_vector_type(2))); typedef __bf16 bf16x2_t __attribute__((ext_vector_type(2)));
__device__ __forceinline__ unsigned cvtpk_s(float lo, float hi) { f32x2_t v = {lo, hi}; bf16x2_t b = __builtin_convertvector(v, bf16x2_t); return __builtin_bit_cast(unsigned, b); }
#define NSA_WAIT_BAR(N) asm volatile("s_waitcnt vmcnt(" #N ") lgkmcnt(0)\n\ts_barrier" ::: "memory")

__device__ __forceinline__ void qkt(f32x16& p0, f32x16& p1, lds_cptr Kslot, const bf16x8* qr, const f32x16& cinit, int r32, int hi) {
    lds_cptr kb = Kslot + hi * 1024 + r32 * 16;
#pragma unroll
    for (int d0 = 0; d0 < 4; ++d0) {
        const bf16x8 b0 = *(const __attribute__((address_space(3))) bf16x8*)(kb + d0 * 2048);
        const bf16x8 b1 = *(const __attribute__((address_space(3))) bf16x8*)(kb + d0 * 2048 + 512);
        if (d0 == 0) { p0 = __builtin_amdgcn_mfma_f32_32x32x16_bf16(b0, qr[0], cinit, 0, 0, 0); p1 = __builtin_amdgcn_mfma_f32_32x32x16_bf16(b1, qr[0], cinit, 0, 0, 0); }
        else { p0 = __builtin_amdgcn_mfma_f32_32x32x16_bf16(b0, qr[d0], p0, 0, 0, 0); p1 = __builtin_amdgcn_mfma_f32_32x32x16_bf16(b1, qr[d0], p1, 0, 0, 0); } }
}
__device__ __forceinline__ float rowmax(const f32x16& p0, const f32x16& p1) {
    float a = fmaxf(fmaxf(p0[0], p0[1]), p1[0]), b = fmaxf(fmaxf(p0[2], p0[3]), p1[1]); a = fmaxf(fmaxf(a, p1[2]), p1[3]);
#pragma unroll
    for (int r = 4; r < 16; r += 4) { a = fmaxf(fmaxf(a, p0[r]), p0[r + 1]); b = fmaxf(fmaxf(b, p0[r + 2]), p0[r + 3]); a = fmaxf(fmaxf(a, p1[r]), p1[r + 1]); b = fmaxf(fmaxf(b, p1[r + 2]), p1[r + 3]); }
    const float m = fmaxf(a, b);
    auto rr = __builtin_amdgcn_permlane32_swap(__float_as_uint(m), __float_as_uint(m), false, false);
    return fmaxf(__uint_as_float(rr[0]), __uint_as_float(rr[1]));
}
__device__ __forceinline__ float xhalf_sum(float v) { auto rr = __builtin_amdgcn_permlane32_swap(__float_as_uint(v), __float_as_uint(v), false, false); return __uint_as_float(rr[0]) + __uint_as_float(rr[1]); }
__device__ __forceinline__ float xhalf_other(float v, int hi) { auto rr = __builtin_amdgcn_permlane32_swap(__float_as_uint(v), __float_as_uint(v), false, false); return hi ? __uint_as_float(rr[0]) : __uint_as_float(rr[1]); }
__device__ __forceinline__ void pv(f32x16* o, int vb, bf16x8 pa0, bf16x8 pa1, bf16x8 pa2, bf16x8 pa3) {
#pragma unroll
    for (int d0 = 0; d0 < 2; ++d0) { s16x4 lo[4], hi[4];
#pragma unroll
        for (int ks = 0; ks < 4; ++ks) {
            asm volatile("ds_read_b64_tr_b16 %0,%1 offset:%c2" : "=&v"(lo[ks]) : "v"(vb), "i"(d0 * 4096 + ks * 1024) : "memory");
            asm volatile("ds_read_b64_tr_b16 %0,%1 offset:%c2" : "=&v"(hi[ks]) : "v"(vb), "i"(d0 * 4096 + ks * 1024 + 512) : "memory"); }
        asm volatile("s_waitcnt lgkmcnt(0)" ::: "memory"); NSA_SBAR();
#define NSA_PK(k) (bf16x8){lo[k][0], lo[k][1], lo[k][2], lo[k][3], hi[k][0], hi[k][1], hi[k][2], hi[k][3]}
        o[d0] = __builtin_amdgcn_mfma_f32_32x32x16_bf16(pa0, NSA_PK(0), o[d0], 0, 0, 0);
        o[d0] = __builtin_amdgcn_mfma_f32_32x32x16_bf16(pa1, NSA_PK(1), o[d0], 0, 0, 0);
        o[d0] = __builtin_amdgcn_mfma_f32_32x32x16_bf16(pa2, NSA_PK(2), o[d0], 0, 0, 0);
        o[d0] = __builtin_amdgcn_mfma_f32_32x32x16_bf16(pa3, NSA_PK(3), o[d0], 0, 0, 0);
#undef NSA_PK
    }
}
__device__ __forceinline__ void mask_range(f32x16& p, int kb, int lo, int hi_) {
#pragma unroll
    for (int r = 0; r < 16; ++r) { const int kk = kb + (r & 3) + 8 * (r >> 2); if (kk < lo || kk > hi_) p[r] = -INFINITY; }
}
#define NSA_PACK(P0, P1) do { pw0 = (u32x4){cvtpk_s(P0[0], P0[1]), cvtpk_s(P0[2], P0[3]), cvtpk_s(P0[4], P0[5]), cvtpk_s(P0[6], P0[7])}; \
    pw1 = (u32x4){cvtpk_s(P0[8], P0[9]), cvtpk_s(P0[10], P0[11]), cvtpk_s(P0[12], P0[13]), cvtpk_s(P0[14], P0[15])}; \
    pw2 = (u32x4){cvtpk_s(P1[0], P1[1]), cvtpk_s(P1[2], P1[3]), cvtpk_s(P1[4], P1[5]), cvtpk_s(P1[6], P1[7])}; \
    pw3 = (u32x4){cvtpk_s(P1[8], P1[9]), cvtpk_s(P1[10], P1[11]), cvtpk_s(P1[12], P1[13]), cvtpk_s(P1[14], P1[15])}; } while (0)
#define NSA_PAF(k) __builtin_bit_cast(bf16x8, pw##k)

struct Tensors { const bf16* Q; const float* GATE; const bf16* KCV; const bf16* KV; bf16* O; };

__device__ __forceinline__ void stream_dma(const bf16* ksrc, const bf16* vsrc, unsigned kdst, unsigned vdst, int n, int NT1, int qt, int slot) {
    const int t_ = (n < NT1) ? n : qt - (n - NT1); const size_t off = (size_t)t_ * 64 * NKV + ((n < NT1) ? 0 : 512);
    glds16(ksrc + off, (unsigned)__builtin_amdgcn_readfirstlane(kdst + slot)); glds16(vsrc + off, (unsigned)__builtin_amdgcn_readfirstlane(vdst + slot));
}
__device__ __forceinline__ void stream_prologue(unsigned lds0, const bf16* Ksel, const bf16* Vsel, int qt, int wid, int lane) {
    const bf16* ksrc = Ksel + (size_t)lane * NKV + wid * 8;
    const bf16* vsrc = Vsel + (size_t)(16 * (wid & 3) + (lane >> 2)) * NKV + (wid >> 2) * 32 + (lane & 3) * 8;
    const unsigned kdst = lds0 + LDS_K + wid * 1024, vdst = lds0 + LDS_V + wid * 1024;
    stream_dma(ksrc, vsrc, kdst, vdst, 0, qt + 1, qt, 0); stream_dma(ksrc, vsrc, kdst, vdst, 1, qt + 1, qt, SLOTB);
}
__device__ __forceinline__ void flash_stream(lds_ptr shm, unsigned lds0, const bf16* Ksel, const bf16* Vsel, int qt, const bf16x8* qr, unsigned selmask, int tq, float g_sel, float g_win,
                                             f32x16* otot, int wid, int lane, int r32, int hi) {
    const bf16* ksrc = Ksel + (size_t)lane * NKV + wid * 8;
    const bf16* vsrc = Vsel + (size_t)(16 * (wid & 3) + (lane >> 2)) * NKV + (wid >> 2) * 32 + (lane & 3) * 8;
    const unsigned kdst = lds0 + LDS_K + wid * 1024, vdst = lds0 + LDS_V + wid * 1024;
    __attribute__((address_space(3))) float* wsf = (__attribute__((address_space(3))) float*)(shm + LDS_WS) + wid * 128;
    const int vb0 = (int)(lds0 + LDS_V) + ((lane >> 4) & 1) * 32 + (lane & 3) * 8 + (4 * hi + ((lane & 15) >> 2)) * 64;
    const int NT1 = qt + 1, NT2 = (qt < 8 ? qt + 1 : 9), NTS = NT1 + NT2;
    float mhat = 0.f, l_reg = 0.f; f32x16 o[2]; o[0] = f32x16{}; o[1] = f32x16{};
#define NSA_FINALIZE(gate_) do { const float l_ = xhalf_sum(l_reg); asm volatile("s_waitcnt lgkmcnt(0)" ::: "memory"); if (hi == 0) wsf[r32] = (gate_) / l_; asm volatile("s_waitcnt lgkmcnt(0)" ::: "memory"); \
        _Pragma("unroll") for (int r = 0; r < 16; ++r) { const float w = wsf[crow(r, hi)]; otot[0][r] += o[0][r] * w; otot[1][r] += o[1][r] * w; } } while (0)
    int sl_cur = 0;
    for (int n = 0; n < NTS; ++n) {
        if (n + 1 < NTS) NSA_WAIT_BAR(2); else NSA_WAIT_BAR(0);
        { const int sl2 = (sl_cur >= SLOTB) ? sl_cur - SLOTB : sl_cur + 2 * SLOTB; if (n + 2 < NTS) stream_dma(ksrc, vsrc, kdst, vdst, n + 2, NT1, qt, sl2); }
        if (n == NT1) { NSA_FINALIZE(g_sel); mhat = 0.f; l_reg = 0.f; o[0] = f32x16{}; o[1] = f32x16{}; }
        const bool win = n >= NT1, first = (n == 0) || (n == NT1);
        const int t = win ? qt - (n - NT1) : n;
        float cval = -mhat;
        if (!win && !((selmask >> t) & 1u)) cval = -INFINITY;
        f32x16 cin;
#pragma unroll
        for (int r = 0; r < 16; ++r) cin[r] = cval;
        f32x16 p0, p1;
        qkt(p0, p1, (lds_cptr)(shm + LDS_K + sl_cur), qr, cin, r32, hi);
        if (t == qt) { mask_range(p0, 4 * hi, 0, tq); mask_range(p1, 32 + 4 * hi, 0, tq); }
        if (win && t == qt - 8) { mask_range(p0, 4 * hi, tq + 1, 63); mask_range(p1, 32 + 4 * hi, tq + 1, 63); }
        const float rm = rowmax(p0, p1);
        bool resc = false;
        if (first || __any(rm > (float)THR)) {
            const float dl = first ? fmaxf(rm, -1e30f) : fmaxf(rm, 0.f); mhat += dl;
#pragma unroll
            for (int r = 0; r < 16; ++r) { p0[r] -= dl; p1[r] -= dl; }
            const float f = __builtin_amdgcn_exp2f(-dl); l_reg *= f; if (hi == 0) wsf[r32] = f; resc = !first;
        }
        float sacc = 0.f;
#pragma unroll
        for (int r = 0; r < 16; ++r) { p0[r] = __builtin_amdgcn_exp2f(p0[r]); p1[r] = __builtin_amdgcn_exp2f(p1[r]); sacc += p0[r] + p1[r]; }
        l_reg += sacc;
        u32x4 pw0, pw1, pw2, pw3; NSA_PACK(p0, p1);
        if (resc) { asm volatile("s_waitcnt lgkmcnt(0)" ::: "memory");
#pragma unroll
            for (int d = 0; d < 2; ++d)
#pragma unroll
                for (int r = 0; r < 16; ++r) o[d][r] *= wsf[crow(r, hi)]; }
        pv(o, vb0 + sl_cur, NSA_PAF(0), NSA_PAF(1), NSA_PAF(2), NSA_PAF(3));
        sl_cur = (sl_cur == (NSLOT - 1) * SLOTB) ? 0 : sl_cur + SLOTB;
    }
    NSA_FINALIZE(g_win);
#undef NSA_FINALIZE
    asm volatile("s_waitcnt lgkmcnt(0)\n\ts_barrier" ::: "memory");
}

__device__ __forceinline__ void attn_unit(int b, int g, int qt, const Tensors& T_, lds_ptr shm, int tid_) {
    int tid = tid_; asm volatile("" : "+v"(tid));
    const int lane = tid & 63, r32 = lane & 31, hi = lane >> 5; const int wid = __builtin_amdgcn_readfirstlane(tid >> 6);
    const int hh = wid & 3, ts = wid >> 2, tq = ts * 32 + r32;
    const size_t m0 = (size_t)b * T + (size_t)qt * 64;
    const unsigned lds0 = (unsigned)(uintptr_t)shm;
    __attribute__((address_space(3))) float* wsf = (__attribute__((address_space(3))) float*)(shm + LDS_WS) + wid * 128;
    {
        const bf16* Kc = T_.KCV + (size_t)(b * 4 + g) * 128 * 64; const bf16* Vc = Kc + (size_t)8192 * 64;
        const bf16* ksrc = Kc + (size_t)lane * 64 + wid * 8;
        const bf16* vsrc = Vc + (size_t)(16 * (wid & 3) + (lane >> 2)) * 64 + (wid >> 2) * 32 + (lane & 3) * 8;
        const unsigned kdst = lds0 + LDS_K + wid * 1024, vdst = lds0 + LDS_V + wid * 1024;
        glds16(ksrc, (unsigned)__builtin_amdgcn_readfirstlane(kdst)); glds16(vsrc, (unsigned)__builtin_amdgcn_readfirstlane(vdst));
        glds16(ksrc + 64 * 64, (unsigned)__builtin_amdgcn_readfirstlane(kdst + SLOTB)); glds16(vsrc + 64 * 64, (unsigned)__builtin_amdgcn_readfirstlane(vdst + SLOTB));
    }
    bf16x8 qr[4];
    {
        const bf16* Qw = T_.Q + (m0 + ts * 32) * 1024 + (g * 4 + hh) * 64;
#pragma unroll
        for (int d0 = 0; d0 < 4; ++d0) qr[d0] = *reinterpret_cast<const bf16x8*>(&Qw[(size_t)r32 * 1024 + d0 * 16 + hi * 8]);
    }
    const float* gp = T_.GATE + (m0 + tq) * 48 + (g * 4 + hh) * 3;
    const float g_cmp = gp[0], g_sel = gp[1], g_win = gp[2];
    f32x16 otot[2];
    NSA_WAIT_BAR(0);
    {
        const int t = qt * 64 + tq;
        const int ncv = (t >= 31) ? ((t - 31) >> 4) + 1 : 0;
        f32x16 zero = f32x16{}; f32x16 pA0, pA1, pB0, pB1;
        qkt(pA0, pA1, (lds_cptr)(shm + LDS_K), qr, zero, r32, hi);
        qkt(pB0, pB1, (lds_cptr)(shm + LDS_K + SLOTB), qr, zero, r32, hi);
        mask_range(pA0, 4 * hi, 0, ncv - 1); mask_range(pA1, 32 + 4 * hi, 0, ncv - 1); mask_range(pB0, 64 + 4 * hi, 0, ncv - 1); mask_range(pB1, 96 + 4 * hi, 0, ncv - 1);
        const float m = fmaxf(fmaxf(rowmax(pA0, pA1), rowmax(pB0, pB1)), -1e30f);
        float sacc = 0.f;
#pragma unroll
        for (int r = 0; r < 16; ++r) { pA0[r] = __builtin_amdgcn_exp2f(pA0[r] - m); pA1[r] = __builtin_amdgcn_exp2f(pA1[r] - m); pB0[r] = __builtin_amdgcn_exp2f(pB0[r] - m); pB1[r] = __builtin_amdgcn_exp2f(pB1[r] - m);
            sacc += (pA0[r] + pA1[r]) + (pB0[r] + pB1[r]); }
        const float l = xhalf_sum(sacc); const float inv = l > 0.f ? 1.0f / l : 0.f;
#pragma unroll
        for (int r = 0; r < 16; ++r) { pA0[r] *= inv; pA1[r] *= inv; pB0[r] *= inv; pB1[r] *= inv; }
        {
            __attribute__((address_space(3))) float* PI = (__attribute__((address_space(3))) float*)(shm + LDS_PI) + (hh * 64 + tq) * 32;
            float prev_oth = 0.f;
#define NSA_GRP(P, blk) _Pragma("unroll") for (int q4 = 0; q4 < 4; ++q4) { const int k = (blk) * 4 + q4; const float Gs = (P[4 * q4] + P[4 * q4 + 1]) + (P[4 * q4 + 2] + P[4 * q4 + 3]); \
                const float oth = xhalf_other(P[4 * q4 + 3], hi); PI[2 * k + hi] = Gs + (hi ? oth : prev_oth); prev_oth = oth; }
            NSA_GRP(pA0, 0) NSA_GRP(pA1, 1) NSA_GRP(pB0, 2) NSA_GRP(pB1, 3)
#undef NSA_GRP
        }
        otot[0] = f32x16{}; otot[1] = f32x16{};
        const int vb0 = (int)(lds0 + LDS_V) + ((lane >> 4) & 1) * 32 + (lane & 3) * 8 + (4 * hi + ((lane & 15) >> 2)) * 64;
        u32x4 pw0, pw1, pw2, pw3;
        NSA_PACK(pA0, pA1); pv(otot, vb0, NSA_PAF(0), NSA_PAF(1), NSA_PAF(2), NSA_PAF(3));
        NSA_PACK(pB0, pB1); pv(otot, vb0 + SLOTB, NSA_PAF(0), NSA_PAF(1), NSA_PAF(2), NSA_PAF(3));
        if (hi == 0) wsf[r32] = g_cmp;
        asm volatile("s_waitcnt lgkmcnt(0)" ::: "memory");
#pragma unroll
        for (int r = 0; r < 16; ++r) { const float w = wsf[crow(r, hi)]; otot[0][r] *= w; otot[1][r] *= w; }
    }
    asm volatile("s_waitcnt lgkmcnt(0)\n\ts_barrier" ::: "memory");
    const bf16* KVb = T_.KV + (size_t)b * T * NKV + g * 64;
    stream_prologue(lds0, KVb + 2 * 256, KVb + 3 * 256, qt, wid, lane);
    {
        const __attribute__((address_space(3))) float* PI = (const __attribute__((address_space(3))) float*)(shm + LDS_PI);
        __attribute__((address_space(3))) unsigned* IMP = (__attribute__((address_space(3))) unsigned*)(shm + LDS_IMP);
        __attribute__((address_space(3))) unsigned* SELM = (__attribute__((address_space(3))) unsigned*)(shm + LDS_SELM);
#pragma unroll
        for (int it = 0; it < 4; ++it) { const int idx = tid + it * 512, tok = idx >> 5, j = idx & 31;
            float imp = ((PI[(0 * 64 + tok) * 32 + j] + PI[(1 * 64 + tok) * 32 + j]) + PI[(2 * 64 + tok) * 32 + j]) + PI[(3 * 64 + tok) * 32 + j];
            unsigned key = (__float_as_uint(imp) & ~31u) | (unsigned)(31 - j);
            if (j > qt) key = (unsigned)(31 - j);
            if (j == 0 || j == qt || j == qt - 1) key = (__float_as_uint(1e4f) & ~31u) | (unsigned)(31 - j);
            IMP[idx] = key; }
        asm volatile("s_waitcnt lgkmcnt(0)\n\ts_barrier" ::: "memory");
#pragma unroll
        for (int it = 0; it < 4; ++it) { const int idx = tid + it * 512, tok = idx >> 5, j = idx & 31;
            const unsigned mine = IMP[idx]; int rank = 0;
#pragma unroll
            for (int i4 = 0; i4 < 8; ++i4) { const u32x4 o4 = *(const __attribute__((address_space(3))) u32x4*)(IMP + tok * 32 + i4 * 4);
                rank += (o4.x > mine) ? 1 : 0; rank += (o4.y > mine) ? 1 : 0; rank += (o4.z > mine) ? 1 : 0; rank += (o4.w > mine) ? 1 : 0; }
            const unsigned long long bal = __ballot(rank < 16 && j <= qt);
            if (lane == 0) SELM[tok] = (unsigned)bal;
            if (lane == 32) SELM[tok] = (unsigned)(bal >> 32); }
        asm volatile("s_waitcnt lgkmcnt(0)\n\ts_barrier" ::: "memory");
    }
    const unsigned selmask = ((const __attribute__((address_space(3))) unsigned*)(shm + LDS_SELM))[tq];
    flash_stream(shm, lds0, KVb + 2 * 256, KVb + 3 * 256, qt, qr, selmask, tq, g_sel, g_win, otot, wid, lane, r32, hi);
    {
        bf16* Ow = T_.O + (m0 + ts * 32) * 1024 + (g * 4 + hh) * 64;
        __attribute__((address_space(3))) bf16* stg = (__attribute__((address_space(3))) bf16*)(shm + LDS_OST) + wid * 2048;
#pragma unroll
        for (int r = 0; r < 16; ++r) { const int orow = crow(r, hi);
#pragma unroll
            for (int d0 = 0; d0 < 2; ++d0) stg[orow * 64 + d0 * 32 + r32] = (bf16)f2bf(otot[d0][r]); }
        asm volatile("s_waitcnt lgkmcnt(0)" ::: "memory");
#pragma unroll
        for (int i = 0; i < 4; ++i) { const int row = i * 8 + (lane >> 3), ch = lane & 7; const u32x4 v = *(const __attribute__((address_space(3))) u32x4*)(stg + row * 64 + ch * 8); *(u32x4*)(Ow + (size_t)row * 1024 + ch * 8) = v; }
    }
    asm volatile("s_waitcnt lgkmcnt(0)\n\ts_barrier" ::: "memory");
}

__device__ __forceinline__ void attn_phase(const Frame& F, const Tensors& T_) {
    lds_ptr shm = (lds_ptr)(F.lds + RING_OFF);
    for (int v = F.vcu; v < BATCH * 4 * 4; v += F.G) {
        const int bg = v >> 2, s = v & 3;
#pragma unroll 1
        for (int i = 0; i < 8; ++i) { const int qt = (i & 1) ? (8 * (i >> 1) + 7 - s) : (8 * (i >> 1) + s);
            attn_unit(bg >> 2, bg & 3, qt, T_, shm, F.tid); }
    }
}
#undef NSA_SBAR
#undef NSA_WAIT_BAR
#undef NSA_PACK
#undef NSA_PAF
}
namespace sgu {
using nsa::bf16x8; using nsa::s16x4; using nsa::f32x16; using nsa::u32x4;
constexpr int LDS_VT = 0  , LDS_ST = 32768  , LDS_OST = 34816  , LDS_END = LDS_OST + 8 * 4096;
__device__ __forceinline__ void sgu_phase(const Frame& F, const bf16* U, const bf16* V, const float* lng, const float* lnb, const bf16* WS16, const float* bs, bf16* GT) {
    typedef __attribute__((address_space(3))) char* lptr;
    lptr shm = (lptr)(F.lds + RING_OFF);
    __attribute__((address_space(3))) float* st = (__attribute__((address_space(3))) float*)(shm + LDS_ST);
    const unsigned lds0 = (unsigned)(uintptr_t)shm;
    for (int ch = F.vcu; ch < M / 128; ch += F.G) {
        int tid = F.tid; asm volatile("" : "+v"(tid));
        const int lane = tid & 63, r32 = lane & 31, hi = lane >> 5; const int wid = __builtin_amdgcn_readfirstlane(tid >> 6);
        const size_t m0 = (size_t)ch * 128;
#pragma unroll 1
        for (int rb = 0; rb < 16; rb += 4) {
            v4u ra[4], rc[4];
#pragma unroll
            for (int r = 0; r < 4; ++r) { const v4u* vp = (const v4u*)(V + (m0 + wid * 16 + rb + r) * D + lane * 16); ra[r] = vp[0]; rc[r] = vp[1]; }
#pragma unroll
            for (int r = 0; r < 4; ++r) { const int row = wid * 16 + rb + r; const v4u a = ra[r], b = rc[r];
                float xv[16] = {bf_lo(a.x), bf_hi(a.x), bf_lo(a.y), bf_hi(a.y), bf_lo(a.z), bf_hi(a.z), bf_lo(a.w), bf_hi(a.w), bf_lo(b.x), bf_hi(b.x), bf_lo(b.y), bf_hi(b.y), bf_lo(b.z), bf_hi(b.z), bf_lo(b.w), bf_hi(b.w)};
                float s = 0.f, q = 0.f;
#pragma unroll
                for (int e = 0; e < 16; ++e) s += xv[e];
                const float mean = wave_sum(s) * (1.0f / D);
#pragma unroll
                for (int e = 0; e < 16; ++e) { const float d = xv[e] - mean; q += d * d; }
                const float rstd = 1.0f / sqrtf(wave_sum(q) * (1.0f / D) + EPS);
                if (lane == 0) { st[row * 2] = mean; st[row * 2 + 1] = rstd; } }
        }
        asm volatile("s_waitcnt lgkmcnt(0)\n\ts_barrier" ::: "memory");
        const int srow = tid >> 2, c4 = tid & 3;
        const float mean_s = st[srow * 2], rstd_s = st[srow * 2 + 1];
        const int tb = wid >> 1, db0 = (wid & 1) * 2;
        const int nks = 2 * tb + 2;
        const int vb0 = (int)(lds0 + LDS_VT) + ((lane >> 4) & 1) * 32 + (lane & 3) * 8 + (4 * hi + ((lane & 15) >> 2)) * 64;
        v4u vnext[4];
#pragma unroll
        for (int i = 0; i < 4; ++i) vnext[i] = *(const v4u*)(V + (m0 + srow) * D + i * 32 + c4 * 8);
#pragma unroll 1
        for (int g = 0; g < 8; ++g) {
            v4u vcur[4];
#pragma unroll
            for (int i = 0; i < 4; ++i) vcur[i] = vnext[i];
            if (g + 1 < 8) {
#pragma unroll
                for (int i = 0; i < 4; ++i) vnext[i] = *(const v4u*)(V + (m0 + srow) * D + (g + 1) * 128 + i * 32 + c4 * 8); }
            v4u uvv[4];
#pragma unroll
            for (int i = 0; i < 4; ++i) uvv[i] = *(const v4u*)(U + (m0 + tb * 32 + i * 8 + (lane >> 3)) * D + g * 128 + db0 * 32 + (lane & 7) * 8);
            const bf16* wrow = WS16 + ((size_t)g * 128 + tb * 32 + r32) * 128 + 4 * hi;
            v2u af[8][2];
#pragma unroll
            for (int ks = 0; ks < 8; ++ks) if (ks < nks) { af[ks][0] = *(const v2u*)(wrow + ks * 16); af[ks][1] = *(const v2u*)(wrow + ks * 16 + 8); }
#pragma unroll
            for (int i = 0; i < 4; ++i) { const int c = g * 128 + i * 32 + c4 * 8;
                const v4u w = vcur[i];
                const f32x4 g0 = *(const f32x4*)(lng + c), g1 = *(const f32x4*)(lng + c + 4), b0 = *(const f32x4*)(lnb + c), b1 = *(const f32x4*)(lnb + c + 4);
                float x[8] = {bf_lo(w.x), bf_hi(w.x), bf_lo(w.y), bf_hi(w.y), bf_lo(w.z), bf_hi(w.z), bf_lo(w.w), bf_hi(w.w)};
                const float gg[8] = {g0.x, g0.y, g0.z, g0.w, g1.x, g1.y, g1.z, g1.w}, bb[8] = {b0.x, b0.y, b0.z, b0.w, b1.x, b1.y, b1.z, b1.w};
#pragma unroll
                for (int e = 0; e < 8; ++e) x[e] = (x[e] - mean_s) * rstd_s * gg[e] + bb[e];
                v4u o; o.x = pk2(x[0], x[1]); o.y = pk2(x[2], x[3]); o.z = pk2(x[4], x[5]); o.w = pk2(x[6], x[7]);
                *(__attribute__((address_space(3))) v4u*)(shm + LDS_VT + (i * 8 + (srow >> 4)) * 1024 + (srow & 15) * 64 + c4 * 16) = o; }
            asm volatile("s_waitcnt lgkmcnt(0)\n\ts_barrier" ::: "memory");
            f32x16 o[2]; o[0] = f32x16{}; o[1] = f32x16{};
#pragma unroll
            for (int ks = 0; ks < 8; ++ks) if (ks < nks) {
                const bf16x8 a = __builtin_bit_cast(bf16x8, (v4u){af[ks][0].x, af[ks][0].y, af[ks][1].x, af[ks][1].y});
#pragma unroll
                for (int dd = 0; dd < 2; ++dd) { s16x4 lo, hi4; const int vb = vb0 + ((db0 + dd) * 8 + ks) * 1024;
                    asm volatile("ds_read_b64_tr_b16 %0,%1" : "=&v"(lo) : "v"(vb) : "memory");
                    asm volatile("ds_read_b64_tr_b16 %0,%1 offset:512" : "=&v"(hi4) : "v"(vb) : "memory");
                    asm volatile("s_waitcnt lgkmcnt(0)" ::: "memory");
                    const bf16x8 bfr = (bf16x8){lo[0], lo[1], lo[2], lo[3], hi4[0], hi4[1], hi4[2], hi4[3]};
                    o[dd] = __builtin_amdgcn_mfma_f32_32x32x16_bf16(a, bfr, o[dd], 0, 0, 0); } }
            __attribute__((address_space(3))) bf16* stg = (__attribute__((address_space(3))) bf16*)(shm + LDS_OST) + wid * 2048;
#pragma unroll
            for (int r = 0; r < 16; ++r) { const int orow = nsa::crow(r, hi); const float bias = bs[g * 128 + tb * 32 + orow];
#pragma unroll
                for (int dd = 0; dd < 2; ++dd) stg[orow * 64 + dd * 32 + r32] = (bf16)f2bf(o[dd][r] + bias); }
            asm volatile("s_waitcnt lgkmcnt(0)" ::: "memory");
#pragma unroll
            for (int i = 0; i < 4; ++i) { const int row = i * 8 + (lane >> 3), chn = lane & 7;
                const v4u mv = *(const __attribute__((address_space(3))) v4u*)(stg + row * 64 + chn * 8);
                const size_t gi = (m0 + tb * 32 + row) * D + g * 128 + db0 * 32 + chn * 8;
                const v4u uv = uvv[i];
                v4u ov; ov.x = pk2(bf_lo(mv.x) * bf_lo(uv.x), bf_hi(mv.x) * bf_hi(uv.x)); ov.y = pk2(bf_lo(mv.y) * bf_lo(uv.y), bf_hi(mv.y) * bf_hi(uv.y));
                ov.z = pk2(bf_lo(mv.z) * bf_lo(uv.z), bf_hi(mv.z) * bf_hi(uv.z)); ov.w = pk2(bf_lo(mv.w) * bf_lo(uv.w), bf_hi(mv.w) * bf_hi(uv.w));
                *(v4u*)(GT + gi) = ov; }
            asm volatile("s_waitcnt lgkmcnt(0)\n\ts_barrier" ::: "memory");
        }
    }
}
}
__global__ void __launch_bounds__(NWAVES * 64, 2) fwd(Args args) {
    extern __shared__ __attribute__((aligned(16))) unsigned char lds[];
    Frame F;
    F.lds = (LAS unsigned char*)lds;
    volatile LAS unsigned* MISC = (volatile LAS unsigned*)(F.lds + MISC_OFF);
    F.tid = threadIdx.x; F.lane = F.tid & 63; F.wave = __builtin_amdgcn_readfirstlane(F.tid >> 6);
    F.G = gridDim.x; { const int bx = blockIdx.x; F.vcu = (F.G % 8 == 0) ? (bx % 8) * (F.G / 8) + bx / 8 : bx; }
    for (int u = F.tid; u < (LDS_BYTES - LDSCTL_OFF) / 4; u += NWAVES * 64) ((LAS unsigned*)(F.lds + LDSCTL_OFF))[u] = 0u;
    __syncthreads();
#if !MK_MULTI
    XcdBarrier bar = xcd_barrier_post((unsigned*)(args.ws + WS_CTL) + CW_BAR, MISC + 8);
    if (threadIdx.x == 0) (void)__hip_atomic_fetch_or((unsigned*)(args.ws + WS_CTL) + CW_GRP + 64 * (F.vcu / GRP_WGS) + 32, 1u << bar.x, RLX_AGENT);
#define GRID_BAR() xcd_barrier(bar)
#define GRP_BAR() grp_barrier((unsigned*)(ws + WS_CTL) + CW_GRP + 64 * grp, (unsigned*)(ws + WS_CTL) + CW_BAR)
#else
#define GRID_BAR() do {} while (0)
#define GRP_BAR() do {} while (0)
#endif
    const int lo = args.ph_lo, hi = args.ph_hi;
    int ph = 0;
#define PH_BEGIN if (ph >= lo && ph < hi) { Frame Fp = F; asm volatile("" : "+v"(Fp.tid), "+v"(Fp.lane)); \
        kargs_t KA = (kargs_t)__builtin_amdgcn_kernarg_segment_ptr(); asm volatile("" : "+s"(KA)); \
        unsigned char* const ws = KA->ws; LAS unsigned char* const ring = Fp.lds + RING_OFF; const int grp = Fp.vcu / GRP_WGS, lc = Fp.vcu % GRP_WGS; const size_t R0 = (size_t)grp * GROWS; (void)ws; (void)ring; (void)lc; (void)R0;
#define PH_END   if (ph + 1 < hi) GRP_BAR(); } ++ph;
#define PH_END_GRID   if (ph + 1 < hi) GRID_BAR(); } ++ph;
#define P_MOD   ((float*)(ws + WS_MOD))
#define P_KVMOD (P_MOD + (size_t)4 * 16 * 6144)
#define P_CB1   ((float*)(ws + WS_CB1))
#define P_GATE  ((float*)(ws + WS_GATE))
#define P_KCV   ((bf16*)(ws + WS_KCV))
#define P_WB    ((bf16*)(ws + WS_W))
#define P_KV    ((bf16*)(ws + WS_KV))
#define P_XB    ((bf16*)(ws + WS_HB))
#define P_Y     ((bf16*)(ws + WS_Y))
#define P_HB    ((bf16*)KA->out + (size_t)grp * (4u << 20))
#define P_BIGW  ((bf16*)(ws + WS_BIG) + (size_t)grp * (8u << 20))
#define P_U     ((bf16*)(ws + WS_BIG) + (size_t)grp * (4u << 20))
#define P_V     (P_U + (4u << 20))
#define P_Q     P_U
#define P_O     P_V
#define P_HKV   P_O
#define P_NG(L, i) (KA->in[4] + ((L) * 4 + (i)) * 1024)

    PH_BEGIN p0_prologue(Fp, KA); PH_END_GRID
    PH_BEGIN norm_phase<false, true, false, false, false>(Fp, KA->in[0], nullptr, nullptr, nullptr, nullptr, P_NG(0, 0), P_MOD + 0, P_MOD + 1024, 6144, P_HB, nullptr, nullptr, nullptr, 0, nullptr); PH_END

#pragma unroll 1
    for (int L = 0; L < DEPTH; ++L) {
        if (L < 2) {
            PH_BEGIN {
                pg8::Gemm g = pg8::make_gemm(P_HB + R0 * D, P_WB + WO_AIN + (size_t)L * 2048 * 1024, GROWS, 2048, D); pg8::GroupOrder S; S.init(GROWS, 2048, GRP_WGS, lc);
                pg8::EpiBf16<2> E{P_U + R0 * D, D, nullptr, 1024, (size_t)(4u << 20), 1.f};
                pg8::gemm_phase<pg8::EpiBf16<2>, pg8::GroupOrder, true, true>(ring, g, S, E);
            } PH_END
            PH_BEGIN sgu::sgu_phase(Fp, P_U, P_V, KA->in[6] + L * 1024, KA->in[7] + L * 1024, P_WB + WO_WS + (size_t)L * 8 * 128 * 128, KA->in[9] + L * 8 * 128, P_HB); PH_END
            PH_BEGIN {
                pg8::Gemm g = pg8::make_gemm(P_HB + R0 * D, P_WB + WO_AOUT + (size_t)L * 1024 * 1024, GROWS, D, D); pg8::GroupOrder S; S.init(GROWS, D, GRP_WGS, lc);
                pg8::EpiBf16<0> E{P_Y + R0 * D, D, nullptr, 0, 0, 1.f};
                pg8::gemm_phase<pg8::EpiBf16<0>, pg8::GroupOrder, true, true>(ring, g, S, E);
            } PH_END
        } else {
            if (L == 2) {
                PH_BEGIN {
                    pg8::Gemm g = pg8::make_gemm(P_HKV + R0 * D, P_WB + WO_KV, GROWS, NKV, D); pg8::GroupOrder S; S.init(GROWS, NKV, GRP_WGS, lc);
                    pg8::EpiBf16<0> E{P_KV + R0 * NKV, NKV, nullptr, 0, 0, 1.f};
                    pg8::gemm_phase<pg8::EpiBf16<0>, pg8::GroupOrder, true, true>(ring, g, S, E);
                } PH_END
            }
            PH_BEGIN {
                {
                    pg8::Gemm g = pg8::make_gemm(P_HB + R0 * D, P_WB + WO_BIN + (size_t)(L - 2) * NQG * 1024, GROWS, NQG, D); pg8::GroupOrder S; S.init(GROWS, NQG, GRP_WGS, lc);
                    pg8::EpiQG E{P_Q + R0 * D, P_GATE + R0 * 48, 0.125f * 1.4426950408889634f};
                    pg8::gemm_phase<pg8::EpiQG, pg8::GroupOrder, true, true>(ring, g, S, E);
                }
                if (L == 2) {
#pragma unroll 1
                    for (int q = 0; q < 4; ++q) { const int j = q >> 1, kh = q & 1;
                        pg8::Gemm g; g.A = P_KV + (size_t)(2 * grp) * T * NKV + j * 256 + (size_t)kh * 16 * NKV; g.Bt = P_WB + WO_C1 + (size_t)j * 256 * 2048 + kh * 1024; g.M = 1024; g.N = 256; g.K = 1024; g.ldb = 2048;
                        g.a_rs = 16u * NKV * 2u; g.a_hstep = 64 * 2; g.a_kstep = (size_t)NKV * 2; g.a_t1 = (size_t)T * NKV * 2; g.a_t0 = 128 * 2; g.a_sh = 1; g.stagger_ticks = 0;
                        pg8::GroupOrder S; S.init(1024, 256, GRP_WGS, (lc + GRP_WGS - 16 - 4 * q) % GRP_WGS);
                        pg8::EpiF32 E{(float*)(ws + WS_Y + (size_t)grp * (8u << 20)) + (size_t)q * 1024 * 256, 256};
                        pg8::gemm_phase<pg8::EpiF32, pg8::GroupOrder, true, true>(ring, g, S, E);
                    }
                }
            } PH_END
            if (L == 2) {
                PH_BEGIN cmp2_phase(Fp, (const float*)P_Y, P_CB1, KA->in[18], KA->in[19], P_KCV); PH_END
            }
            PH_BEGIN { const nsa::Tensors AT{P_Q, P_GATE, P_KCV, P_KV, P_O}; nsa::attn_phase(Fp, AT); } PH_END
            PH_BEGIN {
                pg8::Gemm g = pg8::make_gemm(P_O + R0 * D, P_WB + WO_BOUT + (size_t)(L - 2) * 1024 * 1024, GROWS, D, D); pg8::GroupOrder S; S.init(GROWS, D, GRP_WGS, lc);
                pg8::EpiBf16<0> E{P_Y + R0 * D, D, nullptr, 0, 0, 1.f};
                pg8::gemm_phase<pg8::EpiBf16<0>, pg8::GroupOrder, true, true>(ring, g, S, E);
            } PH_END
        }
        PH_BEGIN { const float* modL = P_MOD + (size_t)L * 16 * 6144;
            if (L == 0) norm_phase<true, true, false, false, true>(Fp, KA->in[0], P_XB, P_Y, P_NG(L, 1), modL + 2 * 1024, P_NG(L, 2), modL + 3 * 1024, modL + 4 * 1024, 6144, P_HB, nullptr, nullptr, nullptr, 0, nullptr);
            else norm_phase<true, true, false, true, true>(Fp, P_XB, P_XB, P_Y, P_NG(L, 1), modL + 2 * 1024, P_NG(L, 2), modL + 3 * 1024, modL + 4 * 1024, 6144, P_HB, nullptr, nullptr, nullptr, 0, nullptr); } PH_END
#pragma unroll 1
        for (int hf = 0; hf < 2; ++hf) {
            PH_BEGIN {
                pg8::Gemm g = pg8::make_gemm(P_HB + (R0 + (size_t)hf * T) * D, P_WB + WO_FIN + (size_t)L * 4096 * 1024, T, FF, D); pg8::GroupOrder S; S.init(T, FF, GRP_WGS, lc);
                pg8::EpiBf16<3> E{P_BIGW, FF, nullptr, 0, 0, 1.f};
                pg8::gemm_phase<pg8::EpiBf16<3>, pg8::GroupOrder, true, true>(ring, g, S, E);
            } PH_END
            PH_BEGIN {
                pg8::Gemm g = pg8::make_gemm(P_BIGW, P_WB + WO_FOUT + (size_t)L * 1024 * 4096, T, D, FF); pg8::GroupOrder S; S.init(T, D, GRP_WGS, lc);
                pg8::EpiBf16<0> E{P_Y + (R0 + (size_t)hf * T) * D, D, nullptr, 0, 0, 1.f};
                pg8::gemm_phase<pg8::EpiBf16<0>, pg8::GroupOrder, true, true>(ring, g, S, E);
            } PH_END
        }
        PH_BEGIN {
            const float* modL = P_MOD + (size_t)L * 16 * 6144;
            const float* gy = P_NG(L, 3); const float* gate = modL + 5 * 1024;
            if (L == 3) norm_phase<true, false, false, true, false>(Fp, P_XB, KA->out, P_Y, gy, gate, nullptr, nullptr, nullptr, 6144, nullptr, nullptr, nullptr, nullptr, 0, nullptr);
            else { const float* modN = P_MOD + (size_t)(L + 1) * 16 * 6144; const float* gn = P_NG(L + 1, 0);
                if (L == 1) norm_phase<true, true, true, true, true>(Fp, P_XB, P_XB, P_Y, gy, gate, gn, modN + 0, modN + 1024, 6144, P_HB, KA->in[13], P_KVMOD + 0, P_KVMOD + 1024, 2048, P_HKV);
                else norm_phase<true, true, false, true, true>(Fp, P_XB, P_XB, P_Y, gy, gate, gn, modN + 0, modN + 1024, 6144, P_HB, nullptr, nullptr, nullptr, 0, nullptr); }
        } PH_END
    }
#undef PH_BEGIN
#undef PH_END
#undef PH_END_GRID
#undef GRID_BAR
#undef GRP_BAR
}

extern "C" void kernel_launch(void* const* d_in, const int* in_sizes, int n_in, void* d_out, int out_size, void* d_ws, size_t ws_size, hipStream_t stream) {
    static int grid = 0;
    if (grid == 0) {
        if (n_in != 24 || out_size != M * D || ws_size < WS_END) { fprintf(stderr, "kernel_launch: unexpected shapes (n_in %d, out %d, ws %zu)\n", n_in, out_size, ws_size); grid = -1; return; }
        int dev = 0, cus = 0, per_cu = 0;
        if (hipGetDevice(&dev) != hipSuccess || hipDeviceGetAttribute(&cus, hipDeviceAttributeMultiprocessorCount, dev) != hipSuccess) { grid = -1; return; }
        if (hipFuncSetAttribute((const void*)fwd, hipFuncAttributeMaxDynamicSharedMemorySize, LDS_BYTES) != hipSuccess) { grid = -1; return; }
        if (hipOccupancyMaxActiveBlocksPerMultiprocessor(&per_cu, (const void*)fwd, NWAVES * 64, LDS_BYTES) != hipSuccess || per_cu < 1)
            fprintf(stderr, "kernel_launch: occupancy query reports %d workgroups per CU\n", per_cu);
        (void)hipGetLastError();
        grid = cus;
        if (grid != NGRP * GRP_WGS) { fprintf(stderr, "kernel_launch: %d CUs, this build deals the work to %d workgroups\n", cus, NGRP * GRP_WGS); grid = -1; return; }
    }
    if (grid < 0) return;
    if (hipMemsetAsync((char*)d_ws + WS_CTL, 0, CTL_ZERO_BYTES, stream) != hipSuccess) return;
    Args a{};
    for (int i = 0; i < 24; ++i) a.in[i] = (const float*)d_in[i];
    a.out = (float*)d_out; a.ws = (unsigned char*)d_ws;
#if MK_MULTI
    static const int probe[] = {PROBE_PHASES, -1};
    for (int p = 0; p < 40; ++p) { a.ph_lo = p; a.ph_hi = p + 1; int n = 1; for (int k = 0; probe[k] >= 0; ++k) if (probe[k] == p) n += PROBE_REPS;
        for (int r = 0; r < n; ++r) hipLaunchKernelGGL(fwd, dim3(grid), dim3(NWAVES * 64), LDS_BYTES, stream, a); }
#else
    a.ph_lo = 0; a.ph_hi = 1000; hipLaunchKernelGGL(fwd, dim3(grid), dim3(NWAVES * 64), LDS_BYTES, stream, a);
#endif
}
```

```cpp
#include <hip/hip_runtime.h>
#include <cstdio>
#include <cstdint>
#include <cmath>
#define MK_MULTI 0
#define PROBE_PHASES -1
#define PROBE_REPS 2
#define PROBE_ATT 0
#define STAGGER_FIN 0
#define GRP_STAGGER_TICKS 0
namespace pg8 {
#define PG8_LAS __attribute__((address_space(3)))
typedef unsigned short bf16_t;
typedef short bf16x8 __attribute__((ext_vector_type(8)));
typedef float f32x4 __attribute__((ext_vector_type(4)));
typedef unsigned u32x4 __attribute__((ext_vector_type(4)));
constexpr int BM = 256, BK = 64, HALF = 128, HTB = HALF * BK * 2  , STAGE_BYTES = 8 * HTB, NXCD = 8, WGM = 8;

__host__ __device__ __forceinline__ int lds_byte(int r, int c) { const int st = (r >> 4) * 2 + (c >> 5), rr = r & 15, cc = c & 31, ob = rr * 64 + cc * 2; return st * 1024 + (ob ^ (((ob >> 9) & 1) << 5)); }
__host__ __device__ __forceinline__ void stage_rc(int b, int& R, int& C) { const int st = b / 1024, sb = b % 1024, swz = sb ^ (((sb >> 9) & 1) << 5); R = (st >> 1) * 16 + swz / 64; C = (st & 1) * 32 + (swz % 64) / 2; }
__host__ __device__ __forceinline__ int perm32(int rho) { const int n = rho >> 4, i = rho & 15; return 8 * (i >> 2) + 4 * n + (i & 3); }

struct Unit { int pm, pn; };
struct Gemm { const bf16_t* A; const bf16_t* Bt; int M, N, K; unsigned a_rs; size_t a_hstep, a_kstep, a_t1, a_t0; int a_sh; int ldb; int stagger_ticks; };
__device__ __forceinline__ Gemm make_gemm(const bf16_t* A, const bf16_t* Bt, int M, int N, int K) {
    Gemm g; g.A = A; g.Bt = Bt; g.M = M; g.N = N; g.K = K; g.a_rs = (unsigned)K * 2u; g.a_hstep = (size_t)HALF * K * 2; g.a_kstep = BK * 2; g.a_t1 = (size_t)BM * K * 2; g.a_t0 = 0; g.a_sh = 0; g.ldb = K; g.stagger_ticks = 0; return g; }

struct StaticOrder {
    int nM, nN, nwg, G, c;
    __host__ __device__ void init(int M, int N, int G_, int c_) { nM = M / BM; nN = N / BM; nwg = nM * nN; G = G_; c = c_; }
    __host__ __device__ bool next(int i, Unit& u) const {
        const long L = (long)i * G + c; if (L >= nwg) return false;
        int wgid = (int)L; { const int q = nwg / NXCD, r = nwg % NXCD, xcd = wgid % NXCD, off = wgid / NXCD; wgid = (xcd < r ? xcd * (q + 1) : r * (q + 1) + (xcd - r) * q) + off; }
        const int nig = WGM * nN, gid = wgid / nig, fm = gid * WGM, gsz = (nM - fm) < WGM ? (nM - fm) : WGM;
        u.pm = fm + ((wgid % nig) % gsz); u.pn = (wgid % nig) / gsz; return true;
    }
    __device__ __forceinline__ void a_ready(const Unit&) const {}
    __device__ __forceinline__ void done(const Unit&) const {}
};
struct GroupOrder {
    int nM, nN, nwg, G, c;
    __host__ __device__ void init(int M, int N, int G_, int c_) { nM = M / BM; nN = N / BM; nwg = nM * nN; G = G_; c = c_; }
    __host__ __device__ bool next(int i, Unit& u) const {
        const int wgid = i * G + c; if (wgid >= nwg) return false;
        const int nig = WGM * nN, gid = wgid / nig, fm = gid * WGM, gsz = (nM - fm) < WGM ? (nM - fm) : WGM;
        u.pm = fm + ((wgid % nig) % gsz); u.pn = (wgid % nig) / gsz; return true;
    }
    __device__ __forceinline__ void a_ready(const Unit&) const {}
    __device__ __forceinline__ void done(const Unit&) const {}
};

__device__ __forceinline__ unsigned cvt_pk_bf16(float lo, float hi) { unsigned r; asm volatile("v_cvt_pk_bf16_f32 %0, %1, %2" : "=v"(r) : "v"(lo), "v"(hi)); return r; }
__device__ __forceinline__ float gelu_tanh(float v) {
    const float u = v * (0.7978845608028654f + 0.035677408136300125f * v * v);
    const float e = __builtin_amdgcn_exp2f(u * -2.8853900817779268f);
    return v * __builtin_amdgcn_rcpf(1.0f + e);
}
template <int ACT> __device__ __forceinline__ float act_fn(float v) {
    if (ACT == 2) return gelu_tanh(v);
    if (ACT == 3) { const float r = v > 0.f ? v : 0.f; return r * r; }
    return v;
}

template <int ACT  > struct EpiBf16 {
    static constexpr bool PERM = true, AFTER_DRAIN = false;
    bf16_t* O; int ldc; const float* bias; int split_cols; size_t split_stride; float scale0;
    __device__ __forceinline__ void operator()(const f32x4 (&acc)[2][2][4][2], const Unit& u, int wr, int wc, int fr, int fq) const {
        const int row0 = u.pm * BM + wr * 64 + fr; int colt = u.pn * BM; bf16_t* base = O;
        float sc = 1.f; if (split_cols) { const int t = colt / split_cols; base += (size_t)t * split_stride; colt -= t * split_cols; if (t == 0) sc = scale0; }
        const int col0 = colt + wc * 32 + 8 * fq, bcol0 = u.pn * BM + wc * 32 + 8 * fq;
        f32x4 bv[2][2];
#pragma unroll
        for (int bj = 0; bj < 2; ++bj)
#pragma unroll
            for (int n = 0; n < 2; ++n) bv[bj][n] = bias ? *(const f32x4*)(bias + bcol0 + bj * HALF + 4 * n) : (f32x4){0.f, 0.f, 0.f, 0.f};
#pragma unroll
        for (int ai = 0; ai < 2; ++ai)
#pragma unroll
            for (int m = 0; m < 4; ++m) { bf16_t* rowp = base + (size_t)(row0 + ai * HALF + m * 16) * ldc + col0;
#pragma unroll
                for (int bj = 0; bj < 2; ++bj) { f32x4 v0 = acc[ai][bj][m][0] + bv[bj][0], v1 = acc[ai][bj][m][1] + bv[bj][1];
                    if (ACT != 0) {
#pragma unroll
                        for (int e = 0; e < 4; ++e) { v0[e] = act_fn<ACT>(v0[e]); v1[e] = act_fn<ACT>(v1[e]); } }
                    v0 = v0 * sc; v1 = v1 * sc; u32x4 w; w.x = cvt_pk_bf16(v0[0], v0[1]); w.y = cvt_pk_bf16(v0[2], v0[3]); w.z = cvt_pk_bf16(v1[0], v1[1]); w.w = cvt_pk_bf16(v1[2], v1[3]);
                    *(u32x4*)(rowp + bj * HALF) = w; } }
    }
};
struct EpiF32 {
    static constexpr bool PERM = false, AFTER_DRAIN = false;
    float* O; int ldc;
    __device__ __forceinline__ void operator()(const f32x4 (&acc)[2][2][4][2], const Unit& u, int wr, int wc, int fr, int fq) const {
        const int row0 = u.pm * BM + wr * 64 + fr, col0 = u.pn * BM + wc * 32 + 4 * fq;
#pragma unroll
        for (int ai = 0; ai < 2; ++ai)
#pragma unroll
            for (int m = 0; m < 4; ++m) { float* rowp = O + (size_t)(row0 + ai * HALF + m * 16) * ldc + col0;
#pragma unroll
                for (int bj = 0; bj < 2; ++bj)
#pragma unroll
                    for (int n = 0; n < 2; ++n) *(f32x4*)(rowp + bj * HALF + n * 16) = acc[ai][bj][m][n]; }
    }
};
struct EpiQG {
    static constexpr bool PERM = true, AFTER_DRAIN = false;
    bf16_t* Q; float* G; float qscale;
    __device__ __forceinline__ void operator()(const f32x4 (&acc)[2][2][4][2], const Unit& u, int wr, int wc, int fr, int fq) const {
        const int row0 = u.pm * BM + wr * 64 + fr;
        if (u.pn < 4) {
            const int col0 = u.pn * BM + wc * 32 + 8 * fq;
#pragma unroll
            for (int ai = 0; ai < 2; ++ai)
#pragma unroll
                for (int m = 0; m < 4; ++m) { bf16_t* rowp = Q + (size_t)(row0 + ai * HALF + m * 16) * 1024 + col0;
#pragma unroll
                    for (int bj = 0; bj < 2; ++bj) { const f32x4 v0 = acc[ai][bj][m][0] * qscale, v1 = acc[ai][bj][m][1] * qscale;
                        u32x4 w; w.x = cvt_pk_bf16(v0[0], v0[1]); w.y = cvt_pk_bf16(v0[2], v0[3]); w.z = cvt_pk_bf16(v1[0], v1[1]); w.w = cvt_pk_bf16(v1[2], v1[3]);
                        *(u32x4*)(rowp + bj * HALF) = w; } }
        } else if (wc < 2) {
#pragma unroll
            for (int ai = 0; ai < 2; ++ai)
#pragma unroll
                for (int m = 0; m < 4; ++m) { float* rowp = G + (size_t)(row0 + ai * HALF + m * 16) * 48;
#pragma unroll
                    for (int n = 0; n < 2; ++n) { const int col = wc * 32 + 8 * fq + 4 * n;
                        if (col < 48) { f32x4 v = acc[ai][0][m][n];
#pragma unroll
                            for (int e = 0; e < 4; ++e) v[e] = __builtin_amdgcn_rcpf(1.0f + __builtin_amdgcn_exp2f(v[e] * -1.4426950408889634f));
                            *(f32x4*)(rowp + col) = v; } } }
        }
    }
};

template <class Epi, class Sched, bool ALIGN_EPI = false, bool SP2 = false>
__device__ __forceinline__ void gemm_phase(PG8_LAS unsigned char* lds, const Gemm g, const Sched& S, const Epi& E) {
    int tid_ = threadIdx.x; asm volatile("" : "+v"(tid_));
    const int tid = tid_, wid = __builtin_amdgcn_readfirstlane(tid >> 6), lane = tid & 63, wr = wid >> 2, wc = wid & 3, fr = lane & 15, fq = lane >> 4;
    const int K = g.K, nt = K / BK;
    unsigned voffA[2], voffB[2];
#pragma unroll
    for (int i = 0; i < 2; ++i) { int R, C; stage_rc(tid * 16 + i * 8192, R, C); const int Rb = Epi::PERM ? ((R & ~31) + perm32(R & 31)) : R;
        voffA[i] = (unsigned)R * g.a_rs + (unsigned)C * 2u; voffB[i] = (unsigned)(Rb * g.ldb + C) * 2u; }
    const size_t kstepA = g.a_kstep, kstepB = (size_t)(BK * 2);
    const size_t hstepA = g.a_hstep, hstepB = (size_t)HALF * g.ldb * 2;
    const size_t tstepB = 2 * hstepB;
    const int a_msk = (1 << g.a_sh) - 1;
#define PG8_ATILE(pm) ((const char*)g.A + (size_t)((pm) >> g.a_sh) * g.a_t1 + (size_t)((pm) & a_msk) * g.a_t0)
    const unsigned ldsw = (unsigned)wid * 1024u;
    const int aoff = lds_byte(wr * 64 + fr, fq * 8), boff = lds_byte(wc * 32 + fr, fq * 8);
#define PG8_SA(b, h) (((b) * 2 + (h)) * HTB)
#define PG8_SB(b, h) ((4 + (b) * 2 + (h)) * HTB)
#define PG8_STAGE(bufoff, gbase, voff) do { _Pragma("unroll") for (int _i = 0; _i < 2; ++_i) \
        __builtin_amdgcn_global_load_lds((const unsigned*)((const char*)(gbase) + (voff)[_i]), (PG8_LAS unsigned*)(lds + (bufoff) + ldsw + _i * 8192), 16, 0, 0); } while (0)
#define PG8_LDA(dst, b, h) do { _Pragma("unroll") for (int m = 0; m < 4; ++m) _Pragma("unroll") for (int k = 0; k < 2; ++k) dst[m][k] = *(const PG8_LAS bf16x8*)(lds + PG8_SA(b, h) + aoff + m * 2048 + k * 1024); } while (0)
#define PG8_LDB(dst, b, h) do { _Pragma("unroll") for (int n = 0; n < 2; ++n) _Pragma("unroll") for (int k = 0; k < 2; ++k) dst[n][k] = *(const PG8_LAS bf16x8*)(lds + PG8_SB(b, h) + boff + n * 2048 + k * 1024); } while (0)
#define PG8_MMA(ai, bj, At, Bt) do { __builtin_amdgcn_s_setprio(1); _Pragma("unroll") for (int m = 0; m < 4; ++m) _Pragma("unroll") for (int n = 0; n < 2; ++n) _Pragma("unroll") for (int k = 0; k < 2; ++k) \
        acc[ai][bj][m][n] = __builtin_amdgcn_mfma_f32_16x16x32_bf16(Bt[n][k], At[m][k], acc[ai][bj][m][n], 0, 0, 0); __builtin_amdgcn_s_setprio(0); } while (0)
#define PG8_WAIT_V(n) asm volatile("s_waitcnt vmcnt(" #n ")" ::: "memory")
#define PG8_WAIT_L(n) asm volatile("s_waitcnt lgkmcnt(" #n ")" ::: "memory")
#define PG8_BAR __builtin_amdgcn_s_barrier()
#define PG8_SCHED __builtin_amdgcn_sched_barrier(0)
    Unit cur, nxt; int ui = 0;
    if (!S.next(0, cur)) return;
    if (g.stagger_ticks > 0) {
        const unsigned long long t0 = __builtin_amdgcn_s_memrealtime(); const unsigned long long dt = (unsigned long long)(((unsigned)blockIdx.x >> 3) & 3u) * (unsigned)g.stagger_ticks;
        while (__builtin_amdgcn_s_memrealtime() - t0 < dt) __builtin_amdgcn_s_sleep(4);
    }
    f32x4 acc[2][2][4][2];
#pragma unroll
    for (int a = 0; a < 2; ++a)
#pragma unroll
        for (int b = 0; b < 2; ++b)
#pragma unroll
            for (int m = 0; m < 4; ++m)
#pragma unroll
                for (int n = 0; n < 2; ++n) acc[a][b][m][n] = (f32x4){0.f, 0.f, 0.f, 0.f};
    bf16x8 At[4][2], B0[2][2], B1[2][2];
    const char* cA = PG8_ATILE(cur.pm); const char* cB = (const char*)g.Bt + (size_t)cur.pn * tstepB;
    S.a_ready(cur);
    if constexpr (SP2) {
        PG8_STAGE(PG8_SB(0, 0), cB, voffB); PG8_STAGE(PG8_SB(0, 1), cB + hstepB, voffB); PG8_STAGE(PG8_SA(0, 0), cA, voffA); PG8_STAGE(PG8_SA(0, 1), cA + hstepA, voffA);
        if (wr == 1) PG8_BAR;
        PG8_WAIT_V(2); PG8_BAR;
        PG8_STAGE(PG8_SB(1, 0), cB + kstepB, voffB); PG8_STAGE(PG8_SA(1, 0), cA + kstepA, voffA); PG8_STAGE(PG8_SB(1, 1), cB + hstepB + kstepB, voffB);
        PG8_WAIT_V(6); PG8_BAR;
    } else {
        PG8_STAGE(PG8_SB(0, 0), cB, voffB); PG8_STAGE(PG8_SA(0, 0), cA, voffA); PG8_STAGE(PG8_SB(0, 1), cB + hstepB, voffB); PG8_STAGE(PG8_SA(0, 1), cA + hstepA, voffA);
        if (wr == 1) PG8_BAR;
        PG8_WAIT_V(4); PG8_BAR;
        PG8_STAGE(PG8_SB(1, 0), cB + kstepB, voffB); PG8_STAGE(PG8_SA(1, 0), cA + kstepA, voffA); PG8_STAGE(PG8_SB(1, 1), cB + hstepB + kstepB, voffB);
        PG8_WAIT_V(6); PG8_BAR;
    }
    for (;;) {
        const bool has_next = S.next(ui + 1, nxt);
        const char* nA = has_next ? PG8_ATILE(nxt.pm) : cA; const char* nB = has_next ? (const char*)g.Bt + (size_t)nxt.pn * tstepB : cB;
        for (int t = 0; t < nt; t += 2) {
            const bool last = (t == nt - 2);
            const char* a1 = cA + (size_t)(t + 1) * kstepA;
            const char* a2 = last ? nA : cA + (size_t)(t + 2) * kstepA; const char* b2 = last ? nB : cB + (size_t)(t + 2) * kstepB;
            const char* a3 = a2 + kstepA; const char* b3 = b2 + kstepB;
            if (last && has_next) S.a_ready(nxt);
            if constexpr (SP2) {
            PG8_LDB(B0, 0, 0); PG8_LDB(B1, 0, 1); PG8_SCHED; PG8_LDA(At, 0, 0); PG8_STAGE(PG8_SA(1, 1), a1 + hstepA, voffA);
            PG8_WAIT_V(8); PG8_WAIT_L(0); PG8_BAR; PG8_MMA(0, 0, At, B0); PG8_MMA(0, 1, At, B1); PG8_BAR; PG8_SCHED;
            PG8_LDA(At, 0, 1); PG8_STAGE(PG8_SB(0, 0), b2, voffB); PG8_STAGE(PG8_SB(0, 1), b2 + hstepB, voffB); PG8_STAGE(PG8_SA(0, 0), a2, voffA);
            PG8_WAIT_V(8); PG8_WAIT_L(0); PG8_BAR; PG8_MMA(1, 0, At, B0); PG8_MMA(1, 1, At, B1); PG8_BAR; PG8_SCHED;
            PG8_LDB(B0, 1, 0); PG8_LDB(B1, 1, 1); PG8_SCHED; PG8_LDA(At, 1, 0); PG8_STAGE(PG8_SA(0, 1), a2 + hstepA, voffA);
            PG8_WAIT_V(8); PG8_WAIT_L(0); PG8_BAR; PG8_MMA(0, 0, At, B0); PG8_MMA(0, 1, At, B1); PG8_BAR; PG8_SCHED;
            PG8_LDA(At, 1, 1); PG8_STAGE(PG8_SB(1, 0), b3, voffB); PG8_STAGE(PG8_SB(1, 1), b3 + hstepB, voffB); PG8_STAGE(PG8_SA(1, 0), a3, voffA);
            PG8_WAIT_V(8); PG8_WAIT_L(0); PG8_BAR; PG8_MMA(1, 0, At, B0); PG8_MMA(1, 1, At, B1); PG8_BAR; PG8_SCHED;
            } else {
            PG8_LDB(B0, 0, 0); PG8_SCHED; PG8_LDA(At, 0, 0); PG8_STAGE(PG8_SA(1, 1), a1 + hstepA, voffA);
            PG8_WAIT_L(8); PG8_BAR; PG8_WAIT_L(0); PG8_MMA(0, 0, At, B0); PG8_BAR; PG8_SCHED;
            PG8_LDB(B1, 0, 1); PG8_STAGE(PG8_SB(0, 0), b2, voffB);
            PG8_BAR; PG8_WAIT_L(0); PG8_MMA(0, 1, At, B1); PG8_BAR;
            PG8_LDA(At, 0, 1); PG8_STAGE(PG8_SA(0, 0), a2, voffA);
            PG8_BAR; PG8_WAIT_L(0); PG8_MMA(1, 0, At, B0); PG8_BAR; PG8_SCHED;
            PG8_STAGE(PG8_SB(0, 1), b2 + hstepB, voffB);
            PG8_WAIT_V(6); PG8_BAR; PG8_MMA(1, 1, At, B1); PG8_BAR;
            PG8_LDB(B0, 1, 0); PG8_SCHED; PG8_LDA(At, 1, 0); PG8_STAGE(PG8_SA(0, 1), a2 + hstepA, voffA);
            PG8_WAIT_L(8); PG8_BAR; PG8_WAIT_L(0); PG8_MMA(0, 0, At, B0); PG8_BAR; PG8_SCHED;
            PG8_LDB(B1, 1, 1); PG8_STAGE(PG8_SB(1, 0), b3, voffB);
            PG8_BAR; PG8_WAIT_L(0); PG8_MMA(0, 1, At, B1); PG8_BAR;
            PG8_LDA(At, 1, 1); PG8_STAGE(PG8_SA(1, 0), a3, voffA);
            PG8_BAR; PG8_WAIT_L(0); PG8_MMA(1, 0, At, B0); PG8_BAR; PG8_SCHED;
            PG8_STAGE(PG8_SB(1, 1), b3 + hstepB, voffB);
            PG8_WAIT_V(6); PG8_BAR; PG8_MMA(1, 1, At, B1); PG8_BAR;
            }
        }
        if constexpr (ALIGN_EPI) { if (wr == 0) PG8_BAR; }
        E(acc, cur, wr, wc, fr, fq); S.done(cur);
        if (!has_next) break;
#pragma unroll
        for (int a = 0; a < 2; ++a)
#pragma unroll
            for (int b = 0; b < 2; ++b)
#pragma unroll
                for (int m = 0; m < 4; ++m)
#pragma unroll
                    for (int n = 0; n < 2; ++n) acc[a][b][m][n] = (f32x4){0.f, 0.f, 0.f, 0.f};
        cur = nxt; cA = nA; cB = nB; ++ui;
        if constexpr (ALIGN_EPI) { if (wr == 1) PG8_BAR; }
    }
    PG8_WAIT_V(0);
    if constexpr (!ALIGN_EPI) { if (wr == 0) PG8_BAR; }
    PG8_BAR;
#undef PG8_ATILE
#undef PG8_SA
#undef PG8_SB
#undef PG8_STAGE
#undef PG8_LDA
#undef PG8_LDB
#undef PG8_MMA
#undef PG8_WAIT_V
#undef PG8_WAIT_L
#undef PG8_BAR
#undef PG8_SCHED
}
}
constexpr int NWAVES = 8;
#ifndef MK_MULTI
#define MK_MULTI 0
#endif

constexpr int BATCH = 16, T = 2048, D = 1024, FF = 4096, DEPTH = 4;
constexpr int M = BATCH * T;
constexpr int MH = M / 2;
constexpr int NKV = 1536;
constexpr int NQG = 1280;
constexpr int NCMP = 127;
constexpr float EPS = 1e-6f;

constexpr size_t MiB = 1u << 20;
constexpr size_t WS_CTL = 0, CTL_ZERO_BYTES = 64 * 1024;
constexpr size_t WS_MOD = 1 * MiB;
constexpr size_t WS_CB1 = 3 * MiB;
constexpr size_t WS_GATE = 4 * MiB;
constexpr size_t WS_KCV = 10 * MiB;
constexpr size_t WS_CH = 16 * MiB;
constexpr size_t WS_W = 32 * MiB;
constexpr size_t WS_KV = 128 * MiB;
constexpr size_t WS_HB = 224 * MiB;
constexpr size_t WS_Y = 288 * MiB;
constexpr size_t WS_BIG = 352 * MiB;
constexpr size_t WS_END = 480 * MiB;
constexpr size_t WO_AIN = 0;
constexpr size_t WO_AOUT = WO_AIN + 2ull * 2048 * 1024;
constexpr size_t WO_KV = WO_AOUT + 2ull * 1024 * 1024;
constexpr size_t WO_BIN = WO_KV + 1536ull * 1024;
constexpr size_t WO_BOUT = WO_BIN + 2ull * 1280 * 1024;
constexpr size_t WO_FIN = WO_BOUT + 2ull * 1024 * 1024;
constexpr size_t WO_FOUT = WO_FIN + 4ull * 4096 * 1024;
constexpr size_t WO_C1 = WO_FOUT + 4ull * 4096 * 1024;
constexpr size_t WO_WS = WO_C1 + 2ull * 256 * 2048;
constexpr size_t WO_END = WO_WS + 2ull * 8 * 128 * 128;
static_assert(WO_END * 2 <= 96 * MiB, "weights fit");
constexpr int CW_BAR = 1024;

constexpr int RING_OFF = 0, RING_BYTES = 131072;
constexpr int LDSCTL_OFF = RING_BYTES, MISC_OFF = LDSCTL_OFF + 320;
constexpr int LDS_BYTES = 147456;

#define GAS __attribute__((address_space(1)))
#define LAS __attribute__((address_space(3)))
typedef unsigned short bf16;
typedef unsigned v4u __attribute__((ext_vector_type(4)));
typedef unsigned v2u __attribute__((ext_vector_type(2)));
typedef float f32x4 __attribute__((ext_vector_type(4)));
typedef GAS unsigned gu32;
#define RLX_AGENT __ATOMIC_RELAXED, __HIP_MEMORY_SCOPE_AGENT
#define LDS_WAIT() asm volatile("s_waitcnt lgkmcnt(0)" ::: "memory")
#define VM_WAIT() asm volatile("s_waitcnt vmcnt(0)" ::: "memory")
__device__ __forceinline__ unsigned f2bf(float f) { unsigned u = __builtin_bit_cast(unsigned, f); return (u + 0x7fffu + ((u >> 16) & 1u)) >> 16; }
__device__ __forceinline__ unsigned pk2(float lo, float hi) { return f2bf(lo) | (f2bf(hi) << 16); }
__device__ __forceinline__ float bf_lo(unsigned w) { return __builtin_bit_cast(float, w << 16); }
__device__ __forceinline__ float bf_hi(unsigned w) { return __builtin_bit_cast(float, w & 0xffff0000u); }
__device__ __forceinline__ float bf1(bf16 h) { return __builtin_bit_cast(float, (unsigned)h << 16); }
__device__ __forceinline__ float wave_sum(float v) {
#pragma unroll
    for (int o = 1; o < 64; o <<= 1) v += __shfl_xor(v, o);
    return v;
}
__device__ __forceinline__ float wave_max(float v) {
#pragma unroll
    for (int o = 1; o < 64; o <<= 1) v = fmaxf(v, __shfl_xor(v, o));
    return v;
}

#define XB_TMO      128
#define XB_XCNT(j)  (256  + 64 * (j))
#define XB_XSUB(j)  (1280 + 64 * (j))
#define XB_XGEN(j)  (2304 + 64 * (j))
#define XB_TOP      3328
#define XB_TOPGEN   3392
#define XCD_BAR_WORDS 3456
#define XB_SPIN_CAP (1u << 18)

__device__ __forceinline__ unsigned xb_ld(unsigned* p)              { return __hip_atomic_load(p, __ATOMIC_RELAXED, __HIP_MEMORY_SCOPE_AGENT); }
__device__ __forceinline__ unsigned xb_add(unsigned* p, unsigned v) { return __hip_atomic_fetch_add(p, v, __ATOMIC_RELAXED, __HIP_MEMORY_SCOPE_AGENT); }
__device__ __forceinline__ unsigned xb_xcc_id() { return (unsigned)__builtin_amdgcn_s_getreg((3 << 11) | 20) & 0xFu; }
#define XB_SPIN(cond, bar) do { unsigned _sp = 0; while (cond) { __builtin_amdgcn_s_sleep(1); \
    if ((++_sp & 255u) == 0u) { if (xb_ld(&(bar)[XB_TMO])) break; if (_sp > XB_SPIN_CAP) { atomicAdd(&(bar)[XB_TMO], 1u); break; } } } } while (0)

struct XcdBarrier {
    unsigned* bar; unsigned x;
    volatile LAS unsigned* st;
};
__device__ __forceinline__ XcdBarrier xcd_barrier_post(unsigned* bar, volatile LAS unsigned* st) {
    XcdBarrier b; b.bar = bar; b.x = xb_xcc_id(); b.st = st;
    if (threadIdx.x == 0) (void)xb_add(&bar[XB_XCNT(b.x)], 1u);
    return b;
}
__device__ __forceinline__ void xcd_barrier_complete(unsigned* bar, unsigned x, unsigned& nloc, unsigned& nx) {
    const unsigned G = gridDim.x * gridDim.y * gridDim.z;
    unsigned sum, cnt, mine, sp = 0u;
    for (;;) {
        sum = 0u; cnt = 0u; mine = 0u;
#pragma unroll
        for (unsigned j = 0; j < 16; ++j) { const unsigned c = xb_ld(&bar[XB_XCNT(j)]); sum += c; cnt += (c > 0u) ? 1u : 0u; mine = (j == x) ? c : mine; }
        if (sum == G) break;
        __builtin_amdgcn_s_sleep(1);
        if ((++sp & 255u) == 0u) { if (xb_ld(&bar[XB_TMO])) break; if (sp > XB_SPIN_CAP) { atomicAdd(&bar[XB_TMO], 1u); break; } }
    }
    nloc = mine > 0u ? mine : 1u; nx = cnt > 0u ? cnt : 1u;
}
__device__ __forceinline__ void xcd_barrier(const XcdBarrier& b) {
    asm volatile("s_waitcnt vmcnt(0)" ::: "memory");
    __syncthreads();
    if (threadIdx.x == 0) {
        unsigned* bar = b.bar;
        __builtin_amdgcn_s_waitcnt(0);
        unsigned nloc = b.st[0], nx = b.st[1];
        if (nloc == 0u) { xcd_barrier_complete(bar, b.x, nloc, nx); b.st[0] = nloc; b.st[1] = nx; }
        const unsigned old = xb_add(&bar[XB_XSUB(b.x)], 1u);
        const unsigned gen = old / nloc;
        if (old + 1u == (gen + 1u) * nloc) {
            __builtin_amdgcn_fence(__ATOMIC_RELEASE, "agent");
            asm volatile("s_waitcnt vmcnt(0)" ::: "memory");
            const unsigned og = xb_add(&bar[XB_TOP], 1u);
            const unsigned tg = og / nx;
            if (og + 1u == (tg + 1u) * nx) xb_add(&bar[XB_TOPGEN], 1u);
            else XB_SPIN(xb_ld(&bar[XB_TOPGEN]) == tg, bar);
            __builtin_amdgcn_fence(__ATOMIC_ACQUIRE, "agent");
            xb_add(&bar[XB_XGEN(b.x)], 1u);
            asm volatile("s_waitcnt vmcnt(0)" ::: "memory");
        } else {
            XB_SPIN(xb_ld(&bar[XB_XGEN(b.x)]) == gen, bar);
            __builtin_amdgcn_fence(__ATOMIC_ACQUIRE, "agent");
            asm volatile("s_waitcnt vmcnt(0)" ::: "memory");
        }
    }
    __syncthreads();
}

constexpr int GRP_WGS = 32, NGRP = 8, CW_GRP = 8192, GROWS = M / NGRP;
__device__ __forceinline__ void grp_barrier(unsigned* w, unsigned* bar) {
    asm volatile("s_waitcnt vmcnt(0)" ::: "memory");
    __syncthreads();
    if (threadIdx.x == 0) {
        const unsigned mask = xb_ld(w + 32); const bool one_xcd = (mask & (mask - 1u)) == 0u;
        if (!one_xcd) { __builtin_amdgcn_fence(__ATOMIC_RELEASE, "agent"); asm volatile("s_waitcnt vmcnt(0)" ::: "memory"); }
        const unsigned old = xb_add(w, 1u);
        const unsigned gen = old / (unsigned)GRP_WGS;
        if (old + 1u == (gen + 1u) * (unsigned)GRP_WGS) xb_add(w + 16, 1u);
        else XB_SPIN(xb_ld(w + 16) == gen, bar);
        __builtin_amdgcn_fence(__ATOMIC_ACQUIRE, "agent");
        asm volatile("s_waitcnt vmcnt(0)" ::: "memory");
    }
    __syncthreads();
}

struct Frame {
    LAS unsigned char* lds;
    int tid, lane, wave;
    int vcu, G;
};
__device__ __forceinline__ void tr_item(const float* W, int K, int ldw, int nvalid, bf16* WT, int nblk, LAS float* scr, int item, int lane) {
    const int kb = item / nblk, nb = item % nblk, k0 = 64 * kb, n0 = 32 * nb;
    const int kr = lane >> 3, n4 = (lane & 7) * 4; const bool ok = (n0 + n4) < nvalid;
    f32x4 v[8];
#pragma unroll
    for (int i = 0; i < 8; ++i) v[i] = ok ? *(const f32x4*)(W + (size_t)(k0 + 8 * i + kr) * ldw + n0 + n4) : (f32x4){0.f, 0.f, 0.f, 0.f};
#pragma unroll
    for (int i = 0; i < 8; ++i) { LAS float* d = scr + (8 * i + kr) * 33 + n4; d[0] = v[i].x; d[1] = v[i].y; d[2] = v[i].z; d[3] = v[i].w; }
    LDS_WAIT(); asm volatile("" ::: "memory");
    const int c = lane & 7;
#pragma unroll
    for (int j = 0; j < 4; ++j) { const int n = (lane >> 3) + 8 * j; const LAS float* s = scr + (8 * c) * 33 + n;
        v4u o; o.x = pk2(s[0 * 33], s[1 * 33]); o.y = pk2(s[2 * 33], s[3 * 33]); o.z = pk2(s[4 * 33], s[5 * 33]); o.w = pk2(s[6 * 33], s[7 * 33]);
        *(GAS v4u*)(WT + (size_t)(n0 + n) * K + k0 + 8 * c) = o; }
    LDS_WAIT(); asm volatile("" ::: "memory");
}

struct Args { const float* in[24]; float* out; unsigned char* ws; int ph_lo, ph_hi; };
typedef const __attribute__((address_space(4))) Args* kargs_t;

constexpr int I_AIN = 16 * 64, I_AOUT = 16 * 32, I_KV = 16 * 48, I_BIN = 16 * 40, I_BOUT = 16 * 32, I_FIN = 16 * 128, I_FOUT = 64 * 32, I_C1 = 32 * 8;
constexpr int O_AOUT = 2 * I_AIN, O_KV = O_AOUT + 2 * I_AOUT, O_BIN = O_KV + I_KV, O_BOUT = O_BIN + 2 * I_BIN, O_FIN = O_BOUT + 2 * I_BOUT, O_FOUT = O_FIN + 4 * I_FIN, O_C1 = O_FOUT + 4 * I_FOUT, NITEMS = O_C1 + 2 * I_C1;
__device__ __forceinline__ void conv_item(kargs_t a, bf16* WB, LAS float* scr, int it, int lane) {
    int r = it;
    if (r < 2 * I_AIN) { const int l = r / I_AIN; tr_item(a->in[5] + (size_t)l * 1024 * 2048, 1024, 2048, 2048, WB + WO_AIN + (size_t)l * 2048 * 1024, 64, scr, r % I_AIN, lane); return; } r -= 2 * I_AIN;
    if (r < 2 * I_AOUT) { const int l = r / I_AOUT; tr_item(a->in[10] + (size_t)l * 1024 * 1024, 1024, 1024, 1024, WB + WO_AOUT + (size_t)l * 1024 * 1024, 32, scr, r % I_AOUT, lane); return; } r -= 2 * I_AOUT;
    if (r < I_KV) { tr_item(a->in[14], 1024, 1536, 1536, WB + WO_KV, 48, scr, r, lane); return; } r -= I_KV;
    if (r < 2 * I_BIN) { const int l = r / I_BIN; tr_item(a->in[20] + (size_t)l * 1024 * 1072, 1024, 1072, 1072, WB + WO_BIN + (size_t)l * 1280 * 1024, 40, scr, r % I_BIN, lane); return; } r -= 2 * I_BIN;
    if (r < 2 * I_BOUT) { const int l = r / I_BOUT; tr_item(a->in[21] + (size_t)l * 1024 * 1024, 1024, 1024, 1024, WB + WO_BOUT + (size_t)l * 1024 * 1024, 32, scr, r % I_BOUT, lane); return; } r -= 2 * I_BOUT;
    if (r < 4 * I_FIN) { const int l = r / I_FIN; tr_item(a->in[22] + (size_t)l * 1024 * 4096, 1024, 4096, 4096, WB + WO_FIN + (size_t)l * 4096 * 1024, 128, scr, r % I_FIN, lane); return; } r -= 4 * I_FIN;
    if (r < 4 * I_FOUT) { const int l = r / I_FOUT; tr_item(a->in[23] + (size_t)l * 4096 * 1024, 4096, 1024, 1024, WB + WO_FOUT + (size_t)l * 1024 * 4096, 32, scr, r % I_FOUT, lane); return; } r -= 4 * I_FOUT;
    { const int l = r / I_C1; tr_item(a->in[16] + (size_t)l * 2048 * 256, 2048, 256, 256, WB + WO_C1 + (size_t)l * 256 * 2048, 8, scr, r % I_C1, lane); }
}
constexpr int N_EARLY = I_AIN + I_AOUT + I_FIN + I_FOUT, N_LATE = NITEMS - N_EARLY;
__device__ __forceinline__ int early_item(int p) { if (p < I_AIN) return p; p -= I_AIN; if (p < I_AOUT) return O_AOUT + p; p -= I_AOUT; if (p < I_FIN) return O_FIN + p; p -= I_FIN; return O_FOUT + p; }
__device__ __forceinline__ int late_item(int p) { if (p < I_AIN) return I_AIN + p; p -= I_AIN; if (p < O_FIN - (O_AOUT + I_AOUT)) return O_AOUT + I_AOUT + p; p -= O_FIN - (O_AOUT + I_AOUT);
    if (p < 3 * I_FIN) return O_FIN + I_FIN + p; p -= 3 * I_FIN; return O_FOUT + I_FOUT + p; }
constexpr int CW_LATE = 12288;
__device__ __forceinline__ void late_convert(const Frame& F, kargs_t a, int first, int count, int wv, int nwv) {
    LAS float* scr = (LAS float*)(F.lds + RING_OFF + F.wave * 16384);
    bf16* WB = (bf16*)(a->ws + WS_W);
    for (int p = first + wv; p < first + count; p += nwv) conv_item(a, WB, scr, late_item(p), F.lane);
}

__device__ __forceinline__ void p0_prologue(const Frame& F, kargs_t a) {
    LAS float* scr = (LAS float*)(F.lds + RING_OFF + F.wave * 16384);
    bf16* WB = (bf16*)(a->ws + WS_W);
    const int gw = F.vcu * NWAVES + F.wave, NGW = F.G * NWAVES;
    for (int p = gw; p < N_EARLY; p += NGW) conv_item(a, WB, scr, early_item(p), F.lane);
#if MK_MULTI
    late_convert(F, a, 0, N_LATE, gw, NGW);
#endif
    for (int i = gw * 64 + F.lane; i < 2 * 8 * 128 * 128; i += NGW * 64) { const int s = i & 127, t = (i >> 7) & 127; WB[WO_WS + i] = (s <= t) ? (bf16)f2bf(a->in[8][i]) : (bf16)0; }
    __syncthreads();
    if (F.vcu < 208) {
        LAS float* cact = (LAS float*)(F.lds);
        LAS float* red = (LAS float*)(F.lds + 65536);
        for (int i = F.tid; i < 16 * 1024; i += NWAVES * 64) { const float c = a->in[1][i]; cact[i] = c / (1.0f + __expf(-c)); }
        __syncthreads();
        const int grp = F.vcu; const float* W; const float* bias; float* out; int ldw, n0, ostride;
        float* MOD = (float*)(a->ws + WS_MOD);
        if (grp < 192) { const int L = grp / 48; n0 = (grp % 48) * 128; W = a->in[2] + (size_t)L * 1024 * 6144; ldw = 6144; bias = a->in[3] + L * 6144; out = MOD + (size_t)L * 16 * 6144; ostride = 6144; }
        else { n0 = (grp - 192) * 128; W = a->in[11]; ldw = 2048; bias = a->in[12]; out = MOD + (size_t)4 * 16 * 6144; ostride = 2048; }
        float acc0[16], acc1[16];
#pragma unroll
        for (int b = 0; b < 16; ++b) { acc0[b] = 0.f; acc1[b] = 0.f; }
        const int kbeg = F.wave * 128;
        for (int k = kbeg; k < kbeg + 128; k += 8) {
            float2 w[8];
#pragma unroll
            for (int u = 0; u < 8; ++u) w[u] = *(const float2*)(W + (size_t)(k + u) * ldw + n0 + 2 * F.lane);
#pragma unroll
            for (int u = 0; u < 8; ++u)
#pragma unroll
                for (int b = 0; b < 16; ++b) { const float cv = cact[b * 1024 + k + u]; acc0[b] += cv * w[u].x; acc1[b] += cv * w[u].y; }
        }
#pragma unroll
        for (int b = 0; b < 16; ++b) { red[(F.wave * 16 + b) * 128 + 2 * F.lane] = acc0[b]; red[(F.wave * 16 + b) * 128 + 2 * F.lane + 1] = acc1[b]; }
        __syncthreads();
        for (int o = F.tid; o < 2048; o += NWAVES * 64) { const int b = o >> 7, n = o & 127; float s = bias[n0 + n];
#pragma unroll
            for (int w = 0; w < 8; ++w) s += red[(w * 16 + b) * 128 + n];
            out[(size_t)b * ostride + n0 + n] = s; }
    } else if (F.vcu == 208) {
        const int j = F.tid >> 8, n = F.tid & 255; float s = a->in[17][j * 256 + n];
        const float* pos = a->in[15] + j * 2048; const float* w1 = a->in[16] + (size_t)j * 2048 * 256 + n;
        for (int kk = 0; kk < 2048; ++kk) s += pos[kk] * w1[(size_t)kk * 256];
        ((float*)(a->ws + WS_CB1))[j * 256 + n] = s;
    }
}

template <bool HAS_Y, bool HAS_H, bool HAS_KV, bool XIN_BF, bool XOUT_BF>
__device__ __forceinline__ void norm_phase(const Frame& F, const void* xin_, void* xout_, const bf16* Y, const float* gy, const float* gate  ,
                                           const float* gn, const float* sh, const float* sc, int mstride, bf16* H,
                                           const float* gkv, const float* shkv, const float* sckv, int kvstride, bf16* HKV) {
    const int gw = F.vcu * NWAVES + F.wave, NGW = F.G * NWAVES;
    for (int blk = gw; blk < M / 16; blk += NGW) {
        const int b = blk / (T / 16);
        f32x4 A1[4], A2[4], A3[4], K2[4], K3[4];
#pragma unroll
        for (int j = 0; j < 4; ++j) { const int col = 256 * j + 4 * F.lane;
            if (HAS_Y) A1[j] = *(const f32x4*)(gate + (size_t)b * mstride + col) * *(const f32x4*)(gy + col);
            if (HAS_H) { A2[j] = *(const f32x4*)(gn + col) * (*(const f32x4*)(sc + (size_t)b * mstride + col) + 1.0f); A3[j] = *(const f32x4*)(sh + (size_t)b * mstride + col); }
            if (HAS_KV) { K2[j] = *(const f32x4*)(gkv + col) * (*(const f32x4*)(sckv + (size_t)b * kvstride + col) + 1.0f); K3[j] = *(const f32x4*)(shkv + (size_t)b * kvstride + col); }
        }
        for (int r = 0; r < 16; r += 2) {
            const size_t m = (size_t)blk * 16 + r;
            f32x4 xa[4], xb[4]; v2u ya[4], yb[4];
#pragma unroll
            for (int j = 0; j < 4; ++j) {
                if (XIN_BF) { const v2u w0 = __builtin_nontemporal_load((const v2u*)((const bf16*)xin_ + m * D + 256 * j + 4 * F.lane)), w1 = __builtin_nontemporal_load((const v2u*)((const bf16*)xin_ + (m + 1) * D + 256 * j + 4 * F.lane));
                    xa[j] = (f32x4){bf_lo(w0.x), bf_hi(w0.x), bf_lo(w0.y), bf_hi(w0.y)}; xb[j] = (f32x4){bf_lo(w1.x), bf_hi(w1.x), bf_lo(w1.y), bf_hi(w1.y)}; }
                else { xa[j] = __builtin_nontemporal_load((const f32x4*)((const float*)xin_ + m * D + 256 * j + 4 * F.lane)); xb[j] = __builtin_nontemporal_load((const f32x4*)((const float*)xin_ + (m + 1) * D + 256 * j + 4 * F.lane)); }
                if (HAS_Y) { ya[j] = __builtin_nontemporal_load((const v2u*)(Y + m * D + 256 * j + 4 * F.lane)); yb[j] = __builtin_nontemporal_load((const v2u*)(Y + (m + 1) * D + 256 * j + 4 * F.lane)); } }
#define NORM_ROW(xv, yw, mm) do { \
            if (HAS_Y) { f32x4 yv[4]; float s = 0.f; \
                _Pragma("unroll") for (int j = 0; j < 4; ++j) { const v2u w = yw[j]; yv[j] = (f32x4){bf_lo(w.x), bf_hi(w.x), bf_lo(w.y), bf_hi(w.y)}; \
                    s += (yv[j].x * yv[j].x + yv[j].y * yv[j].y) + (yv[j].z * yv[j].z + yv[j].w * yv[j].w); } \
                const float rstd = 1.0f / sqrtf(wave_sum(s) * (1.0f / D) + EPS); \
                _Pragma("unroll") for (int j = 0; j < 4; ++j) { xv[j] = xv[j] + A1[j] * (yv[j] * rstd); \
                    if (XOUT_BF) { v2u w; w.x = pk2(xv[j].x, xv[j].y); w.y = pk2(xv[j].z, xv[j].w); __builtin_nontemporal_store(w, (v2u*)((bf16*)xout_ + (mm) * D + 256 * j + 4 * F.lane)); } \
                    else __builtin_nontemporal_store(xv[j], (f32x4*)((float*)xout_ + (mm) * D + 256 * j + 4 * F.lane)); } } \
            if (HAS_H || HAS_KV) { float s = 0.f; \
                _Pragma("unroll") for (int j = 0; j < 4; ++j) s += (xv[j].x * xv[j].x + xv[j].y * xv[j].y) + (xv[j].z * xv[j].z + xv[j].w * xv[j].w); \
                const float rstd = 1.0f / sqrtf(wave_sum(s) * (1.0f / D) + EPS); \
                _Pragma("unroll") for (int j = 0; j < 4; ++j) { const f32x4 xn = xv[j] * rstd; \
                    if (HAS_H) { const f32x4 h = xn * A2[j] + A3[j]; v2u w; w.x = pk2(h.x, h.y); w.y = pk2(h.z, h.w); *(v2u*)(H + (mm) * D + 256 * j + 4 * F.lane) = w; } \
                    if (HAS_KV) { const f32x4 h = xn * K2[j] + K3[j]; v2u w; w.x = pk2(h.x, h.y); w.y = pk2(h.z, h.w); *(v2u*)(HKV + (mm) * D + 256 * j + 4 * F.lane) = w; } } } } while (0)
            NORM_ROW(xa, ya, m);
            NORM_ROW(xb, yb, m + 1);
#undef NORM_ROW
        }
    }
}

__device__ __forceinline__ void cmp2_phase(const Frame& F, const float* PART, const float* cb1, const float* w2, const float* b2, bf16* KCV) {
    LAS float* w2l = (LAS float*)(F.lds + RING_OFF);
    LAS float* hl = (LAS float*)(F.lds + RING_OFF + 65536) + F.wave * 256;
    const int grp = F.vcu / GRP_WGS, lc = F.vcu % GRP_WGS, half = GRP_WGS / 2, j = lc / half, vj = lc % half;
    PART += (size_t)grp * (8u << 20) / 4;
    if (j < 2) {
        for (int i = F.tid; i < 256 * 64 / 4; i += NWAVES * 64) *(LAS f32x4*)(w2l + 4 * i) = *(const f32x4*)(w2 + (size_t)j * 256 * 64 + 4 * i);
    }
    __syncthreads();
    if (j < 2) {
        for (int rl = vj * NWAVES + F.wave; rl < 1024; rl += half * NWAVES) { const int r = grp * 1024 + rl;
            const float* p0 = PART + ((size_t)(j * 2 + 0) * 1024 + rl) * 256; const float* p1 = PART + ((size_t)(j * 2 + 1) * 1024 + rl) * 256;
            const f32x4 a = *(const f32x4*)(p0 + 4 * F.lane), b = *(const f32x4*)(p1 + 4 * F.lane), c = *(const f32x4*)(cb1 + j * 256 + 4 * F.lane);
            f32x4 h = a + b + c; h.x = pg8::gelu_tanh(h.x); h.y = pg8::gelu_tanh(h.y); h.z = pg8::gelu_tanh(h.z); h.w = pg8::gelu_tanh(h.w);
            *(LAS f32x4*)(hl + 4 * F.lane) = h;
            LDS_WAIT();
            float s0 = b2[j * 64 + F.lane], s1 = 0.f, s2 = 0.f, s3 = 0.f;
#pragma unroll 8
            for (int hh = 0; hh < 256; hh += 4) { const f32x4 h4 = *(const LAS f32x4*)(hl + hh);
                s0 += h4.x * w2l[hh * 64 + F.lane]; s1 += h4.y * w2l[(hh + 1) * 64 + F.lane]; s2 += h4.z * w2l[(hh + 2) * 64 + F.lane]; s3 += h4.w * w2l[(hh + 3) * 64 + F.lane]; }
            float s = (s0 + s1) + (s2 + s3);
            if ((r & 127) == 127) s = 0.f;
            KCV[((size_t)j * 8192 + r) * 64 + F.lane] = (bf16)f2bf(s);
            LDS_WAIT();
        }
    }
    __syncthreads();
}

namespace nsa {
using bf16x8 = __attribute__((ext_vector_type(8))) short;
using s16x4 = __attribute__((ext_vector_type(4))) short;
using f32x16 = __attribute__((ext_vector_type(16))) float;
using u32x4 = __attribute__((ext_vector_type(4))) unsigned;
typedef __attribute__((address_space(3))) const char* lds_cptr;
typedef __attribute__((address_space(3))) char* lds_ptr;
constexpr int NSLOT = 3, SLOTB = 8192;
constexpr int LDS_K = 0, LDS_V = NSLOT * SLOTB, LDS_WS = 2 * NSLOT * SLOTB  , LDS_OST = LDS_WS + 8 * 512  ,
              LDS_PI = LDS_OST + 8 * 4096  , LDS_IMP = LDS_PI + 32768  , LDS_SELM = LDS_IMP + 8192  , LDS_END = LDS_SELM + 256;
static_assert(LDS_END <= 131072, "attention LDS map");
constexpr int THR = 8;
__device__ __forceinline__ int crow(int r, int hi) { return (r & 3) + 8 * (r >> 2) + 4 * hi; }
#define NSA_SBAR() __builtin_amdgcn_sched_barrier(0)
__device__ __forceinline__ void glds16(const void* gsrc, unsigned lds_dst) { unsigned keep;
    asm volatile("s_mov_b32 %0, m0\n\ts_mov_b32 m0, %2\n\ts_nop 0\n\tglobal_load_lds_dwordx4 %1, off\n\ts_mov_b32 m0, %0" : "=&s"(keep) : "v"(gsrc), "s"(lds_dst) : "memory"); }
typedef float f32x2_t __attribute__((ext_vector_type(2))); typedef __bf16 bf16x2_t __attribute__((ext_vector_type(2)));
__device__ __forceinline__ unsigned cvtpk_s(float lo, float hi) { f32x2_t v = {lo, hi}; bf16x2_t b = __builtin_convertvector(v, bf16x2_t); return __builtin_bit_cast(unsigned, b); }
#define NSA_WAIT_BAR(N) asm volatile("s_waitcnt vmcnt(" #N ") lgkmcnt(0)\n\ts_barrier" ::: "memory")

__device__ __forceinline__ void qkt(f32x16& p0, f32x16& p1, lds_cptr Kslot, const bf16x8* qr, const f32x16& cinit, int r32, int hi) {
    lds_cptr kb = Kslot + hi * 1024 + r32 * 16;
#pragma unroll
    for (int d0 = 0; d0 < 4; ++d0) {
        const bf16x8 b0 = *(const __attribute__((address_space(3))) bf16x8*)(kb + d0 * 2048);
        const bf16x8 b1 = *(const __attribute__((address_space(3))) bf16x8*)(kb + d0 * 2048 + 512);
        if (d0 == 0) { p0 = __builtin_amdgcn_mfma_f32_32x32x16_bf16(b0, qr[0], cinit, 0, 0, 0); p1 = __builtin_amdgcn_mfma_f32_32x32x16_bf16(b1, qr[0], cinit, 0, 0, 0); }
        else { p0 = __builtin_amdgcn_mfma_f32_32x32x16_bf16(b0, qr[d0], p0, 0, 0, 0); p1 = __builtin_amdgcn_mfma_f32_32x32x16_bf16(b1, qr[d0], p1, 0, 0, 0); } }
}
__device__ __forceinline__ float rowmax(const f32x16& p0, const f32x16& p1) {
    float a = fmaxf(fmaxf(p0[0], p0[1]), p1[0]), b = fmaxf(fmaxf(p0[2], p0[3]), p1[1]); a = fmaxf(fmaxf(a, p1[2]), p1[3]);
#pragma unroll
    for (int r = 4; r < 16; r += 4) { a = fmaxf(fmaxf(a, p0[r]), p0[r + 1]); b = fmaxf(fmaxf(b, p0[r + 2]), p0[r + 3]); a = fmaxf(fmaxf(a, p1[r]), p1[r + 1]); b = fmaxf(fmaxf(b, p1[r + 2]), p1[r + 3]); }
    const float m = fmaxf(a, b);
    auto rr = __builtin_amdgcn_permlane32_swap(__float_as_uint(m), __float_as_uint(m), false, false);
    return fmaxf(__uint_as_float(rr[0]), __uint_as_float(rr[1]));
}
__device__ __forceinline__ float xhalf_sum(float v) { auto rr = __builtin_amdgcn_permlane32_swap(__float_as_uint(v), __float_as_uint(v), false, false); return __uint_as_float(rr[0]) + __uint_as_float(rr[1]); }
__device__ __forceinline__ float xhalf_other(float v, int hi) { auto rr = __builtin_amdgcn_permlane32_swap(__float_as_uint(v), __float_as_uint(v), false, false); return hi ? __uint_as_float(rr[0]) : __uint_as_float(rr[1]); }
__device__ __forceinline__ void pv(f32x16* o, int vb, bf16x8 pa0, bf16x8 pa1, bf16x8 pa2, bf16x8 pa3) {
#pragma unroll
    for (int d0 = 0; d0 < 2; ++d0) { s16x4 lo[4], hi[4];
#pragma unroll
        for (int ks = 0; ks < 4; ++ks) {
            asm volatile("ds_read_b64_tr_b16 %0,%1 offset:%c2" : "=&v"(lo[ks]) : "v"(vb), "i"(d0 * 4096 + ks * 1024) : "memory");
            asm volatile("ds_read_b64_tr_b16 %0,%1 offset:%c2" : "=&v"(hi[ks]) : "v"(vb), "i"(d0 * 4096 + ks * 1024 + 512) : "memory"); }
        asm volatile("s_waitcnt lgkmcnt(0)" ::: "memory"); NSA_SBAR();
#define NSA_PK(k) (bf16x8){lo[k][0], lo[k][1], lo[k][2], lo[k][3], hi[k][0], hi[k][1], hi[k][2], hi[k][3]}
        o[d0] = __builtin_amdgcn_mfma_f32_32x32x16_bf16(pa0, NSA_PK(0), o[d0], 0, 0, 0);
        o[d0] = __builtin_amdgcn_mfma_f32_32x32x16_bf16(pa1, NSA_PK(1), o[d0], 0, 0, 0);
        o[d0] = __builtin_amdgcn_mfma_f32_32x32x16_bf16(pa2, NSA_PK(2), o[d0], 0, 0, 0);
        o[d0] = __builtin_amdgcn_mfma_f32_32x32x16_bf16(pa3, NSA_PK(3), o[d0], 0, 0, 0);
#undef NSA_PK
    }
}
__device__ __forceinline__ void mask_range(f32x16& p, int kb, int lo, int hi_) {
#pragma unroll
    for (int r = 0; r < 16; ++r) { const int kk = kb + (r & 3) + 8 * (r >> 2); if (kk < lo || kk > hi_) p[r] = -INFINITY; }
}
#define NSA_PACK(P0, P1) do { pw0 = (u32x4){cvtpk_s(P0[0], P0[1]), cvtpk_s(P0[2], P0[3]), cvtpk_s(P0[4], P0[5]), cvtpk_s(P0[6], P0[7])}; \
    pw1 = (u32x4){cvtpk_s(P0[8], P0[9]), cvtpk_s(P0[10], P0[11]), cvtpk_s(P0[12], P0[13]), cvtpk_s(P0[14], P0[15])}; \
    pw2 = (u32x4){cvtpk_s(P1[0], P1[1]), cvtpk_s(P1[2], P1[3]), cvtpk_s(P1[4], P1[5]), cvtpk_s(P1[6], P1[7])}; \
    pw3 = (u32x4){cvtpk_s(P1[8], P1[9]), cvtpk_s(P1[10], P1[11]), cvtpk_s(P1[12], P1[13]), cvtpk_s(P1[14], P1[15])}; } while (0)
#define NSA_PAF(k) __builtin_bit_cast(bf16x8, pw##k)

struct Tensors { const bf16* Q; const float* GATE; const bf16* KCV; const bf16* KV; bf16* O; };

__device__ __forceinline__ void stream_dma(const bf16* ksrc, const bf16* vsrc, unsigned kdst, unsigned vdst, int n, int NT1, int qt, int slot) {
    const int t_ = (n < NT1) ? n : qt - (n - NT1); const size_t off = (size_t)t_ * 64 * NKV + ((n < NT1) ? 0 : 512);
    glds16(ksrc + off, (unsigned)__builtin_amdgcn_readfirstlane(kdst + slot)); glds16(vsrc + off, (unsigned)__builtin_amdgcn_readfirstlane(vdst + slot));
}
__device__ __forceinline__ void stream_prologue(unsigned lds0, const bf16* Ksel, const bf16* Vsel, int qt, int wid, int lane) {
    const bf16* ksrc = Ksel + (size_t)lane * NKV + wid * 8;
    const bf16* vsrc = Vsel + (size_t)(16 * (wid & 3) + (lane >> 2)) * NKV + (wid >> 2) * 32 + (lane & 3) * 8;
    const unsigned kdst = lds0 + LDS_K + wid * 1024, vdst = lds0 + LDS_V + wid * 1024;
    stream_dma(ksrc, vsrc, kdst, vdst, 0, qt + 1, qt, 0); stream_dma(ksrc, vsrc, kdst, vdst, 1, qt + 1, qt, SLOTB);
}
__device__ __forceinline__ void flash_stream(lds_ptr shm, unsigned lds0, const bf16* Ksel, const bf16* Vsel, int qt, const bf16x8* qr, unsigned selmask, int tq, float g_sel, float g_win,
                                             f32x16* otot, int wid, int lane, int r32, int hi) {
    const bf16* ksrc = Ksel + (size_t)lane * NKV + wid * 8;
    const bf16* vsrc = Vsel + (size_t)(16 * (wid & 3) + (lane >> 2)) * NKV + (wid >> 2) * 32 + (lane & 3) * 8;
    const unsigned kdst = lds0 + LDS_K + wid * 1024, vdst = lds0 + LDS_V + wid * 1024;
    __attribute__((address_space(3))) float* wsf = (__attribute__((address_space(3))) float*)(shm + LDS_WS) + wid * 128;
    const int vb0 = (int)(lds0 + LDS_V) + ((lane >> 4) & 1) * 32 + (lane & 3) * 8 + (4 * hi + ((lane & 15) >> 2)) * 64;
    const int NT1 = qt + 1, NT2 = (qt < 8 ? qt + 1 : 9), NTS = NT1 + NT2;
    float mhat = 0.f, l_reg = 0.f; f32x16 o[2]; o[0] = f32x16{}; o[1] = f32x16{};
#define NSA_FINALIZE(gate_) do { const float l_ = xhalf_sum(l_reg); asm volatile("s_waitcnt lgkmcnt(0)" ::: "memory"); if (hi == 0) wsf[r32] = (gate_) / l_; asm volatile("s_waitcnt lgkmcnt(0)" ::: "memory"); \
        _Pragma("unroll") for (int r = 0; r < 16; ++r) { const float w = wsf[crow(r, hi)]; otot[0][r] += o[0][r] * w; otot[1][r] += o[1][r] * w; } } while (0)
    int sl_cur = 0;
    for (int n = 0; n < NTS; ++n) {
        if (n + 1 < NTS) NSA_WAIT_BAR(2); else NSA_WAIT_BAR(0);
        { const int sl2 = (sl_cur >= SLOTB) ? sl_cur - SLOTB : sl_cur + 2 * SLOTB; if (n + 2 < NTS) stream_dma(ksrc, vsrc, kdst, vdst, n + 2, NT1, qt, sl2); }
        if (n == NT1) { NSA_FINALIZE(g_sel); mhat = 0.f; l_reg = 0.f; o[0] = f32x16{}; o[1] = f32x16{}; }
        const bool win = n >= NT1, first = (n == 0) || (n == NT1);
        const int t = win ? qt - (n - NT1) : n;
        float cval = -mhat;
        if (!win && !((selmask >> t) & 1u)) cval = -INFINITY;
        f32x16 cin;
#pragma unroll
        for (int r = 0; r < 16; ++r) cin[r] = cval;
        f32x16 p0, p1;
        qkt(p0, p1, (lds_cptr)(shm + LDS_K + sl_cur), qr, cin, r32, hi);
        if (t == qt) { mask_range(p0, 4 * hi, 0, tq); mask_range(p1, 32 + 4 * hi, 0, tq); }
        if (win && t == qt - 8) { mask_range(p0, 4 * hi, tq + 1, 63); mask_range(p1, 32 + 4 * hi, tq + 1, 63); }
        const float rm = rowmax(p0, p1);
        bool resc = false;
        if (first || __any(rm > (float)THR)) {
            const float dl = first ? fmaxf(rm, -1e30f) : fmaxf(rm, 0.f); mhat += dl;
#pragma unroll
            for (int r = 0; r < 16; ++r) { p0[r] -= dl; p1[r] -= dl; }
            const float f = __builtin_amdgcn_exp2f(-dl); l_reg *= f; if (hi == 0) wsf[r32] = f; resc = !first;
        }
        float sacc = 0.f;
#pragma unroll
        for (int r = 0; r < 16; ++r) { p0[r] = __builtin_amdgcn_exp2f(p0[r]); p1[r] = __builtin_amdgcn_exp2f(p1[r]); sacc += p0[r] + p1[r]; }
        l_reg += sacc;
        u32x4 pw0, pw1, pw2, pw3; NSA_PACK(p0, p1);
        if (resc) { asm volatile("s_waitcnt lgkmcnt(0)" ::: "memory");
#pragma unroll
            for (int d = 0; d < 2; ++d)
#pragma unroll
                for (int r = 0; r < 16; ++r) o[d][r] *= wsf[crow(r, hi)]; }
        pv(o, vb0 + sl_cur, NSA_PAF(0), NSA_PAF(1), NSA_PAF(2), NSA_PAF(3));
        sl_cur = (sl_cur == (NSLOT - 1) * SLOTB) ? 0 : sl_cur + SLOTB;
    }
    NSA_FINALIZE(g_win);
#undef NSA_FINALIZE
    asm volatile("s_waitcnt lgkmcnt(0)\n\ts_barrier" ::: "memory");
}

__device__ __forceinline__ void attn_unit(int b, int g, int qt, const Tensors& T_, lds_ptr shm, int tid_) {
    int tid = tid_; asm volatile("" : "+v"(tid));
    const int lane = tid & 63, r32 = lane & 31, hi = lane >> 5; const int wid = __builtin_amdgcn_readfirstlane(tid >> 6);
    const int hh = wid & 3, ts = wid >> 2, tq = ts * 32 + r32;
    const size_t m0 = (size_t)b * T + (size_t)qt * 64;
    const unsigned lds0 = (unsigned)(uintptr_t)shm;
    __attribute__((address_space(3))) float* wsf = (__attribute__((address_space(3))) float*)(shm + LDS_WS) + wid * 128;
    {
        const bf16* Kc = T_.KCV + (size_t)(b * 4 + g) * 128 * 64; const bf16* Vc = Kc + (size_t)8192 * 64;
        const bf16* ksrc = Kc + (size_t)lane * 64 + wid * 8;
        const bf16* vsrc = Vc + (size_t)(16 * (wid & 3) + (lane >> 2)) * 64 + (wid >> 2) * 32 + (lane & 3) * 8;
        const unsigned kdst = lds0 + LDS_K + wid * 1024, vdst = lds0 + LDS_V + wid * 1024;
        glds16(ksrc, (unsigned)__builtin_amdgcn_readfirstlane(kdst)); glds16(vsrc, (unsigned)__builtin_amdgcn_readfirstlane(vdst));
        glds16(ksrc + 64 * 64, (unsigned)__builtin_amdgcn_readfirstlane(kdst + SLOTB)); glds16(vsrc + 64 * 64, (unsigned)__builtin_amdgcn_readfirstlane(vdst + SLOTB));
    }
    bf16x8 qr[4];
    {
        const bf16* Qw = T_.Q + (m0 + ts * 32) * 1024 + (g * 4 + hh) * 64;
#pragma unroll
        for (int d0 = 0; d0 < 4; ++d0) qr[d0] = *reinterpret_cast<const bf16x8*>(&Qw[(size_t)r32 * 1024 + d0 * 16 + hi * 8]);
    }
    const float* gp = T_.GATE + (m0 + tq) * 48 + (g * 4 + hh) * 3;
    const float g_cmp = gp[0], g_sel = gp[1], g_win = gp[2];
    f32x16 otot[2];
    NSA_WAIT_BAR(0);
    {
        const int t = qt * 64 + tq;
        const int ncv = (t >= 31) ? ((t - 31) >> 4) + 1 : 0;
        f32x16 zero = f32x16{}; f32x16 pA0, pA1, pB0, pB1;
        qkt(pA0, pA1, (lds_cptr)(shm + LDS_K), qr, zero, r32, hi);
        qkt(pB0, pB1, (lds_cptr)(shm + LDS_K + SLOTB), qr, zero, r32, hi);
        mask_range(pA0, 4 * hi, 0, ncv - 1); mask_range(pA1, 32 + 4 * hi, 0, ncv - 1); mask_range(pB0, 64 + 4 * hi, 0, ncv - 1); mask_range(pB1, 96 + 4 * hi, 0, ncv - 1);
        const float m = fmaxf(fmaxf(rowmax(pA0, pA1), rowmax(pB0, pB1)), -1e30f);
        float sacc = 0.f;
#pragma unroll
        for (int r = 0; r < 16; ++r) { pA0[r] = __builtin_amdgcn_exp2f(pA0[r] - m); pA1[r] = __builtin_amdgcn_exp2f(pA1[r] - m); pB0[r] = __builtin_amdgcn_exp2f(pB0[r] - m); pB1[r] = __builtin_amdgcn_exp2f(pB1[r] - m);
            sacc += (pA0[r] + pA1[r]) + (pB0[r] + pB1[r]); }
        const float l = xhalf_sum(sacc); const float inv = l > 0.f ? 1.0f / l : 0.f;
#pragma unroll
        for (int r = 0; r < 16; ++r) { pA0[r] *= inv; pA1[r] *= inv; pB0[r] *= inv; pB1[r] *= inv; }
        {
            __attribute__((address_space(3))) float* PI = (__attribute__((address_space(3))) float*)(shm + LDS_PI) + (hh * 64 + tq) * 32;
            float prev_oth = 0.f;
#define NSA_GRP(P, blk) _Pragma("unroll") for (int q4 = 0; q4 < 4; ++q4) { const int k = (blk) * 4 + q4; const float Gs = (P[4 * q4] + P[4 * q4 + 1]) + (P[4 * q4 + 2] + P[4 * q4 + 3]); \
                const float oth = xhalf_other(P[4 * q4 + 3], hi); PI[2 * k + hi] = Gs + (hi ? oth : prev_oth); prev_oth = oth; }
            NSA_GRP(pA0, 0) NSA_GRP(pA1, 1) NSA_GRP(pB0, 2) NSA_GRP(pB1, 3)
#undef NSA_GRP
        }
        otot[0] = f32x16{}; otot[1] = f32x16{};
        const int vb0 = (int)(lds0 + LDS_V) + ((lane >> 4) & 1) * 32 + (lane & 3) * 8 + (4 * hi + ((lane & 15) >> 2)) * 64;
        u32x4 pw0, pw1, pw2, pw3;
        NSA_PACK(pA0, pA1); pv(otot, vb0, NSA_PAF(0), NSA_PAF(1), NSA_PAF(2), NSA_PAF(3));
        NSA_PACK(pB0, pB1); pv(otot, vb0 + SLOTB, NSA_PAF(0), NSA_PAF(1), NSA_PAF(2), NSA_PAF(3));
        if (hi == 0) wsf[r32] = g_cmp;
        asm volatile("s_waitcnt lgkmcnt(0)" ::: "memory");
#pragma unroll
        for (int r = 0; r < 16; ++r) { const float w = wsf[crow(r, hi)]; otot[0][r] *= w; otot[1][r] *= w; }
    }
    asm volatile("s_waitcnt lgkmcnt(0)\n\ts_barrier" ::: "memory");
    const bf16* KVb = T_.KV + (size_t)b * T * NKV + g * 64;
    stream_prologue(lds0, KVb + 2 * 256, KVb + 3 * 256, qt, wid, lane);
    {
        const __attribute__((address_space(3))) float* PI = (const __attribute__((address_space(3))) float*)(shm + LDS_PI);
        __attribute__((address_space(3))) unsigned* IMP = (__attribute__((address_space(3))) unsigned*)(shm + LDS_IMP);
        __attribute__((address_space(3))) unsigned* SELM = (__attribute__((address_space(3))) unsigned*)(shm + LDS_SELM);
#pragma unroll
        for (int it = 0; it < 4; ++it) { const int idx = tid + it * 512, tok = idx >> 5, j = idx & 31;
            float imp = ((PI[(0 * 64 + tok) * 32 + j] + PI[(1 * 64 + tok) * 32 + j]) + PI[(2 * 64 + tok) * 32 + j]) + PI[(3 * 64 + tok) * 32 + j];
            unsigned key = (__float_as_uint(imp) & ~31u) | (unsigned)(31 - j);
            if (j > qt) key = (unsigned)(31 - j);
            if (j == 0 || j == qt || j == qt - 1) key = (__float_as_uint(1e4f) & ~31u) | (unsigned)(31 - j);
            IMP[idx] = key; }
        asm volatile("s_waitcnt lgkmcnt(0)\n\ts_barrier" ::: "memory");
#pragma unroll
        for (int it = 0; it < 4; ++it) { const int idx = tid + it * 512, tok = idx >> 5, j = idx & 31;
            const unsigned mine = IMP[idx]; int rank = 0;
#pragma unroll
            for (int i4 = 0; i4 < 8; ++i4) { const u32x4 o4 = *(const __attribute__((address_space(3))) u32x4*)(IMP + tok * 32 + i4 * 4);
                rank += (o4.x > mine) ? 1 : 0; rank += (o4.y > mine) ? 1 : 0; rank += (o4.z > mine) ? 1 : 0; rank += (o4.w > mine) ? 1 : 0; }
            const unsigned long long bal = __ballot(rank < 16 && j <= qt);
            if (lane == 0) SELM[tok] = (unsigned)bal;
            if (lane == 32) SELM[tok] = (unsigned)(bal >> 32); }
        asm volatile("s_waitcnt lgkmcnt(0)\n\ts_barrier" ::: "memory");
    }
    const unsigned selmask = ((const __attribute__((address_space(3))) unsigned*)(shm + LDS_SELM))[tq];
    flash_stream(shm, lds0, KVb + 2 * 256, KVb + 3 * 256, qt, qr, selmask, tq, g_sel, g_win, otot, wid, lane, r32, hi);
    {
        bf16* Ow = T_.O + (m0 + ts * 32) * 1024 + (g * 4 + hh) * 64;
        __attribute__((address_space(3))) bf16* stg = (__attribute__((address_space(3))) bf16*)(shm + LDS_OST) + wid * 2048;
#pragma unroll
        for (int r = 0; r < 16; ++r) { const int orow = crow(r, hi);
#pragma unroll
            for (int d0 = 0; d0 < 2; ++d0) stg[orow * 64 + d0 * 32 + r32] = (bf16)f2bf(otot[d0][r]); }
        asm volatile("s_waitcnt lgkmcnt(0)" ::: "memory");
#pragma unroll
        for (int i = 0; i < 4; ++i) { const int row = i * 8 + (lane >> 3), ch = lane & 7; const u32x4 v = *(const __attribute__((address_space(3))) u32x4*)(stg + row * 64 + ch * 8); *(u32x4*)(Ow + (size_t)row * 1024 + ch * 8) = v; }
    }
    asm volatile("s_waitcnt lgkmcnt(0)\n\ts_barrier" ::: "memory");
}

__device__ __forceinline__ void attn_phase(const Frame& F, const Tensors& T_) {
    lds_ptr shm = (lds_ptr)(F.lds + RING_OFF);
    for (int v = F.vcu; v < BATCH * 4 * 4; v += F.G) {
        const int bg = v >> 2, s = v & 3;
#pragma unroll 1
        for (int i = 0; i < 8; ++i) { const int qt = (i & 1) ? (8 * (i >> 1) + 7 - s) : (8 * (i >> 1) + s);
            attn_unit(bg >> 2, bg & 3, qt, T_, shm, F.tid); }
    }
}
#undef NSA_SBAR
#undef NSA_WAIT_BAR
#undef NSA_PACK
#undef NSA_PAF
}
namespace sgu {
using nsa::bf16x8; using nsa::s16x4; using nsa::f32x16; using nsa::u32x4;
constexpr int LDS_VT = 0  , LDS_ST = 32768  , LDS_OST = 34816  , LDS_END = LDS_OST + 8 * 4096;
__device__ __forceinline__ void sgu_phase(const Frame& F, const bf16* U, const bf16* V, const float* lng, const float* lnb, const bf16* WS16, const float* bs, bf16* GT) {
    typedef __attribute__((address_space(3))) char* lptr;
    lptr shm = (lptr)(F.lds + RING_OFF);
    __attribute__((address_space(3))) float* st = (__attribute__((address_space(3))) float*)(shm + LDS_ST);
    const unsigned lds0 = (unsigned)(uintptr_t)shm;
    for (int ch = F.vcu; ch < M / 128; ch += F.G) {
        int tid = F.tid; asm volatile("" : "+v"(tid));
        const int lane = tid & 63, r32 = lane & 31, hi = lane >> 5; const int wid = __builtin_amdgcn_readfirstlane(tid >> 6);
        const size_t m0 = (size_t)ch * 128;
#pragma unroll 1
        for (int rb = 0; rb < 16; rb += 4) {
            v4u ra[4], rc[4];
#pragma unroll
            for (int r = 0; r < 4; ++r) { const v4u* vp = (const v4u*)(V + (m0 + wid * 16 + rb + r) * D + lane * 16); ra[r] = vp[0]; rc[r] = vp[1]; }
#pragma unroll
            for (int r = 0; r < 4; ++r) { const int row = wid * 16 + rb + r; const v4u a = ra[r], b = rc[r];
                float xv[16] = {bf_lo(a.x), bf_hi(a.x), bf_lo(a.y), bf_hi(a.y), bf_lo(a.z), bf_hi(a.z), bf_lo(a.w), bf_hi(a.w), bf_lo(b.x), bf_hi(b.x), bf_lo(b.y), bf_hi(b.y), bf_lo(b.z), bf_hi(b.z), bf_lo(b.w), bf_hi(b.w)};
                float s = 0.f, q = 0.f;
#pragma unroll
                for (int e = 0; e < 16; ++e) s += xv[e];
                const float mean = wave_sum(s) * (1.0f / D);
#pragma unroll
                for (int e = 0; e < 16; ++e) { const float d = xv[e] - mean; q += d * d; }
                const float rstd = 1.0f / sqrtf(wave_sum(q) * (1.0f / D) + EPS);
                if (lane == 0) { st[row * 2] = mean; st[row * 2 + 1] = rstd; } }
        }
        asm volatile("s_waitcnt lgkmcnt(0)\n\ts_barrier" ::: "memory");
        const int srow = tid >> 2, c4 = tid & 3;
        const float mean_s = st[srow * 2], rstd_s = st[srow * 2 + 1];
        const int tb = wid >> 1, db0 = (wid & 1) * 2;
        const int nks = 2 * tb + 2;
        const int vb0 = (int)(lds0 + LDS_VT) + ((lane >> 4) & 1) * 32 + (lane & 3) * 8 + (4 * hi + ((lane & 15) >> 2)) * 64;
        v4u vnext[4];
#pragma unroll
        for (int i = 0; i < 4; ++i) vnext[i] = *(const v4u*)(V + (m0 + srow) * D + i * 32 + c4 * 8);
#pragma unroll 1
        for (int g = 0; g < 8; ++g) {
            v4u vcur[4];
#pragma unroll
            for (int i = 0; i < 4; ++i) vcur[i] = vnext[i];
            if (g + 1 < 8) {
#pragma unroll
                for (int i = 0; i < 4; ++i) vnext[i] = *(const v4u*)(V + (m0 + srow) * D + (g + 1) * 128 + i * 32 + c4 * 8); }
            v4u uvv[4];
#pragma unroll
            for (int i = 0; i < 4; ++i) uvv[i] = *(const v4u*)(U + (m0 + tb * 32 + i * 8 + (lane >> 3)) * D + g * 128 + db0 * 32 + (lane & 7) * 8);
            const bf16* wrow = WS16 + ((size_t)g * 128 + tb * 32 + r32) * 128 + 4 * hi;
            v2u af[8][2];
#pragma unroll
            for (int ks = 0; ks < 8; ++ks) if (ks < nks) { af[ks][0] = *(const v2u*)(wrow + ks * 16); af[ks][1] = *(const v2u*)(wrow + ks * 16 + 8); }
#pragma unroll
            for (int i = 0; i < 4; ++i) { const int c = g * 128 + i * 32 + c4 * 8;
                const v4u w = vcur[i];
                const f32x4 g0 = *(const f32x4*)(lng + c), g1 = *(const f32x4*)(lng + c + 4), b0 = *(const f32x4*)(lnb + c), b1 = *(const f32x4*)(lnb + c + 4);
                float x[8] = {bf_lo(w.x), bf_hi(w.x), bf_lo(w.y), bf_hi(w.y), bf_lo(w.z), bf_hi(w.z), bf_lo(w.w), bf_hi(w.w)};
                const float gg[8] = {g0.x, g0.y, g0.z, g0.w, g1.x, g1.y, g1.z, g1.w}, bb[8] = {b0.x, b0.y, b0.z, b0.w, b1.x, b1.y, b1.z, b1.w};
#pragma unroll
                for (int e = 0; e < 8; ++e) x[e] = (x[e] - mean_s) * rstd_s * gg[e] + bb[e];
                v4u o; o.x = pk2(x[0], x[1]); o.y = pk2(x[2], x[3]); o.z = pk2(x[4], x[5]); o.w = pk2(x[6], x[7]);
                *(__attribute__((address_space(3))) v4u*)(shm + LDS_VT + (i * 8 + (srow >> 4)) * 1024 + (srow & 15) * 64 + c4 * 16) = o; }
            asm volatile("s_waitcnt lgkmcnt(0)\n\ts_barrier" ::: "memory");
            f32x16 o[2]; o[0] = f32x16{}; o[1] = f32x16{};
#pragma unroll
            for (int ks = 0; ks < 8; ++ks) if (ks < nks) {
                const bf16x8 a = __builtin_bit_cast(bf16x8, (v4u){af[ks][0].x, af[ks][0].y, af[ks][1].x, af[ks][1].y});
#pragma unroll
                for (int dd = 0; dd < 2; ++dd) { s16x4 lo, hi4; const int vb = vb0 + ((db0 + dd) * 8 + ks) * 1024;
                    asm volatile("ds_read_b64_tr_b16 %0,%1" : "=&v"(lo) : "v"(vb) : "memory");
                    asm volatile("ds_read_b64_tr_b16 %0,%1 offset:512" : "=&v"(hi4) : "v"(vb) : "memory");
                    asm volatile("s_waitcnt lgkmcnt(0)" ::: "memory");
                    const bf16x8 bfr = (bf16x8){lo[0], lo[1], lo[2], lo[3], hi4[0], hi4[1], hi4[2], hi4[3]};
                    o[dd] = __builtin_amdgcn_mfma_f32_32x32x16_bf16(a, bfr, o[dd], 0, 0, 0); } }
            __attribute__((address_space(3))) bf16* stg = (__attribute__((address_space(3))) bf16*)(shm + LDS_OST) + wid * 2048;
#pragma unroll
            for (int r = 0; r < 16; ++r) { const int orow = nsa::crow(r, hi); const float bias = bs[g * 128 + tb * 32 + orow];
#pragma unroll
                for (int dd = 0; dd < 2; ++dd) stg[orow * 64 + dd * 32 + r32] = (bf16)f2bf(o[dd][r] + bias); }
            asm volatile("s_waitcnt lgkmcnt(0)" ::: "memory");
#pragma unroll
            for (int i = 0; i < 4; ++i) { const int row = i * 8 + (lane >> 3), chn = lane & 7;
                const v4u mv = *(const __attribute__((address_space(3))) v4u*)(stg + row * 64 + chn * 8);
                const size_t gi = (m0 + tb * 32 + row) * D + g * 128 + db0 * 32 + chn * 8;
                const v4u uv = uvv[i];
                v4u ov; ov.x = pk2(bf_lo(mv.x) * bf_lo(uv.x), bf_hi(mv.x) * bf_hi(uv.x)); ov.y = pk2(bf_lo(mv.y) * bf_lo(uv.y), bf_hi(mv.y) * bf_hi(uv.y));
                ov.z = pk2(bf_lo(mv.z) * bf_lo(uv.z), bf_hi(mv.z) * bf_hi(uv.z)); ov.w = pk2(bf_lo(mv.w) * bf_lo(uv.w), bf_hi(mv.w) * bf_hi(uv.w));
                *(v4u*)(GT + gi) = ov; }
            asm volatile("s_waitcnt lgkmcnt(0)\n\ts_barrier" ::: "memory");
        }
    }
}
}
__global__ void __launch_bounds__(NWAVES * 64, 2) fwd(Args args) {
    extern __shared__ __attribute__((aligned(16))) unsigned char lds[];
    Frame F;
    F.lds = (LAS unsigned char*)lds;
    volatile LAS unsigned* MISC = (volatile LAS unsigned*)(F.lds + MISC_OFF);
    F.tid = threadIdx.x; F.lane = F.tid & 63; F.wave = __builtin_amdgcn_readfirstlane(F.tid >> 6);
    F.G = gridDim.x; { const int bx = blockIdx.x; F.vcu = (F.G % 8 == 0) ? (bx % 8) * (F.G / 8) + bx / 8 : bx; }
    for (int u = F.tid; u < (LDS_BYTES - LDSCTL_OFF) / 4; u += NWAVES * 64) ((LAS unsigned*)(F.lds + LDSCTL_OFF))[u] = 0u;
    __syncthreads();
#if !MK_MULTI
    XcdBarrier bar = xcd_barrier_post((unsigned*)(args.ws + WS_CTL) + CW_BAR, MISC + 8);
    if (threadIdx.x == 0) (void)__hip_atomic_fetch_or((unsigned*)(args.ws + WS_CTL) + CW_GRP + 64 * (F.vcu / GRP_WGS) + 32, 1u << bar.x, RLX_AGENT);
#define GRID_BAR() xcd_barrier(bar)
#define GRP_BAR() grp_barrier((unsigned*)(ws + WS_CTL) + CW_GRP + 64 * grp, (unsigned*)(ws + WS_CTL) + CW_BAR)
#else
#define GRID_BAR() do {} while (0)
#define GRP_BAR() do {} while (0)
#endif
    const int lo = args.ph_lo, hi = args.ph_hi;
    int ph = 0;
#define PH_BEGIN if (ph >= lo && ph < hi) { Frame Fp = F; asm volatile("" : "+v"(Fp.tid), "+v"(Fp.lane)); \
        kargs_t KA = (kargs_t)__builtin_amdgcn_kernarg_segment_ptr(); asm volatile("" : "+s"(KA)); \
        unsigned char* const ws = KA->ws; LAS unsigned char* const ring = Fp.lds + RING_OFF; const int grp = Fp.vcu / GRP_WGS, lc = Fp.vcu % GRP_WGS; const size_t R0 = (size_t)grp * GROWS; (void)ws; (void)ring; (void)lc; (void)R0;
#define PH_END   if (ph + 1 < hi) GRP_BAR(); } ++ph;
#define PH_END_GRID   if (ph + 1 < hi) GRID_BAR(); } ++ph;
#define P_MOD   ((float*)(ws + WS_MOD))
#define P_KVMOD (P_MOD + (size_t)4 * 16 * 6144)
#define P_CB1   ((float*)(ws + WS_CB1))
#define P_GATE  ((float*)(ws + WS_GATE))
#define P_KCV   ((bf16*)(ws + WS_KCV))
#define P_WB    ((bf16*)(ws + WS_W))
#define P_KV    ((bf16*)(ws + WS_KV))
#define P_XB    ((bf16*)(ws + WS_HB))
#define P_Y     ((bf16*)(ws + WS_Y))
#define P_HB    ((bf16*)KA->out + (size_t)grp * (4u << 20))
#define P_BIGW  ((bf16*)(ws + WS_BIG) + (size_t)grp * (8u << 20))
#define P_U     ((bf16*)(ws + WS_BIG) + (size_t)grp * (4u << 20))
#define P_V     (P_U + (4u << 20))
#define P_Q     P_U
#define P_O     P_V
#define P_HKV   P_O
#define P_NG(L, i) (KA->in[4] + ((L) * 4 + (i)) * 1024)

    PH_BEGIN p0_prologue(Fp, KA); PH_END_GRID
#if !MK_MULTI
    if (lo == 0) {
        const int g_ = F.vcu / GRP_WGS, first = (int)((long)N_LATE * (g_ * (g_ - 1) / 2) / 28), end = (int)((long)N_LATE * ((g_ + 1) * g_ / 2) / 28);
        if (end > first) {
            Frame Fp = F; asm volatile("" : "+v"(Fp.tid), "+v"(Fp.lane));
            kargs_t KA = (kargs_t)__builtin_amdgcn_kernarg_segment_ptr(); asm volatile("" : "+s"(KA));
            late_convert(Fp, KA, first, end - first, (F.vcu % GRP_WGS) * NWAVES + F.wave, GRP_WGS * NWAVES);
            asm volatile("s_waitcnt vmcnt(0)" ::: "memory");
            __syncthreads();
            if (threadIdx.x == 0) { __builtin_amdgcn_fence(__ATOMIC_RELEASE, "agent"); asm volatile("s_waitcnt vmcnt(0)" ::: "memory"); (void)xb_add((unsigned*)(KA->ws + WS_CTL) + CW_LATE, 1u); }
        }
#if GRP_STAGGER_TICKS > 0
        { const unsigned long long t0 = __builtin_amdgcn_s_memrealtime(); const unsigned long long dt = (unsigned long long)g_ * GRP_STAGGER_TICKS;
          while (__builtin_amdgcn_s_memrealtime() - t0 < dt) __builtin_amdgcn_s_sleep(8); }
#endif
    }
#endif
    PH_BEGIN norm_phase<false, true, false, false, false>(Fp, KA->in[0], nullptr, nullptr, nullptr, nullptr, P_NG(0, 0), P_MOD + 0, P_MOD + 1024, 6144, P_HB, nullptr, nullptr, nullptr, 0, nullptr); PH_END

#pragma unroll 1
    for (int L = 0; L < DEPTH; ++L) {
#if !MK_MULTI
        if (L == 1) {
            if (threadIdx.x == 0) { unsigned* ctl = (unsigned*)(args.ws + WS_CTL); XB_SPIN(xb_ld(ctl + CW_LATE) < (unsigned)((NGRP - 1) * GRP_WGS), ctl + CW_BAR);
                __builtin_amdgcn_fence(__ATOMIC_ACQUIRE, "agent"); asm volatile("s_waitcnt vmcnt(0)" ::: "memory"); }
            __syncthreads();
        }
#endif
        if (L < 2) {
            PH_BEGIN {
                pg8::Gemm g = pg8::make_gemm(P_HB + R0 * D, P_WB + WO_AIN + (size_t)L * 2048 * 1024, GROWS, 2048, D); pg8::GroupOrder S; S.init(GROWS, 2048, GRP_WGS, lc);
                pg8::EpiBf16<2> E{P_U + R0 * D, D, nullptr, 1024, (size_t)(4u << 20), 1.f};
                pg8::gemm_phase<pg8::EpiBf16<2>, pg8::GroupOrder, true, true>(ring, g, S, E);
            } PH_END
            PH_BEGIN sgu::sgu_phase(Fp, P_U, P_V, KA->in[6] + L * 1024, KA->in[7] + L * 1024, P_WB + WO_WS + (size_t)L * 8 * 128 * 128, KA->in[9] + L * 8 * 128, P_HB); PH_END
            PH_BEGIN {
                pg8::Gemm g = pg8::make_gemm(P_HB + R0 * D, P_WB + WO_AOUT + (size_t)L * 1024 * 1024, GROWS, D, D); pg8::GroupOrder S; S.init(GROWS, D, GRP_WGS, lc);
                pg8::EpiBf16<0> E{P_Y + R0 * D, D, nullptr, 0, 0, 1.f};
                pg8::gemm_phase<pg8::EpiBf16<0>, pg8::GroupOrder, true, true>(ring, g, S, E);
            } PH_END
        } else {
            if (L == 2) {
                PH_BEGIN {
                    pg8::Gemm g = pg8::make_gemm(P_HKV + R0 * D, P_WB + WO_KV, GROWS, NKV, D); pg8::GroupOrder S; S.init(GROWS, NKV, GRP_WGS, lc);
                    pg8::EpiBf16<0> E{P_KV + R0 * NKV, NKV, nullptr, 0, 0, 1.f};
                    pg8::gemm_phase<pg8::EpiBf16<0>, pg8::GroupOrder, true, true>(ring, g, S, E);
                } PH_END
            }
            PH_BEGIN {
                {
                    pg8::Gemm g = pg8::make_gemm(P_HB + R0 * D, P_WB + WO_BIN + (size_t)(L - 2) * NQG * 1024, GROWS, NQG, D); pg8::GroupOrder S; S.init(GROWS, NQG, GRP_WGS, lc);
                    pg8::EpiQG E{P_Q + R0 * D, P_GATE + R0 * 48, 0.125f * 1.4426950408889634f};
                    pg8::gemm_phase<pg8::EpiQG, pg8::GroupOrder, true, true>(ring, g, S, E);
                }
                if (L == 2) {
#pragma unroll 1
                    for (int q = 0; q < 4; ++q) { const int j = q >> 1, kh = q & 1;
                        pg8::Gemm g; g.A = P_KV + (size_t)(2 * grp) * T * NKV + j * 256 + (size_t)kh * 16 * NKV; g.Bt = P_WB + WO_C1 + (size_t)j * 256 * 2048 + kh * 1024; g.M = 1024; g.N = 256; g.K = 1024; g.ldb = 2048;
                        g.a_rs = 16u * NKV * 2u; g.a_hstep = 64 * 2; g.a_kstep = (size_t)NKV * 2; g.a_t1 = (size_t)T * NKV * 2; g.a_t0 = 128 * 2; g.a_sh = 1; g.stagger_ticks = 0;
                        pg8::GroupOrder S; S.init(1024, 256, GRP_WGS, (lc + GRP_WGS - 16 - 4 * q) % GRP_WGS);
                        pg8::EpiF32 E{(float*)(ws + WS_Y + (size_t)grp * (8u << 20)) + (size_t)q * 1024 * 256, 256};
                        pg8::gemm_phase<pg8::EpiF32, pg8::GroupOrder, true, true>(ring, g, S, E);
                    }
                }
            } PH_END
            if (L == 2) {
                PH_BEGIN cmp2_phase(Fp, (const float*)P_Y, P_CB1, KA->in[18], KA->in[19], P_KCV); PH_END
            }
            PH_BEGIN { const nsa::Tensors AT{P_Q, P_GATE, P_KCV, P_KV, P_O}; nsa::attn_phase(Fp, AT); } PH_END
            PH_BEGIN {
                pg8::Gemm g = pg8::make_gemm(P_O + R0 * D, P_WB + WO_BOUT + (size_t)(L - 2) * 1024 * 1024, GROWS, D, D); pg8::GroupOrder S; S.init(GROWS, D, GRP_WGS, lc);
                pg8::EpiBf16<0> E{P_Y + R0 * D, D, nullptr, 0, 0, 1.f};
                pg8::gemm_phase<pg8::EpiBf16<0>, pg8::GroupOrder, true, true>(ring, g, S, E);
            } PH_END
        }
        PH_BEGIN { const float* modL = P_MOD + (size_t)L * 16 * 6144;
            if (L == 0) norm_phase<true, true, false, false, true>(Fp, KA->in[0], P_XB, P_Y, P_NG(L, 1), modL + 2 * 1024, P_NG(L, 2), modL + 3 * 1024, modL + 4 * 1024, 6144, P_HB, nullptr, nullptr, nullptr, 0, nullptr);
            else norm_phase<true, true, false, true, true>(Fp, P_XB, P_XB, P_Y, P_NG(L, 1), modL + 2 * 1024, P_NG(L, 2), modL + 3 * 1024, modL + 4 * 1024, 6144, P_HB, nullptr, nullptr, nullptr, 0, nullptr); } PH_END
#pragma unroll 1
        for (int hf = 0; hf < 2; ++hf) {
            PH_BEGIN {
                pg8::Gemm g = pg8::make_gemm(P_HB + (R0 + (size_t)hf * T) * D, P_WB + WO_FIN + (size_t)L * 4096 * 1024, T, FF, D); pg8::GroupOrder S; S.init(T, FF, GRP_WGS, lc);
                pg8::EpiBf16<3> E{P_BIGW, FF, nullptr, 0, 0, 1.f};
                pg8::gemm_phase<pg8::EpiBf16<3>, pg8::GroupOrder, true, true>(ring, g, S, E);
            } PH_END
            PH_BEGIN {
                pg8::Gemm g = pg8::make_gemm(P_BIGW, P_WB + WO_FOUT + (size_t)L * 1024 * 4096, T, D, FF); pg8::GroupOrder S; S.init(T, D, GRP_WGS, lc);
                pg8::EpiBf16<0> E{P_Y + (R0 + (size_t)hf * T) * D, D, nullptr, 0, 0, 1.f};
                pg8::gemm_phase<pg8::EpiBf16<0>, pg8::GroupOrder, true, true>(ring, g, S, E);
            } PH_END
        }
        PH_BEGIN {
            const float* modL = P_MOD + (size_t)L * 16 * 6144;
            const float* gy = P_NG(L, 3); const float* gate = modL + 5 * 1024;
            if (L == 3) norm_phase<true, false, false, true, false>(Fp, P_XB, KA->out, P_Y, gy, gate, nullptr, nullptr, nullptr, 6144, nullptr, nullptr, nullptr, nullptr, 0, nullptr);
            else { const float* modN = P_MOD + (size_t)(L + 1) * 16 * 6144; const float* gn = P_NG(L + 1, 0);
                if (L == 1) norm_phase<true, true, true, true, true>(Fp, P_XB, P_XB, P_Y, gy, gate, gn, modN + 0, modN + 1024, 6144, P_HB, KA->in[13], P_KVMOD + 0, P_KVMOD + 1024, 2048, P_HKV);
                else norm_phase<true, true, false, true, true>(Fp, P_XB, P_XB, P_Y, gy, gate, gn, modN + 0, modN + 1024, 6144, P_HB, nullptr, nullptr, nullptr, 0, nullptr); }
        } PH_END
    }
#undef PH_BEGIN
#undef PH_END
#undef PH_END_GRID
#undef GRID_BAR
#undef GRP_BAR
}

extern "C" void kernel_launch(void* const* d_in, const int* in_sizes, int n_in, void* d_out, int out_size, void* d_ws, size_t ws_size, hipStream_t stream) {
    static int grid = 0;
    if (grid == 0) {
        if (n_in != 24 || out_size != M * D || ws_size < WS_END) { fprintf(stderr, "kernel_launch: unexpected shapes (n_in %d, out %d, ws %zu)\n", n_in, out_size, ws_size); grid = -1; return; }
        int dev = 0, cus = 0, per_cu = 0;
        if (hipGetDevice(&dev) != hipSuccess || hipDeviceGetAttribute(&cus, hipDeviceAttributeMultiprocessorCount, dev) != hipSuccess) { grid = -1; return; }
        if (hipFuncSetAttribute((const void*)fwd, hipFuncAttributeMaxDynamicSharedMemorySize, LDS_BYTES) != hipSuccess) { grid = -1; return; }
        if (hipOccupancyMaxActiveBlocksPerMultiprocessor(&per_cu, (const void*)fwd, NWAVES * 64, LDS_BYTES) != hipSuccess || per_cu < 1)
            fprintf(stderr, "kernel_launch: occupancy query reports %d workgroups per CU\n", per_cu);
        (void)hipGetLastError();
        grid = cus;
        if (grid != NGRP * GRP_WGS) { fprintf(stderr, "kernel_launch: %d CUs, this build deals the work to %d workgroups\n", cus, NGRP * GRP_WGS); grid = -1; return; }
    }
    if (grid < 0) return;
    if (hipMemsetAsync((char*)d_ws + WS_CTL, 0, CTL_ZERO_BYTES, stream) != hipSuccess) return;
    Args a{};
    for (int i = 0; i < 24; ++i) a.in[i] = (const float*)d_in[i];
    a.out = (float*)d_out; a.ws = (unsigned char*)d_ws;
#if MK_MULTI
    static const int probe[] = {PROBE_PHASES, -1};
    for (int p = 0; p < 40; ++p) { a.ph_lo = p; a.ph_hi = p + 1; int n = 1; for (int k = 0; probe[k] >= 0; ++k) if (probe[k] == p) n += PROBE_REPS;
        for (int r = 0; r < n; ++r) hipLaunchKernelGGL(fwd, dim3(grid), dim3(NWAVES * 64), LDS_BYTES, stream, a); }
#else
    a.ph_lo = 0; a.ph_hi = 1000; hipLaunchKernelGGL(fwd, dim3(grid), dim3(NWAVES * 64), LDS_BYTES, stream, a);
#endif
}
```
